# Optimizing an MI355X kernel written in HIP

```python
import numpy as np
import jax
import jax.numpy as jnp
from jax import lax

D_MODEL = 1024
BATCH = 16
SEQ = 2048
DEPTH = 2

HEAD_DIM = 64
MIX_WIDTH = D_MODEL
N_GROUPS = 4
GROUP_WIDTH = MIX_WIDTH // N_GROUPS
NSA_HEADS = GROUP_WIDTH // HEAD_DIM
NSA_BRANCHES = 3
CMP_LEN = 32
CMP_STRIDE = 16
CMP_HIDDEN = 128
SLC_BLOCK = 64
SLC_TOP = 8
NSA_WINDOW = 512
CONV_K = 3
SWA_HEADS = GROUP_WIDTH // HEAD_DIM
SWA_KV_HEADS = 2
SWA_WINDOW = 128
POOL_WINDOWS = (2, 4, 8, 16)
POOL_DIM = GROUP_WIDTH // len(POOL_WINDOWS)
D_FF = 128 * ((8 * D_MODEL // 3 + 127) // 128)
Q_BLOCK = 128
EPS = 1e-6
NEG = -1e30
FORCE = 1e4
ATTN_SCALE = HEAD_DIM ** -0.5

SPLIT_SIZES = (
    NSA_HEADS * HEAD_DIM,
    HEAD_DIM, HEAD_DIM,
    HEAD_DIM, HEAD_DIM,
    HEAD_DIM, HEAD_DIM,
    NSA_HEADS * NSA_BRANCHES,
    GROUP_WIDTH, GROUP_WIDTH, GROUP_WIDTH,
    SWA_HEADS * HEAD_DIM,
    SWA_KV_HEADS * HEAD_DIM, SWA_KV_HEADS * HEAD_DIM,
    GROUP_WIDTH,
)
IN_WIDTH = sum(SPLIT_SIZES)

kernel_name = 'hymba_style_hybrid_nsa_conv_swa_pool'


def rms_norm(x, g):
    xf = x.astype(jnp.float32)
    y = xf * lax.rsqrt(jnp.mean(xf * xf, axis=-1, keepdims=True) + EPS)
    return (y * g.astype(jnp.float32)).astype(x.dtype)


def swiglu(h, w1, w3, w2):
    return (jax.nn.silu(h @ w1) * (h @ w3)) @ w2


def banded_attention(q, k, v, window, sinks=None):
    B, T, H, dh = q.shape
    G = k.shape[2]
    R = H // G
    nb = T // Q_BLOCK
    span = Q_BLOCK + window
    kp = jnp.pad(k, ((0, 0), (window, 0), (0, 0), (0, 0)))
    vp = jnp.pad(v, ((0, 0), (window, 0), (0, 0), (0, 0)))
    idx = np.arange(nb)[:, None] * Q_BLOCK + np.arange(span)[None, :]
    kb = kp[:, idx]
    vb = vp[:, idx]
    qb = q.reshape(B, nb, Q_BLOCK, G, R, dh)
    s = jnp.einsum('bnqgrd,bnkgd->bngrqk', qb, kb).astype(jnp.float32) * ATTN_SCALE
    qpos = np.arange(nb)[:, None, None] * Q_BLOCK + np.arange(Q_BLOCK)[None, :, None]
    kpos = idx[:, None, :] - window
    diff = qpos - kpos
    mask = (diff >= 0) & (diff < window) & (kpos >= 0)
    s = jnp.where(mask[None, :, None, None], s, NEG)
    if sinks is None:
        p = jax.nn.softmax(s, axis=-1)
    else:
        sink = sinks.astype(jnp.float32).reshape(1, 1, G, R, 1, 1)
        m = jnp.maximum(jnp.max(s, axis=-1, keepdims=True), sink)
        e = jnp.exp(s - m)
        p = e / (jnp.sum(e, axis=-1, keepdims=True) + jnp.exp(sink - m))
    o = jnp.einsum('bngrqk,bnkgd->bnqgrd', p.astype(v.dtype), vb)
    return o.reshape(B, T, H, dh)


def compress(kv, pos, w1, w2):
    B, T, dh = kv.shape
    n_c = (T - CMP_LEN) // CMP_STRIDE + 1
    idx = np.arange(n_c)[:, None] * CMP_STRIDE + np.arange(CMP_LEN)[None, :]
    blk = kv[:, idx] + pos.astype(kv.dtype)
    return jax.nn.gelu(blk.reshape(B, n_c, CMP_LEN * dh) @ w1) @ w2


def selected_attention(q, k, v, sel):
    B, T, H, dh = q.shape
    n = sel.shape[-1]
    kb = k.reshape(B, T // SLC_BLOCK, SLC_BLOCK, dh)
    vb = v.reshape(B, T // SLC_BLOCK, SLC_BLOCK, dh)
    gather = jax.vmap(lambda blocks, ix: blocks[ix])
    offs = jnp.arange(SLC_BLOCK)

    def one_block(i):
        t0 = i * Q_BLOCK
        qb = lax.dynamic_slice_in_dim(q, t0, Q_BLOCK, axis=1)
        ib = lax.dynamic_slice_in_dim(sel, t0, Q_BLOCK, axis=1)
        kg = gather(kb, ib)
        vg = gather(vb, ib)
        s = jnp.einsum('bqhd,bqnld->bqhnl', qb, kg).astype(jnp.float32) * ATTN_SCALE
        kpos = ib[..., None] * SLC_BLOCK + offs
        tpos = t0 + jnp.arange(Q_BLOCK)
        mask = (kpos <= tpos[None, :, None, None])[:, :, None]
        s = jnp.where(mask, s, NEG).reshape(B, Q_BLOCK, H, n * SLC_BLOCK)
        p = jax.nn.softmax(s, axis=-1).reshape(B, Q_BLOCK, H, n, SLC_BLOCK)
        return jnp.einsum('bqhnl,bqnld->bqhd', p.astype(vg.dtype), vg)

    out = lax.map(one_block, jnp.arange(T // Q_BLOCK))
    return jnp.moveaxis(out, 0, 1).reshape(B, T, H, dh)


def nsa(q, kc, vc, ks, vs, kw, vw, gates):
    B, T, H, dh = q.shape
    n_c = kc.shape[1]
    t = np.arange(T)
    s = jnp.einsum('bthd,bnd->bhtn', q, kc).astype(jnp.float32) * ATTN_SCALE
    c_valid = (np.arange(n_c)[None, :] * CMP_STRIDE + CMP_LEN - 1) <= t[:, None]
    p_cmp = jax.nn.softmax(jnp.where(c_valid, s, NEG), axis=-1) * c_valid
    o_cmp = jnp.einsum('bhtn,bnd->bthd', p_cmp.astype(vc.dtype), vc)
    n_sel = T // SLC_BLOCK
    ci = np.arange(n_c)[:, None] * CMP_STRIDE
    sj = np.arange(n_sel)[None, :] * SLC_BLOCK
    overlap = ((ci <= sj + SLC_BLOCK - 1) & (ci + CMP_LEN - 1 >= sj)).astype(np.float32)
    imp = jnp.einsum('bhtn,nj->btj', p_cmp, jnp.asarray(overlap))
    j = np.arange(n_sel)[None, :]
    cur = (t // SLC_BLOCK)[:, None]
    forced = (j == 0) | (j == cur) | (j == cur - 1)
    future = j * SLC_BLOCK > t[:, None]
    score = jnp.where(forced, FORCE, jnp.where(future, -1.0, imp))
    _, sel = lax.top_k(score, min(SLC_TOP, n_sel))
    o_slc = selected_attention(q, ks, vs, sel)
    o_win = banded_attention(q, kw[:, :, None], vw[:, :, None], NSA_WINDOW)
    return gates[..., 0:1] * o_cmp + gates[..., 1:2] * o_slc + gates[..., 2:3] * o_win


def causal_depthwise_conv(z, w):
    C = z.shape[-1]
    return lax.conv_general_dilated(
        z, w[:, None, :].astype(z.dtype), window_strides=(1,),
        padding=[(CONV_K - 1, 0)], dimension_numbers=('NWC', 'WIO', 'NWC'),
        feature_group_count=C)


def multiscale_pool(v, pool_w, pool_scale):
    B, T, _ = v.shape
    vf = v.astype(jnp.float32).reshape(B, T, len(POOL_WINDOWS), POOL_DIM)
    cs = jnp.cumsum(vf, axis=1)
    outs = []
    for g, w in enumerate(POOL_WINDOWS):
        c = cs[:, :, g]
        prev = jnp.pad(c, ((0, 0), (w, 0), (0, 0)))[:, :T]
        cnt = jnp.minimum(jnp.arange(1, T + 1), w).astype(jnp.float32)[None, :, None]
        outs.append((c - prev) / cnt - vf[:, :, g])
    d = jnp.stack(outs, axis=2)
    d = jnp.einsum('btgc,gcd->btgd', d, pool_w.astype(jnp.float32)).reshape(B, T, GROUP_WIDTH)
    return (d * pool_scale.astype(jnp.float32)).astype(v.dtype)


def token_mixing(h, w_in, nsa_q_norm, nsa_kc_norm, nsa_ks_norm, nsa_kw_norm,
                 cmp_pos_k, cmp_w1_k, cmp_w2_k, cmp_pos_v, cmp_w1_v, cmp_w2_v,
                 conv_w, swa_q_norm, swa_k_norm, swa_sinks, pool_w, pool_scale,
                 group_norm, w_out):
    B, T, _ = h.shape
    u = h @ w_in
    points = [int(p) for p in np.cumsum(SPLIT_SIZES)[:-1]]
    (a_q, a_kc, a_vc, a_ks, a_vs, a_kw, a_vw, a_g,
     b_b, b_c, b_x, c_q, c_k, c_v, d_v) = jnp.split(u, points, axis=-1)
    q = rms_norm(a_q.reshape(B, T, NSA_HEADS, HEAD_DIM), nsa_q_norm)
    kc = rms_norm(compress(a_kc, cmp_pos_k, cmp_w1_k, cmp_w2_k), nsa_kc_norm)
    vc = compress(a_vc, cmp_pos_v, cmp_w1_v, cmp_w2_v)
    ks = rms_norm(a_ks, nsa_ks_norm)
    kw = rms_norm(a_kw, nsa_kw_norm)
    gates = jax.nn.sigmoid(a_g.reshape(B, T, NSA_HEADS, NSA_BRANCHES))
    o_a = nsa(q, kc, vc, ks, a_vs, kw, a_vw, gates)
    o_b = b_b * causal_depthwise_conv(b_c * b_x, conv_w)
    cq = rms_norm(c_q.reshape(B, T, SWA_HEADS, HEAD_DIM), swa_q_norm)
    ck = rms_norm(c_k.reshape(B, T, SWA_KV_HEADS, HEAD_DIM), swa_k_norm)
    cv = c_v.reshape(B, T, SWA_KV_HEADS, HEAD_DIM)
    o_c = banded_attention(cq, ck, cv, SWA_WINDOW, swa_sinks)
    o_d = multiscale_pool(d_v, pool_w, pool_scale)
    y = jnp.concatenate([o_a.reshape(B, T, GROUP_WIDTH), o_b,
                         o_c.reshape(B, T, GROUP_WIDTH), o_d], axis=-1)
    y = rms_norm(y.reshape(B, T, N_GROUPS, GROUP_WIDTH),
                 group_norm.reshape(N_GROUPS, GROUP_WIDTH)).reshape(B, T, MIX_WIDTH)
    return y @ w_out


def setup_inputs(seed: int = 0) -> dict:
    key = jax.random.key(seed)
    keys = iter(jax.random.split(key, 40))
    L, D = DEPTH, D_MODEL

    def nrm(shape, scale):
        return scale * jax.random.normal(next(keys), shape, jnp.float32)

    def gain(shape):
        return 1.0 + nrm(shape, 0.1)

    return {
        'x': nrm((BATCH, SEQ, D), 1.0),
        'ffn1_norm': gain((L, D)),
        'ffn1_w1': nrm((L, D, D_FF), D ** -0.5),
        'ffn1_w3': nrm((L, D, D_FF), D ** -0.5),
        'ffn1_w2': nrm((L, D_FF, D), D_FF ** -0.5),
        'mix_norm': gain((L, D)),
        'w_in': nrm((L, D, IN_WIDTH), D ** -0.5),
        'nsa_q_norm': gain((L, HEAD_DIM)),
        'nsa_kc_norm': gain((L, HEAD_DIM)),
        'nsa_ks_norm': gain((L, HEAD_DIM)),
        'nsa_kw_norm': gain((L, HEAD_DIM)),
        'cmp_pos_k': nrm((L, CMP_LEN, HEAD_DIM), 0.1),
        'cmp_w1_k': nrm((L, CMP_LEN * HEAD_DIM, CMP_HIDDEN), (CMP_LEN * HEAD_DIM) ** -0.5),
        'cmp_w2_k': nrm((L, CMP_HIDDEN, HEAD_DIM), CMP_HIDDEN ** -0.5),
        'cmp_pos_v': nrm((L, CMP_LEN, HEAD_DIM), 0.1),
        'cmp_w1_v': nrm((L, CMP_LEN * HEAD_DIM, CMP_HIDDEN), (CMP_LEN * HEAD_DIM) ** -0.5),
        'cmp_w2_v': nrm((L, CMP_HIDDEN, HEAD_DIM), CMP_HIDDEN ** -0.5),
        'conv_w': nrm((L, CONV_K, GROUP_WIDTH), CONV_K ** -0.5),
        'swa_q_norm': gain((L, HEAD_DIM)),
        'swa_k_norm': gain((L, HEAD_DIM)),
        'swa_sinks': nrm((L, SWA_HEADS), 0.5),
        'pool_w': nrm((L, len(POOL_WINDOWS), POOL_DIM, POOL_DIM), POOL_DIM ** -0.5),
        'pool_scale': gain((L, GROUP_WIDTH)),
        'group_norm': gain((L, MIX_WIDTH)),
        'w_out': nrm((L, MIX_WIDTH, D), MIX_WIDTH ** -0.5),
        'ffn2_norm': gain((L, D)),
        'ffn2_w1': nrm((L, D, D_FF), D ** -0.5),
        'ffn2_w3': nrm((L, D, D_FF), D ** -0.5),
        'ffn2_w2': nrm((L, D_FF, D), D_FF ** -0.5),
    }


def reference(x, ffn1_norm, ffn1_w1, ffn1_w3, ffn1_w2, mix_norm, w_in,
              nsa_q_norm, nsa_kc_norm, nsa_ks_norm, nsa_kw_norm,
              cmp_pos_k, cmp_w1_k, cmp_w2_k, cmp_pos_v, cmp_w1_v, cmp_w2_v,
              conv_w, swa_q_norm, swa_k_norm, swa_sinks, pool_w, pool_scale,
              group_norm, w_out, ffn2_norm, ffn2_w1, ffn2_w3, ffn2_w2):
    for l in range(DEPTH):
        h = rms_norm(x, ffn1_norm[l])
        x = x + 0.5 * swiglu(h, ffn1_w1[l], ffn1_w3[l], ffn1_w2[l])
        h = rms_norm(x, mix_norm[l])
        x = x + token_mixing(h, w_in[l], nsa_q_norm[l], nsa_kc_norm[l], nsa_ks_norm[l],
                             nsa_kw_norm[l], cmp_pos_k[l], cmp_w1_k[l], cmp_w2_k[l],
                             cmp_pos_v[l], cmp_w1_v[l], cmp_w2_v[l], conv_w[l],
                             swa_q_norm[l], swa_k_norm[l], swa_sinks[l], pool_w[l],
                             pool_scale[l], group_norm[l], w_out[l])
        h = rms_norm(x, ffn2_norm[l])
        x = x + 0.5 * swiglu(h, ffn2_w1[l], ffn2_w3[l], ffn2_w2[l])
    return x
```

```cpp
#include <hip/hip_runtime.h>
#include <cstdio>
#include <cstdint>
struct KArgs { const float* in[29]; float* out; unsigned char* ws; };
namespace pg8 {
#define PG8_LAS __attribute__((address_space(3)))
typedef unsigned short bf16_t;
typedef short bf16x8 __attribute__((ext_vector_type(8)));
typedef float f32x4 __attribute__((ext_vector_type(4)));
typedef unsigned u32x4 __attribute__((ext_vector_type(4)));
constexpr int BM = 256, BK = 64, HALF = 128, HTB = HALF * BK * 2  , STAGE_BYTES = 8 * HTB, NXCD = 8, WGM = 8;

__host__ __device__ __forceinline__ int lds_byte(int r, int c) { const int st = (r >> 4) * 2 + (c >> 5), rr = r & 15, cc = c & 31, ob = rr * 64 + cc * 2; return st * 1024 + (ob ^ (((ob >> 9) & 1) << 5)); }
__host__ __device__ __forceinline__ void stage_rc(int b, int& R, int& C) { const int st = b / 1024, sb = b % 1024, swz = sb ^ (((sb >> 9) & 1) << 5); R = (st >> 1) * 16 + swz / 64; C = (st & 1) * 32 + (swz % 64) / 2; }
__host__ __device__ __forceinline__ int perm32(int rho) { const int n = rho >> 4, i = rho & 15; return 8 * (i >> 2) + 4 * n + (i & 3); }

struct Unit { int pm, pn; };
struct Gemm { const bf16_t* A; const bf16_t* Bt; int M, N, K; };

struct StaticOrder {
    int nM, nN, nwg, G, c;
    __host__ __device__ void init(int M, int N, int G_, int c_) { nM = M / BM; nN = N / BM; nwg = nM * nN; G = G_; c = c_; }
    __host__ __device__ bool next(int i, Unit& u) const {
        const long L = (long)i * G + c; if (L >= nwg) return false;
        int wgid = (int)L; { const int q = nwg / NXCD, r = nwg % NXCD, xcd = wgid % NXCD, off = wgid / NXCD; wgid = (xcd < r ? xcd * (q + 1) : r * (q + 1) + (xcd - r) * q) + off; }
        const int nig = WGM * nN, gid = wgid / nig, fm = gid * WGM, gsz = (nM - fm) < WGM ? (nM - fm) : WGM;
        u.pm = fm + ((wgid % nig) % gsz); u.pn = (wgid % nig) / gsz; return true;
    }
    __device__ __forceinline__ void a_ready(const Unit&) const {}
    __device__ __forceinline__ void done(const Unit&) const {}
};

__device__ __forceinline__ unsigned cvt_pk_bf16(float lo, float hi) { unsigned r; asm volatile("v_cvt_pk_bf16_f32 %0, %1, %2" : "=v"(r) : "v"(lo), "v"(hi)); return r; }

typedef unsigned u32x2 __attribute__((ext_vector_type(2)));
typedef int i32x4 __attribute__((ext_vector_type(4)));
typedef int i32x8 __attribute__((ext_vector_type(8)));
#ifndef MFMA8_SCALE
#define MFMA8_SCALE 1
#endif
__device__ __forceinline__ i32x8 cat8(bf16x8 a, bf16x8 b) { return __builtin_shufflevector(__builtin_bit_cast(i32x4, a), __builtin_bit_cast(i32x4, b), 0, 1, 2, 3, 4, 5, 6, 7); }
__device__ __forceinline__ void mfma8(f32x4& acc, const i32x8& b, const i32x8& a, int sc) {
#if MFMA8_SCALE
    asm volatile("v_mfma_scale_f32_16x16x128_f8f6f4 %0, %1, %2, %0, %3, %3 op_sel_hi:[0,0,0]" : "+v"(acc) : "v"(b), "v"(a), "v"(sc));
#else
    asm volatile("v_mfma_f32_16x16x128_f8f6f4 %0, %1, %2, %0" : "+v"(acc) : "v"(b), "v"(a));
#endif
}
__device__ __forceinline__ unsigned pk4_fp8(float a, float b, float c, float d) { int w = 0; w = __builtin_amdgcn_cvt_pk_fp8_f32(a, b, w, false); w = __builtin_amdgcn_cvt_pk_fp8_f32(c, d, w, true); return (unsigned)w; }
__device__ __forceinline__ unsigned pkbf(float lo, float hi) { typedef float f2_t __attribute__((ext_vector_type(2))); typedef __bf16 b2_t __attribute__((ext_vector_type(2))); f2_t v = {lo, hi}; b2_t b = __builtin_convertvector(v, b2_t); return __builtin_bit_cast(unsigned, b); }
__device__ __forceinline__ float bf_lo(unsigned u) { return __builtin_bit_cast(float, u << 16); }
__device__ __forceinline__ float bf_hi(unsigned u) { return __builtin_bit_cast(float, u & 0xffff0000u); }
__device__ __forceinline__ float swap32_add(float v) { auto rr = __builtin_amdgcn_permlane32_swap(__float_as_uint(v), __float_as_uint(v), false, false); return __uint_as_float(rr[0]) + __uint_as_float(rr[1]); }
__device__ __forceinline__ void fill_rstd_tbl(PG8_LAS unsigned char* tblp, const float* ssq, int pm, int wid, int lane) {
    const int r = wid * 32 + (lane >> 1), hf = lane & 1; const float* p = ssq + (size_t)(pm * BM + r) * 16 + 8 * hf;
    const f32x4 a = *(const f32x4*)p, b = *(const f32x4*)(p + 4);
    float s = ((a[0] + a[1]) + (a[2] + a[3])) + ((b[0] + b[1]) + (b[2] + b[3]));
    s += __builtin_bit_cast(float, __builtin_amdgcn_update_dpp(0, __builtin_bit_cast(int, s), 0xB1, 0xf, 0xf, true));
    if (hf == 0) ((PG8_LAS float*)tblp)[r] = __builtin_amdgcn_rsqf(s * (1.0f / 1024.0f) + 1e-6f);
}
__device__ __forceinline__ void rows_rstd(float (&rs)[2][4], const PG8_LAS unsigned char* tblp, int wr, int fr, float scale) {
#pragma unroll
    for (int ai = 0; ai < 2; ++ai)
#pragma unroll
        for (int m = 0; m < 4; ++m) rs[ai][m] = ((const PG8_LAS float*)tblp)[ai * HALF + wr * 64 + m * 16 + fr] * scale;
}
template <bool F8> struct EpiSwiglu {
    static constexpr bool PERM = true, AFTER_DRAIN = false, ROW_RSTD = true;
    void* O; int ldc; const float* ssq; float insc, oscale; PG8_LAS unsigned char* tbl; mutable int pmA, pmB, pmC;
    __device__ __forceinline__ void set_panels(int a, int b, int c) const { pmA = a; pmB = b; pmC = c; }
    __device__ __forceinline__ void fill_rstd(PG8_LAS unsigned char* t, int pm, int wid, int lane) const { fill_rstd_tbl(t, ssq, pm, wid, lane); }
    __device__ __forceinline__ void operator()(const f32x4 (&acc)[2][2][4][2], const Unit& u, int wr, int wc, int fr_, int fq_) const {
        int tl_ = threadIdx.x; asm volatile("" : "+v"(tl_)); const int fr = tl_ & 15, fq = (tl_ >> 4) & 3; (void)fr_; (void)fq_;
        const int row0 = u.pm * BM + wr * 64 + fr, col0 = u.pn * HALF + wc * 32 + 8 * fq;
        float rsv[2][4]; rows_rstd(rsv, tbl + (u.pm == pmA ? 0 : (u.pm == pmB ? 1024 : (u.pm == pmC ? 2048 : 3072))), wr, fr, insc);
#pragma unroll
        for (int ai = 0; ai < 2; ++ai)
#pragma unroll
            for (int m = 0; m < 4; ++m) { const int row = row0 + ai * HALF + m * 16; const float rs = rsv[ai][m], rsb = rs * (F8 ? oscale : 1.0f); f32x4 ov[2];
#pragma unroll
                for (int n = 0; n < 2; ++n) { const f32x4 a = acc[ai][0][m][n] * rs, b = acc[ai][1][m][n] * rsb, tt = a * -1.4426950408889634f; f32x4 r;
#pragma unroll
                    for (int e = 0; e < 4; ++e) r[e] = __builtin_amdgcn_rcpf(1.0f + __builtin_amdgcn_exp2f(tt[e]));
                    ov[n] = (a * b) * r; }
                const float o[8] = {ov[0][0], ov[0][1], ov[0][2], ov[0][3], ov[1][0], ov[1][1], ov[1][2], ov[1][3]};
                if constexpr (F8) { u32x2 w; w.x = pk4_fp8(o[0], o[1], o[2], o[3]); w.y = pk4_fp8(o[4], o[5], o[6], o[7]);
                    *(u32x2*)((unsigned char*)O + (size_t)row * ldc + col0) = w; }
                else { u32x4 w; w.x = pkbf(o[0], o[1]); w.y = pkbf(o[2], o[3]); w.z = pkbf(o[4], o[5]); w.w = pkbf(o[6], o[7]);
                    *(u32x4*)((bf16_t*)O + (size_t)row * ldc + col0) = w; } }
    }
};
struct EpiScaleBf16 {
    static constexpr bool PERM = true, AFTER_DRAIN = false, ROW_RSTD = true;
    bf16_t* O; int ldc; const float* ssq; PG8_LAS unsigned char* tbl; mutable int pmA, pmB, pmC;
    __device__ __forceinline__ void set_panels(int a, int b, int c) const { pmA = a; pmB = b; pmC = c; }
    __device__ __forceinline__ void fill_rstd(PG8_LAS unsigned char* t, int pm, int wid, int lane) const { fill_rstd_tbl(t, ssq, pm, wid, lane); }
    __device__ __forceinline__ void operator()(const f32x4 (&acc)[2][2][4][2], const Unit& u, int wr, int wc, int fr_, int fq_) const {
        int tl_ = threadIdx.x; asm volatile("" : "+v"(tl_)); const int fr = tl_ & 15, fq = (tl_ >> 4) & 3; (void)fr_; (void)fq_;
        const int row0 = u.pm * BM + wr * 64 + fr, col0 = u.pn * BM + wc * 32 + 8 * fq;
        float rsv[2][4]; rows_rstd(rsv, tbl + (u.pm == pmA ? 0 : (u.pm == pmB ? 1024 : (u.pm == pmC ? 2048 : 3072))), wr, fr, 1.0f);
#pragma unroll
        for (int ai = 0; ai < 2; ++ai)
#pragma unroll
            for (int m = 0; m < 4; ++m) { const int row = row0 + ai * HALF + m * 16; const float rs = rsv[ai][m];
#pragma unroll
                for (int bj = 0; bj < 2; ++bj) { const f32x4 v0 = acc[ai][bj][m][0] * rs, v1 = acc[ai][bj][m][1] * rs;
                    u32x4 w; w.x = pkbf(v0[0], v0[1]); w.y = pkbf(v0[2], v0[3]); w.z = pkbf(v1[0], v1[1]); w.w = pkbf(v1[2], v1[3]);
                    *(u32x4*)(O + (size_t)row * ldc + col0 + bj * HALF) = w; } }
    }
};
struct EpiRes {
    static constexpr bool PERM = false, AFTER_DRAIN = false, ROW_RSTD = false;
    bf16_t* xb; float* ssq; int mode; unsigned char* x8p; float* outp; int w8, fin;
    __device__ __forceinline__ void operator()(const f32x4 (&acc)[2][2][4][2], const Unit& u, int wr, int wc, int fr_, int fq_) const {
        int tl_ = threadIdx.x; asm volatile("" : "+v"(tl_)); const int fr = tl_ & 15, fq = (tl_ >> 4) & 3; (void)fr_; (void)fq_;
        const int row0 = u.pm * BM + wr * 64 + fr, col0 = u.pn * BM + wc * 32 + 4 * fq;
        int md_ = __builtin_amdgcn_readfirstlane(mode), w8_ = __builtin_amdgcn_readfirstlane(w8), fin_ = __builtin_amdgcn_readfirstlane(fin); asm volatile("" : "+s"(md_), "+s"(w8_), "+s"(fin_));
        const float alpha = md_ == 0 ? 0.5f : (md_ == 1 ? 0.5f / 256.0f : 1.0f);
        float* const outf = fin_ ? outp : nullptr; unsigned char* const x8 = w8_ ? x8p : nullptr;
#pragma unroll
        for (int ai = 0; ai < 2; ++ai) { u32x2 old[4][2][2];
#pragma unroll
            for (int m = 0; m < 4; ++m)
#pragma unroll
                for (int bj = 0; bj < 2; ++bj)
#pragma unroll
                    for (int n = 0; n < 2; ++n) old[m][bj][n] = *(const u32x2*)(xb + (size_t)(row0 + ai * HALF + m * 16) * 1024 + col0 + bj * HALF + n * 16);
            float ssv[4];
#pragma unroll
            for (int m = 0; m < 4; ++m) { const int row = row0 + ai * HALF + m * 16; const size_t off = (size_t)row * 1024 + col0; float ss = 0.f;
#pragma unroll
                for (int bj = 0; bj < 2; ++bj)
#pragma unroll
                    for (int n = 0; n < 2; ++n) { const u32x2 ow = old[m][bj][n]; const f32x4 xo = (f32x4){bf_lo(ow.x), bf_hi(ow.x), bf_lo(ow.y), bf_hi(ow.y)}; const f32x4 xn = xo + acc[ai][bj][m][n] * alpha;
                        if (outf) *(f32x4*)(outf + off + bj * HALF + n * 16) = xn;
                        else { ss += (xn[0] * xn[0] + xn[1] * xn[1]) + (xn[2] * xn[2] + xn[3] * xn[3]);
                            u32x2 w; w.x = pkbf(xn[0], xn[1]); w.y = pkbf(xn[2], xn[3]); *(u32x2*)(xb + off + bj * HALF + n * 16) = w;
                            if (x8) *(unsigned*)(x8 + off + bj * HALF + n * 16) = pk4_fp8(xn[0], xn[1], xn[2], xn[3]); } }
                ssv[m] = ss; }
            if (!outf) { float tv[4];
#pragma unroll
                for (int m = 0; m < 4; ++m) ssv[m] = swap32_add(ssv[m]);
#pragma unroll
                for (int m = 0; m < 4; ++m) tv[m] = __shfl_xor(ssv[m], 16);
#pragma unroll
                for (int m = 0; m < 4; ++m) if (fq == 0) ssq[(size_t)(row0 + ai * HALF + m * 16) * 16 + u.pn * 4 + wc] = ssv[m] + tv[m]; }
            asm volatile("" ::: "memory"); }
    }
};

struct EpiNull {
    static constexpr bool PERM = true, AFTER_DRAIN = false, ROW_RSTD = false;
    float* sink;
    __device__ __forceinline__ void operator()(const f32x4 (&acc)[2][2][4][2], const Unit& u, int wr, int wc, int fr, int fq) const {
        float s = 0.f;
#pragma unroll
        for (int ai = 0; ai < 2; ++ai)
#pragma unroll
            for (int bj = 0; bj < 2; ++bj)
#pragma unroll
                for (int m = 0; m < 4; ++m)
#pragma unroll
                    for (int n = 0; n < 2; ++n) s += acc[ai][bj][m][n][0];
        if (s == 12345.678f) sink[0] = s;
    }
};
template <int PIN> struct FixedOrder : StaticOrder {
    __device__ bool next(int i, Unit& u) const { const bool ok = StaticOrder::next(i, u); if (PIN & 1) u.pn = 0; if (PIN & 2) u.pm = (int)(blockIdx.x & 7); return ok; }
};
template <class Epi, class Sched, bool ALIGN_EPI = false, bool SP2 = false, bool FP8 = false>
__device__ __forceinline__ void gemm_phase(PG8_LAS unsigned char* lds, const Gemm g, const Sched& S, const Epi& E) {
    int tid = threadIdx.x; asm volatile("" : "+v"(tid));
    const int wid = __builtin_amdgcn_readfirstlane(tid >> 6), lane = tid & 63, wr = wid >> 2, wc = wid & 3, fr = lane & 15, fq = lane >> 4;
    const int K = g.K, nt = K / BK;
    unsigned voffA[2], voffB[2];
#pragma unroll
    for (int i = 0; i < 2; ++i) { int R, C; stage_rc(tid * 16 + i * 8192, R, C); const int Rb = Epi::PERM ? ((R & ~31) + perm32(R & 31)) : R;
        voffA[i] = (unsigned)(R * K + C) * 2u; voffB[i] = (unsigned)(Rb * K + C) * 2u; }
    const size_t kstep = (size_t)(BK * 2);
    const size_t hstep = (size_t)HALF * K * 2;
    const size_t tstep = 2 * hstep;
    const unsigned ldsw = (unsigned)wid * 1024u;
    const int aoff = lds_byte(wr * 64 + fr, fq * 8), boff = lds_byte(wc * 32 + fr, fq * 8);
#define PG8_SA(b, h) (((b) * 2 + (h)) * HTB)
#define PG8_SB(b, h) ((4 + (b) * 2 + (h)) * HTB)
#define PG8_STAGE(bufoff, gbase, voff) do { _Pragma("unroll") for (int _i = 0; _i < 2; ++_i) \
        __builtin_amdgcn_global_load_lds((const unsigned*)((const char*)(gbase) + (voff)[_i]), (PG8_LAS unsigned*)(lds + (bufoff) + ldsw + _i * 8192), 16, 0, 0); } while (0)
#define PG8_LDA(dst, b, h) do { if constexpr (FP8) { _Pragma("unroll") for (int m = 0; m < 4; ++m) dst##8[m] = cat8(*(const PG8_LAS bf16x8*)(lds + PG8_SA(b, h) + aoff + m * 2048), *(const PG8_LAS bf16x8*)(lds + PG8_SA(b, h) + aoff + m * 2048 + 1024)); } \
        else { _Pragma("unroll") for (int m = 0; m < 4; ++m) _Pragma("unroll") for (int k = 0; k < 2; ++k) dst[m][k] = *(const PG8_LAS bf16x8*)(lds + PG8_SA(b, h) + aoff + m * 2048 + k * 1024); } } while (0)
#define PG8_LDB(dst, b, h) do { if constexpr (FP8) { _Pragma("unroll") for (int n = 0; n < 2; ++n) dst##8[n] = cat8(*(const PG8_LAS bf16x8*)(lds + PG8_SB(b, h) + boff + n * 2048), *(const PG8_LAS bf16x8*)(lds + PG8_SB(b, h) + boff + n * 2048 + 1024)); } \
        else { _Pragma("unroll") for (int n = 0; n < 2; ++n) _Pragma("unroll") for (int k = 0; k < 2; ++k) dst[n][k] = *(const PG8_LAS bf16x8*)(lds + PG8_SB(b, h) + boff + n * 2048 + k * 1024); } } while (0)
#define PG8_MMA(ai, bj, At, Bt) do { __builtin_amdgcn_s_setprio(1); \
        if constexpr (FP8) { _Pragma("unroll") for (int m = 0; m < 4; ++m) _Pragma("unroll") for (int n = 0; n < 2; ++n) \
            mfma8(acc[ai][bj][m][n], Bt##8[n], At##8[m], sc8); } \
        else { _Pragma("unroll") for (int m = 0; m < 4; ++m) _Pragma("unroll") for (int n = 0; n < 2; ++n) _Pragma("unroll") for (int k = 0; k < 2; ++k) \
            acc[ai][bj][m][n] = __builtin_amdgcn_mfma_f32_16x16x32_bf16(Bt[n][k], At[m][k], acc[ai][bj][m][n], 0, 0, 0); } \
        __builtin_amdgcn_s_setprio(0); } while (0)
#define PG8_WAIT_V(n) asm volatile("s_waitcnt vmcnt(" #n ")" ::: "memory")
#define PG8_WAIT_L(n) asm volatile("s_waitcnt lgkmcnt(" #n ")" ::: "memory")
#define PG8_BAR __builtin_amdgcn_s_barrier()
#define PG8_SCHED __builtin_amdgcn_sched_barrier(0)
    Unit cur, nxt; int ui = 0;
    if (!S.next(0, cur)) return;
    if constexpr (Epi::ROW_RSTD) {
        int p0 = cur.pm, p1 = -1, p2 = -1, p3 = -1; { Unit t_; for (int n_ = 1; S.next(n_, t_); ++n_) { const int p = t_.pm; if (p != p0 && p != p1 && p != p2 && p != p3) { if (p1 < 0) p1 = p; else if (p2 < 0) p2 = p; else p3 = p; } } }
        E.fill_rstd(lds + STAGE_BYTES, p0, wid, lane); if (p1 >= 0) E.fill_rstd(lds + STAGE_BYTES + 1024, p1, wid, lane); if (p2 >= 0) E.fill_rstd(lds + STAGE_BYTES + 2048, p2, wid, lane); if (p3 >= 0) E.fill_rstd(lds + STAGE_BYTES + 3072, p3, wid, lane);
        E.set_panels(p0, p1, p2);
        PG8_WAIT_L(0); PG8_BAR; asm volatile("" ::: "memory"); }
    f32x4 acc[2][2][4][2];
#pragma unroll
    for (int a = 0; a < 2; ++a)
#pragma unroll
        for (int b = 0; b < 2; ++b)
#pragma unroll
            for (int m = 0; m < 4; ++m)
#pragma unroll
                for (int n = 0; n < 2; ++n) acc[a][b][m][n] = (f32x4){0.f, 0.f, 0.f, 0.f};
    bf16x8 At[4][2], B0[2][2], B1[2][2]; i32x8 At8[4], B08[2], B18[2]; int sc8 = 0x7F7F7F7F; asm volatile("" : "+v"(sc8));
    const char* cA = (const char*)g.A + (size_t)cur.pm * tstep; const char* cB = (const char*)g.Bt + (size_t)cur.pn * tstep;
    S.a_ready(cur);
    if constexpr (SP2) {
        PG8_STAGE(PG8_SB(0, 0), cB, voffB); PG8_STAGE(PG8_SB(0, 1), cB + hstep, voffB); PG8_STAGE(PG8_SA(0, 0), cA, voffA); PG8_STAGE(PG8_SA(0, 1), cA + hstep, voffA);
        if (wr == 1) PG8_BAR;
        PG8_WAIT_V(2); PG8_BAR;
        PG8_STAGE(PG8_SB(1, 0), cB + kstep, voffB); PG8_STAGE(PG8_SA(1, 0), cA + kstep, voffA); PG8_STAGE(PG8_SB(1, 1), cB + hstep + kstep, voffB);
        PG8_WAIT_V(6); PG8_BAR;
    } else {
        PG8_STAGE(PG8_SB(0, 0), cB, voffB); PG8_STAGE(PG8_SA(0, 0), cA, voffA); PG8_STAGE(PG8_SB(0, 1), cB + hstep, voffB); PG8_STAGE(PG8_SA(0, 1), cA + hstep, voffA);
        if (wr == 1) PG8_BAR;
        PG8_WAIT_V(4); PG8_BAR;
        PG8_STAGE(PG8_SB(1, 0), cB + kstep, voffB); PG8_STAGE(PG8_SA(1, 0), cA + kstep, voffA); PG8_STAGE(PG8_SB(1, 1), cB + hstep + kstep, voffB);
        PG8_WAIT_V(6); PG8_BAR;
    }
    for (;;) {
        const bool has_next = S.next(ui + 1, nxt);
        const char* nA = has_next ? (const char*)g.A + (size_t)nxt.pm * tstep : cA; const char* nB = has_next ? (const char*)g.Bt + (size_t)nxt.pn * tstep : cB;
#pragma nounroll
        for (int t = 0; t < nt; t += 2) {
            const bool last = (t == nt - 2);
            const char* a1 = cA + (size_t)(t + 1) * kstep;
            const char* a2 = last ? nA : cA + (size_t)(t + 2) * kstep; const char* b2 = last ? nB : cB + (size_t)(t + 2) * kstep;
            const char* a3 = a2 + kstep; const char* b3 = b2 + kstep;
            if (last && has_next) S.a_ready(nxt);
            if constexpr (SP2) {
            PG8_LDB(B0, 0, 0); PG8_LDB(B1, 0, 1); PG8_SCHED; PG8_LDA(At, 0, 0); PG8_STAGE(PG8_SA(1, 1), a1 + hstep, voffA);
            PG8_WAIT_V(8); PG8_WAIT_L(0); PG8_BAR; PG8_MMA(0, 0, At, B0); PG8_MMA(0, 1, At, B1); PG8_BAR; PG8_SCHED;
            PG8_LDA(At, 0, 1); PG8_STAGE(PG8_SB(0, 0), b2, voffB); PG8_STAGE(PG8_SB(0, 1), b2 + hstep, voffB); PG8_STAGE(PG8_SA(0, 0), a2, voffA);
            PG8_WAIT_V(8); PG8_WAIT_L(0); PG8_BAR; PG8_MMA(1, 0, At, B0); PG8_MMA(1, 1, At, B1); PG8_BAR; PG8_SCHED;
            PG8_LDB(B0, 1, 0); PG8_LDB(B1, 1, 1); PG8_SCHED; PG8_LDA(At, 1, 0); PG8_STAGE(PG8_SA(0, 1), a2 + hstep, voffA);
            PG8_WAIT_V(8); PG8_WAIT_L(0); PG8_BAR; PG8_MMA(0, 0, At, B0); PG8_MMA(0, 1, At, B1); PG8_BAR; PG8_SCHED;
            PG8_LDA(At, 1, 1); PG8_STAGE(PG8_SB(1, 0), b3, voffB); PG8_STAGE(PG8_SB(1, 1), b3 + hstep, voffB); PG8_STAGE(PG8_SA(1, 0), a3, voffA);
            PG8_WAIT_V(8); PG8_WAIT_L(0); PG8_BAR; PG8_MMA(1, 0, At, B0); PG8_MMA(1, 1, At, B1); PG8_BAR; PG8_SCHED;
            } else {
            PG8_LDB(B0, 0, 0); PG8_SCHED; PG8_LDA(At, 0, 0); PG8_STAGE(PG8_SA(1, 1), a1 + hstep, voffA);
            PG8_WAIT_L(8); PG8_BAR; PG8_WAIT_L(0); PG8_MMA(0, 0, At, B0); PG8_BAR; PG8_SCHED;
            PG8_LDB(B1, 0, 1); PG8_STAGE(PG8_SB(0, 0), b2, voffB);
            PG8_BAR; PG8_WAIT_L(0); PG8_MMA(0, 1, At, B1); PG8_BAR;
            PG8_LDA(At, 0, 1); PG8_STAGE(PG8_SA(0, 0), a2, voffA);
            PG8_BAR; PG8_WAIT_L(0); PG8_MMA(1, 0, At, B0); PG8_BAR; PG8_SCHED;
            PG8_STAGE(PG8_SB(0, 1), b2 + hstep, voffB);
            PG8_WAIT_V(6); PG8_BAR; PG8_MMA(1, 1, At, B1); PG8_BAR;
            PG8_LDB(B0, 1, 0); PG8_SCHED; PG8_LDA(At, 1, 0); PG8_STAGE(PG8_SA(0, 1), a2 + hstep, voffA);
            PG8_WAIT_L(8); PG8_BAR; PG8_WAIT_L(0); PG8_MMA(0, 0, At, B0); PG8_BAR; PG8_SCHED;
            PG8_LDB(B1, 1, 1); PG8_STAGE(PG8_SB(1, 0), b3, voffB);
            PG8_BAR; PG8_WAIT_L(0); PG8_MMA(0, 1, At, B1); PG8_BAR;
            PG8_LDA(At, 1, 1); PG8_STAGE(PG8_SA(1, 0), a3, voffA);
            PG8_BAR; PG8_WAIT_L(0); PG8_MMA(1, 0, At, B0); PG8_BAR; PG8_SCHED;
            PG8_STAGE(PG8_SB(1, 1), b3 + hstep, voffB);
            PG8_WAIT_V(6); PG8_BAR; PG8_MMA(1, 1, At, B1); PG8_BAR;
            }
        }
        if constexpr (ALIGN_EPI) { if (wr == 0) PG8_BAR; }
        if constexpr (FP8) asm volatile("s_nop 15\n\ts_nop 15" ::: "memory");
        if constexpr (!Epi::AFTER_DRAIN) { E(acc, cur, wr, wc, fr, fq); S.done(cur); }
        if (!has_next) break;
#pragma unroll
        for (int a = 0; a < 2; ++a)
#pragma unroll
            for (int b = 0; b < 2; ++b)
#pragma unroll
                for (int m = 0; m < 4; ++m)
#pragma unroll
                    for (int n = 0; n < 2; ++n) acc[a][b][m][n] = (f32x4){0.f, 0.f, 0.f, 0.f};
        cur = nxt; cA = nA; cB = nB; ++ui;
        if constexpr (ALIGN_EPI) { if (wr == 1) PG8_BAR; }
    }
    PG8_WAIT_V(0);
    if constexpr (!ALIGN_EPI) { if (wr == 0) PG8_BAR; }
    PG8_BAR;
    if constexpr (Epi::AFTER_DRAIN) { E.fused(acc, cur, wr, wc, fr, fq, lds, wid, lane); S.done(cur); }
#undef PG8_SA
#undef PG8_SB
#undef PG8_STAGE
#undef PG8_LDA
#undef PG8_LDB
#undef PG8_MMA
#undef PG8_WAIT_V
#undef PG8_WAIT_L
#undef PG8_BAR
#undef PG8_SCHED
}
}

constexpr int NWAVES = 8;
constexpr int BATCH = 16, T = 2048, D = 1024, M = BATCH * T, DFF = 2816, NF1 = 2 * DFF, NU = 2304, DEPTH = 2, NCP = 128;
constexpr float EPS = 1e-6f, LOG2E = 1.4426950408889634f, C2 = 0.125f * LOG2E;
constexpr int UQ = 0, UKS = 256, UKW = 320, UCK = 384, UCQ = 512, UKC = 768, UVC = 832, UVS = 896, UVW = 960, UCV = 1024, UG = 1152, UBB = 1280, UBC = 1536, UBX = 1792, UDV = 2048;
constexpr size_t MiB = 1u << 20;
constexpr size_t WS_CTL = 0, CTL_ZERO_BYTES = 1 * MiB;
constexpr size_t WS_W13 = 1 * MiB, WS_W2 = 45 * MiB, WS_WIN = 67 * MiB, WS_WOUT = 76 * MiB, WS_C1 = 80 * MiB;
constexpr size_t WS_SSQ = 82 * MiB, WS_GATES = 84 * MiB, WS_KC = 86 * MiB, WS_VC = 86 * MiB + 512 * 1024;
constexpr size_t WS_XB = 88 * MiB, WS_QKN = 152 * MiB, WS_YN = 200 * MiB, WS_ACT = 264 * MiB, WS_U = WS_ACT, WS_X8 = 440 * MiB, WS_IMG = 472 * MiB, WS_END = 504 * MiB;
#ifndef UP8_MASK_V
#define UP8_MASK_V 0xE
#endif
#ifndef DN8_MASK_V
#define DN8_MASK_V 0xE
#endif
constexpr unsigned UP8_MASK = UP8_MASK_V, DN8_MASK = DN8_MASK_V;
constexpr float W8_SCALE = 64.0f, ACT8_SCALE = 4.0f; static_assert(W8_SCALE * ACT8_SCALE == 256.0f, "EpiRes mode 1");
constexpr int CW_BAR = 4096;
constexpr int LDS_BYTES = 163840, MISC_OFF = LDS_BYTES - 256;

#define GAS __attribute__((address_space(1)))
#define LAS __attribute__((address_space(3)))
typedef unsigned short bf16;
typedef unsigned v4u __attribute__((ext_vector_type(4)));
typedef unsigned u32x2 __attribute__((ext_vector_type(2)));
typedef float f32x4 __attribute__((ext_vector_type(4)));
typedef float f32x2_t __attribute__((ext_vector_type(2)));
typedef __bf16 bf16x2_t __attribute__((ext_vector_type(2)));
typedef short bf16x8 __attribute__((ext_vector_type(8)));
typedef float f32x16 __attribute__((ext_vector_type(16)));
typedef short v4i16_t __attribute__((ext_vector_type(4)));
#define LDS_WAIT() asm volatile("s_waitcnt lgkmcnt(0)" ::: "memory")
__device__ __forceinline__ unsigned pk2(float lo, float hi) { f32x2_t v = {lo, hi}; bf16x2_t b = __builtin_convertvector(v, bf16x2_t); return __builtin_bit_cast(unsigned, b); }
__device__ __forceinline__ float bflo(unsigned u) { return __builtin_bit_cast(float, u << 16); }
__device__ __forceinline__ float bfhi(unsigned u) { return __builtin_bit_cast(float, u & 0xffff0000u); }
__device__ __forceinline__ f32x4 ld4bf(const bf16* p) { const u32x2 w = *(const u32x2*)p; return (f32x4){bflo(w.x), bfhi(w.x), bflo(w.y), bfhi(w.y)}; }
__device__ __forceinline__ void st4bf(bf16* p, f32x4 v) { u32x2 w; w.x = pk2(v[0], v[1]); w.y = pk2(v[2], v[3]); *(u32x2*)p = w; }
template <int CTRL> __device__ __forceinline__ float dpp_add(float v) { return v + __builtin_bit_cast(float, __builtin_amdgcn_update_dpp(0, __builtin_bit_cast(int, v), CTRL, 0xf, 0xf, true)); }
__device__ __forceinline__ float row16_sum(float v) { v = dpp_add<0xB1>(v); v = dpp_add<0x4E>(v); v = dpp_add<0x141>(v); v = dpp_add<0x140>(v); return v; }
__device__ __forceinline__ float wave_sum(float v) {
    v = row16_sum(v); v += __shfl_xor(v, 16);
    auto rr = __builtin_amdgcn_permlane32_swap(__float_as_uint(v), __float_as_uint(v), false, false); return __uint_as_float(rr[0]) + __uint_as_float(rr[1]);
}
__device__ __forceinline__ f32x4 up4(u32x2 w) { return (f32x4){bflo(w.x), bfhi(w.x), bflo(w.y), bfhi(w.y)}; }
__device__ __forceinline__ float sq4(f32x4 v) { return (v[0] * v[0] + v[1] * v[1]) + (v[2] * v[2] + v[3] * v[3]); }

__device__ __forceinline__ int kimg_off(int r, int d) { return (d >> 3) * 512 + r * 8 + (d & 7); }
__device__ __forceinline__ int vimg_off(int r, int d) { return ((d >> 5) * 4 + (r >> 4)) * 512 + (r & 15) * 32 + (d & 31); }
#define XB_TMO      128
#define XB_XCNT(j)  (256  + 64 * (j))
#define XB_XSUB(j)  (1280 + 64 * (j))
#define XB_XGEN(j)  (2304 + 64 * (j))
#define XB_TOP      3328
#define XB_TOPGEN   3392
#define XCD_BAR_WORDS 3456
#define XB_SPIN_CAP (1u << 18)

__device__ __forceinline__ unsigned xb_ld(unsigned* p)              { return __hip_atomic_load(p, __ATOMIC_RELAXED, __HIP_MEMORY_SCOPE_AGENT); }
__device__ __forceinline__ unsigned xb_add(unsigned* p, unsigned v) { return __hip_atomic_fetch_add(p, v, __ATOMIC_RELAXED, __HIP_MEMORY_SCOPE_AGENT); }
__device__ __forceinline__ unsigned xb_xcc_id() { return (unsigned)__builtin_amdgcn_s_getreg((3 << 11) | 20) & 0xFu; }
#define XB_SPIN(cond, bar) do { unsigned _sp = 0; while (cond) { __builtin_amdgcn_s_sleep(1); \
    if ((++_sp & 255u) == 0u) { if (xb_ld(&(bar)[XB_TMO])) break; if (_sp > XB_SPIN_CAP) { atomicAdd(&(bar)[XB_TMO], 1u); break; } } } } while (0)

struct XcdBarrier {
    unsigned* bar; unsigned x;
    volatile LAS unsigned* st;
};

__device__ __forceinline__ XcdBarrier xcd_barrier_post(unsigned* bar, volatile LAS unsigned* st) {
    XcdBarrier b; b.bar = bar; b.x = xb_xcc_id(); b.st = st;
    if (threadIdx.x == 0) (void)xb_add(&bar[XB_XCNT(b.x)], 1u);
    return b;
}
__device__ __forceinline__ void xcd_barrier_complete(unsigned* bar, unsigned x, unsigned& nloc, unsigned& nx) {
    const unsigned G = gridDim.x * gridDim.y * gridDim.z;
    unsigned sum, cnt, mine, sp = 0u;
    for (;;) {
        sum = 0u; cnt = 0u; mine = 0u;
#pragma unroll
        for (unsigned j = 0; j < 16; ++j) { const unsigned c = xb_ld(&bar[XB_XCNT(j)]); sum += c; cnt += (c > 0u) ? 1u : 0u; mine = (j == x) ? c : mine; }
        if (sum == G) break;
        __builtin_amdgcn_s_sleep(1);
        if ((++sp & 255u) == 0u) { if (xb_ld(&bar[XB_TMO])) break; if (sp > XB_SPIN_CAP) { atomicAdd(&bar[XB_TMO], 1u); break; } }
    }
    nloc = mine > 0u ? mine : 1u; nx = cnt > 0u ? cnt : 1u;
}

__device__ __forceinline__ void xcd_barrier(const XcdBarrier& b) {
    asm volatile("s_waitcnt vmcnt(0)" ::: "memory");
    __syncthreads();
    if (threadIdx.x == 0) {
        unsigned* bar = b.bar;
        __builtin_amdgcn_s_waitcnt(0);
        unsigned nloc = b.st[0], nx = b.st[1];
        if (nloc == 0u) { xcd_barrier_complete(bar, b.x, nloc, nx); b.st[0] = nloc; b.st[1] = nx; }
        const unsigned old = xb_add(&bar[XB_XSUB(b.x)], 1u);
        const unsigned gen = old / nloc;
        if (old + 1u == (gen + 1u) * nloc) {
            __builtin_amdgcn_fence(__ATOMIC_RELEASE, "agent");
            asm volatile("s_waitcnt vmcnt(0)" ::: "memory");
            const unsigned og = xb_add(&bar[XB_TOP], 1u);
            const unsigned tg = og / nx;
            if (og + 1u == (tg + 1u) * nx) xb_add(&bar[XB_TOPGEN], 1u);
            else XB_SPIN(xb_ld(&bar[XB_TOPGEN]) == tg, bar);
            __builtin_amdgcn_fence(__ATOMIC_ACQUIRE, "agent");
            xb_add(&bar[XB_XGEN(b.x)], 1u);
            asm volatile("s_waitcnt vmcnt(0)" ::: "memory");
        } else {
            XB_SPIN(xb_ld(&bar[XB_XGEN(b.x)]) == gen, bar);
            __builtin_amdgcn_fence(__ATOMIC_ACQUIRE, "agent");
            asm volatile("s_waitcnt vmcnt(0)" ::: "memory");
        }
    }
    __syncthreads();
}


typedef KArgs Args;
struct Frame {
    LAS unsigned char* lds;
    int tid, lane, wave, vcu, G;
    const Args* a;
};
#define FIN(i) (F.a->in[i])
#define FOUT (F.a->out)
#define FWS(off, type) ((type*)(F.a->ws + (off)))
#define F_W13T FWS(WS_W13, bf16)
#define F_W2T FWS(WS_W2, bf16)
#define F_WINT FWS(WS_WIN, bf16)
#define F_WOUTT FWS(WS_WOUT, bf16)
#define F_C1T FWS(WS_C1, bf16)
#define F_XB FWS(WS_XB, bf16)
#define F_QA FWS(WS_QKN, bf16)
#define F_QC FWS(WS_QKN + 16 * MiB, bf16)
#define F_KSI FWS(WS_IMG, bf16)
#define F_KWI FWS(WS_IMG + 4 * MiB, bf16)
#define F_CKI FWS(WS_IMG + 8 * MiB, bf16)
#define F_VSI FWS(WS_IMG + 16 * MiB, bf16)
#define F_VWI FWS(WS_IMG + 20 * MiB, bf16)
#define F_CVI FWS(WS_IMG + 24 * MiB, bf16)
#define F_YN FWS(WS_YN, bf16)
#define F_ACT FWS(WS_ACT, bf16)
#define F_U FWS(WS_U, bf16)
#define F_KC FWS(WS_KC, bf16)
#define F_VC FWS(WS_VC, bf16)
#define F_SSQ FWS(WS_SSQ, float)
#define F_GATES FWS(WS_GATES, float)
#define F_X8 FWS(WS_X8, unsigned char)
enum { I_X = 0, I_F1N, I_F1W1, I_F1W3, I_F1W2, I_MIXN, I_WIN, I_NQN, I_NKCN, I_NKSN, I_NKWN, I_POSK, I_C1K, I_C2K, I_POSV, I_C1V, I_C2V, I_CONVW, I_SQN, I_SKN, I_SINK, I_POOLW, I_POOLS, I_GN, I_WOUT,
       I_F2N, I_F2W1, I_F2W3, I_F2W2 };

__device__ __forceinline__ int win_src_col(int dr) {
    if (dr < 256) return dr;
    if (dr < 320) return 384 + (dr - 256);
    if (dr < 384) return 512 + (dr - 320);
    if (dr < 512) return 1676 + (dr - 384);
    if (dr < 768) return 1420 + (dr - 512);
    if (dr < 832) return 256 + (dr - 768);
    if (dr < 896) return 320 + (dr - 832);
    if (dr < 960) return 448 + (dr - 896);
    if (dr < 1024) return 576 + (dr - 960);
    if (dr < 1152) return 1804 + (dr - 1024);
    if (dr < 1164) return 640 + (dr - 1152);
    if (dr < 1280) return -1;
    if (dr < 1536) return 652 + (dr - 1280);
    if (dr < 1792) return 908 + (dr - 1536);
    if (dr < 2048) return 1164 + (dr - 1792);
    return 1932 + (dr - 2048);
}
struct TrItem { const float* src; const float* gain; void* dst; int N, K, k0, srccol, dstrow0; bool f8; };
__device__ __forceinline__ void tr_load(const TrItem& t, f32x4 (&v)[16], int lane) {
    const int kr = lane >> 4;
#pragma unroll
    for (int i = 0; i < 16; ++i) { v[i] = (f32x4){0.f, 0.f, 0.f, 0.f}; if (t.srccol >= 0) v[i] = *(const f32x4*)(t.src + (size_t)(t.k0 + 4 * i + kr) * t.N + t.srccol); }
}
__device__ __forceinline__ void tr_store(const TrItem& t, f32x4 (&v)[16], LAS float* scr, int lane) {
    const int kr = lane >> 4;
    if (t.gain) {
#pragma unroll
        for (int i = 0; i < 16; ++i) v[i] *= t.gain[t.k0 + 4 * i + kr]; }
#pragma unroll
    for (int i = 0; i < 16; ++i) { LAS float* p = scr + (4 * i + kr) * 65 + 4 * (lane & 15); p[0] = v[i][0]; p[1] = v[i][1]; p[2] = v[i][2]; p[3] = v[i][3]; }
    LDS_WAIT(); asm volatile("" ::: "memory");
    if (t.f8) { const int c = lane & 3;
#pragma unroll
        for (int j = 0; j < 4; ++j) { const int n = (lane >> 2) + 16 * j; const LAS float* q = scr + (16 * c) * 65 + n; v4u o;
            o.x = pg8::pk4_fp8(q[0 * 65] * W8_SCALE, q[1 * 65] * W8_SCALE, q[2 * 65] * W8_SCALE, q[3 * 65] * W8_SCALE); o.y = pg8::pk4_fp8(q[4 * 65] * W8_SCALE, q[5 * 65] * W8_SCALE, q[6 * 65] * W8_SCALE, q[7 * 65] * W8_SCALE);
            o.z = pg8::pk4_fp8(q[8 * 65] * W8_SCALE, q[9 * 65] * W8_SCALE, q[10 * 65] * W8_SCALE, q[11 * 65] * W8_SCALE); o.w = pg8::pk4_fp8(q[12 * 65] * W8_SCALE, q[13 * 65] * W8_SCALE, q[14 * 65] * W8_SCALE, q[15 * 65] * W8_SCALE);
            *(v4u*)((unsigned char*)t.dst + (size_t)(t.dstrow0 + n) * t.K + t.k0 + 16 * c) = o; } }
    else { const int c = lane & 7;
#pragma unroll
        for (int j = 0; j < 8; ++j) { const int n = (lane >> 3) + 8 * j; const LAS float* q = scr + (8 * c) * 65 + n;
            v4u o; o.x = pk2(q[0 * 65], q[1 * 65]); o.y = pk2(q[2 * 65], q[3 * 65]); o.z = pk2(q[4 * 65], q[5 * 65]); o.w = pk2(q[6 * 65], q[7 * 65]);
            *(v4u*)((bf16*)t.dst + (size_t)(t.dstrow0 + n) * t.K + t.k0 + 8 * c) = o; } }
    LDS_WAIT(); asm volatile("" ::: "memory");
}
__device__ __forceinline__ void tr_decode(Frame& F, int it, int lane, TrItem& t) {
    constexpr int I_W = 704, I_IN = 16 * 36, I_OUT = 16 * 16, I_C1 = 32 * 2, PER_LAYER = 6 * I_W + I_IN + I_OUT + 2 * I_C1;
    const int L = it / PER_LAYER, l4 = 4 * (lane & 15); int r = it % PER_LAYER;
    t.gain = nullptr; t.f8 = false;
    if (r < 6 * I_W) { const int mat = r / I_W; r %= I_W; const int ffn = mat / 3, w = mat % 3;
        if (w < 2) { const int kb = r / 44, nb = r % 44, n0 = 64 * nb; t.N = DFF; t.K = D; t.k0 = 64 * kb; t.srccol = n0 + l4;
            t.src = FIN(ffn ? (w ? I_F2W3 : I_F2W1) : (w ? I_F1W3 : I_F1W1)) + (size_t)L * D * DFF; t.gain = FIN(ffn ? I_F2N : I_F1N) + L * D;
            t.dst = (unsigned char*)F_W13T + (size_t)(L * 2 + ffn) * NF1 * D * 2; t.dstrow0 = (n0 / 128) * 256 + w * 128 + (n0 % 128); t.f8 = (UP8_MASK >> (L * 2 + ffn)) & 1u; }
        else { const int kb = r / 16, nb = r % 16, n0 = 64 * nb; t.N = D; t.K = DFF; t.k0 = 64 * kb; t.srccol = n0 + l4;
            t.src = FIN(ffn ? I_F2W2 : I_F1W2) + (size_t)L * DFF * D; t.dst = (unsigned char*)F_W2T + (size_t)(L * 2 + ffn) * D * DFF * 2; t.dstrow0 = n0; t.f8 = (DN8_MASK >> (L * 2 + ffn)) & 1u; } }
    else { r -= 6 * I_W;
        if (r < I_IN) { const int kb = r / 36, rb = r % 36; t.N = 2188; t.K = D; t.k0 = 64 * kb; t.srccol = win_src_col(64 * rb + l4);
            t.src = FIN(I_WIN) + (size_t)L * D * 2188; t.gain = FIN(I_MIXN) + L * D; t.dst = F_WINT + (size_t)L * NU * D; t.dstrow0 = 64 * rb; }
        else if (r < I_IN + I_OUT) { r -= I_IN; const int kb = r / 16, nb = r % 16, n0 = 64 * nb; t.N = D; t.K = D; t.k0 = 64 * kb; t.srccol = n0 + l4;
            t.src = FIN(I_WOUT) + (size_t)L * D * D; t.gain = FIN(I_GN) + L * D; t.dst = F_WOUTT + (size_t)L * D * D; t.dstrow0 = n0; }
        else { r -= I_IN + I_OUT; const int kv = r / I_C1; r %= I_C1; const int kb = r / 2, nb = r % 2, n0 = 64 * nb; t.N = 128; t.K = 2048; t.k0 = 64 * kb; t.srccol = n0 + l4;
            t.src = FIN(kv ? I_C1V : I_C1K) + (size_t)L * 2048 * 128; t.dst = F_C1T + (size_t)(L * 2 + kv) * 128 * 2048; t.dstrow0 = n0; } }
}
__device__ __forceinline__ void prologue(Frame& F) {
    int lane = F.lane; asm volatile("" : "+v"(lane));
    LAS float* scr = (LAS float*)(F.lds + F.wave * 16640);
    const int gw = F.vcu * NWAVES + F.wave, NGW = F.G * NWAVES;
    constexpr int NITEMS = DEPTH * (6 * 704 + 16 * 36 + 16 * 16 + 2 * 64);
    if (gw < NITEMS) { TrItem ta, tb; f32x4 va[16], vb[16];
        tr_decode(F, gw, lane, ta); tr_load(ta, va, lane);
        for (int it = gw; it < NITEMS; it += 2 * NGW) {
            const bool hb = it + NGW < NITEMS; if (hb) { tr_decode(F, it + NGW, lane, tb); tr_load(tb, vb, lane); }
            tr_store(ta, va, scr, lane);
            const bool ha = it + 2 * NGW < NITEMS; if (ha) { tr_decode(F, it + 2 * NGW, lane, ta); tr_load(ta, va, lane); }
            if (hb) tr_store(tb, vb, scr, lane);
        } }
    const float* x = FIN(I_X);
    for (int m4 = gw * 4; m4 < M; m4 += NGW * 4) {
        f32x4 v[4][4];
#pragma unroll
        for (int r = 0; r < 4; ++r)
#pragma unroll
            for (int j = 0; j < 4; ++j) v[r][j] = *((const f32x4*)(x + (size_t)(m4 + r) * D) + lane + 64 * j);
#pragma unroll
        for (int r = 0; r < 4; ++r) { float sr = 0.f;
#pragma unroll
            for (int j = 0; j < 4; ++j) { sr += sq4(v[r][j]); st4bf(F_XB + (size_t)(m4 + r) * D + 256 * j + 4 * lane, v[r][j]);
                if (UP8_MASK & 1u) *(unsigned*)(F_X8 + (size_t)(m4 + r) * D + 256 * j + 4 * lane) = pg8::pk4_fp8(v[r][j][0], v[r][j][1], v[r][j][2], v[r][j][3]); }
            sr = wave_sum(sr);
            if (lane < 16) F_SSQ[(size_t)(m4 + r) * 16 + lane] = lane == 0 ? sr : 0.f; }
    }
}

#ifndef PROBE_PREP
#define PROBE_PREP 0
#endif
__device__ __forceinline__ void prep_phase(Frame& F, int L) {
    int tid = F.tid; asm volatile("" : "+v"(tid));
    const int lane = tid & 63, ch = 4 * lane;
    LAS bf16* PWt = (LAS bf16*)F.lds;
    LAS bf16* DTb = (LAS bf16*)(F.lds + 65536) + F.wave * (16 * 264);
    { const float* pw = FIN(I_POOLW) + (size_t)L * 16384;
      for (int i = tid; i < 16384; i += NWAVES * 64) { const int g = i >> 12, c = (i >> 6) & 63, e = i & 63; PWt[(g * 64 + e) * 72 + c] = (bf16)(pk2(pw[i], 0.f) & 0xffffu); } }
    __syncthreads();
    f32x4 g0, g1, g2, cw0, cw1, cw2;
    { const float* nq = FIN(I_NQN) + L * 64; const float* nks = FIN(I_NKSN) + L * 64; const float* nkw = FIN(I_NKWN) + L * 64; const float* sk = FIN(I_SKN) + L * 64; const float* sq = FIN(I_SQN) + L * 64;
      g0 = *(const f32x4*)(nq + (ch & 63)) * C2;
      g1 = ch < 64 ? *(const f32x4*)(nks + ch) : (ch < 128 ? *(const f32x4*)(nkw + (ch - 64)) : *(const f32x4*)(sk + (ch & 63)));
      g2 = *(const f32x4*)(sq + (ch & 63)) * C2;
      const float* cw = FIN(I_CONVW) + L * 768; cw0 = *(const f32x4*)(cw + ch); cw1 = *(const f32x4*)(cw + 256 + ch); cw2 = *(const f32x4*)(cw + 512 + ch);
      }
    const int grp = lane >> 4, win = 2 << grp;
    const int gw = F.vcu * NWAVES + F.wave, NGW = F.G * NWAVES;
    for (int blk = gw; blk < M / 16; blk += NGW) {
        const int m0 = blk * 16, t0 = m0 & (T - 1);
        const bf16* u0 = F_U + (size_t)m0 * NU;
        const int gt = m0 >> 6, rb = m0 & 63, dk = ch & 63;
        bf16* kimg = (ch < 64 ? F_KSI : (ch < 128 ? F_KWI : F_CKI + (size_t)((ch - 128) >> 6) * 512 * 4096)) + (size_t)gt * 4096 + kimg_off(rb, dk);
        bf16* vimg = (ch < 64 ? F_VSI : (ch < 128 ? F_VWI : F_CVI + (size_t)((ch - 128) >> 6) * 512 * 4096)) + (size_t)gt * 4096 + vimg_off(rb, dk);
#pragma nounroll
        for (int i8 = 0; i8 < 16; i8 += 8) { u32x2 raw[8][4];
#pragma unroll
            for (int i = 0; i < 8; ++i) {
#pragma unroll
                for (int k = 0; k < 3; ++k) raw[i][k] = *(const u32x2*)(u0 + (size_t)(i8 + i) * NU + 256 * k + ch);
                raw[i][3] = *(const u32x2*)(u0 + (size_t)(i8 + i) * NU + UVS + ch); }
#pragma unroll
            for (int i = 0; i < 8; ++i) { const f32x4 v0 = up4(raw[i][0]), v1 = up4(raw[i][1]), v2 = up4(raw[i][2]);
                const float s0 = row16_sum(sq4(v0)), s1 = row16_sum(sq4(v1)), s2 = row16_sum(sq4(v2));
                const float r0 = __builtin_amdgcn_rsqf(s0 * (1.f / 64.f) + EPS), r1 = __builtin_amdgcn_rsqf(s1 * (1.f / 64.f) + EPS), r2 = __builtin_amdgcn_rsqf(s2 * (1.f / 64.f) + EPS);
                st4bf(F_QA + (size_t)(m0 + i8 + i) * 256 + ch, v0 * r0 * g0); st4bf(kimg + (i8 + i) * 8, v1 * r1 * g1); st4bf(F_QC + (size_t)(m0 + i8 + i) * 256 + ch, v2 * r2 * g2);
                *(u32x2*)(vimg + (i8 + i) * 32) = raw[i][3]; } }
#pragma unroll
        for (int k = 0; k < 3; ++k) { const int idx = lane + 64 * k, tk = idx / 12, gi = idx - 12 * tk;
            const float a = bflo((unsigned)u0[(size_t)tk * NU + UG + gi]); F_GATES[(size_t)m0 * 12 + idx] = __builtin_amdgcn_rcpf(1.0f + __builtin_amdgcn_exp2f(a * -LOG2E)); }
        { f32x4 zm1 = {0.f, 0.f, 0.f, 0.f}, zm2 = {0.f, 0.f, 0.f, 0.f};
          if (t0 > 0) { zm1 = ld4bf(u0 - NU + UBC + ch) * ld4bf(u0 - NU + UBX + ch); zm2 = ld4bf(u0 - 2 * NU + UBC + ch) * ld4bf(u0 - 2 * NU + UBX + ch); }
#pragma nounroll
          for (int i8 = 0; i8 < 16; i8 += 8) { u32x2 raw[8][3]; f32x4 ob[8]; float ss[8];
#pragma unroll
              for (int i = 0; i < 8; ++i)
#pragma unroll
                  for (int k = 0; k < 3; ++k) raw[i][k] = *(const u32x2*)(u0 + (size_t)(i8 + i) * NU + UBB + 256 * k + ch);
#pragma unroll
              for (int i = 0; i < 8; ++i) { const f32x4 z0 = up4(raw[i][1]) * up4(raw[i][2]);
                  ob[i] = up4(raw[i][0]) * (cw2 * z0 + cw1 * zm1 + cw0 * zm2); zm2 = zm1; zm1 = z0; ss[i] = sq4(ob[i]); }
#pragma unroll
              for (int i = 0; i < 8; ++i) ss[i] = wave_sum(ss[i]);
#pragma unroll
              for (int i = 0; i < 8; ++i) st4bf(F_YN + (size_t)(m0 + i8 + i) * D + 256 + ch, ob[i] * (__builtin_amdgcn_rsqf(ss[i] * (1.f / 256.f) + EPS))); } }
        for (int rep4 = 0; rep4 < ((PROBE_PREP & 4) ? 2 : 1); ++rep4)
        { u32x2 raw[32];
#pragma unroll
          for (int i = 0; i < 16; ++i) { raw[i] = (u32x2){0u, 0u}; if (t0 > 0) raw[i] = *(const u32x2*)(u0 - (size_t)(16 - i) * NU + UDV + ch); }
#pragma unroll
          for (int i = 0; i < 16; ++i) raw[16 + i] = *(const u32x2*)(u0 + (size_t)i * NU + UDV + ch);
          f32x4 S2 = up4(raw[15]) + up4(raw[14]), S4 = S2 + up4(raw[13]) + up4(raw[12]), S8 = S4, S16;
#pragma unroll
          for (int i = 8; i < 12; ++i) S8 += up4(raw[i]);
          S16 = S8;
#pragma unroll
          for (int i = 0; i < 8; ++i) S16 += up4(raw[i]);
#pragma unroll
          for (int ti = 0; ti < 16; ++ti) { const f32x4 v = up4(raw[16 + ti]);
              S2 += v - up4(raw[16 + ti - 2]); S4 += v - up4(raw[16 + ti - 4]); S8 += v - up4(raw[16 + ti - 8]); S16 += v - up4(raw[ti]);
              const f32x4 Sw = grp == 0 ? S2 : (grp == 1 ? S4 : (grp == 2 ? S8 : S16));
              const int cn = (t0 + ti + 1) < win ? (t0 + ti + 1) : win;
              const f32x4 dd = Sw * __builtin_amdgcn_rcpf((float)cn) - v;
              u32x2 w; w.x = pk2(dd[0], dd[1]); w.y = pk2(dd[2], dd[3]); *(LAS u32x2*)(DTb + ti * 264 + ch) = w; }
          const int fr = lane & 15, fq = lane >> 4;
          const float* psp = FIN(I_POOLS) + L * 256 + fr;
          f32x4 acc[4][4];
#pragma unroll
          for (int g = 0; g < 4; ++g) { const bf16x8 a0 = *(const LAS bf16x8*)(DTb + fr * 264 + g * 64 + 8 * fq), a1 = *(const LAS bf16x8*)(DTb + fr * 264 + g * 64 + 32 + 8 * fq);
#pragma unroll
              for (int cb = 0; cb < 4; ++cb) { const LAS bf16* bp = PWt + (g * 64 + 16 * cb + fr) * 72 + 8 * fq;
                  f32x4 c = {0.f, 0.f, 0.f, 0.f};
                  c = __builtin_amdgcn_mfma_f32_16x16x32_bf16(a0, *(const LAS bf16x8*)bp, c, 0, 0, 0);
                  c = __builtin_amdgcn_mfma_f32_16x16x32_bf16(a1, *(const LAS bf16x8*)(bp + 32), c, 0, 0, 0);
                  acc[g][cb] = c * psp[g * 64 + 16 * cb]; } }
          float ss[4];
#pragma unroll
          for (int i = 0; i < 4; ++i) { float q = 0.f;
#pragma unroll
              for (int g = 0; g < 4; ++g)
#pragma unroll
                  for (int cb = 0; cb < 4; ++cb) q += acc[g][cb][i] * acc[g][cb][i];
              ss[i] = __builtin_amdgcn_rsqf(row16_sum(q) * (1.f / 256.f) + EPS); }
          asm volatile("s_waitcnt lgkmcnt(0)" ::: "memory");
#pragma unroll
          for (int g = 0; g < 4; ++g)
#pragma unroll
              for (int cb = 0; cb < 4; ++cb)
#pragma unroll
                  for (int i = 0; i < 4; ++i) DTb[(4 * fq + i) * 264 + g * 64 + 16 * cb + fr] = (bf16)(pk2(acc[g][cb][i] * ss[i], 0.f) & 0xffffu);
#pragma unroll
          for (int ti = 0; ti < 16; ++ti) *(u32x2*)(F_YN + (size_t)(m0 + ti) * D + 768 + ch) = *(const LAS u32x2*)(DTb + ti * 264 + ch); }
    }
    __syncthreads();
    LAS float* PART = (LAS float*)F.lds;
    LAS float* H = (LAS float*)(F.lds + 65536);
    LAS float* O2 = (LAS float*)(F.lds + 65536 + 16384);
    const int fr = lane & 15, fq = lane >> 4, wave = F.wave;
    for (int rep8 = 0; rep8 < ((PROBE_PREP & 8) ? 2 : 1); ++rep8)
    for (int uid = blockIdx.x; uid < 256; uid += F.G) {
        const int b = uid >> 4, kv = (uid >> 3) & 1, n0 = 16 * (uid & 7);
        const bf16* W1t = F_C1T + (size_t)(L * 2 + kv) * 128 * 2048;
        const float* pos = FIN(kv ? I_POSV : I_POSK) + (size_t)L * 2048;
        const float* W2 = FIN(kv ? I_C2V : I_C2K) + (size_t)L * 128 * 64;
        const int nrow = (n0 + fr) < 126 ? (n0 + fr) : 126;
        const bf16* arow = F_U + (size_t)(b * T + 16 * nrow) * NU + UKC + 64 * kv;
        const bf16* brow = W1t + (size_t)fr * 2048;
        f32x4 acc[8];
#pragma unroll
        for (int ct = 0; ct < 8; ++ct) acc[ct] = (f32x4){0.f, 0.f, 0.f, 0.f};
#pragma unroll 2
        for (int ks = 0; ks < 8; ++ks) { const int kk = 8 * wave + ks, l = kk >> 1, c = 32 * (kk & 1) + 8 * fq;
            const v4u ar = *(const v4u*)(arow + (size_t)l * NU + c); const f32x4 p0 = *(const f32x4*)(pos + l * 64 + c), p1 = *(const f32x4*)(pos + l * 64 + c + 4);
            bf16x8 bfr[8];
#pragma unroll
            for (int ct = 0; ct < 8; ++ct) bfr[ct] = *(const bf16x8*)(brow + (size_t)(16 * ct) * 2048 + 32 * kk + 8 * fq);
            v4u aw; aw.x = pk2(bflo(ar.x) + p0[0], bfhi(ar.x) + p0[1]); aw.y = pk2(bflo(ar.y) + p0[2], bfhi(ar.y) + p0[3]); aw.z = pk2(bflo(ar.z) + p1[0], bfhi(ar.z) + p1[1]); aw.w = pk2(bflo(ar.w) + p1[2], bfhi(ar.w) + p1[3]);
#pragma unroll
            for (int ct = 0; ct < 8; ++ct) acc[ct] = __builtin_amdgcn_mfma_f32_16x16x32_bf16(__builtin_bit_cast(bf16x8, aw), bfr[ct], acc[ct], 0, 0, 0); }
#pragma unroll
        for (int ct = 0; ct < 8; ++ct)
#pragma unroll
            for (int i = 0; i < 4; ++i) PART[(wave * 16 + 4 * fq + i) * 128 + 16 * ct + fr] = acc[ct][i];
        __syncthreads();
        { const int e0 = 4 * tid; f32x4 sum = *(const LAS f32x4*)(PART + e0);
#pragma unroll
          for (int w = 1; w < 8; ++w) sum += *(const LAS f32x4*)(PART + w * 2048 + e0);
          const int hr = e0 >> 7, hc = e0 & 127;
#pragma unroll
          for (int i = 0; i < 4; ++i) { const float xh = sum[i]; const float y2 = 2.0f * 0.7978845608028654f * (xh + 0.044715f * xh * xh * xh); H[hr * 132 + hc + i] = xh * __builtin_amdgcn_rcpf(1.0f + __builtin_amdgcn_exp2f(y2 * -LOG2E)); } }
        __syncthreads();
        if (wave < 4) { f32x4 a2 = {0.f, 0.f, 0.f, 0.f};
#pragma unroll
            for (int s = 0; s < 4; ++s) { const LAS float* hp = H + fr * 132 + 32 * s + 8 * fq; const float* wp = W2 + (size_t)(32 * s + 8 * fq) * 64 + 16 * wave + fr;
                v4u aw; aw.x = pk2(hp[0], hp[1]); aw.y = pk2(hp[2], hp[3]); aw.z = pk2(hp[4], hp[5]); aw.w = pk2(hp[6], hp[7]);
                v4u bw; bw.x = pk2(wp[0], wp[64]); bw.y = pk2(wp[128], wp[192]); bw.z = pk2(wp[256], wp[320]); bw.w = pk2(wp[384], wp[448]);
                a2 = __builtin_amdgcn_mfma_f32_16x16x32_bf16(__builtin_bit_cast(bf16x8, aw), __builtin_bit_cast(bf16x8, bw), a2, 0, 0, 0); }
#pragma unroll
            for (int i = 0; i < 4; ++i) O2[(4 * fq + i) * 68 + 16 * wave + fr] = a2[i]; }
        __syncthreads();
        if (wave == 0) { const int row = lane >> 2, c0 = (lane & 3) * 16; float v[16]; float ss = 0.f;
#pragma unroll
            for (int e = 0; e < 16; ++e) { v[e] = O2[row * 68 + c0 + e]; ss += v[e] * v[e]; }
            ss += __shfl_xor(ss, 1); ss += __shfl_xor(ss, 2);
            const float rs = __builtin_amdgcn_rsqf(ss * (1.f / 64.f) + EPS); const float* gn = FIN(I_NKCN) + L * 64 + c0;
            const int n = n0 + row; const bool dead = n >= 127;
            v4u w0, w1; float o[16];
#pragma unroll
            for (int e = 0; e < 16; ++e) { o[e] = kv ? v[e] : v[e] * rs * gn[e]; if (dead) o[e] = 0.f; }
            w0.x = pk2(o[0], o[1]); w0.y = pk2(o[2], o[3]); w0.z = pk2(o[4], o[5]); w0.w = pk2(o[6], o[7]); w1.x = pk2(o[8], o[9]); w1.y = pk2(o[10], o[11]); w1.z = pk2(o[12], o[13]); w1.w = pk2(o[14], o[15]);
            const int tl = n >> 6, rr = n & 63;
            if (kv) { bf16* dstp = F_VC + (size_t)(b * 2 + tl) * 4096 + vimg_off(rr, c0); *(v4u*)dstp = w0; *(v4u*)(dstp + 8) = w1; }
            else { bf16* dstp = F_KC + (size_t)(b * 2 + tl) * 4096; *(v4u*)(dstp + kimg_off(rr, c0)) = w0; *(v4u*)(dstp + kimg_off(rr, c0 + 8)) = w1; } }
        __syncthreads();
    }
}

#ifndef PROBE_ATT
#define PROBE_ATT 0
#endif
namespace att {
constexpr int STG = 32768;
constexpr int L_STG = 0, L_IA = 65536, IAB = 4 * 64 * 33 * 4, L_IB = L_IA + IAB, L_SC = L_IB + IAB, L_SEL = L_SC + 64 * 33 * 4, L_UNI = L_SEL + 256, L_WSF = L_UNI + 256, L_END = L_WSF + NWAVES * 256;
static_assert(L_END <= MISC_OFF, "attention LDS map");
constexpr int OSTP = 264;
#define ATT_BAR() asm volatile("s_waitcnt vmcnt(0) lgkmcnt(0)\n\ts_barrier" ::: "memory")
#define ATT_LBAR() asm volatile("s_waitcnt lgkmcnt(0)\n\ts_barrier" ::: "memory")
__device__ __forceinline__ int crow(int r, int hi) { return (r & 3) + 8 * (r >> 2) + 4 * hi; }
__device__ __forceinline__ float pair_max(float v) { auto rr = __builtin_amdgcn_permlane32_swap(__float_as_uint(v), __float_as_uint(v), false, false); return fmaxf(__uint_as_float(rr[0]), __uint_as_float(rr[1])); }
__device__ __forceinline__ float pair_sum(float v) { auto rr = __builtin_amdgcn_permlane32_swap(__float_as_uint(v), __float_as_uint(v), false, false); return __uint_as_float(rr[0]) + __uint_as_float(rr[1]); }
__device__ __forceinline__ void dma_tile(const bf16* tile, LAS unsigned char* slot, int wave, int lane) {
    __builtin_amdgcn_global_load_lds((const unsigned*)(tile + wave * 512 + lane * 8), (LAS unsigned*)(slot + wave * 1024), 16, 0, 0); }
__device__ __forceinline__ void qk_tile(f32x16& p0, f32x16& p1, const LAS unsigned char* kslot, const bf16x8 (&qr)[4], int r32, int hi) {
    const LAS unsigned char* kp = kslot + hi * 1024 + r32 * 16;
    p0 = (f32x16){}; p1 = (f32x16){};
#pragma unroll
    for (int d0 = 0; d0 < 4; ++d0) { const bf16x8 b0 = *(const LAS bf16x8*)(kp + d0 * 2048), b1 = *(const LAS bf16x8*)(kp + d0 * 2048 + 512);
        p0 = __builtin_amdgcn_mfma_f32_32x32x16_bf16(b0, qr[d0], p0, 0, 0, 0); p1 = __builtin_amdgcn_mfma_f32_32x32x16_bf16(b1, qr[d0], p1, 0, 0, 0); }
}
__device__ __forceinline__ v4i16_t vtr(const LAS unsigned char* p) { return __builtin_amdgcn_ds_read_tr16_b64_v4i16((LAS v4i16_t*)p); }
__device__ __forceinline__ void pv_tile(f32x16& o0, f32x16& o1, const LAS unsigned char* vslot, const v4u (&pw)[4], int lane, int hi) {
    const unsigned vb = (unsigned)(uintptr_t)(vslot + ((lane >> 4) & 1) * 32 + (lane & 3) * 8 + (4 * hi + ((lane & 15) >> 2)) * 64);
    v4i16_t a0[4], a1[4], b0[4], b1[4];
#pragma unroll
    for (int s_ = 0; s_ < 4; ++s_) {
        asm volatile("ds_read_b64_tr_b16 %0, %1 offset:%c2" : "=&v"(a0[s_]) : "v"(vb), "i"(s_ * 1024) : "memory");
        asm volatile("ds_read_b64_tr_b16 %0, %1 offset:%c2" : "=&v"(a1[s_]) : "v"(vb), "i"(s_ * 1024 + 512) : "memory");
        asm volatile("ds_read_b64_tr_b16 %0, %1 offset:%c2" : "=&v"(b0[s_]) : "v"(vb), "i"(4096 + s_ * 1024) : "memory");
        asm volatile("ds_read_b64_tr_b16 %0, %1 offset:%c2" : "=&v"(b1[s_]) : "v"(vb), "i"(4096 + s_ * 1024 + 512) : "memory"); }
#define PV_STEP(s_, N) do { asm volatile("s_waitcnt lgkmcnt(" #N ")" : "+v"(a0[s_]), "+v"(a1[s_]), "+v"(b0[s_]), "+v"(b1[s_]) :: "memory"); \
        const bf16x8 v0 = (bf16x8){a0[s_][0], a0[s_][1], a0[s_][2], a0[s_][3], a1[s_][0], a1[s_][1], a1[s_][2], a1[s_][3]}, v1 = (bf16x8){b0[s_][0], b0[s_][1], b0[s_][2], b0[s_][3], b1[s_][0], b1[s_][1], b1[s_][2], b1[s_][3]}; \
        const bf16x8 pa = __builtin_bit_cast(bf16x8, pw[s_]); \
        o0 = __builtin_amdgcn_mfma_f32_32x32x16_bf16(pa, v0, o0, 0, 0, 0); o1 = __builtin_amdgcn_mfma_f32_32x32x16_bf16(pa, v1, o1, 0, 0, 0); } while (0)
    PV_STEP(0, 12); PV_STEP(1, 8); PV_STEP(2, 4); PV_STEP(3, 0);
#undef PV_STEP
}
__device__ __forceinline__ void pack_p(v4u (&pw)[4], const f32x16& p0, const f32x16& p1) {
    pw[0] = (v4u){pk2(p0[0], p0[1]), pk2(p0[2], p0[3]), pk2(p0[4], p0[5]), pk2(p0[6], p0[7])};
    pw[1] = (v4u){pk2(p0[8], p0[9]), pk2(p0[10], p0[11]), pk2(p0[12], p0[13]), pk2(p0[14], p0[15])};
    pw[2] = (v4u){pk2(p1[0], p1[1]), pk2(p1[2], p1[3]), pk2(p1[4], p1[5]), pk2(p1[6], p1[7])};
    pw[3] = (v4u){pk2(p1[8], p1[9]), pk2(p1[10], p1[11]), pk2(p1[12], p1[13]), pk2(p1[14], p1[15])};
}
__device__ __forceinline__ void softmax_step(float& m, float& l, f32x16& o0, f32x16& o1, f32x16& p0, f32x16& p1, v4u (&pw)[4], LAS float* wsf, int r32, int hi) {
    float mt = fmaxf(p0[0], p1[0]);
#pragma unroll
    for (int r = 1; r < 16; ++r) mt = fmaxf(mt, fmaxf(p0[r], p1[r]));
    mt = pair_max(mt);
    if (__any(mt > m + 8.0f)) {
        const float mn = fmaxf(m, mt);
        const float al = __builtin_amdgcn_exp2f(m - mn); l *= al; m = mn;
        if (hi == 0) wsf[r32] = al;
        f32x4 a[4];
#pragma unroll
        for (int g = 0; g < 4; ++g) a[g] = *(const LAS f32x4*)(wsf + 8 * g + 4 * hi);
#pragma unroll
        for (int r = 0; r < 16; ++r) { o0[r] *= a[r >> 2][r & 3]; o1[r] *= a[r >> 2][r & 3]; }
    }
    float rs = 0.f;
#pragma unroll
    for (int r = 0; r < 16; ++r) { p0[r] = __builtin_amdgcn_exp2f(p0[r] - m); p1[r] = __builtin_amdgcn_exp2f(p1[r] - m); rs += p0[r] + p1[r]; }
    l += rs;
    pack_p(pw, p0, p1);
}
__device__ __forceinline__ void scale_rows(f32x16& a0, f32x16& a1, const f32x16& o0, const f32x16& o1, float fac, LAS float* wsf, int r32, int hi) {
    if (hi == 0) wsf[32 + r32] = fac;
    f32x4 f[4];
#pragma unroll
    for (int g = 0; g < 4; ++g) f[g] = *(const LAS f32x4*)(wsf + 32 + 8 * g + 4 * hi);
#pragma unroll
    for (int r = 0; r < 16; ++r) { a0[r] += o0[r] * f[r >> 2][r & 3]; a1[r] += o1[r] * f[r >> 2][r & 3]; }
}
template <int MODE>
__device__ __forceinline__ void run_branch(unsigned tiles, const bf16* Kg  , const bf16* Vg, int kvsel, unsigned selm, int tq, const bf16x8 (&qr)[4],
                                           float& m, float& l, f32x16& o0, f32x16& o1, LAS unsigned char* lds, LAS float* wsf, int wave, int lane) {
    constexpr int NKV = MODE == 2 ? 2 : 1, SLOT = 16384 * NKV, NS = MODE == 2 ? 4 : 8;
    const int r32 = lane & 31, hi = lane >> 5;
    m = -1e30f; l = 0.f; o0 = (f32x16){}; o1 = (f32x16){};
    unsigned remc = (unsigned)__builtin_amdgcn_readfirstlane((int)tiles), remi = remc;
    int nleft = __builtin_popcount(remc), slot_i = 0, slot_c = 0;
    ATT_LBAR();
#define ATT_ISSUE() do { const int ji = __builtin_ctz(remi); remi &= remi - 1; LAS unsigned char* st_ = lds + L_STG + slot_i * SLOT; slot_i = (slot_i + 1) & (NS - 1); \
        _Pragma("unroll") for (int g = 0; g < NKV; ++g) { dma_tile(Kg + (size_t)(g * 512 + ji) * 4096, st_ + g * 8192, wave, lane); dma_tile(Vg + (size_t)(g * 512 + ji) * 4096, st_ + NKV * 8192 + g * 8192, wave, lane); } } while (0)
#define ATT_WB(n) asm volatile("s_waitcnt vmcnt(" #n ") lgkmcnt(0)\n\ts_barrier" ::: "memory")
#pragma nounroll
    for (int k = 0; k < NS - 1; ++k) if (remi) ATT_ISSUE();
    for (;;) {
        const int pend = (nleft - 1 < NS - 2 ? nleft - 1 : NS - 2) * NKV;
        switch (pend) { case 0: ATT_WB(0); break; case 1: ATT_WB(2); break; case 2: ATT_WB(4); break; case 3: ATT_WB(6); break; case 4: ATT_WB(8); break; case 5: ATT_WB(10); break; default: ATT_WB(12); break; }
        if (remi) ATT_ISSUE();
        const int j = __builtin_ctz(remc); remc &= remc - 1; --nleft;
        const LAS unsigned char* st = lds + L_STG + slot_c * SLOT; slot_c = (slot_c + 1) & (NS - 1);
        f32x16 p0, p1; qk_tile(p0, p1, st + kvsel * 8192, qr, r32, hi);
        const int kb = 64 * j + 4 * hi; const bool sel = MODE != 0 || ((selm >> j) & 1u);
        constexpr int W = MODE == 1 ? 512 : 128;
        const int curt = __builtin_amdgcn_readfirstlane(tq) >> 6;
        const bool edge = MODE == 3 || j == curt || (MODE != 0 && j + W / 64 == curt);
        if (edge) {
#pragma unroll
            for (int r = 0; r < 16; ++r) { const int kp = kb + (r & 3) + 8 * (r >> 2);
                bool v0, v1;
                if (MODE == 0) { v0 = sel && kp <= tq; v1 = sel && kp + 32 <= tq; }
                else if (MODE == 3) { v0 = 16 * kp + 31 <= tq; v1 = 16 * (kp + 32) + 31 <= tq; }
                else { v0 = kp <= tq && kp + W > tq; v1 = kp + 32 <= tq && kp + 32 + W > tq; }
                p0[r] = v0 ? p0[r] : -INFINITY; p1[r] = v1 ? p1[r] : -INFINITY; }
        } else if (MODE == 0) {
#pragma unroll
            for (int r = 0; r < 16; ++r) { p0[r] = sel ? p0[r] : -INFINITY; p1[r] = sel ? p1[r] : -INFINITY; }
        }
        v4u pw[4]; softmax_step(m, l, o0, o1, p0, p1, pw, wsf, r32, hi);
        pv_tile(o0, o1, st + NKV * 8192 + kvsel * 8192, pw, lane, hi);
        if (nleft == 0) break;
    }
#undef ATT_ISSUE
#undef ATT_WB
}
__device__ __forceinline__ void stage_norm_store(const f32x16& o0, const f32x16& o1, bf16* ynb  , LAS unsigned char* lds, int wave, int lane) {
    const int r32 = lane & 31, hi = lane >> 5, h = wave & 3, th = wave >> 2;
    LAS bf16* OST = (LAS bf16*)(lds + L_STG);
    ATT_LBAR();
#pragma unroll
    for (int r = 0; r < 16; ++r) { LAS bf16* p = OST + (32 * th + crow(r, hi)) * OSTP + h * 64 + r32;
        p[0] = (bf16)(pk2(o0[r], 0.f) & 0xffffu); p[32] = (bf16)(pk2(o1[r], 0.f) & 0xffffu); }
    ATT_LBAR();
    f32x4 vv[8]; float ssn[8];
#pragma unroll
    for (int i = 0; i < 8; ++i) { const u32x2 w = *(const LAS u32x2*)(OST + (8 * wave + i) * OSTP + 4 * lane); vv[i] = (f32x4){bflo(w.x), bfhi(w.x), bflo(w.y), bfhi(w.y)}; ssn[i] = sq4(vv[i]); }
#pragma unroll
    for (int i = 0; i < 8; ++i) ssn[i] = wave_sum(ssn[i]);
#pragma unroll
    for (int i = 0; i < 8; ++i) st4bf(ynb + (size_t)(8 * wave + i) * D + 4 * lane, vv[i] * __builtin_amdgcn_rsqf(ssn[i] * (1.f / 256.f) + EPS));
}
__device__ __forceinline__ void attn_unit(Frame& F, int L, int b, int qt) {
    LAS unsigned char* lds = F.lds;
    int tid = F.tid; asm volatile("" : "+v"(tid));
    const int wave = F.wave, lane = tid & 63, r32 = lane & 31, hi = lane >> 5, h = wave & 3, th = wave >> 2;
    const int t0 = qt * 64, cur = qt, qrow = 32 * th + r32, tq = t0 + qrow;
    const size_t mrow = (size_t)b * T + tq;
    LAS float* wsf = (LAS float*)(lds + L_WSF) + wave * 64;
    LAS float* IA = (LAS float*)(lds + L_IA); LAS float* IB = (LAS float*)(lds + L_IB); LAS float* SC = (LAS float*)(lds + L_SC);
    LAS unsigned* SEL = (LAS unsigned*)(lds + L_SEL); LAS unsigned* UNI = (LAS unsigned*)(lds + L_UNI);
    const size_t tb = (size_t)b * 32 * 4096;
    bf16x8 qr[4];
#pragma unroll
    for (int d0 = 0; d0 < 4; ++d0) qr[d0] = *(const bf16x8*)(F_QA + mrow * 256 + h * 64 + d0 * 16 + hi * 8);
    const float* gp = F_GATES + mrow * 12 + h * 3; const float g0 = gp[0], g1 = gp[1], g2 = gp[2];
    f32x16 ot0 = (f32x16){}, ot1 = (f32x16){};
    float mb, lb; f32x16 ob0, ob1;
    for (int rep = 0; rep < ((PROBE_ATT & 4) ? 2 : 1); ++rep) {
        if (rep) { ATT_LBAR(); ot0 = (f32x16){}; ot1 = (f32x16){}; }
        if (tid == 0) UNI[0] = 0u;
        run_branch<3>(3u, F_KC + (size_t)b * 2 * 4096, F_VC + (size_t)b * 2 * 4096, 0, 0u, tq, qr, mb, lb, ob0, ob1, lds, wsf, wave, lane);
        const float lt = pair_sum(lb); const float inv = lt > 0.f ? 1.0f / lt : 0.f;
        scale_rows(ot0, ot1, ob0, ob1, g0 * inv, wsf, r32, hi);
        LAS float* ia = IA + (h * 64 + qrow) * 33; LAS float* ib = IB + (h * 64 + qrow) * 33;
#pragma unroll
        for (int tl = 0; tl < 2; ++tl) { f32x16 p0, p1; qk_tile(p0, p1, lds + L_STG + tl * 16384, qr, r32, hi);
#pragma unroll
            for (int r = 0; r < 16; ++r) { const int n = 64 * tl + crow(r, hi);
                p0[r] = 16 * n + 31 <= tq ? __builtin_amdgcn_exp2f(p0[r] - mb) * inv : 0.f; p1[r] = 16 * (n + 32) + 31 <= tq ? __builtin_amdgcn_exp2f(p1[r] - mb) * inv : 0.f; }
#pragma unroll
            for (int G = 0; G < 4; ++G) {
                ia[hi + 2 * (G + 8 * tl)] = (p0[4 * G] + p0[4 * G + 1]) + (p0[4 * G + 2] + p0[4 * G + 3]); ib[hi + 2 * (G + 8 * tl)] = p0[4 * G + 3];
                ia[hi + 2 * (G + 4 + 8 * tl)] = (p1[4 * G] + p1[4 * G + 1]) + (p1[4 * G + 2] + p1[4 * G + 3]); ib[hi + 2 * (G + 4 + 8 * tl)] = p1[4 * G + 3]; } }
        ATT_LBAR();
        const int q = tid >> 3, jg = tid & 7, tqq = t0 + q;
#pragma unroll
        for (int i = 0; i < 4; ++i) { const int j = 4 * jg + i; float imp = 0.f;
#pragma unroll
            for (int hh = 0; hh < 4; ++hh) { imp += IA[(hh * 64 + q) * 33 + j]; if (j > 0) imp += IB[(hh * 64 + q) * 33 + j - 1]; }
            const bool forced = j == 0 || j == cur || j == cur - 1, future = j * 64 > tqq;
            SC[q * 33 + j] = forced ? 1e4f : (future ? -1.0f : imp); }
        ATT_LBAR();
        unsigned bits = 0u;
#pragma unroll
        for (int i = 0; i < 4; ++i) { const int j = 4 * jg + i; const float sj = SC[q * 33 + j]; int rank = 0;
#pragma unroll 8
            for (int k = 0; k < 32; ++k) { const float sk = SC[q * 33 + k]; rank += (sk > sj || (sk == sj && k < j)) ? 1 : 0; }
            if (rank < 8) bits |= 1u << j; }
        bits |= __shfl_xor(bits, 1); bits |= __shfl_xor(bits, 2); bits |= __shfl_xor(bits, 4);
        if (jg == 0) { SEL[q] = bits; atomicOr((unsigned*)UNI, bits); }
        ATT_LBAR();
    }
    { const unsigned selm = SEL[qrow]; const unsigned uni = UNI[0] & ((2u << cur) - 1u);
      if (PROBE_ATT & 1) run_branch<0>(uni, F_KSI + tb, F_VSI + tb, 0, selm, tq, qr, mb, lb, ob0, ob1, lds, wsf, wave, lane);
      run_branch<0>(uni, F_KSI + tb, F_VSI + tb, 0, selm, tq, qr, mb, lb, ob0, ob1, lds, wsf, wave, lane);
      const float lt = pair_sum(lb); scale_rows(ot0, ot1, ob0, ob1, g1 / lt, wsf, r32, hi); }
    { const int lo = cur >= 8 ? cur - 8 : 0; const unsigned tiles = ((2u << cur) - 1u) & ~((1u << lo) - 1u);
      if (PROBE_ATT & 2) run_branch<1>(tiles, F_KWI + tb, F_VWI + tb, 0, 0u, tq, qr, mb, lb, ob0, ob1, lds, wsf, wave, lane);
      run_branch<1>(tiles, F_KWI + tb, F_VWI + tb, 0, 0u, tq, qr, mb, lb, ob0, ob1, lds, wsf, wave, lane);
      const float lt = pair_sum(lb); scale_rows(ot0, ot1, ob0, ob1, g2 / lt, wsf, r32, hi); }
    stage_norm_store(ot0, ot1, F_YN + ((size_t)b * T + t0) * D + 0, lds, wave, lane);
    for (int rep = 0; rep < ((PROBE_ATT & 16) ? 2 : 1); ++rep) {
#pragma unroll
        for (int d0 = 0; d0 < 4; ++d0) qr[d0] = *(const bf16x8*)(F_QC + mrow * 256 + h * 64 + d0 * 16 + hi * 8);
        const int lo = cur >= 2 ? cur - 2 : 0; const unsigned tiles = ((2u << cur) - 1u) & ~((1u << lo) - 1u);
        run_branch<2>(tiles, F_CKI + tb, F_CVI + tb, h >> 1, 0u, tq, qr, mb, lb, ob0, ob1, lds, wsf, wave, lane);
        const float sink2 = FIN(I_SINK)[L * 4 + h] * LOG2E;
        const float mf = fmaxf(mb, sink2), sc = __builtin_amdgcn_exp2f(mb - mf);
        const float lt = pair_sum(lb) * sc + __builtin_amdgcn_exp2f(sink2 - mf);
        ot0 = (f32x16){}; ot1 = (f32x16){};
        scale_rows(ot0, ot1, ob0, ob1, sc / lt, wsf, r32, hi);
        stage_norm_store(ot0, ot1, F_YN + ((size_t)b * T + t0) * D + 512, lds, wave, lane);
    }
}
__device__ __forceinline__ void attn_phase(Frame& F, int L) {
    for (int w = F.vcu; w < 256; w += F.G) { const int b = w >> 4, i = w & 15;
#pragma nounroll
        for (int u2 = 0; u2 < 2; ++u2) attn_unit(F, L, b, u2 ? 31 - i : i); }
    ATT_LBAR();
}
}

__global__ void __launch_bounds__(NWAVES * 64, 2) fwd(Args args) {
    extern __shared__ __attribute__((aligned(16))) unsigned char lds[];
    Frame F;
    F.lds = (LAS unsigned char*)lds;
    F.tid = threadIdx.x; F.lane = F.tid & 63; F.wave = __builtin_amdgcn_readfirstlane(F.tid >> 6);
    F.G = gridDim.x; { const int bx = blockIdx.x; F.vcu = (F.G % 8 == 0) ? (bx % 8) * (F.G / 8) + bx / 8 : bx; }
    F.a = &args;
    unsigned char* ws = args.ws;
    volatile LAS unsigned* MISC = (volatile LAS unsigned*)(F.lds + MISC_OFF);
    if (F.tid < 64) MISC[F.tid] = 0u;
    __syncthreads();
#define GRID_BAR() do { XcdBarrier b2_ = bar; { unsigned xx_ = b2_.x; asm volatile("" : "+s"(xx_)); b2_.x = xx_; }     \
        xcd_barrier(b2_); if (PROBE_DUP & 1024) xcd_barrier(b2_); __builtin_amdgcn_s_waitcnt(0); } while (0)
    XcdBarrier bar = xcd_barrier_post((unsigned*)(ws + WS_CTL) + CW_BAR, MISC + 8);

#ifndef PH_MASK
#define PH_MASK 127
#endif
#ifndef PROBE_DUP
#define PROBE_DUP 0
#endif
    if (PH_MASK & 1) prologue(F);
    if (PROBE_DUP & 1) prologue(F);
    GRID_BAR();
    for (int s = 0; s < 2 * DEPTH; ++s) {
        const int L = s >> 1, which = s & 1;
        const bool up8 = (UP8_MASK >> s) & 1u, dn8 = (DN8_MASK >> s) & 1u;
        if (PH_MASK & 2) {
            const bf16* wt = (const bf16*)((unsigned char*)F_W13T + (size_t)s * NF1 * D * 2); pg8::StaticOrder S; S.init(M, NF1, F.G, (int)blockIdx.x);
            if (up8) { pg8::Gemm g{(const bf16*)F_X8, wt, M, NF1, D / 2};
                if (PROBE_DUP & 128) { pg8::EpiNull EN{F_GATES}; pg8::gemm_phase<pg8::EpiNull, pg8::StaticOrder, true, true, true>(F.lds, g, S, EN); }
                if (PROBE_DUP & 256) { pg8::EpiNull EN{F_GATES}; pg8::FixedOrder<1> S2; S2.init(M, NF1, F.G, (int)blockIdx.x); pg8::gemm_phase<pg8::EpiNull, pg8::FixedOrder<1>, true, true, true>(F.lds, g, S2, EN); }
                if (PROBE_DUP & 512) { pg8::EpiNull EN{F_GATES}; pg8::FixedOrder<3> S2; S2.init(M, NF1, F.G, (int)blockIdx.x); pg8::gemm_phase<pg8::EpiNull, pg8::FixedOrder<3>, true, true, true>(F.lds, g, S2, EN); }
                if (dn8) { pg8::EpiSwiglu<true> E{(void*)F_ACT, DFF, F_SSQ, 1.0f / W8_SCALE, ACT8_SCALE, F.lds + pg8::STAGE_BYTES, 0, 0, 0}; for (int rep = 0; rep < ((PROBE_DUP & 2) ? 2 : 1); ++rep) pg8::gemm_phase<pg8::EpiSwiglu<true>, pg8::StaticOrder, true, false, true>(F.lds, g, S, E); }
                else if (((UP8_MASK & ~DN8_MASK) & 0xFu) != 0u) { pg8::EpiSwiglu<false> E{(void*)F_ACT, DFF, F_SSQ, 1.0f / W8_SCALE, 1.0f, F.lds + pg8::STAGE_BYTES, 0, 0, 0}; for (int rep = 0; rep < ((PROBE_DUP & 2) ? 2 : 1); ++rep) pg8::gemm_phase<pg8::EpiSwiglu<false>, pg8::StaticOrder, true, false, true>(F.lds, g, S, E); } }
            else { pg8::Gemm g{F_XB, wt, M, NF1, D};
                if (dn8) { if (((~UP8_MASK & DN8_MASK) & 0xFu) != 0u) { pg8::EpiSwiglu<true> E{(void*)F_ACT, DFF, F_SSQ, 1.0f, ACT8_SCALE, F.lds + pg8::STAGE_BYTES, 0, 0, 0}; for (int rep = 0; rep < ((PROBE_DUP & 2) ? 2 : 1); ++rep) pg8::gemm_phase<pg8::EpiSwiglu<true>, pg8::StaticOrder, true, true, false>(F.lds, g, S, E); } }
                else if (((~UP8_MASK & ~DN8_MASK) & 0xFu) != 0u) { pg8::EpiSwiglu<false> E{(void*)F_ACT, DFF, F_SSQ, 1.0f, 1.0f, F.lds + pg8::STAGE_BYTES, 0, 0, 0}; for (int rep = 0; rep < ((PROBE_DUP & 2) ? 2 : 1); ++rep) pg8::gemm_phase<pg8::EpiSwiglu<false>, pg8::StaticOrder, true, true, false>(F.lds, g, S, E); } }
        }
        GRID_BAR();
        if (PH_MASK & 4) {
            const bf16* wt = (const bf16*)((unsigned char*)F_W2T + (size_t)s * D * DFF * 2); pg8::StaticOrder S; S.init(M, D, F.G, (int)blockIdx.x);
            const int last = (s + 1 == 2 * DEPTH) ? 1 : 0, w8 = ((s & 1) && !last && ((UP8_MASK >> (s + 1)) & 1u)) ? 1 : 0;
            if (dn8) { if (DN8_MASK & 0xFu) { pg8::Gemm g{F_ACT, wt, M, D, DFF / 2}; pg8::EpiRes E{F_XB, F_SSQ, 1, F_X8, FOUT, w8, last}; pg8::gemm_phase<pg8::EpiRes, pg8::StaticOrder, true, false, true>(F.lds, g, S, E); } }
            else if ((~DN8_MASK) & 0xFu) { pg8::Gemm g{F_ACT, wt, M, D, DFF}; pg8::EpiRes E{F_XB, F_SSQ, 0, F_X8, FOUT, w8, last}; pg8::gemm_phase<pg8::EpiRes, pg8::StaticOrder, true, true, false>(F.lds, g, S, E); }
        }
        if (s + 1 < 2 * DEPTH) GRID_BAR();
        if (which == 0) {
            if (PH_MASK & 8) {
                pg8::Gemm g{F_XB, F_WINT + (size_t)L * NU * D, M, NU, D}; pg8::StaticOrder S; S.init(M, NU, F.G, (int)blockIdx.x);
                pg8::EpiScaleBf16 E{F_U, NU, F_SSQ, F.lds + pg8::STAGE_BYTES, 0, 0, 0};
                for (int rep = 0; rep < ((PROBE_DUP & 8) ? 2 : 1); ++rep) pg8::gemm_phase<pg8::EpiScaleBf16, pg8::StaticOrder, true, true>(F.lds, g, S, E);
            }
            GRID_BAR();
            if (PH_MASK & 16) prep_phase(F, L);
            if (PROBE_DUP & 16) prep_phase(F, L);
            GRID_BAR();
            if (PH_MASK & 32) att::attn_phase(F, L);
            if (PROBE_DUP & 32) att::attn_phase(F, L);
            GRID_BAR();
            if (PH_MASK & 64) {
                pg8::Gemm g{F_YN, F_WOUTT + (size_t)L * D * D, M, D, D}; pg8::StaticOrder S; S.init(M, D, F.G, (int)blockIdx.x);
                pg8::EpiRes E{F_XB, F_SSQ, 2, F_X8, FOUT, (int)((UP8_MASK >> (2 * L + 1)) & 1u), 0};
                pg8::gemm_phase<pg8::EpiRes, pg8::StaticOrder, true, true>(F.lds, g, S, E);
            }
            GRID_BAR();
        }
    }
}

extern "C" void kernel_launch(void* const* d_in, const int* in_sizes, int n_in, void* d_out, int out_size, void* d_ws, size_t ws_size, hipStream_t stream) {
    static int grid = 0;
    if (grid == 0) {
        if (n_in != 29 || in_sizes[0] != M * D || out_size != M * D || ws_size < WS_END) { fprintf(stderr, "kernel_launch: unexpected shapes (n_in %d, in0 %d, out %d, ws %zu); nothing launched\n", n_in, n_in > 0 ? in_sizes[0] : -1, out_size, ws_size); grid = -1; return; }
        int dev = 0, cus = 0, per_cu = 0;
        if (hipGetDevice(&dev) != hipSuccess || hipDeviceGetAttribute(&cus, hipDeviceAttributeMultiprocessorCount, dev) != hipSuccess) { grid = -1; return; }
        if (hipFuncSetAttribute((const void*)fwd, hipFuncAttributeMaxDynamicSharedMemorySize, LDS_BYTES) != hipSuccess) { fprintf(stderr, "kernel_launch: hipFuncSetAttribute failed\n"); grid = -1; return; }
        if (hipOccupancyMaxActiveBlocksPerMultiprocessor(&per_cu, (const void*)fwd, NWAVES * 64, LDS_BYTES) != hipSuccess || per_cu < 1) fprintf(stderr, "kernel_launch: occupancy query says %d\n", per_cu);
        (void)hipGetLastError();
        grid = cus;
    }
    if (grid < 0) return;
    if (hipMemsetAsync((char*)d_ws + WS_CTL, 0, CTL_ZERO_BYTES, stream) != hipSuccess) return;
    Args a{};
    for (int i = 0; i < 29; ++i) a.in[i] = (const float*)d_in[i];
    a.out = (float*)d_out; a.ws = (unsigned char*)d_ws;
    hipLaunchKernelGGL(fwd, dim3(grid), dim3(NWAVES * 64), LDS_BYTES, stream, a);
}
```

```cpp
#include <hip/hip_runtime.h>
#include <cstdio>
#include <cstdint>
struct KArgs { const float* in[29]; float* out; unsigned char* ws; };
namespace pg8 {
#define PG8_LAS __attribute__((address_space(3)))
typedef unsigned short bf16_t;
typedef short bf16x8 __attribute__((ext_vector_type(8)));
typedef float f32x4 __attribute__((ext_vector_type(4)));
typedef unsigned u32x4 __attribute__((ext_vector_type(4)));
constexpr int BM = 256, BK = 64, HALF = 128, HTB = HALF * BK * 2  , STAGE_BYTES = 8 * HTB, NXCD = 8, WGM = 8;

__host__ __device__ __forceinline__ int lds_byte(int r, int c) { const int st = (r >> 4) * 2 + (c >> 5), rr = r & 15, cc = c & 31, ob = rr * 64 + cc * 2; return st * 1024 + (ob ^ (((ob >> 9) & 1) << 5)); }
__host__ __device__ __forceinline__ void stage_rc(int b, int& R, int& C) { const int st = b / 1024, sb = b % 1024, swz = sb ^ (((sb >> 9) & 1) << 5); R = (st >> 1) * 16 + swz / 64; C = (st & 1) * 32 + (swz % 64) / 2; }
__host__ __device__ __forceinline__ int perm32(int rho) { const int n = rho >> 4, i = rho & 15; return 8 * (i >> 2) + 4 * n + (i & 3); }

struct Unit { int pm, pn; };
struct Gemm { const bf16_t* A; const bf16_t* Bt; int M, N, K; };

struct StaticOrder {
    int nM, nN, nwg, G, c;
    __host__ __device__ void init(int M, int N, int G_, int c_) { nM = M / BM; nN = N / BM; nwg = nM * nN; G = G_; c = c_; }
    __host__ __device__ bool next(int i, Unit& u) const {
        const long L = (long)i * G + c; if (L >= nwg) return false;
        int wgid = (int)L; { const int q = nwg / NXCD, r = nwg % NXCD, xcd = wgid % NXCD, off = wgid / NXCD; wgid = (xcd < r ? xcd * (q + 1) : r * (q + 1) + (xcd - r) * q) + off; }
        const int nig = WGM * nN, gid = wgid / nig, fm = gid * WGM, gsz = (nM - fm) < WGM ? (nM - fm) : WGM;
        u.pm = fm + ((wgid % nig) % gsz); u.pn = (wgid % nig) / gsz; return true;
    }
    __device__ __forceinline__ void a_ready(const Unit&) const {}
    __device__ __forceinline__ void done(const Unit&) const {}
};

__device__ __forceinline__ unsigned cvt_pk_bf16(float lo, float hi) { unsigned r; asm volatile("v_cvt_pk_bf16_f32 %0, %1, %2" : "=v"(r) : "v"(lo), "v"(hi)); return r; }

typedef unsigned u32x2 __attribute__((ext_vector_type(2)));
typedef int i32x4 __attribute__((ext_vector_type(4)));
typedef int i32x8 __attribute__((ext_vector_type(8)));
#ifndef MFMA8_SCALE
#define MFMA8_SCALE 1
#endif
__device__ __forceinline__ i32x8 cat8(bf16x8 a, bf16x8 b) { return __builtin_shufflevector(__builtin_bit_cast(i32x4, a), __builtin_bit_cast(i32x4, b), 0, 1, 2, 3, 4, 5, 6, 7); }
__device__ __forceinline__ void mfma8(f32x4& acc, const i32x8& b, const i32x8& a, int sc) {
#if MFMA8_SCALE
    asm volatile("v_mfma_scale_f32_16x16x128_f8f6f4 %0, %1, %2, %0, %3, %3 op_sel_hi:[0,0,0]" : "+v"(acc) : "v"(b), "v"(a), "v"(sc));
#else
    asm volatile("v_mfma_f32_16x16x128_f8f6f4 %0, %1, %2, %0" : "+v"(acc) : "v"(b), "v"(a));
#endif
}
__device__ __forceinline__ unsigned pk4_fp8(float a, float b, float c, float d) { int w = 0; w = __builtin_amdgcn_cvt_pk_fp8_f32(a, b, w, false); w = __builtin_amdgcn_cvt_pk_fp8_f32(c, d, w, true); return (unsigned)w; }
__device__ __forceinline__ unsigned pkbf(float lo, float hi) { typedef float f2_t __attribute__((ext_vector_type(2))); typedef __bf16 b2_t __attribute__((ext_vector_type(2))); f2_t v = {lo, hi}; b2_t b = __builtin_convertvector(v, b2_t); return __builtin_bit_cast(unsigned, b); }
__device__ __forceinline__ float bf_lo(unsigned u) { return __builtin_bit_cast(float, u << 16); }
__device__ __forceinline__ float bf_hi(unsigned u) { return __builtin_bit_cast(float, u & 0xffff0000u); }
__device__ __forceinline__ float swap32_add(float v) { auto rr = __builtin_amdgcn_permlane32_swap(__float_as_uint(v), __float_as_uint(v), false, false); return __uint_as_float(rr[0]) + __uint_as_float(rr[1]); }
__device__ __forceinline__ void fill_rstd_tbl(PG8_LAS unsigned char* tblp, const float* ssq, int pm, int wid, int lane) {
    const int r = wid * 32 + (lane >> 1), hf = lane & 1; const float* p = ssq + (size_t)(pm * BM + r) * 16 + 8 * hf;
    const f32x4 a = *(const f32x4*)p, b = *(const f32x4*)(p + 4);
    float s = ((a[0] + a[1]) + (a[2] + a[3])) + ((b[0] + b[1]) + (b[2] + b[3]));
    s += __builtin_bit_cast(float, __builtin_amdgcn_update_dpp(0, __builtin_bit_cast(int, s), 0xB1, 0xf, 0xf, true));
    if (hf == 0) ((PG8_LAS float*)tblp)[r] = __builtin_amdgcn_rsqf(s * (1.0f / 1024.0f) + 1e-6f);
}
__device__ __forceinline__ void rows_rstd(float (&rs)[2][4], const PG8_LAS unsigned char* tblp, int wr, int fr, float scale) {
#pragma unroll
    for (int ai = 0; ai < 2; ++ai)
#pragma unroll
        for (int m = 0; m < 4; ++m) rs[ai][m] = ((const PG8_LAS float*)tblp)[ai * HALF + wr * 64 + m * 16 + fr] * scale;
}
template <bool F8> struct EpiSwiglu {
    static constexpr bool PERM = true, AFTER_DRAIN = false, ROW_RSTD = true;
    void* O; int ldc; const float* ssq; float insc, oscale; PG8_LAS unsigned char* tbl; mutable int pmA, pmB, pmC;
    __device__ __forceinline__ void set_panels(int a, int b, int c) const { pmA = a; pmB = b; pmC = c; }
    __device__ __forceinline__ void fill_rstd(PG8_LAS unsigned char* t, int pm, int wid, int lane) const { fill_rstd_tbl(t, ssq, pm, wid, lane); }
    __device__ __forceinline__ void operator()(const f32x4 (&acc)[2][2][4][2], const Unit& u, int wr, int wc, int fr_, int fq_) const {
        int tl_ = threadIdx.x; asm volatile("" : "+v"(tl_)); const int fr = tl_ & 15, fq = (tl_ >> 4) & 3; (void)fr_; (void)fq_;
        const int row0 = u.pm * BM + wr * 64 + fr, col0 = u.pn * HALF + wc * 32 + 8 * fq;
        float rsv[2][4]; rows_rstd(rsv, tbl + (u.pm == pmA ? 0 : (u.pm == pmB ? 1024 : (u.pm == pmC ? 2048 : 3072))), wr, fr, insc);
#pragma unroll
        for (int ai = 0; ai < 2; ++ai)
#pragma unroll
            for (int m = 0; m < 4; ++m) { const int row = row0 + ai * HALF + m * 16; const float rs = rsv[ai][m], rsb = rs * (F8 ? oscale : 1.0f); f32x4 ov[2];
#pragma unroll
                for (int n = 0; n < 2; ++n) { const f32x4 tt = acc[ai][0][m][n] * (rs * -1.4426950408889634f), pp = acc[ai][0][m][n] * acc[ai][1][m][n]; f32x4 r;
#pragma unroll
                    for (int e = 0; e < 4; ++e) r[e] = __builtin_amdgcn_rcpf(1.0f + __builtin_amdgcn_exp2f(tt[e]));
                    ov[n] = (pp * (rs * rsb)) * r; }
                const float o[8] = {ov[0][0], ov[0][1], ov[0][2], ov[0][3], ov[1][0], ov[1][1], ov[1][2], ov[1][3]};
                if constexpr (F8) { u32x2 w; w.x = pk4_fp8(o[0], o[1], o[2], o[3]); w.y = pk4_fp8(o[4], o[5], o[6], o[7]);
                    *(u32x2*)((unsigned char*)O + (size_t)row * ldc + col0) = w; }
                else { u32x4 w; w.x = pkbf(o[0], o[1]); w.y = pkbf(o[2], o[3]); w.z = pkbf(o[4], o[5]); w.w = pkbf(o[6], o[7]);
                    *(u32x4*)((bf16_t*)O + (size_t)row * ldc + col0) = w; } }
    }
};
struct EpiScaleBf16 {
    static constexpr bool PERM = true, AFTER_DRAIN = false, ROW_RSTD = true;
    bf16_t* O; int ldc; const float* ssq; PG8_LAS unsigned char* tbl; mutable int pmA, pmB, pmC;
    __device__ __forceinline__ void set_panels(int a, int b, int c) const { pmA = a; pmB = b; pmC = c; }
    __device__ __forceinline__ void fill_rstd(PG8_LAS unsigned char* t, int pm, int wid, int lane) const { fill_rstd_tbl(t, ssq, pm, wid, lane); }
    __device__ __forceinline__ void operator()(const f32x4 (&acc)[2][2][4][2], const Unit& u, int wr, int wc, int fr_, int fq_) const {
        int tl_ = threadIdx.x; asm volatile("" : "+v"(tl_)); const int fr = tl_ & 15, fq = (tl_ >> 4) & 3; (void)fr_; (void)fq_;
        const int row0 = u.pm * BM + wr * 64 + fr, col0 = u.pn * BM + wc * 32 + 8 * fq;
        float rsv[2][4]; rows_rstd(rsv, tbl + (u.pm == pmA ? 0 : (u.pm == pmB ? 1024 : (u.pm == pmC ? 2048 : 3072))), wr, fr, 1.0f);
#pragma unroll
        for (int ai = 0; ai < 2; ++ai)
#pragma unroll
            for (int m = 0; m < 4; ++m) { const int row = row0 + ai * HALF + m * 16; const float rs = rsv[ai][m];
#pragma unroll
                for (int bj = 0; bj < 2; ++bj) { const f32x4 v0 = acc[ai][bj][m][0] * rs, v1 = acc[ai][bj][m][1] * rs;
                    u32x4 w; w.x = pkbf(v0[0], v0[1]); w.y = pkbf(v0[2], v0[3]); w.z = pkbf(v1[0], v1[1]); w.w = pkbf(v1[2], v1[3]);
                    *(u32x4*)(O + (size_t)row * ldc + col0 + bj * HALF) = w; } }
    }
};
struct EpiRes {
    static constexpr bool PERM = false, AFTER_DRAIN = false, ROW_RSTD = false;
    bf16_t* xb; float* ssq; int mode; unsigned char* x8p; float* outp; int w8, fin;
    __device__ __forceinline__ void operator()(const f32x4 (&acc)[2][2][4][2], const Unit& u, int wr, int wc, int fr_, int fq_) const {
        int tl_ = threadIdx.x; asm volatile("" : "+v"(tl_)); const int fr = tl_ & 15, fq = (tl_ >> 4) & 3; (void)fr_; (void)fq_;
        const int row0 = u.pm * BM + wr * 64 + fr, col0 = u.pn * BM + wc * 32 + 4 * fq;
        int md_ = __builtin_amdgcn_readfirstlane(mode), w8_ = __builtin_amdgcn_readfirstlane(w8), fin_ = __builtin_amdgcn_readfirstlane(fin); asm volatile("" : "+s"(md_), "+s"(w8_), "+s"(fin_));
        const float alpha = md_ == 0 ? 0.5f : (md_ == 1 ? 0.5f / 256.0f : 1.0f);
        float* const outf = fin_ ? outp : nullptr; unsigned char* const x8 = w8_ ? x8p : nullptr;
#pragma unroll
        for (int ai = 0; ai < 2; ++ai) { u32x2 old[4][2][2];
#pragma unroll
            for (int m = 0; m < 4; ++m)
#pragma unroll
                for (int bj = 0; bj < 2; ++bj)
#pragma unroll
                    for (int n = 0; n < 2; ++n) old[m][bj][n] = *(const u32x2*)(xb + (size_t)(row0 + ai * HALF + m * 16) * 1024 + col0 + bj * HALF + n * 16);
            float ssv[4];
#pragma unroll
            for (int m = 0; m < 4; ++m) { const int row = row0 + ai * HALF + m * 16; const size_t off = (size_t)row * 1024 + col0; float ss = 0.f;
#pragma unroll
                for (int bj = 0; bj < 2; ++bj)
#pragma unroll
                    for (int n = 0; n < 2; ++n) { const u32x2 ow = old[m][bj][n]; const f32x4 xo = (f32x4){bf_lo(ow.x), bf_hi(ow.x), bf_lo(ow.y), bf_hi(ow.y)}; const f32x4 xn = xo + acc[ai][bj][m][n] * alpha;
                        if (outf) *(f32x4*)(outf + off + bj * HALF + n * 16) = xn;
                        else { ss += (xn[0] * xn[0] + xn[1] * xn[1]) + (xn[2] * xn[2] + xn[3] * xn[3]);
                            u32x2 w; w.x = pkbf(xn[0], xn[1]); w.y = pkbf(xn[2], xn[3]); *(u32x2*)(xb + off + bj * HALF + n * 16) = w;
                            if (x8) *(unsigned*)(x8 + off + bj * HALF + n * 16) = pk4_fp8(xn[0], xn[1], xn[2], xn[3]); } }
                ssv[m] = ss; }
            if (!outf) { float tv[4];
#pragma unroll
                for (int m = 0; m < 4; ++m) ssv[m] = swap32_add(ssv[m]);
#pragma unroll
                for (int m = 0; m < 4; ++m) tv[m] = __shfl_xor(ssv[m], 16);
#pragma unroll
                for (int m = 0; m < 4; ++m) if (fq == 0) ssq[(size_t)(row0 + ai * HALF + m * 16) * 16 + u.pn * 4 + wc] = ssv[m] + tv[m]; }
            asm volatile("" ::: "memory"); }
    }
};

struct EpiNull {
    static constexpr bool PERM = true, AFTER_DRAIN = false, ROW_RSTD = false;
    float* sink;
    __device__ __forceinline__ void operator()(const f32x4 (&acc)[2][2][4][2], const Unit& u, int wr, int wc, int fr, int fq) const {
        float s = 0.f;
#pragma unroll
        for (int ai = 0; ai < 2; ++ai)
#pragma unroll
            for (int bj = 0; bj < 2; ++bj)
#pragma unroll
                for (int m = 0; m < 4; ++m)
#pragma unroll
                    for (int n = 0; n < 2; ++n) s += acc[ai][bj][m][n][0];
        if (s == 12345.678f) sink[0] = s;
    }
};
template <int PIN> struct FixedOrder : StaticOrder {
    __device__ bool next(int i, Unit& u) const { const bool ok = StaticOrder::next(i, u); if (PIN & 1) u.pn = 0; if (PIN & 2) u.pm = (int)(blockIdx.x & 7); return ok; }
};
template <class Epi, class Sched, bool ALIGN_EPI = false, bool SP2 = false, bool FP8 = false>
__device__ __forceinline__ void gemm_phase(PG8_LAS unsigned char* lds, const Gemm g, const Sched& S, const Epi& E) {
    int tid = threadIdx.x; asm volatile("" : "+v"(tid));
    const int wid = __builtin_amdgcn_readfirstlane(tid >> 6), lane = tid & 63, wr = wid >> 2, wc = wid & 3, fr = lane & 15, fq = lane >> 4;
    const int K = g.K, nt = K / BK;
    unsigned voffA[2], voffB[2];
#pragma unroll
    for (int i = 0; i < 2; ++i) { int R, C; stage_rc(tid * 16 + i * 8192, R, C); const int Rb = Epi::PERM ? ((R & ~31) + perm32(R & 31)) : R;
        voffA[i] = (unsigned)(R * K + C) * 2u; voffB[i] = (unsigned)(Rb * K + C) * 2u; }
    const size_t kstep = (size_t)(BK * 2);
    const size_t hstep = (size_t)HALF * K * 2;
    const size_t tstep = 2 * hstep;
    const unsigned ldsw = (unsigned)wid * 1024u;
    const int aoff = lds_byte(wr * 64 + fr, fq * 8), boff = lds_byte(wc * 32 + fr, fq * 8);
#define PG8_SA(b, h) (((b) * 2 + (h)) * HTB)
#define PG8_SB(b, h) ((4 + (b) * 2 + (h)) * HTB)
#define PG8_STAGE(bufoff, gbase, voff) do { _Pragma("unroll") for (int _i = 0; _i < 2; ++_i) \
        __builtin_amdgcn_global_load_lds((const unsigned*)((const char*)(gbase) + (voff)[_i]), (PG8_LAS unsigned*)(lds + (bufoff) + ldsw + _i * 8192), 16, 0, 0); } while (0)
#define PG8_LDA(dst, b, h) do { if constexpr (FP8) { _Pragma("unroll") for (int m = 0; m < 4; ++m) dst##8[m] = cat8(*(const PG8_LAS bf16x8*)(lds + PG8_SA(b, h) + aoff + m * 2048), *(const PG8_LAS bf16x8*)(lds + PG8_SA(b, h) + aoff + m * 2048 + 1024)); } \
        else { _Pragma("unroll") for (int m = 0; m < 4; ++m) _Pragma("unroll") for (int k = 0; k < 2; ++k) dst[m][k] = *(const PG8_LAS bf16x8*)(lds + PG8_SA(b, h) + aoff + m * 2048 + k * 1024); } } while (0)
#define PG8_LDB(dst, b, h) do { if constexpr (FP8) { _Pragma("unroll") for (int n = 0; n < 2; ++n) dst##8[n] = cat8(*(const PG8_LAS bf16x8*)(lds + PG8_SB(b, h) + boff + n * 2048), *(const PG8_LAS bf16x8*)(lds + PG8_SB(b, h) + boff + n * 2048 + 1024)); } \
        else { _Pragma("unroll") for (int n = 0; n < 2; ++n) _Pragma("unroll") for (int k = 0; k < 2; ++k) dst[n][k] = *(const PG8_LAS bf16x8*)(lds + PG8_SB(b, h) + boff + n * 2048 + k * 1024); } } while (0)
#define PG8_MMA(ai, bj, At, Bt) do { __builtin_amdgcn_s_setprio(1); \
        if constexpr (FP8) { _Pragma("unroll") for (int m = 0; m < 4; ++m) _Pragma("unroll") for (int n = 0; n < 2; ++n) \
            mfma8(acc[ai][bj][m][n], Bt##8[n], At##8[m], sc8); } \
        else { _Pragma("unroll") for (int m = 0; m < 4; ++m) _Pragma("unroll") for (int n = 0; n < 2; ++n) _Pragma("unroll") for (int k = 0; k < 2; ++k) \
            acc[ai][bj][m][n] = __builtin_amdgcn_mfma_f32_16x16x32_bf16(Bt[n][k], At[m][k], acc[ai][bj][m][n], 0, 0, 0); } \
        __builtin_amdgcn_s_setprio(0); } while (0)
#define PG8_WAIT_V(n) asm volatile("s_waitcnt vmcnt(" #n ")" ::: "memory")
#define PG8_WAIT_L(n) asm volatile("s_waitcnt lgkmcnt(" #n ")" ::: "memory")
#define PG8_BAR __builtin_amdgcn_s_barrier()
#define PG8_SCHED __builtin_amdgcn_sched_barrier(0)
    Unit cur, nxt; int ui = 0;
    if (!S.next(0, cur)) return;
    if constexpr (Epi::ROW_RSTD) {
        int p0 = cur.pm, p1 = -1, p2 = -1, p3 = -1; { Unit t_; for (int n_ = 1; S.next(n_, t_); ++n_) { const int p = t_.pm; if (p != p0 && p != p1 && p != p2 && p != p3) { if (p1 < 0) p1 = p; else if (p2 < 0) p2 = p; else p3 = p; } } }
        E.fill_rstd(lds + STAGE_BYTES, p0, wid, lane); if (p1 >= 0) E.fill_rstd(lds + STAGE_BYTES + 1024, p1, wid, lane); if (p2 >= 0) E.fill_rstd(lds + STAGE_BYTES + 2048, p2, wid, lane); if (p3 >= 0) E.fill_rstd(lds + STAGE_BYTES + 3072, p3, wid, lane);
        E.set_panels(p0, p1, p2);
        PG8_WAIT_L(0); PG8_BAR; asm volatile("" ::: "memory"); }
    f32x4 acc[2][2][4][2];
#pragma unroll
    for (int a = 0; a < 2; ++a)
#pragma unroll
        for (int b = 0; b < 2; ++b)
#pragma unroll
            for (int m = 0; m < 4; ++m)
#pragma unroll
                for (int n = 0; n < 2; ++n) acc[a][b][m][n] = (f32x4){0.f, 0.f, 0.f, 0.f};
    bf16x8 At[4][2], B0[2][2], B1[2][2]; i32x8 At8[4], B08[2], B18[2]; int sc8 = 0x7F7F7F7F; asm volatile("" : "+v"(sc8));
    const char* cA = (const char*)g.A + (size_t)cur.pm * tstep; const char* cB = (const char*)g.Bt + (size_t)cur.pn * tstep;
    S.a_ready(cur);
    if constexpr (SP2) {
        PG8_STAGE(PG8_SB(0, 0), cB, voffB); PG8_STAGE(PG8_SB(0, 1), cB + hstep, voffB); PG8_STAGE(PG8_SA(0, 0), cA, voffA); PG8_STAGE(PG8_SA(0, 1), cA + hstep, voffA);
        if (wr == 1) PG8_BAR;
        PG8_WAIT_V(2); PG8_BAR;
        PG8_STAGE(PG8_SB(1, 0), cB + kstep, voffB); PG8_STAGE(PG8_SA(1, 0), cA + kstep, voffA); PG8_STAGE(PG8_SB(1, 1), cB + hstep + kstep, voffB);
        PG8_WAIT_V(6); PG8_BAR;
    } else {
        PG8_STAGE(PG8_SB(0, 0), cB, voffB); PG8_STAGE(PG8_SA(0, 0), cA, voffA); PG8_STAGE(PG8_SB(0, 1), cB + hstep, voffB); PG8_STAGE(PG8_SA(0, 1), cA + hstep, voffA);
        if (wr == 1) PG8_BAR;
        PG8_WAIT_V(4); PG8_BAR;
        PG8_STAGE(PG8_SB(1, 0), cB + kstep, voffB); PG8_STAGE(PG8_SA(1, 0), cA + kstep, voffA); PG8_STAGE(PG8_SB(1, 1), cB + hstep + kstep, voffB);
        PG8_WAIT_V(6); PG8_BAR;
    }
    for (;;) {
        const bool has_next = S.next(ui + 1, nxt);
        const char* nA = has_next ? (const char*)g.A + (size_t)nxt.pm * tstep : cA; const char* nB = has_next ? (const char*)g.Bt + (size_t)nxt.pn * tstep : cB;
#pragma nounroll
        for (int t = 0; t < nt; t += 2) {
            const bool last = (t == nt - 2);
            const char* a1 = cA + (size_t)(t + 1) * kstep;
            const char* a2 = last ? nA : cA + (size_t)(t + 2) * kstep; const char* b2 = last ? nB : cB + (size_t)(t + 2) * kstep;
            const char* a3 = a2 + kstep; const char* b3 = b2 + kstep;
            if (last && has_next) S.a_ready(nxt);
            if constexpr (SP2) {
            PG8_LDB(B0, 0, 0); PG8_LDB(B1, 0, 1); PG8_SCHED; PG8_LDA(At, 0, 0); PG8_STAGE(PG8_SA(1, 1), a1 + hstep, voffA);
            PG8_WAIT_V(8); PG8_WAIT_L(0); PG8_BAR; PG8_MMA(0, 0, At, B0); PG8_MMA(0, 1, At, B1); PG8_BAR; PG8_SCHED;
            PG8_LDA(At, 0, 1); PG8_STAGE(PG8_SB(0, 0), b2, voffB); PG8_STAGE(PG8_SB(0, 1), b2 + hstep, voffB); PG8_STAGE(PG8_SA(0, 0), a2, voffA);
            PG8_WAIT_V(8); PG8_WAIT_L(0); PG8_BAR; PG8_MMA(1, 0, At, B0); PG8_MMA(1, 1, At, B1); PG8_BAR; PG8_SCHED;
            PG8_LDB(B0, 1, 0); PG8_LDB(B1, 1, 1); PG8_SCHED; PG8_LDA(At, 1, 0); PG8_STAGE(PG8_SA(0, 1), a2 + hstep, voffA);
            PG8_WAIT_V(8); PG8_WAIT_L(0); PG8_BAR; PG8_MMA(0, 0, At, B0); PG8_MMA(0, 1, At, B1); PG8_BAR; PG8_SCHED;
            PG8_LDA(At, 1, 1); PG8_STAGE(PG8_SB(1, 0), b3, voffB); PG8_STAGE(PG8_SB(1, 1), b3 + hstep, voffB); PG8_STAGE(PG8_SA(1, 0), a3, voffA);
            PG8_WAIT_V(8); PG8_WAIT_L(0); PG8_BAR; PG8_MMA(1, 0, At, B0); PG8_MMA(1, 1, At, B1); PG8_BAR; PG8_SCHED;
            } else {
            PG8_LDB(B0, 0, 0); PG8_SCHED; PG8_LDA(At, 0, 0); PG8_STAGE(PG8_SA(1, 1), a1 + hstep, voffA);
            PG8_WAIT_L(8); PG8_BAR; PG8_WAIT_L(0); PG8_MMA(0, 0, At, B0); PG8_BAR; PG8_SCHED;
            PG8_LDB(B1, 0, 1); PG8_STAGE(PG8_SB(0, 0), b2, voffB);
            PG8_BAR; PG8_WAIT_L(0); PG8_MMA(0, 1, At, B1); PG8_BAR;
            PG8_LDA(At, 0, 1); PG8_STAGE(PG8_SA(0, 0), a2, voffA);
            PG8_BAR; PG8_WAIT_L(0); PG8_MMA(1, 0, At, B0); PG8_BAR; PG8_SCHED;
            PG8_STAGE(PG8_SB(0, 1), b2 + hstep, voffB);
            PG8_WAIT_V(6); PG8_BAR; PG8_MMA(1, 1, At, B1); PG8_BAR;
            PG8_LDB(B0, 1, 0); PG8_SCHED; PG8_LDA(At, 1, 0); PG8_STAGE(PG8_SA(0, 1), a2 + hstep, voffA);
            PG8_WAIT_L(8); PG8_BAR; PG8_WAIT_L(0); PG8_MMA(0, 0, At, B0); PG8_BAR; PG8_SCHED;
            PG8_LDB(B1, 1, 1); PG8_STAGE(PG8_SB(1, 0), b3, voffB);
            PG8_BAR; PG8_WAIT_L(0); PG8_MMA(0, 1, At, B1); PG8_BAR;
            PG8_LDA(At, 1, 1); PG8_STAGE(PG8_SA(1, 0), a3, voffA);
            PG8_BAR; PG8_WAIT_L(0); PG8_MMA(1, 0, At, B0); PG8_BAR; PG8_SCHED;
            PG8_STAGE(PG8_SB(1, 1), b3 + hstep, voffB);
            PG8_WAIT_V(6); PG8_BAR; PG8_MMA(1, 1, At, B1); PG8_BAR;
            }
        }
        if constexpr (ALIGN_EPI) { if (wr == 0) PG8_BAR; }
        if constexpr (FP8) asm volatile("s_nop 15\n\ts_nop 15" ::: "memory");
        if constexpr (!Epi::AFTER_DRAIN) { E(acc, cur, wr, wc, fr, fq); S.done(cur); }
        if (!has_next) break;
#pragma unroll
        for (int a = 0; a < 2; ++a)
#pragma unroll
            for (int b = 0; b < 2; ++b)
#pragma unroll
                for (int m = 0; m < 4; ++m)
#pragma unroll
                    for (int n = 0; n < 2; ++n) acc[a][b][m][n] = (f32x4){0.f, 0.f, 0.f, 0.f};
        cur = nxt; cA = nA; cB = nB; ++ui;
        if constexpr (ALIGN_EPI) { if (wr == 1) PG8_BAR; }
    }
    PG8_WAIT_V(0);
    if constexpr (!ALIGN_EPI) { if (wr == 0) PG8_BAR; }
    PG8_BAR;
    if constexpr (Epi::AFTER_DRAIN) { E.fused(acc, cur, wr, wc, fr, fq, lds, wid, lane); S.done(cur); }
#undef PG8_SA
#undef PG8_SB
#undef PG8_STAGE
#undef PG8_LDA
#undef PG8_LDB
#undef PG8_MMA
#undef PG8_WAIT_V
#undef PG8_WAIT_L
#undef PG8_BAR
#undef PG8_SCHED
}
}

constexpr int NWAVES = 8;
constexpr int BATCH = 16, T = 2048, D = 1024, M = BATCH * T, DFF = 2816, NF1 = 2 * DFF, NU = 2304, DEPTH = 2, NCP = 128;
constexpr float EPS = 1e-6f, LOG2E = 1.4426950408889634f, C2 = 0.125f * LOG2E;
constexpr int UQ = 0, UKS = 256, UKW = 320, UCK = 384, UCQ = 512, UKC = 768, UVC = 832, UVS = 896, UVW = 960, UCV = 1024, UG = 1152, UBB = 1280, UBC = 1536, UBX = 1792, UDV = 2048;
constexpr size_t MiB = 1u << 20;
constexpr size_t WS_CTL = 0, CTL_ZERO_BYTES = 1 * MiB;
constexpr size_t WS_W13 = 1 * MiB, WS_W2 = 45 * MiB, WS_WIN = 67 * MiB, WS_WOUT = 76 * MiB, WS_C1 = 80 * MiB;
constexpr size_t WS_SSQ = 82 * MiB, WS_GATES = 84 * MiB, WS_KC = 86 * MiB, WS_VC = 86 * MiB + 512 * 1024;
constexpr size_t WS_XB = 88 * MiB, WS_QKN = 152 * MiB, WS_YN = 200 * MiB, WS_ACT = 264 * MiB, WS_U = WS_ACT, WS_X8 = 440 * MiB, WS_IMG = 472 * MiB, WS_END = 504 * MiB;
#ifndef UP8_MASK_V
#define UP8_MASK_V 0xE
#endif
#ifndef DN8_MASK_V
#define DN8_MASK_V 0xE
#endif
constexpr unsigned UP8_MASK = UP8_MASK_V, DN8_MASK = DN8_MASK_V;
constexpr float W8_SCALE = 64.0f, ACT8_SCALE = 4.0f; static_assert(W8_SCALE * ACT8_SCALE == 256.0f, "EpiRes mode 1");
constexpr int CW_BAR = 4096;
constexpr int LDS_BYTES = 163840, MISC_OFF = LDS_BYTES - 256;

#define GAS __attribute__((address_space(1)))
#define LAS __attribute__((address_space(3)))
typedef unsigned short bf16;
typedef unsigned v4u __attribute__((ext_vector_type(4)));
typedef unsigned u32x2 __attribute__((ext_vector_type(2)));
typedef float f32x4 __attribute__((ext_vector_type(4)));
typedef float f32x2_t __attribute__((ext_vector_type(2)));
typedef __bf16 bf16x2_t __attribute__((ext_vector_type(2)));
typedef short bf16x8 __attribute__((ext_vector_type(8)));
typedef float f32x16 __attribute__((ext_vector_type(16)));
typedef short v4i16_t __attribute__((ext_vector_type(4)));
#define LDS_WAIT() asm volatile("s_waitcnt lgkmcnt(0)" ::: "memory")
__device__ __forceinline__ unsigned pk2(float lo, float hi) { f32x2_t v = {lo, hi}; bf16x2_t b = __builtin_convertvector(v, bf16x2_t); return __builtin_bit_cast(unsigned, b); }
__device__ __forceinline__ float bflo(unsigned u) { return __builtin_bit_cast(float, u << 16); }
__device__ __forceinline__ float bfhi(unsigned u) { return __builtin_bit_cast(float, u & 0xffff0000u); }
__device__ __forceinline__ f32x4 ld4bf(const bf16* p) { const u32x2 w = *(const u32x2*)p; return (f32x4){bflo(w.x), bfhi(w.x), bflo(w.y), bfhi(w.y)}; }
__device__ __forceinline__ void st4bf(bf16* p, f32x4 v) { u32x2 w; w.x = pk2(v[0], v[1]); w.y = pk2(v[2], v[3]); *(u32x2*)p = w; }
template <int CTRL> __device__ __forceinline__ float dpp_add(float v) { return v + __builtin_bit_cast(float, __builtin_amdgcn_update_dpp(0, __builtin_bit_cast(int, v), CTRL, 0xf, 0xf, true)); }
__device__ __forceinline__ float row16_sum(float v) { v = dpp_add<0xB1>(v); v = dpp_add<0x4E>(v); v = dpp_add<0x141>(v); v = dpp_add<0x140>(v); return v; }
__device__ __forceinline__ float wave_sum(float v) {
    v = row16_sum(v); v += __shfl_xor(v, 16);
    auto rr = __builtin_amdgcn_permlane32_swap(__float_as_uint(v), __float_as_uint(v), false, false); return __uint_as_float(rr[0]) + __uint_as_float(rr[1]);
}
__device__ __forceinline__ f32x4 up4(u32x2 w) { return (f32x4){bflo(w.x), bfhi(w.x), bflo(w.y), bfhi(w.y)}; }
__device__ __forceinline__ float sq4(f32x4 v) { return (v[0] * v[0] + v[1] * v[1]) + (v[2] * v[2] + v[3] * v[3]); }

__device__ __forceinline__ int kimg_off(int r, int d) { return (d >> 3) * 512 + r * 8 + (d & 7); }
__device__ __forceinline__ int vimg_off(int r, int d) { return ((d >> 5) * 4 + (r >> 4)) * 512 + (r & 15) * 32 + (d & 31); }
#define XB_TMO      128
#define XB_XCNT(j)  (256  + 64 * (j))
#define XB_XSUB(j)  (1280 + 64 * (j))
#define XB_XGEN(j)  (2304 + 64 * (j))
#define XB_TOP      3328
#define XB_TOPGEN   3392
#define XCD_BAR_WORDS 3456
#define XB_SPIN_CAP (1u << 18)

__device__ __forceinline__ unsigned xb_ld(unsigned* p)              { return __hip_atomic_load(p, __ATOMIC_RELAXED, __HIP_MEMORY_SCOPE_AGENT); }
__device__ __forceinline__ unsigned xb_add(unsigned* p, unsigned v) { return __hip_atomic_fetch_add(p, v, __ATOMIC_RELAXED, __HIP_MEMORY_SCOPE_AGENT); }
__device__ __forceinline__ unsigned xb_xcc_id() { return (unsigned)__builtin_amdgcn_s_getreg((3 << 11) | 20) & 0xFu; }
#define XB_SPIN(cond, bar) do { unsigned _sp = 0; while (cond) { __builtin_amdgcn_s_sleep(1); \
    if ((++_sp & 255u) == 0u) { if (xb_ld(&(bar)[XB_TMO])) break; if (_sp > XB_SPIN_CAP) { atomicAdd(&(bar)[XB_TMO], 1u); break; } } } } while (0)

struct XcdBarrier {
    unsigned* bar; unsigned x;
    volatile LAS unsigned* st;
};

__device__ __forceinline__ XcdBarrier xcd_barrier_post(unsigned* bar, volatile LAS unsigned* st) {
    XcdBarrier b; b.bar = bar; b.x = xb_xcc_id(); b.st = st;
    if (threadIdx.x == 0) (void)xb_add(&bar[XB_XCNT(b.x)], 1u);
    return b;
}
__device__ __forceinline__ void xcd_barrier_complete(unsigned* bar, unsigned x, unsigned& nloc, unsigned& nx) {
    const unsigned G = gridDim.x * gridDim.y * gridDim.z;
    unsigned sum, cnt, mine, sp = 0u;
    for (;;) {
        sum = 0u; cnt = 0u; mine = 0u;
#pragma unroll
        for (unsigned j = 0; j < 16; ++j) { const unsigned c = xb_ld(&bar[XB_XCNT(j)]); sum += c; cnt += (c > 0u) ? 1u : 0u; mine = (j == x) ? c : mine; }
        if (sum == G) break;
        __builtin_amdgcn_s_sleep(1);
        if ((++sp & 255u) == 0u) { if (xb_ld(&bar[XB_TMO])) break; if (sp > XB_SPIN_CAP) { atomicAdd(&bar[XB_TMO], 1u); break; } }
    }
    nloc = mine > 0u ? mine : 1u; nx = cnt > 0u ? cnt : 1u;
}

__device__ __forceinline__ void xcd_barrier(const XcdBarrier& b) {
    asm volatile("s_waitcnt vmcnt(0)" ::: "memory");
    __syncthreads();
    if (threadIdx.x == 0) {
        unsigned* bar = b.bar;
        __builtin_amdgcn_s_waitcnt(0);
        unsigned nloc = b.st[0], nx = b.st[1];
        if (nloc == 0u) { xcd_barrier_complete(bar, b.x, nloc, nx); b.st[0] = nloc; b.st[1] = nx; }
        const unsigned old = xb_add(&bar[XB_XSUB(b.x)], 1u);
        const unsigned gen = old / nloc;
        if (old + 1u == (gen + 1u) * nloc) {
            __builtin_amdgcn_fence(__ATOMIC_RELEASE, "agent");
            asm volatile("s_waitcnt vmcnt(0)" ::: "memory");
            const unsigned og = xb_add(&bar[XB_TOP], 1u);
            const unsigned tg = og / nx;
            if (og + 1u == (tg + 1u) * nx) xb_add(&bar[XB_TOPGEN], 1u);
            else XB_SPIN(xb_ld(&bar[XB_TOPGEN]) == tg, bar);
            __builtin_amdgcn_fence(__ATOMIC_ACQUIRE, "agent");
            xb_add(&bar[XB_XGEN(b.x)], 1u);
            asm volatile("s_waitcnt vmcnt(0)" ::: "memory");
        } else {
            XB_SPIN(xb_ld(&bar[XB_XGEN(b.x)]) == gen, bar);
            __builtin_amdgcn_fence(__ATOMIC_ACQUIRE, "agent");
            asm volatile("s_waitcnt vmcnt(0)" ::: "memory");
        }
    }
    __syncthreads();
}


typedef KArgs Args;
struct Frame {
    LAS unsigned char* lds;
    int tid, lane, wave, vcu, G;
    const Args* a;
};
#define FIN(i) (F.a->in[i])
#define FOUT (F.a->out)
#define FWS(off, type) ((type*)(F.a->ws + (off)))
#define F_W13T FWS(WS_W13, bf16)
#define F_W2T FWS(WS_W2, bf16)
#define F_WINT FWS(WS_WIN, bf16)
#define F_WOUTT FWS(WS_WOUT, bf16)
#define F_C1T FWS(WS_C1, bf16)
#define F_XB FWS(WS_XB, bf16)
#define F_QA FWS(WS_QKN, bf16)
#define F_QC FWS(WS_QKN + 16 * MiB, bf16)
#define F_KSI FWS(WS_IMG, bf16)
#define F_KWI FWS(WS_IMG + 4 * MiB, bf16)
#define F_CKI FWS(WS_IMG + 8 * MiB, bf16)
#define F_VSI FWS(WS_IMG + 16 * MiB, bf16)
#define F_VWI FWS(WS_IMG + 20 * MiB, bf16)
#define F_CVI FWS(WS_IMG + 24 * MiB, bf16)
#define F_YN FWS(WS_YN, bf16)
#define F_ACT FWS(WS_ACT, bf16)
#define F_U FWS(WS_U, bf16)
#define F_KC FWS(WS_KC, bf16)
#define F_VC FWS(WS_VC, bf16)
#define F_SSQ FWS(WS_SSQ, float)
#define F_GATES FWS(WS_GATES, float)
#define F_X8 FWS(WS_X8, unsigned char)
enum { I_X = 0, I_F1N, I_F1W1, I_F1W3, I_F1W2, I_MIXN, I_WIN, I_NQN, I_NKCN, I_NKSN, I_NKWN, I_POSK, I_C1K, I_C2K, I_POSV, I_C1V, I_C2V, I_CONVW, I_SQN, I_SKN, I_SINK, I_POOLW, I_POOLS, I_GN, I_WOUT,
       I_F2N, I_F2W1, I_F2W3, I_F2W2 };

__device__ __forceinline__ int win_src_col(int dr) {
    if (dr < 256) return dr;
    if (dr < 320) return 384 + (dr - 256);
    if (dr < 384) return 512 + (dr - 320);
    if (dr < 512) return 1676 + (dr - 384);
    if (dr < 768) return 1420 + (dr - 512);
    if (dr < 832) return 256 + (dr - 768);
    if (dr < 896) return 320 + (dr - 832);
    if (dr < 960) return 448 + (dr - 896);
    if (dr < 1024) return 576 + (dr - 960);
    if (dr < 1152) return 1804 + (dr - 1024);
    if (dr < 1164) return 640 + (dr - 1152);
    if (dr < 1280) return -1;
    if (dr < 1536) return 652 + (dr - 1280);
    if (dr < 1792) return 908 + (dr - 1536);
    if (dr < 2048) return 1164 + (dr - 1792);
    return 1932 + (dr - 2048);
}
struct TrItem { const float* src; const float* gain; void* dst; int N, K, k0, srccol, dstrow0; bool f8; };
__device__ __forceinline__ void tr_load(const TrItem& t, f32x4 (&v)[16], int lane) {
    const int kr = lane >> 4;
#pragma unroll
    for (int i = 0; i < 16; ++i) { v[i] = (f32x4){0.f, 0.f, 0.f, 0.f}; if (t.srccol >= 0) v[i] = *(const f32x4*)(t.src + (size_t)(t.k0 + 4 * i + kr) * t.N + t.srccol); }
}
__device__ __forceinline__ void tr_store(const TrItem& t, f32x4 (&v)[16], LAS float* scr, int lane) {
    const int kr = lane >> 4;
    if (t.gain) {
#pragma unroll
        for (int i = 0; i < 16; ++i) v[i] *= t.gain[t.k0 + 4 * i + kr]; }
#pragma unroll
    for (int i = 0; i < 16; ++i) { LAS float* p = scr + (4 * i + kr) * 65 + 4 * (lane & 15); p[0] = v[i][0]; p[1] = v[i][1]; p[2] = v[i][2]; p[3] = v[i][3]; }
    LDS_WAIT(); asm volatile("" ::: "memory");
    if (t.f8) { const int c = lane & 3;
#pragma unroll
        for (int j = 0; j < 4; ++j) { const int n = (lane >> 2) + 16 * j; const LAS float* q = scr + (16 * c) * 65 + n; v4u o;
            o.x = pg8::pk4_fp8(q[0 * 65] * W8_SCALE, q[1 * 65] * W8_SCALE, q[2 * 65] * W8_SCALE, q[3 * 65] * W8_SCALE); o.y = pg8::pk4_fp8(q[4 * 65] * W8_SCALE, q[5 * 65] * W8_SCALE, q[6 * 65] * W8_SCALE, q[7 * 65] * W8_SCALE);
            o.z = pg8::pk4_fp8(q[8 * 65] * W8_SCALE, q[9 * 65] * W8_SCALE, q[10 * 65] * W8_SCALE, q[11 * 65] * W8_SCALE); o.w = pg8::pk4_fp8(q[12 * 65] * W8_SCALE, q[13 * 65] * W8_SCALE, q[14 * 65] * W8_SCALE, q[15 * 65] * W8_SCALE);
            *(v4u*)((unsigned char*)t.dst + (size_t)(t.dstrow0 + n) * t.K + t.k0 + 16 * c) = o; } }
    else { const int c = lane & 7;
#pragma unroll
        for (int j = 0; j < 8; ++j) { const int n = (lane >> 3) + 8 * j; const LAS float* q = scr + (8 * c) * 65 + n;
            v4u o; o.x = pk2(q[0 * 65], q[1 * 65]); o.y = pk2(q[2 * 65], q[3 * 65]); o.z = pk2(q[4 * 65], q[5 * 65]); o.w = pk2(q[6 * 65], q[7 * 65]);
            *(v4u*)((bf16*)t.dst + (size_t)(t.dstrow0 + n) * t.K + t.k0 + 8 * c) = o; } }
    LDS_WAIT(); asm volatile("" ::: "memory");
}
__device__ __forceinline__ void tr_decode(Frame& F, int it, int lane, TrItem& t) {
    constexpr int I_W = 704, I_IN = 16 * 36, I_OUT = 16 * 16, I_C1 = 32 * 2, PER_LAYER = 6 * I_W + I_IN + I_OUT + 2 * I_C1;
    const int L = it / PER_LAYER, l4 = 4 * (lane & 15); int r = it % PER_LAYER;
    t.gain = nullptr; t.f8 = false;
    if (r < 6 * I_W) { const int mat = r / I_W; r %= I_W; const int ffn = mat / 3, w = mat % 3;
        if (w < 2) { const int kb = r / 44, nb = r % 44, n0 = 64 * nb; t.N = DFF; t.K = D; t.k0 = 64 * kb; t.srccol = n0 + l4;
            t.src = FIN(ffn ? (w ? I_F2W3 : I_F2W1) : (w ? I_F1W3 : I_F1W1)) + (size_t)L * D * DFF; t.gain = FIN(ffn ? I_F2N : I_F1N) + L * D;
            t.dst = (unsigned char*)F_W13T + (size_t)(L * 2 + ffn) * NF1 * D * 2; t.dstrow0 = (n0 / 128) * 256 + w * 128 + (n0 % 128); t.f8 = (UP8_MASK >> (L * 2 + ffn)) & 1u; }
        else { const int kb = r / 16, nb = r % 16, n0 = 64 * nb; t.N = D; t.K = DFF; t.k0 = 64 * kb; t.srccol = n0 + l4;
            t.src = FIN(ffn ? I_F2W2 : I_F1W2) + (size_t)L * DFF * D; t.dst = (unsigned char*)F_W2T + (size_t)(L * 2 + ffn) * D * DFF * 2; t.dstrow0 = n0; t.f8 = (DN8_MASK >> (L * 2 + ffn)) & 1u; } }
    else { r -= 6 * I_W;
        if (r < I_IN) { const int kb = r / 36, rb = r % 36; t.N = 2188; t.K = D; t.k0 = 64 * kb; t.srccol = win_src_col(64 * rb + l4);
            t.src = FIN(I_WIN) + (size_t)L * D * 2188; t.gain = FIN(I_MIXN) + L * D; t.dst = F_WINT + (size_t)L * NU * D; t.dstrow0 = 64 * rb; }
        else if (r < I_IN + I_OUT) { r -= I_IN; const int kb = r / 16, nb = r % 16, n0 = 64 * nb; t.N = D; t.K = D; t.k0 = 64 * kb; t.srccol = n0 + l4;
            t.src = FIN(I_WOUT) + (size_t)L * D * D; t.gain = FIN(I_GN) + L * D; t.dst = F_WOUTT + (size_t)L * D * D; t.dstrow0 = n0; }
        else { r -= I_IN + I_OUT; const int kv = r / I_C1; r %= I_C1; const int kb = r / 2, nb = r % 2, n0 = 64 * nb; t.N = 128; t.K = 2048; t.k0 = 64 * kb; t.srccol = n0 + l4;
            t.src = FIN(kv ? I_C1V : I_C1K) + (size_t)L * 2048 * 128; t.dst = F_C1T + (size_t)(L * 2 + kv) * 128 * 2048; t.dstrow0 = n0; } }
}
__device__ __forceinline__ void prologue(Frame& F) {
    int lane = F.lane; asm volatile("" : "+v"(lane));
    LAS float* scr = (LAS float*)(F.lds + F.wave * 16640);
    const int gw = F.vcu * NWAVES + F.wave, NGW = F.G * NWAVES;
    constexpr int NITEMS = DEPTH * (6 * 704 + 16 * 36 + 16 * 16 + 2 * 64);
    if (gw < NITEMS) { TrItem ta, tb; f32x4 va[16], vb[16];
        tr_decode(F, gw, lane, ta); tr_load(ta, va, lane);
        for (int it = gw; it < NITEMS; it += 2 * NGW) {
            const bool hb = it + NGW < NITEMS; if (hb) { tr_decode(F, it + NGW, lane, tb); tr_load(tb, vb, lane); }
            tr_store(ta, va, scr, lane);
            const bool ha = it + 2 * NGW < NITEMS; if (ha) { tr_decode(F, it + 2 * NGW, lane, ta); tr_load(ta, va, lane); }
            if (hb) tr_store(tb, vb, scr, lane);
        } }
    const float* x = FIN(I_X);
    for (int m4 = gw * 4; m4 < M; m4 += NGW * 4) {
        f32x4 v[4][4];
#pragma unroll
        for (int r = 0; r < 4; ++r)
#pragma unroll
            for (int j = 0; j < 4; ++j) v[r][j] = *((const f32x4*)(x + (size_t)(m4 + r) * D) + lane + 64 * j);
#pragma unroll
        for (int r = 0; r < 4; ++r) { float sr = 0.f;
#pragma unroll
            for (int j = 0; j < 4; ++j) { sr += sq4(v[r][j]); st4bf(F_XB + (size_t)(m4 + r) * D + 256 * j + 4 * lane, v[r][j]);
                if (UP8_MASK & 1u) *(unsigned*)(F_X8 + (size_t)(m4 + r) * D + 256 * j + 4 * lane) = pg8::pk4_fp8(v[r][j][0], v[r][j][1], v[r][j][2], v[r][j][3]); }
            sr = wave_sum(sr);
            if (lane < 16) F_SSQ[(size_t)(m4 + r) * 16 + lane] = lane == 0 ? sr : 0.f; }
    }
}

#ifndef PROBE_PREP
#define PROBE_PREP 0
#endif
__device__ __forceinline__ void prep_phase(Frame& F, int L) {
    int tid = F.tid; asm volatile("" : "+v"(tid));
    const int lane = tid & 63, ch = 4 * lane;
    LAS bf16* PWt = (LAS bf16*)F.lds;
    LAS bf16* DTb = (LAS bf16*)(F.lds + 65536) + F.wave * (16 * 264);
    { const float* pw = FIN(I_POOLW) + (size_t)L * 16384;
      for (int i = tid; i < 16384; i += NWAVES * 64) { const int g = i >> 12, c = (i >> 6) & 63, e = i & 63; PWt[(g * 64 + e) * 72 + c] = (bf16)(pk2(pw[i], 0.f) & 0xffffu); } }
    __syncthreads();
    f32x4 g0, g1, g2, cw0, cw1, cw2;
    { const float* nq = FIN(I_NQN) + L * 64; const float* nks = FIN(I_NKSN) + L * 64; const float* nkw = FIN(I_NKWN) + L * 64; const float* sk = FIN(I_SKN) + L * 64; const float* sq = FIN(I_SQN) + L * 64;
      g0 = *(const f32x4*)(nq + (ch & 63)) * C2;
      g1 = ch < 64 ? *(const f32x4*)(nks + ch) : (ch < 128 ? *(const f32x4*)(nkw + (ch - 64)) : *(const f32x4*)(sk + (ch & 63)));
      g2 = *(const f32x4*)(sq + (ch & 63)) * C2;
      const float* cw = FIN(I_CONVW) + L * 768; cw0 = *(const f32x4*)(cw + ch); cw1 = *(const f32x4*)(cw + 256 + ch); cw2 = *(const f32x4*)(cw + 512 + ch);
      }
    const int grp = lane >> 4, win = 2 << grp;
    const int gw = F.vcu * NWAVES + F.wave, NGW = F.G * NWAVES;
    for (int blk = gw; blk < M / 16; blk += NGW) {
        const int m0 = blk * 16, t0 = m0 & (T - 1);
        const bf16* u0 = F_U + (size_t)m0 * NU;
        const int gt = m0 >> 6, rb = m0 & 63, dk = ch & 63;
        bf16* kimg = (ch < 64 ? F_KSI : (ch < 128 ? F_KWI : F_CKI + (size_t)((ch - 128) >> 6) * 512 * 4096)) + (size_t)gt * 4096 + kimg_off(rb, dk);
        bf16* vimg = (ch < 64 ? F_VSI : (ch < 128 ? F_VWI : F_CVI + (size_t)((ch - 128) >> 6) * 512 * 4096)) + (size_t)gt * 4096 + vimg_off(rb, dk);
#pragma nounroll
        for (int i8 = 0; i8 < 16; i8 += 8) { u32x2 raw[8][4];
#pragma unroll
            for (int i = 0; i < 8; ++i) {
#pragma unroll
                for (int k = 0; k < 3; ++k) raw[i][k] = *(const u32x2*)(u0 + (size_t)(i8 + i) * NU + 256 * k + ch);
                raw[i][3] = *(const u32x2*)(u0 + (size_t)(i8 + i) * NU + UVS + ch); }
#pragma unroll
            for (int i = 0; i < 8; ++i) { const f32x4 v0 = up4(raw[i][0]), v1 = up4(raw[i][1]), v2 = up4(raw[i][2]);
                const float s0 = row16_sum(sq4(v0)), s1 = row16_sum(sq4(v1)), s2 = row16_sum(sq4(v2));
                const float r0 = __builtin_amdgcn_rsqf(s0 * (1.f / 64.f) + EPS), r1 = __builtin_amdgcn_rsqf(s1 * (1.f / 64.f) + EPS), r2 = __builtin_amdgcn_rsqf(s2 * (1.f / 64.f) + EPS);
                st4bf(F_QA + (size_t)(m0 + i8 + i) * 256 + ch, v0 * r0 * g0); st4bf(kimg + (i8 + i) * 8, v1 * r1 * g1); st4bf(F_QC + (size_t)(m0 + i8 + i) * 256 + ch, v2 * r2 * g2);
                *(u32x2*)(vimg + (i8 + i) * 32) = raw[i][3]; } }
#pragma unroll
        for (int k = 0; k < 3; ++k) { const int idx = lane + 64 * k, tk = idx / 12, gi = idx - 12 * tk;
            const float a = bflo((unsigned)u0[(size_t)tk * NU + UG + gi]); F_GATES[(size_t)m0 * 12 + idx] = __builtin_amdgcn_rcpf(1.0f + __builtin_amdgcn_exp2f(a * -LOG2E)); }
        { f32x4 zm1 = {0.f, 0.f, 0.f, 0.f}, zm2 = {0.f, 0.f, 0.f, 0.f};
          if (t0 > 0) { zm1 = ld4bf(u0 - NU + UBC + ch) * ld4bf(u0 - NU + UBX + ch); zm2 = ld4bf(u0 - 2 * NU + UBC + ch) * ld4bf(u0 - 2 * NU + UBX + ch); }
#pragma nounroll
          for (int i8 = 0; i8 < 16; i8 += 8) { u32x2 raw[8][3]; f32x4 ob[8]; float ss[8];
#pragma unroll
              for (int i = 0; i < 8; ++i)
#pragma unroll
                  for (int k = 0; k < 3; ++k) raw[i][k] = *(const u32x2*)(u0 + (size_t)(i8 + i) * NU + UBB + 256 * k + ch);
#pragma unroll
              for (int i = 0; i < 8; ++i) { const f32x4 z0 = up4(raw[i][1]) * up4(raw[i][2]);
                  ob[i] = up4(raw[i][0]) * (cw2 * z0 + cw1 * zm1 + cw0 * zm2); zm2 = zm1; zm1 = z0; ss[i] = sq4(ob[i]); }
#pragma unroll
              for (int i = 0; i < 8; ++i) ss[i] = wave_sum(ss[i]);
#pragma unroll
              for (int i = 0; i < 8; ++i) st4bf(F_YN + (size_t)(m0 + i8 + i) * D + 256 + ch, ob[i] * (__builtin_amdgcn_rsqf(ss[i] * (1.f / 256.f) + EPS))); } }
        for (int rep4 = 0; rep4 < ((PROBE_PREP & 4) ? 2 : 1); ++rep4)
        { u32x2 raw[32];
#pragma unroll
          for (int i = 0; i < 16; ++i) { raw[i] = (u32x2){0u, 0u}; if (t0 > 0) raw[i] = *(const u32x2*)(u0 - (size_t)(16 - i) * NU + UDV + ch); }
#pragma unroll
          for (int i = 0; i < 16; ++i) raw[16 + i] = *(const u32x2*)(u0 + (size_t)i * NU + UDV + ch);
          f32x4 S2 = up4(raw[15]) + up4(raw[14]), S4 = S2 + up4(raw[13]) + up4(raw[12]), S8 = S4, S16;
#pragma unroll
          for (int i = 8; i < 12; ++i) S8 += up4(raw[i]);
          S16 = S8;
#pragma unroll
          for (int i = 0; i < 8; ++i) S16 += up4(raw[i]);
#pragma unroll
          for (int ti = 0; ti < 16; ++ti) { const f32x4 v = up4(raw[16 + ti]);
              S2 += v - up4(raw[16 + ti - 2]); S4 += v - up4(raw[16 + ti - 4]); S8 += v - up4(raw[16 + ti - 8]); S16 += v - up4(raw[ti]);
              const f32x4 Sw = grp == 0 ? S2 : (grp == 1 ? S4 : (grp == 2 ? S8 : S16));
              const int cn = (t0 + ti + 1) < win ? (t0 + ti + 1) : win;
              const f32x4 dd = Sw * __builtin_amdgcn_rcpf((float)cn) - v;
              u32x2 w; w.x = pk2(dd[0], dd[1]); w.y = pk2(dd[2], dd[3]); *(LAS u32x2*)(DTb + ti * 264 + ch) = w; }
          const int fr = lane & 15, fq = lane >> 4;
          const float* psp = FIN(I_POOLS) + L * 256 + fr;
          f32x4 acc[4][4];
#pragma unroll
          for (int g = 0; g < 4; ++g) { const bf16x8 a0 = *(const LAS bf16x8*)(DTb + fr * 264 + g * 64 + 8 * fq), a1 = *(const LAS bf16x8*)(DTb + fr * 264 + g * 64 + 32 + 8 * fq);
#pragma unroll
              for (int cb = 0; cb < 4; ++cb) { const LAS bf16* bp = PWt + (g * 64 + 16 * cb + fr) * 72 + 8 * fq;
                  f32x4 c = {0.f, 0.f, 0.f, 0.f};
                  c = __builtin_amdgcn_mfma_f32_16x16x32_bf16(a0, *(const LAS bf16x8*)bp, c, 0, 0, 0);
                  c = __builtin_amdgcn_mfma_f32_16x16x32_bf16(a1, *(const LAS bf16x8*)(bp + 32), c, 0, 0, 0);
                  acc[g][cb] = c * psp[g * 64 + 16 * cb]; } }
          float ss[4];
#pragma unroll
          for (int i = 0; i < 4; ++i) { float q = 0.f;
#pragma unroll
              for (int g = 0; g < 4; ++g)
#pragma unroll
                  for (int cb = 0; cb < 4; ++cb) q += acc[g][cb][i] * acc[g][cb][i];
              ss[i] = __builtin_amdgcn_rsqf(row16_sum(q) * (1.f / 256.f) + EPS); }
          asm volatile("s_waitcnt lgkmcnt(0)" ::: "memory");
#pragma unroll
          for (int g = 0; g < 4; ++g)
#pragma unroll
              for (int cb = 0; cb < 4; ++cb)
#pragma unroll
                  for (int i = 0; i < 4; ++i) DTb[(4 * fq + i) * 264 + g * 64 + 16 * cb + fr] = (bf16)(pk2(acc[g][cb][i] * ss[i], 0.f) & 0xffffu);
#pragma unroll
          for (int ti = 0; ti < 16; ++ti) *(u32x2*)(F_YN + (size_t)(m0 + ti) * D + 768 + ch) = *(const LAS u32x2*)(DTb + ti * 264 + ch); }
    }
    __syncthreads();
    LAS float* PART = (LAS float*)F.lds;
    LAS float* H = (LAS float*)(F.lds + 65536);
    LAS float* O2 = (LAS float*)(F.lds + 65536 + 16384);
    const int fr = lane & 15, fq = lane >> 4, wave = F.wave;
    for (int rep8 = 0; rep8 < ((PROBE_PREP & 8) ? 2 : 1); ++rep8)
    for (int uid = blockIdx.x; uid < 256; uid += F.G) {
        const int b = uid >> 4, kv = (uid >> 3) & 1, n0 = 16 * (uid & 7);
        const bf16* W1t = F_C1T + (size_t)(L * 2 + kv) * 128 * 2048;
        const float* pos = FIN(kv ? I_POSV : I_POSK) + (size_t)L * 2048;
        const float* W2 = FIN(kv ? I_C2V : I_C2K) + (size_t)L * 128 * 64;
        const int nrow = (n0 + fr) < 126 ? (n0 + fr) : 126;
        const bf16* arow = F_U + (size_t)(b * T + 16 * nrow) * NU + UKC + 64 * kv;
        const bf16* brow = W1t + (size_t)fr * 2048;
        f32x4 acc[8];
#pragma unroll
        for (int ct = 0; ct < 8; ++ct) acc[ct] = (f32x4){0.f, 0.f, 0.f, 0.f};
#pragma unroll 2
        for (int ks = 0; ks < 8; ++ks) { const int kk = 8 * wave + ks, l = kk >> 1, c = 32 * (kk & 1) + 8 * fq;
            const v4u ar = *(const v4u*)(arow + (size_t)l * NU + c); const f32x4 p0 = *(const f32x4*)(pos + l * 64 + c), p1 = *(const f32x4*)(pos + l * 64 + c + 4);
            bf16x8 bfr[8];
#pragma unroll
            for (int ct = 0; ct < 8; ++ct) bfr[ct] = *(const bf16x8*)(brow + (size_t)(16 * ct) * 2048 + 32 * kk + 8 * fq);
            v4u aw; aw.x = pk2(bflo(ar.x) + p0[0], bfhi(ar.x) + p0[1]); aw.y = pk2(bflo(ar.y) + p0[2], bfhi(ar.y) + p0[3]); aw.z = pk2(bflo(ar.z) + p1[0], bfhi(ar.z) + p1[1]); aw.w = pk2(bflo(ar.w) + p1[2], bfhi(ar.w) + p1[3]);
#pragma unroll
            for (int ct = 0; ct < 8; ++ct) acc[ct] = __builtin_amdgcn_mfma_f32_16x16x32_bf16(__builtin_bit_cast(bf16x8, aw), bfr[ct], acc[ct], 0, 0, 0); }
#pragma unroll
        for (int ct = 0; ct < 8; ++ct)
#pragma unroll
            for (int i = 0; i < 4; ++i) PART[(wave * 16 + 4 * fq + i) * 128 + 16 * ct + fr] = acc[ct][i];
        __syncthreads();
        { const int e0 = 4 * tid; f32x4 sum = *(const LAS f32x4*)(PART + e0);
#pragma unroll
          for (int w = 1; w < 8; ++w) sum += *(const LAS f32x4*)(PART + w * 2048 + e0);
          const int hr = e0 >> 7, hc = e0 & 127;
#pragma unroll
          for (int i = 0; i < 4; ++i) { const float xh = sum[i]; const float y2 = 2.0f * 0.7978845608028654f * (xh + 0.044715f * xh * xh * xh); H[hr * 132 + hc + i] = xh * __builtin_amdgcn_rcpf(1.0f + __builtin_amdgcn_exp2f(y2 * -LOG2E)); } }
        __syncthreads();
        if (wave < 4) { f32x4 a2 = {0.f, 0.f, 0.f, 0.f};
#pragma unroll
            for (int s = 0; s < 4; ++s) { const LAS float* hp = H + fr * 132 + 32 * s + 8 * fq; const float* wp = W2 + (size_t)(32 * s + 8 * fq) * 64 + 16 * wave + fr;
                v4u aw; aw.x = pk2(hp[0], hp[1]); aw.y = pk2(hp[2], hp[3]); aw.z = pk2(hp[4], hp[5]); aw.w = pk2(hp[6], hp[7]);
                v4u bw; bw.x = pk2(wp[0], wp[64]); bw.y = pk2(wp[128], wp[192]); bw.z = pk2(wp[256], wp[320]); bw.w = pk2(wp[384], wp[448]);
                a2 = __builtin_amdgcn_mfma_f32_16x16x32_bf16(__builtin_bit_cast(bf16x8, aw), __builtin_bit_cast(bf16x8, bw), a2, 0, 0, 0); }
#pragma unroll
            for (int i = 0; i < 4; ++i) O2[(4 * fq + i) * 68 + 16 * wave + fr] = a2[i]; }
        __syncthreads();
        if (wave == 0) { const int row = lane >> 2, c0 = (lane & 3) * 16; float v[16]; float ss = 0.f;
#pragma unroll
            for (int e = 0; e < 16; ++e) { v[e] = O2[row * 68 + c0 + e]; ss += v[e] * v[e]; }
            ss += __shfl_xor(ss, 1); ss += __shfl_xor(ss, 2);
            const float rs = __builtin_amdgcn_rsqf(ss * (1.f / 64.f) + EPS); const float* gn = FIN(I_NKCN) + L * 64 + c0;
            const int n = n0 + row; const bool dead = n >= 127;
            v4u w0, w1; float o[16];
#pragma unroll
            for (int e = 0; e < 16; ++e) { o[e] = kv ? v[e] : v[e] * rs * gn[e]; if (dead) o[e] = 0.f; }
            w0.x = pk2(o[0], o[1]); w0.y = pk2(o[2], o[3]); w0.z = pk2(o[4], o[5]); w0.w = pk2(o[6], o[7]); w1.x = pk2(o[8], o[9]); w1.y = pk2(o[10], o[11]); w1.z = pk2(o[12], o[13]); w1.w = pk2(o[14], o[15]);
            const int tl = n >> 6, rr = n & 63;
            if (kv) { bf16* dstp = F_VC + (size_t)(b * 2 + tl) * 4096 + vimg_off(rr, c0); *(v4u*)dstp = w0; *(v4u*)(dstp + 8) = w1; }
            else { bf16* dstp = F_KC + (size_t)(b * 2 + tl) * 4096; *(v4u*)(dstp + kimg_off(rr, c0)) = w0; *(v4u*)(dstp + kimg_off(rr, c0 + 8)) = w1; } }
        __syncthreads();
    }
}

#ifndef PROBE_ATT
#define PROBE_ATT 0
#endif
namespace att {
constexpr int STG = 32768;
constexpr int L_STG = 0, L_IA = 65536, IAB = 4 * 64 * 33 * 4, L_IB = L_IA + IAB, L_SC = L_IB + IAB, L_SEL = L_SC + 64 * 33 * 4, L_UNI = L_SEL + 256, L_WSF = L_UNI + 256, L_END = L_WSF + NWAVES * 256;
static_assert(L_END <= MISC_OFF, "attention LDS map");
constexpr int OSTP = 264;
#define ATT_BAR() asm volatile("s_waitcnt vmcnt(0) lgkmcnt(0)\n\ts_barrier" ::: "memory")
#define ATT_LBAR() asm volatile("s_waitcnt lgkmcnt(0)\n\ts_barrier" ::: "memory")
__device__ __forceinline__ int crow(int r, int hi) { return (r & 3) + 8 * (r >> 2) + 4 * hi; }
__device__ __forceinline__ float pair_max(float v) { auto rr = __builtin_amdgcn_permlane32_swap(__float_as_uint(v), __float_as_uint(v), false, false); return fmaxf(__uint_as_float(rr[0]), __uint_as_float(rr[1])); }
__device__ __forceinline__ float pair_sum(float v) { auto rr = __builtin_amdgcn_permlane32_swap(__float_as_uint(v), __float_as_uint(v), false, false); return __uint_as_float(rr[0]) + __uint_as_float(rr[1]); }
__device__ __forceinline__ void dma_tile(const bf16* tile, LAS unsigned char* slot, int wave, int lane) {
    __builtin_amdgcn_global_load_lds((const unsigned*)(tile + wave * 512 + lane * 8), (LAS unsigned*)(slot + wave * 1024), 16, 0, 0); }
__device__ __forceinline__ void qk_tile(f32x16& p0, f32x16& p1, const LAS unsigned char* kslot, const bf16x8 (&qr)[4], int r32, int hi) {
    const LAS unsigned char* kp = kslot + hi * 1024 + r32 * 16;
    p0 = (f32x16){}; p1 = (f32x16){};
#pragma unroll
    for (int d0 = 0; d0 < 4; ++d0) { const bf16x8 b0 = *(const LAS bf16x8*)(kp + d0 * 2048), b1 = *(const LAS bf16x8*)(kp + d0 * 2048 + 512);
        p0 = __builtin_amdgcn_mfma_f32_32x32x16_bf16(b0, qr[d0], p0, 0, 0, 0); p1 = __builtin_amdgcn_mfma_f32_32x32x16_bf16(b1, qr[d0], p1, 0, 0, 0); }
}
__device__ __forceinline__ v4i16_t vtr(const LAS unsigned char* p) { return __builtin_amdgcn_ds_read_tr16_b64_v4i16((LAS v4i16_t*)p); }
__device__ __forceinline__ void pv_tile(f32x16& o0, f32x16& o1, const LAS unsigned char* vslot, const v4u (&pw)[4], int lane, int hi) {
    const unsigned vb = (unsigned)(uintptr_t)(vslot + ((lane >> 4) & 1) * 32 + (lane & 3) * 8 + (4 * hi + ((lane & 15) >> 2)) * 64);
    v4i16_t a0[4], a1[4], b0[4], b1[4];
#pragma unroll
    for (int s_ = 0; s_ < 4; ++s_) {
        asm volatile("ds_read_b64_tr_b16 %0, %1 offset:%c2" : "=&v"(a0[s_]) : "v"(vb), "i"(s_ * 1024) : "memory");
        asm volatile("ds_read_b64_tr_b16 %0, %1 offset:%c2" : "=&v"(a1[s_]) : "v"(vb), "i"(s_ * 1024 + 512) : "memory");
        asm volatile("ds_read_b64_tr_b16 %0, %1 offset:%c2" : "=&v"(b0[s_]) : "v"(vb), "i"(4096 + s_ * 1024) : "memory");
        asm volatile("ds_read_b64_tr_b16 %0, %1 offset:%c2" : "=&v"(b1[s_]) : "v"(vb), "i"(4096 + s_ * 1024 + 512) : "memory"); }
#define PV_STEP(s_, N) do { asm volatile("s_waitcnt lgkmcnt(" #N ")" : "+v"(a0[s_]), "+v"(a1[s_]), "+v"(b0[s_]), "+v"(b1[s_]) :: "memory"); \
        const bf16x8 v0 = (bf16x8){a0[s_][0], a0[s_][1], a0[s_][2], a0[s_][3], a1[s_][0], a1[s_][1], a1[s_][2], a1[s_][3]}, v1 = (bf16x8){b0[s_][0], b0[s_][1], b0[s_][2], b0[s_][3], b1[s_][0], b1[s_][1], b1[s_][2], b1[s_][3]}; \
        const bf16x8 pa = __builtin_bit_cast(bf16x8, pw[s_]); \
        o0 = __builtin_amdgcn_mfma_f32_32x32x16_bf16(pa, v0, o0, 0, 0, 0); o1 = __builtin_amdgcn_mfma_f32_32x32x16_bf16(pa, v1, o1, 0, 0, 0); } while (0)
    PV_STEP(0, 12); PV_STEP(1, 8); PV_STEP(2, 4); PV_STEP(3, 0);
#undef PV_STEP
}
__device__ __forceinline__ void pack_p(v4u (&pw)[4], const f32x16& p0, const f32x16& p1) {
    pw[0] = (v4u){pk2(p0[0], p0[1]), pk2(p0[2], p0[3]), pk2(p0[4], p0[5]), pk2(p0[6], p0[7])};
    pw[1] = (v4u){pk2(p0[8], p0[9]), pk2(p0[10], p0[11]), pk2(p0[12], p0[13]), pk2(p0[14], p0[15])};
    pw[2] = (v4u){pk2(p1[0], p1[1]), pk2(p1[2], p1[3]), pk2(p1[4], p1[5]), pk2(p1[6], p1[7])};
    pw[3] = (v4u){pk2(p1[8], p1[9]), pk2(p1[10], p1[11]), pk2(p1[12], p1[13]), pk2(p1[14], p1[15])};
}
__device__ __forceinline__ void softmax_step(float& m, float& l, f32x16& o0, f32x16& o1, f32x16& p0, f32x16& p1, v4u (&pw)[4], LAS float* wsf, int r32, int hi) {
    float mt = fmaxf(p0[0], p1[0]);
#pragma unroll
    for (int r = 1; r < 16; ++r) mt = fmaxf(mt, fmaxf(p0[r], p1[r]));
    mt = pair_max(mt);
    if (__any(mt > m + 8.0f)) {
        const float mn = fmaxf(m, mt);
        const float al = __builtin_amdgcn_exp2f(m - mn); l *= al; m = mn;
        if (hi == 0) wsf[r32] = al;
        f32x4 a[4];
#pragma unroll
        for (int g = 0; g < 4; ++g) a[g] = *(const LAS f32x4*)(wsf + 8 * g + 4 * hi);
#pragma unroll
        for (int r = 0; r < 16; ++r) { o0[r] *= a[r >> 2][r & 3]; o1[r] *= a[r >> 2][r & 3]; }
    }
    float rs = 0.f;
#pragma unroll
    for (int r = 0; r < 16; ++r) { p0[r] = __builtin_amdgcn_exp2f(p0[r] - m); p1[r] = __builtin_amdgcn_exp2f(p1[r] - m); rs += p0[r] + p1[r]; }
    l += rs;
    pack_p(pw, p0, p1);
}
__device__ __forceinline__ void scale_rows(f32x16& a0, f32x16& a1, const f32x16& o0, const f32x16& o1, float fac, LAS float* wsf, int r32, int hi) {
    if (hi == 0) wsf[32 + r32] = fac;
    f32x4 f[4];
#pragma unroll
    for (int g = 0; g < 4; ++g) f[g] = *(const LAS f32x4*)(wsf + 32 + 8 * g + 4 * hi);
#pragma unroll
    for (int r = 0; r < 16; ++r) { a0[r] += o0[r] * f[r >> 2][r & 3]; a1[r] += o1[r] * f[r >> 2][r & 3]; }
}
template <int MODE>
__device__ __forceinline__ void run_branch(unsigned tiles, const bf16* Kg  , const bf16* Vg, int kvsel, unsigned selm, int tq, const bf16x8 (&qr)[4],
                                           float& m, float& l, f32x16& o0, f32x16& o1, LAS unsigned char* lds, LAS float* wsf, int wave, int lane) {
    constexpr int NKV = MODE == 2 ? 2 : 1, SLOT = 16384 * NKV, NS = MODE == 2 ? 4 : 8;
    const int r32 = lane & 31, hi = lane >> 5;
    m = -1e30f; l = 0.f; o0 = (f32x16){}; o1 = (f32x16){};
    unsigned remc = (unsigned)__builtin_amdgcn_readfirstlane((int)tiles), remi = remc;
    int nleft = __builtin_popcount(remc), slot_i = 0, slot_c = 0;
    ATT_LBAR();
#define ATT_ISSUE() do { const int ji = __builtin_ctz(remi); remi &= remi - 1; LAS unsigned char* st_ = lds + L_STG + slot_i * SLOT; slot_i = (slot_i + 1) & (NS - 1); \
        _Pragma("unroll") for (int g = 0; g < NKV; ++g) { dma_tile(Kg + (size_t)(g * 512 + ji) * 4096, st_ + g * 8192, wave, lane); dma_tile(Vg + (size_t)(g * 512 + ji) * 4096, st_ + NKV * 8192 + g * 8192, wave, lane); } } while (0)
#define ATT_WB(n) asm volatile("s_waitcnt vmcnt(" #n ") lgkmcnt(0)\n\ts_barrier" ::: "memory")
#pragma nounroll
    for (int k = 0; k < NS - 1; ++k) if (remi) ATT_ISSUE();
    for (;;) {
        const int pend = (nleft - 1 < NS - 2 ? nleft - 1 : NS - 2) * NKV;
        switch (pend) { case 0: ATT_WB(0); break; case 1: ATT_WB(2); break; case 2: ATT_WB(4); break; case 3: ATT_WB(6); break; case 4: ATT_WB(8); break; case 5: ATT_WB(10); break; default: ATT_WB(12); break; }
        if (remi) ATT_ISSUE();
        const int j = __builtin_ctz(remc); remc &= remc - 1; --nleft;
        const LAS unsigned char* st = lds + L_STG + slot_c * SLOT; slot_c = (slot_c + 1) & (NS - 1);
        f32x16 p0, p1; qk_tile(p0, p1, st + kvsel * 8192, qr, r32, hi);
        const int kb = 64 * j + 4 * hi; const bool sel = MODE != 0 || ((selm >> j) & 1u);
        constexpr int W = MODE == 1 ? 512 : 128;
        const int curt = __builtin_amdgcn_readfirstlane(tq) >> 6;
        const bool edge = MODE == 3 || j == curt || (MODE != 0 && j + W / 64 == curt);
        if (edge) {
#pragma unroll
            for (int r = 0; r < 16; ++r) { const int kp = kb + (r & 3) + 8 * (r >> 2);
                bool v0, v1;
                if (MODE == 0) { v0 = sel && kp <= tq; v1 = sel && kp + 32 <= tq; }
                else if (MODE == 3) { v0 = 16 * kp + 31 <= tq; v1 = 16 * (kp + 32) + 31 <= tq; }
                else { v0 = kp <= tq && kp + W > tq; v1 = kp + 32 <= tq && kp + 32 + W > tq; }
                p0[r] = v0 ? p0[r] : -INFINITY; p1[r] = v1 ? p1[r] : -INFINITY; }
        } else if (MODE == 0) {
#pragma unroll
            for (int r = 0; r < 16; ++r) { p0[r] = sel ? p0[r] : -INFINITY; p1[r] = sel ? p1[r] : -INFINITY; }
        }
        v4u pw[4]; softmax_step(m, l, o0, o1, p0, p1, pw, wsf, r32, hi);
        pv_tile(o0, o1, st + NKV * 8192 + kvsel * 8192, pw, lane, hi);
        if (nleft == 0) break;
    }
#undef ATT_ISSUE
#undef ATT_WB
}
__device__ __forceinline__ void stage_norm_store(const f32x16& o0, const f32x16& o1, bf16* ynb  , LAS unsigned char* lds, int wave, int lane) {
    const int r32 = lane & 31, hi = lane >> 5, h = wave & 3, th = wave >> 2;
    LAS bf16* OST = (LAS bf16*)(lds + L_STG);
    ATT_LBAR();
#pragma unroll
    for (int r = 0; r < 16; ++r) { LAS bf16* p = OST + (32 * th + crow(r, hi)) * OSTP + h * 64 + r32;
        p[0] = (bf16)(pk2(o0[r], 0.f) & 0xffffu); p[32] = (bf16)(pk2(o1[r], 0.f) & 0xffffu); }
    ATT_LBAR();
    f32x4 vv[8]; float ssn[8];
#pragma unroll
    for (int i = 0; i < 8; ++i) { const u32x2 w = *(const LAS u32x2*)(OST + (8 * wave + i) * OSTP + 4 * lane); vv[i] = (f32x4){bflo(w.x), bfhi(w.x), bflo(w.y), bfhi(w.y)}; ssn[i] = sq4(vv[i]); }
#pragma unroll
    for (int i = 0; i < 8; ++i) ssn[i] = wave_sum(ssn[i]);
#pragma unroll
    for (int i = 0; i < 8; ++i) st4bf(ynb + (size_t)(8 * wave + i) * D + 4 * lane, vv[i] * __builtin_amdgcn_rsqf(ssn[i] * (1.f / 256.f) + EPS));
}
__device__ __forceinline__ void attn_unit(Frame& F, int L, int b, int qt) {
    LAS unsigned char* lds = F.lds;
    int tid = F.tid; asm volatile("" : "+v"(tid));
    const int wave = F.wave, lane = tid & 63, r32 = lane & 31, hi = lane >> 5, h = wave & 3, th = wave >> 2;
    const int t0 = qt * 64, cur = qt, qrow = 32 * th + r32, tq = t0 + qrow;
    const size_t mrow = (size_t)b * T + tq;
    LAS float* wsf = (LAS float*)(lds + L_WSF) + wave * 64;
    LAS float* IA = (LAS float*)(lds + L_IA); LAS float* IB = (LAS float*)(lds + L_IB); LAS float* SC = (LAS float*)(lds + L_SC);
    LAS unsigned* SEL = (LAS unsigned*)(lds + L_SEL); LAS unsigned* UNI = (LAS unsigned*)(lds + L_UNI);
    const size_t tb = (size_t)b * 32 * 4096;
    bf16x8 qr[4];
#pragma unroll
    for (int d0 = 0; d0 < 4; ++d0) qr[d0] = *(const bf16x8*)(F_QA + mrow * 256 + h * 64 + d0 * 16 + hi * 8);
    const float* gp = F_GATES + mrow * 12 + h * 3; const float g0 = gp[0], g1 = gp[1], g2 = gp[2];
    f32x16 ot0 = (f32x16){}, ot1 = (f32x16){};
    float mb, lb; f32x16 ob0, ob1;
    for (int rep = 0; rep < ((PROBE_ATT & 4) ? 2 : 1); ++rep) {
        if (rep) { ATT_LBAR(); ot0 = (f32x16){}; ot1 = (f32x16){}; }
        if (tid == 0) UNI[0] = 0u;
        run_branch<3>(3u, F_KC + (size_t)b * 2 * 4096, F_VC + (size_t)b * 2 * 4096, 0, 0u, tq, qr, mb, lb, ob0, ob1, lds, wsf, wave, lane);
        const float lt = pair_sum(lb); const float inv = lt > 0.f ? 1.0f / lt : 0.f;
        scale_rows(ot0, ot1, ob0, ob1, g0 * inv, wsf, r32, hi);
        LAS float* ia = IA + (h * 64 + qrow) * 33; LAS float* ib = IB + (h * 64 + qrow) * 33;
#pragma unroll
        for (int tl = 0; tl < 2; ++tl) { f32x16 p0, p1; qk_tile(p0, p1, lds + L_STG + tl * 16384, qr, r32, hi);
#pragma unroll
            for (int r = 0; r < 16; ++r) { const int n = 64 * tl + crow(r, hi);
                p0[r] = 16 * n + 31 <= tq ? __builtin_amdgcn_exp2f(p0[r] - mb) * inv : 0.f; p1[r] = 16 * (n + 32) + 31 <= tq ? __builtin_amdgcn_exp2f(p1[r] - mb) * inv : 0.f; }
#pragma unroll
            for (int G = 0; G < 4; ++G) {
                ia[hi + 2 * (G + 8 * tl)] = (p0[4 * G] + p0[4 * G + 1]) + (p0[4 * G + 2] + p0[4 * G + 3]); ib[hi + 2 * (G + 8 * tl)] = p0[4 * G + 3];
                ia[hi + 2 * (G + 4 + 8 * tl)] = (p1[4 * G] + p1[4 * G + 1]) + (p1[4 * G + 2] + p1[4 * G + 3]); ib[hi + 2 * (G + 4 + 8 * tl)] = p1[4 * G + 3]; } }
        ATT_LBAR();
        const int q = tid >> 3, jg = tid & 7, tqq = t0 + q;
#pragma unroll
        for (int i = 0; i < 4; ++i) { const int j = 4 * jg + i; float imp = 0.f;
#pragma unroll
            for (int hh = 0; hh < 4; ++hh) { imp += IA[(hh * 64 + q) * 33 + j]; if (j > 0) imp += IB[(hh * 64 + q) * 33 + j - 1]; }
            const bool forced = j == 0 || j == cur || j == cur - 1, future = j * 64 > tqq;
            SC[q * 33 + j] = forced ? 1e4f : (future ? -1.0f : imp); }
        ATT_LBAR();
        unsigned bits = 0u;
#pragma unroll
        for (int i = 0; i < 4; ++i) { const int j = 4 * jg + i; const float sj = SC[q * 33 + j]; int rank = 0;
#pragma unroll 8
            for (int k = 0; k < 32; ++k) { const float sk = SC[q * 33 + k]; rank += (sk > sj || (sk == sj && k < j)) ? 1 : 0; }
            if (rank < 8) bits |= 1u << j; }
        bits |= __shfl_xor(bits, 1); bits |= __shfl_xor(bits, 2); bits |= __shfl_xor(bits, 4);
        if (jg == 0) { SEL[q] = bits; atomicOr((unsigned*)UNI, bits); }
        ATT_LBAR();
    }
    { const unsigned selm = SEL[qrow]; const unsigned uni = UNI[0] & ((2u << cur) - 1u);
      if (PROBE_ATT & 1) run_branch<0>(uni, F_KSI + tb, F_VSI + tb, 0, selm, tq, qr, mb, lb, ob0, ob1, lds, wsf, wave, lane);
      run_branch<0>(uni, F_KSI + tb, F_VSI + tb, 0, selm, tq, qr, mb, lb, ob0, ob1, lds, wsf, wave, lane);
      const float lt = pair_sum(lb); scale_rows(ot0, ot1, ob0, ob1, g1 / lt, wsf, r32, hi); }
    { const int lo = cur >= 8 ? cur - 8 : 0; const unsigned tiles = ((2u << cur) - 1u) & ~((1u << lo) - 1u);
      if (PROBE_ATT & 2) run_branch<1>(tiles, F_KWI + tb, F_VWI + tb, 0, 0u, tq, qr, mb, lb, ob0, ob1, lds, wsf, wave, lane);
      run_branch<1>(tiles, F_KWI + tb, F_VWI + tb, 0, 0u, tq, qr, mb, lb, ob0, ob1, lds, wsf, wave, lane);
      const float lt = pair_sum(lb); scale_rows(ot0, ot1, ob0, ob1, g2 / lt, wsf, r32, hi); }
    stage_norm_store(ot0, ot1, F_YN + ((size_t)b * T + t0) * D + 0, lds, wave, lane);
    for (int rep = 0; rep < ((PROBE_ATT & 16) ? 2 : 1); ++rep) {
#pragma unroll
        for (int d0 = 0; d0 < 4; ++d0) qr[d0] = *(const bf16x8*)(F_QC + mrow * 256 + h * 64 + d0 * 16 + hi * 8);
        const int lo = cur >= 2 ? cur - 2 : 0; const unsigned tiles = ((2u << cur) - 1u) & ~((1u << lo) - 1u);
        run_branch<2>(tiles, F_CKI + tb, F_CVI + tb, h >> 1, 0u, tq, qr, mb, lb, ob0, ob1, lds, wsf, wave, lane);
        const float sink2 = FIN(I_SINK)[L * 4 + h] * LOG2E;
        const float mf = fmaxf(mb, sink2), sc = __builtin_amdgcn_exp2f(mb - mf);
        const float lt = pair_sum(lb) * sc + __builtin_amdgcn_exp2f(sink2 - mf);
        ot0 = (f32x16){}; ot1 = (f32x16){};
        scale_rows(ot0, ot1, ob0, ob1, sc / lt, wsf, r32, hi);
        stage_norm_store(ot0, ot1, F_YN + ((size_t)b * T + t0) * D + 512, lds, wave, lane);
    }
}
__device__ __forceinline__ void attn_phase(Frame& F, int L) {
    for (int w = F.vcu; w < 256; w += F.G) { const int b = w >> 4, i = w & 15;
#pragma nounroll
        for (int u2 = 0; u2 < 2; ++u2) attn_unit(F, L, b, u2 ? 31 - i : i); }
    ATT_LBAR();
}
}

__global__ void __launch_bounds__(NWAVES * 64, 2) fwd(Args args) {
    extern __shared__ __attribute__((aligned(16))) unsigned char lds[];
    Frame F;
    F.lds = (LAS unsigned char*)lds;
    F.tid = threadIdx.x; F.lane = F.tid & 63; F.wave = __builtin_amdgcn_readfirstlane(F.tid >> 6);
    F.G = gridDim.x; { const int bx = blockIdx.x; F.vcu = (F.G % 8 == 0) ? (bx % 8) * (F.G / 8) + bx / 8 : bx; }
    F.a = &args;
    unsigned char* ws = args.ws;
    volatile LAS unsigned* MISC = (volatile LAS unsigned*)(F.lds + MISC_OFF);
    if (F.tid < 64) MISC[F.tid] = 0u;
    __syncthreads();
#define GRID_BAR() do { XcdBarrier b2_ = bar; { unsigned xx_ = b2_.x; asm volatile("" : "+s"(xx_)); b2_.x = xx_; }     \
        xcd_barrier(b2_); if (PROBE_DUP & 1024) xcd_barrier(b2_); __builtin_amdgcn_s_waitcnt(0); } while (0)
    XcdBarrier bar = xcd_barrier_post((unsigned*)(ws + WS_CTL) + CW_BAR, MISC + 8);

#ifndef PH_MASK
#define PH_MASK 127
#endif
#ifndef PROBE_DUP
#define PROBE_DUP 0
#endif
    if (PH_MASK & 1) prologue(F);
    if (PROBE_DUP & 1) prologue(F);
    GRID_BAR();
    for (int s = 0; s < 2 * DEPTH; ++s) {
        const int L = s >> 1, which = s & 1;
        const bool up8 = (UP8_MASK >> s) & 1u, dn8 = (DN8_MASK >> s) & 1u;
        if (PH_MASK & 2) {
            const bf16* wt = (const bf16*)((unsigned char*)F_W13T + (size_t)s * NF1 * D * 2); pg8::StaticOrder S; S.init(M, NF1, F.G, (int)blockIdx.x);
            if (up8) { pg8::Gemm g{(const bf16*)F_X8, wt, M, NF1, D / 2};
                if (PROBE_DUP & 128) { pg8::EpiNull EN{F_GATES}; pg8::gemm_phase<pg8::EpiNull, pg8::StaticOrder, true, true, true>(F.lds, g, S, EN); }
                if (PROBE_DUP & 256) { pg8::EpiNull EN{F_GATES}; pg8::FixedOrder<1> S2; S2.init(M, NF1, F.G, (int)blockIdx.x); pg8::gemm_phase<pg8::EpiNull, pg8::FixedOrder<1>, true, true, true>(F.lds, g, S2, EN); }
                if (PROBE_DUP & 512) { pg8::EpiNull EN{F_GATES}; pg8::FixedOrder<3> S2; S2.init(M, NF1, F.G, (int)blockIdx.x); pg8::gemm_phase<pg8::EpiNull, pg8::FixedOrder<3>, true, true, true>(F.lds, g, S2, EN); }
                if (dn8) { pg8::EpiSwiglu<true> E{(void*)F_ACT, DFF, F_SSQ, 1.0f / W8_SCALE, ACT8_SCALE, F.lds + pg8::STAGE_BYTES, 0, 0, 0}; for (int rep = 0; rep < ((PROBE_DUP & 2) ? 2 : 1); ++rep) pg8::gemm_phase<pg8::EpiSwiglu<true>, pg8::StaticOrder, true, true, true>(F.lds, g, S, E); }
                else if (((UP8_MASK & ~DN8_MASK) & 0xFu) != 0u) { pg8::EpiSwiglu<false> E{(void*)F_ACT, DFF, F_SSQ, 1.0f / W8_SCALE, 1.0f, F.lds + pg8::STAGE_BYTES, 0, 0, 0}; for (int rep = 0; rep < ((PROBE_DUP & 2) ? 2 : 1); ++rep) pg8::gemm_phase<pg8::EpiSwiglu<false>, pg8::StaticOrder, true, true, true>(F.lds, g, S, E); } }
            else { pg8::Gemm g{F_XB, wt, M, NF1, D};
                if (dn8) { if (((~UP8_MASK & DN8_MASK) & 0xFu) != 0u) { pg8::EpiSwiglu<true> E{(void*)F_ACT, DFF, F_SSQ, 1.0f, ACT8_SCALE, F.lds + pg8::STAGE_BYTES, 0, 0, 0}; for (int rep = 0; rep < ((PROBE_DUP & 2) ? 2 : 1); ++rep) pg8::gemm_phase<pg8::EpiSwiglu<true>, pg8::StaticOrder, true, true, false>(F.lds, g, S, E); } }
                else if (((~UP8_MASK & ~DN8_MASK) & 0xFu) != 0u) { pg8::EpiSwiglu<false> E{(void*)F_ACT, DFF, F_SSQ, 1.0f, 1.0f, F.lds + pg8::STAGE_BYTES, 0, 0, 0}; for (int rep = 0; rep < ((PROBE_DUP & 2) ? 2 : 1); ++rep) pg8::gemm_phase<pg8::EpiSwiglu<false>, pg8::StaticOrder, true, true, false>(F.lds, g, S, E); } }
        }
        GRID_BAR();
        if (PH_MASK & 4) {
            const bf16* wt = (const bf16*)((unsigned char*)F_W2T + (size_t)s * D * DFF * 2); pg8::StaticOrder S; S.init(M, D, F.G, (int)blockIdx.x);
            const int last = (s + 1 == 2 * DEPTH) ? 1 : 0, w8 = ((s & 1) && !last && ((UP8_MASK >> (s + 1)) & 1u)) ? 1 : 0;
            if (dn8) { if (DN8_MASK & 0xFu) { pg8::Gemm g{F_ACT, wt, M, D, DFF / 2}; pg8::EpiRes E{F_XB, F_SSQ, 1, F_X8, FOUT, w8, last}; pg8::gemm_phase<pg8::EpiRes, pg8::StaticOrder, true, true, true>(F.lds, g, S, E); } }
            else if ((~DN8_MASK) & 0xFu) { pg8::Gemm g{F_ACT, wt, M, D, DFF}; pg8::EpiRes E{F_XB, F_SSQ, 0, F_X8, FOUT, w8, last}; pg8::gemm_phase<pg8::EpiRes, pg8::StaticOrder, true, true, false>(F.lds, g, S, E); }
        }
        if (s + 1 < 2 * DEPTH) GRID_BAR();
        if (which == 0) {
            if (PH_MASK & 8) {
                pg8::Gemm g{F_XB, F_WINT + (size_t)L * NU * D, M, NU, D}; pg8::StaticOrder S; S.init(M, NU, F.G, (int)blockIdx.x);
                pg8::EpiScaleBf16 E{F_U, NU, F_SSQ, F.lds + pg8::STAGE_BYTES, 0, 0, 0};
                for (int rep = 0; rep < ((PROBE_DUP & 8) ? 2 : 1); ++rep) pg8::gemm_phase<pg8::EpiScaleBf16, pg8::StaticOrder, true, true>(F.lds, g, S, E);
            }
            GRID_BAR();
            if (PH_MASK & 16) prep_phase(F, L);
            if (PROBE_DUP & 16) prep_phase(F, L);
            GRID_BAR();
            if (PH_MASK & 32) att::attn_phase(F, L);
            if (PROBE_DUP & 32) att::attn_phase(F, L);
            GRID_BAR();
            if (PH_MASK & 64) {
                pg8::Gemm g{F_YN, F_WOUTT + (size_t)L * D * D, M, D, D}; pg8::StaticOrder S; S.init(M, D, F.G, (int)blockIdx.x);
                pg8::EpiRes E{F_XB, F_SSQ, 2, F_X8, FOUT, (int)((UP8_MASK >> (2 * L + 1)) & 1u), 0};
                pg8::gemm_phase<pg8::EpiRes, pg8::StaticOrder, true, true>(F.lds, g, S, E);
            }
            GRID_BAR();
        }
    }
}

extern "C" void kernel_launch(void* const* d_in, const int* in_sizes, int n_in, void* d_out, int out_size, void* d_ws, size_t ws_size, hipStream_t stream) {
    static int grid = 0;
    if (grid == 0) {
        if (n_in != 29 || in_sizes[0] != M * D || out_size != M * D || ws_size < WS_END) { fprintf(stderr, "kernel_launch: unexpected shapes (n_in %d, in0 %d, out %d, ws %zu); nothing launched\n", n_in, n_in > 0 ? in_sizes[0] : -1, out_size, ws_size); grid = -1; return; }
        int dev = 0, cus = 0, per_cu = 0;
        if (hipGetDevice(&dev) != hipSuccess || hipDeviceGetAttribute(&cus, hipDeviceAttributeMultiprocessorCount, dev) != hipSuccess) { grid = -1; return; }
        if (hipFuncSetAttribute((const void*)fwd, hipFuncAttributeMaxDynamicSharedMemorySize, LDS_BYTES) != hipSuccess) { fprintf(stderr, "kernel_launch: hipFuncSetAttribute failed\n"); grid = -1; return; }
        if (hipOccupancyMaxActiveBlocksPerMultiprocessor(&per_cu, (const void*)fwd, NWAVES * 64, LDS_BYTES) != hipSuccess || per_cu < 1) fprintf(stderr, "kernel_launch: occupancy query says %d\n", per_cu);
        (void)hipGetLastError();
        grid = cus;
    }
    if (grid < 0) return;
    if (hipMemsetAsync((char*)d_ws + WS_CTL, 0, CTL_ZERO_BYTES, stream) != hipSuccess) return;
    Args a{};
    for (int i = 0; i < 29; ++i) a.in[i] = (const float*)d_in[i];
    a.out = (float*)d_out; a.ws = (unsigned char*)d_ws;
    hipLaunchKernelGGL(fwd, dim3(grid), dim3(NWAVES * 64), LDS_BYTES, stream, a);
}
```

```cpp
#include <hip/hip_runtime.h>
#include <cstdio>
#include <cstdint>
struct KArgs { const float* in[29]; float* out; unsigned char* ws; };
namespace pg8 {
#define PG8_LAS __attribute__((address_space(3)))
typedef unsigned short bf16_t;
typedef short bf16x8 __attribute__((ext_vector_type(8)));
typedef float f32x4 __attribute__((ext_vector_type(4)));
typedef unsigned u32x4 __attribute__((ext_vector_type(4)));
constexpr int BM = 256, BK = 64, HALF = 128, HTB = HALF * BK * 2  , STAGE_BYTES = 8 * HTB, NXCD = 8, WGM = 8;

__host__ __device__ __forceinline__ int lds_byte(int r, int c) { const int st = (r >> 4) * 2 + (c >> 5), rr = r & 15, cc = c & 31, ob = rr * 64 + cc * 2; return st * 1024 + (ob ^ (((ob >> 9) & 1) << 5)); }
__host__ __device__ __forceinline__ void stage_rc(int b, int& R, int& C) { const int st = b / 1024, sb = b % 1024, swz = sb ^ (((sb >> 9) & 1) << 5); R = (st >> 1) * 16 + swz / 64; C = (st & 1) * 32 + (swz % 64) / 2; }
__host__ __device__ __forceinline__ int perm32(int rho) { const int n = rho >> 4, i = rho & 15; return 8 * (i >> 2) + 4 * n + (i & 3); }

struct Unit { int pm, pn; };
struct Gemm { const bf16_t* A; const bf16_t* Bt; int M, N, K; };

struct StaticOrder {
    int nM, nN, nwg, G, c;
    __host__ __device__ void init(int M, int N, int G_, int c_) { nM = M / BM; nN = N / BM; nwg = nM * nN; G = G_; c = c_; }
    __host__ __device__ bool next(int i, Unit& u) const {
        const long L = (long)i * G + c; if (L >= nwg) return false;
        int wgid = (int)L; { const int q = nwg / NXCD, r = nwg % NXCD, xcd = wgid % NXCD, off = wgid / NXCD; wgid = (xcd < r ? xcd * (q + 1) : r * (q + 1) + (xcd - r) * q) + off; }
        const int nig = WGM * nN, gid = wgid / nig, fm = gid * WGM, gsz = (nM - fm) < WGM ? (nM - fm) : WGM;
        u.pm = fm + ((wgid % nig) % gsz); u.pn = (wgid % nig) / gsz; return true;
    }
    __device__ __forceinline__ void a_ready(const Unit&) const {}
    __device__ __forceinline__ void done(const Unit&) const {}
};

__device__ __forceinline__ unsigned cvt_pk_bf16(float lo, float hi) { unsigned r; asm volatile("v_cvt_pk_bf16_f32 %0, %1, %2" : "=v"(r) : "v"(lo), "v"(hi)); return r; }

typedef unsigned u32x2 __attribute__((ext_vector_type(2)));
typedef int i32x4 __attribute__((ext_vector_type(4)));
typedef int i32x8 __attribute__((ext_vector_type(8)));
#ifndef MFMA8_SCALE
#define MFMA8_SCALE 1
#endif
__device__ __forceinline__ i32x8 cat8(bf16x8 a, bf16x8 b) { return __builtin_shufflevector(__builtin_bit_cast(i32x4, a), __builtin_bit_cast(i32x4, b), 0, 1, 2, 3, 4, 5, 6, 7); }
__device__ __forceinline__ void mfma8(f32x4& acc, const i32x8& b, const i32x8& a, int sc) {
#if MFMA8_SCALE
    asm volatile("v_mfma_scale_f32_16x16x128_f8f6f4 %0, %1, %2, %0, %3, %3 op_sel_hi:[0,0,0]" : "+v"(acc) : "v"(b), "v"(a), "v"(sc));
#else
    asm volatile("v_mfma_f32_16x16x128_f8f6f4 %0, %1, %2, %0" : "+v"(acc) : "v"(b), "v"(a));
#endif
}
__device__ __forceinline__ unsigned pk4_fp8(float a, float b, float c, float d) { int w = 0; w = __builtin_amdgcn_cvt_pk_fp8_f32(a, b, w, false); w = __builtin_amdgcn_cvt_pk_fp8_f32(c, d, w, true); return (unsigned)w; }
__device__ __forceinline__ unsigned pkbf(float lo, float hi) { typedef float f2_t __attribute__((ext_vector_type(2))); typedef __bf16 b2_t __attribute__((ext_vector_type(2))); f2_t v = {lo, hi}; b2_t b = __builtin_convertvector(v, b2_t); return __builtin_bit_cast(unsigned, b); }
__device__ __forceinline__ float bf_lo(unsigned u) { return __builtin_bit_cast(float, u << 16); }
__device__ __forceinline__ float bf_hi(unsigned u) { return __builtin_bit_cast(float, u & 0xffff0000u); }
__device__ __forceinline__ float swap32_add(float v) { auto rr = __builtin_amdgcn_permlane32_swap(__float_as_uint(v), __float_as_uint(v), false, false); return __uint_as_float(rr[0]) + __uint_as_float(rr[1]); }
__device__ __forceinline__ void fill_rstd_tbl(PG8_LAS unsigned char* tblp, const float* ssq, int pm, int wid, int lane) {
    const int r = wid * 32 + (lane >> 1), hf = lane & 1; const float* p = ssq + (size_t)(pm * BM + r) * 16 + 8 * hf;
    const f32x4 a = *(const f32x4*)p, b = *(const f32x4*)(p + 4);
    float s = ((a[0] + a[1]) + (a[2] + a[3])) + ((b[0] + b[1]) + (b[2] + b[3]));
    s += __builtin_bit_cast(float, __builtin_amdgcn_update_dpp(0, __builtin_bit_cast(int, s), 0xB1, 0xf, 0xf, true));
    if (hf == 0) ((PG8_LAS float*)tblp)[r] = __builtin_amdgcn_rsqf(s * (1.0f / 1024.0f) + 1e-6f);
}
__device__ __forceinline__ void rows_rstd(float (&rs)[2][4], const PG8_LAS unsigned char* tblp, int wr, int fr, float scale) {
#pragma unroll
    for (int ai = 0; ai < 2; ++ai)
#pragma unroll
        for (int m = 0; m < 4; ++m) rs[ai][m] = ((const PG8_LAS float*)tblp)[ai * HALF + wr * 64 + m * 16 + fr] * scale;
}
template <bool F8> struct EpiSwiglu {
    static constexpr bool PERM = true, AFTER_DRAIN = false, ROW_RSTD = true;
    void* O; int ldc; const float* ssq; float insc, oscale; PG8_LAS unsigned char* tbl; mutable int pmA, pmB, pmC;
    __device__ __forceinline__ void set_panels(int a, int b, int c) const { pmA = a; pmB = b; pmC = c; }
    __device__ __forceinline__ void fill_rstd(PG8_LAS unsigned char* t, int pm, int wid, int lane) const { fill_rstd_tbl(t, ssq, pm, wid, lane); }
    __device__ __forceinline__ void operator()(const f32x4 (&acc)[2][2][4][2], const Unit& u, int wr, int wc, int fr_, int fq_) const {
        int tl_ = threadIdx.x; asm volatile("" : "+v"(tl_)); const int fr = tl_ & 15, fq = (tl_ >> 4) & 3; (void)fr_; (void)fq_;
        const int row0 = u.pm * BM + wr * 64 + fr, col0 = u.pn * HALF + wc * 32 + 8 * fq;
        float rsv[2][4]; rows_rstd(rsv, tbl + (u.pm == pmA ? 0 : (u.pm == pmB ? 1024 : (u.pm == pmC ? 2048 : 3072))), wr, fr, insc);
#pragma unroll
        for (int ai = 0; ai < 2; ++ai)
#pragma unroll
            for (int m = 0; m < 4; ++m) { const int row = row0 + ai * HALF + m * 16; const float rs = rsv[ai][m], rsb = rs * (F8 ? oscale : 1.0f); f32x4 ov[2];
#pragma unroll
                for (int n = 0; n < 2; ++n) { const f32x4 a = acc[ai][0][m][n] * rs, b = acc[ai][1][m][n] * rsb, tt = a * -1.4426950408889634f; f32x4 r;
#pragma unroll
                    for (int e = 0; e < 4; ++e) r[e] = __builtin_amdgcn_rcpf(1.0f + __builtin_amdgcn_exp2f(tt[e]));
                    ov[n] = (a * b) * r; }
                const float o[8] = {ov[0][0], ov[0][1], ov[0][2], ov[0][3], ov[1][0], ov[1][1], ov[1][2], ov[1][3]};
                if constexpr (F8) { u32x2 w; w.x = pk4_fp8(o[0], o[1], o[2], o[3]); w.y = pk4_fp8(o[4], o[5], o[6], o[7]);
                    *(u32x2*)((unsigned char*)O + (size_t)row * ldc + col0) = w; }
                else { u32x4 w; w.x = pkbf(o[0], o[1]); w.y = pkbf(o[2], o[3]); w.z = pkbf(o[4], o[5]); w.w = pkbf(o[6], o[7]);
                    *(u32x4*)((bf16_t*)O + (size_t)row * ldc + col0) = w; } }
    }
};
struct EpiScaleBf16 {
    static constexpr bool PERM = true, AFTER_DRAIN = false, ROW_RSTD = true;
    bf16_t* O; int ldc; const float* ssq; PG8_LAS unsigned char* tbl; mutable int pmA, pmB, pmC;
    __device__ __forceinline__ void set_panels(int a, int b, int c) const { pmA = a; pmB = b; pmC = c; }
    __device__ __forceinline__ void fill_rstd(PG8_LAS unsigned char* t, int pm, int wid, int lane) const { fill_rstd_tbl(t, ssq, pm, wid, lane); }
    __device__ __forceinline__ void operator()(const f32x4 (&acc)[2][2][4][2], const Unit& u, int wr, int wc, int fr_, int fq_) const {
        int tl_ = threadIdx.x; asm volatile("" : "+v"(tl_)); const int fr = tl_ & 15, fq = (tl_ >> 4) & 3; (void)fr_; (void)fq_;
        const int row0 = u.pm * BM + wr * 64 + fr, col0 = u.pn * BM + wc * 32 + 8 * fq;
        float rsv[2][4]; rows_rstd(rsv, tbl + (u.pm == pmA ? 0 : (u.pm == pmB ? 1024 : (u.pm == pmC ? 2048 : 3072))), wr, fr, 1.0f);
#pragma unroll
        for (int ai = 0; ai < 2; ++ai)
#pragma unroll
            for (int m = 0; m < 4; ++m) { const int row = row0 + ai * HALF + m * 16; const float rs = rsv[ai][m];
#pragma unroll
                for (int bj = 0; bj < 2; ++bj) { const f32x4 v0 = acc[ai][bj][m][0] * rs, v1 = acc[ai][bj][m][1] * rs;
                    u32x4 w; w.x = pkbf(v0[0], v0[1]); w.y = pkbf(v0[2], v0[3]); w.z = pkbf(v1[0], v1[1]); w.w = pkbf(v1[2], v1[3]);
                    *(u32x4*)(O + (size_t)row * ldc + col0 + bj * HALF) = w; } }
    }
};
struct EpiRes {
    static constexpr bool PERM = false, AFTER_DRAIN = false, ROW_RSTD = false;
    bf16_t* xb; float* ssq; int mode; unsigned char* x8p; float* outp; int w8, fin;
    __device__ __forceinline__ void operator()(const f32x4 (&acc)[2][2][4][2], const Unit& u, int wr, int wc, int fr_, int fq_) const {
        int tl_ = threadIdx.x; asm volatile("" : "+v"(tl_)); const int fr = tl_ & 15, fq = (tl_ >> 4) & 3; (void)fr_; (void)fq_;
        const int row0 = u.pm * BM + wr * 64 + fr, col0 = u.pn * BM + wc * 32 + 4 * fq;
        int md_ = __builtin_amdgcn_readfirstlane(mode), w8_ = __builtin_amdgcn_readfirstlane(w8), fin_ = __builtin_amdgcn_readfirstlane(fin); asm volatile("" : "+s"(md_), "+s"(w8_), "+s"(fin_));
        const float alpha = md_ == 0 ? 0.5f : (md_ == 1 ? 0.5f / 256.0f : 1.0f);
        float* const outf = fin_ ? outp : nullptr; unsigned char* const x8 = w8_ ? x8p : nullptr;
#pragma unroll
        for (int ai = 0; ai < 2; ++ai) { u32x2 old[4][2][2];
#pragma unroll
            for (int m = 0; m < 4; ++m)
#pragma unroll
                for (int bj = 0; bj < 2; ++bj)
#pragma unroll
                    for (int n = 0; n < 2; ++n) old[m][bj][n] = *(const u32x2*)(xb + (size_t)(row0 + ai * HALF + m * 16) * 1024 + col0 + bj * HALF + n * 16);
            float ssv[4];
#pragma unroll
            for (int m = 0; m < 4; ++m) { const int row = row0 + ai * HALF + m * 16; const size_t off = (size_t)row * 1024 + col0; float ss = 0.f;
#pragma unroll
                for (int bj = 0; bj < 2; ++bj)
#pragma unroll
                    for (int n = 0; n < 2; ++n) { const u32x2 ow = old[m][bj][n]; const f32x4 xo = (f32x4){bf_lo(ow.x), bf_hi(ow.x), bf_lo(ow.y), bf_hi(ow.y)}; const f32x4 xn = xo + acc[ai][bj][m][n] * alpha;
                        if (outf) *(f32x4*)(outf + off + bj * HALF + n * 16) = xn;
                        else { ss += (xn[0] * xn[0] + xn[1] * xn[1]) + (xn[2] * xn[2] + xn[3] * xn[3]);
                            u32x2 w; w.x = pkbf(xn[0], xn[1]); w.y = pkbf(xn[2], xn[3]); *(u32x2*)(xb + off + bj * HALF + n * 16) = w;
                            if (x8) *(unsigned*)(x8 + off + bj * HALF + n * 16) = pk4_fp8(xn[0], xn[1], xn[2], xn[3]); } }
                ssv[m] = ss; }
            if (!outf) { float tv[4];
#pragma unroll
                for (int m = 0; m < 4; ++m) ssv[m] = swap32_add(ssv[m]);
#pragma unroll
                for (int m = 0; m < 4; ++m) tv[m] = __shfl_xor(ssv[m], 16);
#pragma unroll
                for (int m = 0; m < 4; ++m) if (fq == 0) ssq[(size_t)(row0 + ai * HALF + m * 16) * 16 + u.pn * 4 + wc] = ssv[m] + tv[m]; }
            asm volatile("" ::: "memory"); }
    }
};

struct EpiNull {
    static constexpr bool PERM = true, AFTER_DRAIN = false, ROW_RSTD = false;
    float* sink;
    __device__ __forceinline__ void operator()(const f32x4 (&acc)[2][2][4][2], const Unit& u, int wr, int wc, int fr, int fq) const {
        float s = 0.f;
#pragma unroll
        for (int ai = 0; ai < 2; ++ai)
#pragma unroll
            for (int bj = 0; bj < 2; ++bj)
#pragma unroll
                for (int m = 0; m < 4; ++m)
#pragma unroll
                    for (int n = 0; n < 2; ++n) s += acc[ai][bj][m][n][0];
        if (s == 12345.678f) sink[0] = s;
    }
};
template <int PIN> struct FixedOrder : StaticOrder {
    __device__ bool next(int i, Unit& u) const { const bool ok = StaticOrder::next(i, u); if (PIN & 1) u.pn = 0; if (PIN & 2) u.pm = (int)(blockIdx.x & 7); return ok; }
};
template <class Epi, class Sched, bool ALIGN_EPI = false, bool SP2 = false, bool FP8 = false>
__device__ __forceinline__ void gemm_phase(PG8_LAS unsigned char* lds, const Gemm g, const Sched& S, const Epi& E) {
    int tid = threadIdx.x; asm volatile("" : "+v"(tid));
    const int wid = __builtin_amdgcn_readfirstlane(tid >> 6), lane = tid & 63, wr = wid >> 2, wc = wid & 3, fr = lane & 15, fq = lane >> 4;
    const int K = g.K, nt = K / BK;
    unsigned voffA[2], voffB[2];
#pragma unroll
    for (int i = 0; i < 2; ++i) { int R, C; stage_rc(tid * 16 + i * 8192, R, C); const int Rb = Epi::PERM ? ((R & ~31) + perm32(R & 31)) : R;
        voffA[i] = (unsigned)(R * K + C) * 2u; voffB[i] = (unsigned)(Rb * K + C) * 2u; }
    const size_t kstep = (size_t)(BK * 2);
    const size_t hstep = (size_t)HALF * K * 2;
    const size_t tstep = 2 * hstep;
    const unsigned ldsw = (unsigned)wid * 1024u;
    const int aoff = lds_byte(wr * 64 + fr, fq * 8), boff = lds_byte(wc * 32 + fr, fq * 8);
#define PG8_SA(b, h) (((b) * 2 + (h)) * HTB)
#define PG8_SB(b, h) ((4 + (b) * 2 + (h)) * HTB)
#define PG8_STAGE(bufoff, gbase, voff) do { _Pragma("unroll") for (int _i = 0; _i < 2; ++_i) \
        __builtin_amdgcn_global_load_lds((const unsigned*)((const char*)(gbase) + (voff)[_i]), (PG8_LAS unsigned*)(lds + (bufoff) + ldsw + _i * 8192), 16, 0, 0); } while (0)
#define PG8_LDA(dst, b, h) do { if constexpr (FP8) { _Pragma("unroll") for (int m = 0; m < 4; ++m) dst##8[m] = cat8(*(const PG8_LAS bf16x8*)(lds + PG8_SA(b, h) + aoff + m * 2048), *(const PG8_LAS bf16x8*)(lds + PG8_SA(b, h) + aoff + m * 2048 + 1024)); } \
        else { _Pragma("unroll") for (int m = 0; m < 4; ++m) _Pragma("unroll") for (int k = 0; k < 2; ++k) dst[m][k] = *(const PG8_LAS bf16x8*)(lds + PG8_SA(b, h) + aoff + m * 2048 + k * 1024); } } while (0)
#define PG8_LDB(dst, b, h) do { if constexpr (FP8) { _Pragma("unroll") for (int n = 0; n < 2; ++n) dst##8[n] = cat8(*(const PG8_LAS bf16x8*)(lds + PG8_SB(b, h) + boff + n * 2048), *(const PG8_LAS bf16x8*)(lds + PG8_SB(b, h) + boff + n * 2048 + 1024)); } \
        else { _Pragma("unroll") for (int n = 0; n < 2; ++n) _Pragma("unroll") for (int k = 0; k < 2; ++k) dst[n][k] = *(const PG8_LAS bf16x8*)(lds + PG8_SB(b, h) + boff + n * 2048 + k * 1024); } } while (0)
#define PG8_MMA(ai, bj, At, Bt) do { __builtin_amdgcn_s_setprio(1); \
        if constexpr (FP8) { _Pragma("unroll") for (int m = 0; m < 4; ++m) _Pragma("unroll") for (int n = 0; n < 2; ++n) \
            mfma8(acc[ai][bj][m][n], Bt##8[n], At##8[m], sc8); } \
        else { _Pragma("unroll") for (int m = 0; m < 4; ++m) _Pragma("unroll") for (int n = 0; n < 2; ++n) _Pragma("unroll") for (int k = 0; k < 2; ++k) \
            acc[ai][bj][m][n] = __builtin_amdgcn_mfma_f32_16x16x32_bf16(Bt[n][k], At[m][k], acc[ai][bj][m][n], 0, 0, 0); } \
        __builtin_amdgcn_s_setprio(0); } while (0)
#define PG8_WAIT_V(n) asm volatile("s_waitcnt vmcnt(" #n ")" ::: "memory")
#define PG8_WAIT_L(n) asm volatile("s_waitcnt lgkmcnt(" #n ")" ::: "memory")
#define PG8_BAR __builtin_amdgcn_s_barrier()
#define PG8_SCHED __builtin_amdgcn_sched_barrier(0)
    Unit cur, nxt; int ui = 0;
    if (!S.next(0, cur)) return;
    if constexpr (Epi::ROW_RSTD) {
        int p0 = cur.pm, p1 = -1, p2 = -1, p3 = -1; { Unit t_; for (int n_ = 1; S.next(n_, t_); ++n_) { const int p = t_.pm; if (p != p0 && p != p1 && p != p2 && p != p3) { if (p1 < 0) p1 = p; else if (p2 < 0) p2 = p; else p3 = p; } } }
        E.fill_rstd(lds + STAGE_BYTES, p0, wid, lane); if (p1 >= 0) E.fill_rstd(lds + STAGE_BYTES + 1024, p1, wid, lane); if (p2 >= 0) E.fill_rstd(lds + STAGE_BYTES + 2048, p2, wid, lane); if (p3 >= 0) E.fill_rstd(lds + STAGE_BYTES + 3072, p3, wid, lane);
        E.set_panels(p0, p1, p2);
        PG8_WAIT_L(0); PG8_BAR; asm volatile("" ::: "memory"); }
    f32x4 acc[2][2][4][2];
#pragma unroll
    for (int a = 0; a < 2; ++a)
#pragma unroll
        for (int b = 0; b < 2; ++b)
#pragma unroll
            for (int m = 0; m < 4; ++m)
#pragma unroll
                for (int n = 0; n < 2; ++n) acc[a][b][m][n] = (f32x4){0.f, 0.f, 0.f, 0.f};
    bf16x8 At[4][2], B0[2][2], B1[2][2]; i32x8 At8[4], B08[2], B18[2]; int sc8 = 0x7F7F7F7F; asm volatile("" : "+v"(sc8));
    const char* cA = (const char*)g.A + (size_t)cur.pm * tstep; const char* cB = (const char*)g.Bt + (size_t)cur.pn * tstep;
    S.a_ready(cur);
    if constexpr (SP2) {
        PG8_STAGE(PG8_SB(0, 0), cB, voffB); PG8_STAGE(PG8_SB(0, 1), cB + hstep, voffB); PG8_STAGE(PG8_SA(0, 0), cA, voffA); PG8_STAGE(PG8_SA(0, 1), cA + hstep, voffA);
        if (wr == 1) PG8_BAR;
        PG8_WAIT_V(2); PG8_BAR;
        PG8_STAGE(PG8_SB(1, 0), cB + kstep, voffB); PG8_STAGE(PG8_SA(1, 0), cA + kstep, voffA); PG8_STAGE(PG8_SB(1, 1), cB + hstep + kstep, voffB);
        PG8_WAIT_V(6); PG8_BAR;
    } else {
        PG8_STAGE(PG8_SB(0, 0), cB, voffB); PG8_STAGE(PG8_SA(0, 0), cA, voffA); PG8_STAGE(PG8_SB(0, 1), cB + hstep, voffB); PG8_STAGE(PG8_SA(0, 1), cA + hstep, voffA);
        if (wr == 1) PG8_BAR;
        PG8_WAIT_V(4); PG8_BAR;
        PG8_STAGE(PG8_SB(1, 0), cB + kstep, voffB); PG8_STAGE(PG8_SA(1, 0), cA + kstep, voffA); PG8_STAGE(PG8_SB(1, 1), cB + hstep + kstep, voffB);
        PG8_WAIT_V(6); PG8_BAR;
    }
    for (;;) {
        const bool has_next = S.next(ui + 1, nxt);
        const char* nA = has_next ? (const char*)g.A + (size_t)nxt.pm * tstep : cA; const char* nB = has_next ? (const char*)g.Bt + (size_t)nxt.pn * tstep : cB;
#pragma nounroll
        for (int t = 0; t < nt; t += 2) {
            const bool last = (t == nt - 2);
            const char* a1 = cA + (size_t)(t + 1) * kstep;
            const char* a2 = last ? nA : cA + (size_t)(t + 2) * kstep; const char* b2 = last ? nB : cB + (size_t)(t + 2) * kstep;
            const char* a3 = a2 + kstep; const char* b3 = b2 + kstep;
            if (last && has_next) S.a_ready(nxt);
            if constexpr (SP2) {
            PG8_LDB(B0, 0, 0); PG8_LDB(B1, 0, 1); PG8_SCHED; PG8_LDA(At, 0, 0); PG8_STAGE(PG8_SA(1, 1), a1 + hstep, voffA);
            PG8_WAIT_V(8); PG8_WAIT_L(0); PG8_BAR; PG8_MMA(0, 0, At, B0); PG8_MMA(0, 1, At, B1); PG8_BAR; PG8_SCHED;
            PG8_LDA(At, 0, 1); PG8_STAGE(PG8_SB(0, 0), b2, voffB); PG8_STAGE(PG8_SB(0, 1), b2 + hstep, voffB); PG8_STAGE(PG8_SA(0, 0), a2, voffA);
            PG8_WAIT_V(8); PG8_WAIT_L(0); PG8_BAR; PG8_MMA(1, 0, At, B0); PG8_MMA(1, 1, At, B1); PG8_BAR; PG8_SCHED;
            PG8_LDB(B0, 1, 0); PG8_LDB(B1, 1, 1); PG8_SCHED; PG8_LDA(At, 1, 0); PG8_STAGE(PG8_SA(0, 1), a2 + hstep, voffA);
            PG8_WAIT_V(8); PG8_WAIT_L(0); PG8_BAR; PG8_MMA(0, 0, At, B0); PG8_MMA(0, 1, At, B1); PG8_BAR; PG8_SCHED;
            PG8_LDA(At, 1, 1); PG8_STAGE(PG8_SB(1, 0), b3, voffB); PG8_STAGE(PG8_SB(1, 1), b3 + hstep, voffB); PG8_STAGE(PG8_SA(1, 0), a3, voffA);
            PG8_WAIT_V(8); PG8_WAIT_L(0); PG8_BAR; PG8_MMA(1, 0, At, B0); PG8_MMA(1, 1, At, B1); PG8_BAR; PG8_SCHED;
            } else {
            PG8_LDB(B0, 0, 0); PG8_SCHED; PG8_LDA(At, 0, 0); PG8_STAGE(PG8_SA(1, 1), a1 + hstep, voffA);
            PG8_WAIT_L(8); PG8_BAR; PG8_WAIT_L(0); PG8_MMA(0, 0, At, B0); PG8_BAR; PG8_SCHED;
            PG8_LDB(B1, 0, 1); PG8_STAGE(PG8_SB(0, 0), b2, voffB);
            PG8_BAR; PG8_WAIT_L(0); PG8_MMA(0, 1, At, B1); PG8_BAR;
            PG8_LDA(At, 0, 1); PG8_STAGE(PG8_SA(0, 0), a2, voffA);
            PG8_BAR; PG8_WAIT_L(0); PG8_MMA(1, 0, At, B0); PG8_BAR; PG8_SCHED;
            PG8_STAGE(PG8_SB(0, 1), b2 + hstep, voffB);
            PG8_WAIT_V(6); PG8_BAR; PG8_MMA(1, 1, At, B1); PG8_BAR;
            PG8_LDB(B0, 1, 0); PG8_SCHED; PG8_LDA(At, 1, 0); PG8_STAGE(PG8_SA(0, 1), a2 + hstep, voffA);
            PG8_WAIT_L(8); PG8_BAR; PG8_WAIT_L(0); PG8_MMA(0, 0, At, B0); PG8_BAR; PG8_SCHED;
            PG8_LDB(B1, 1, 1); PG8_STAGE(PG8_SB(1, 0), b3, voffB);
            PG8_BAR; PG8_WAIT_L(0); PG8_MMA(0, 1, At, B1); PG8_BAR;
            PG8_LDA(At, 1, 1); PG8_STAGE(PG8_SA(1, 0), a3, voffA);
            PG8_BAR; PG8_WAIT_L(0); PG8_MMA(1, 0, At, B0); PG8_BAR; PG8_SCHED;
            PG8_STAGE(PG8_SB(1, 1), b3 + hstep, voffB);
            PG8_WAIT_V(6); PG8_BAR; PG8_MMA(1, 1, At, B1); PG8_BAR;
            }
        }
        if constexpr (ALIGN_EPI) { if (wr == 0) PG8_BAR; }
        if constexpr (FP8) asm volatile("s_nop 15\n\ts_nop 15" ::: "memory");
        if constexpr (!Epi::AFTER_DRAIN) { E(acc, cur, wr, wc, fr, fq); S.done(cur); }
        if (!has_next) break;
#pragma unroll
        for (int a = 0; a < 2; ++a)
#pragma unroll
            for (int b = 0; b < 2; ++b)
#pragma unroll
                for (int m = 0; m < 4; ++m)
#pragma unroll
                    for (int n = 0; n < 2; ++n) acc[a][b][m][n] = (f32x4){0.f, 0.f, 0.f, 0.f};
        cur = nxt; cA = nA; cB = nB; ++ui;
        if constexpr (ALIGN_EPI) { if (wr == 1) PG8_BAR; }
    }
    PG8_WAIT_V(0);
    if constexpr (!ALIGN_EPI) { if (wr == 0) PG8_BAR; }
    PG8_BAR;
    if constexpr (Epi::AFTER_DRAIN) { E.fused(acc, cur, wr, wc, fr, fq, lds, wid, lane); S.done(cur); }
#undef PG8_SA
#undef PG8_SB
#undef PG8_STAGE
#undef PG8_LDA
#undef PG8_LDB
#undef PG8_MMA
#undef PG8_WAIT_V
#undef PG8_WAIT_L
#undef PG8_BAR
#undef PG8_SCHED
}
}

constexpr int NWAVES = 8;
constexpr int BATCH = 16, T = 2048, D = 1024, M = BATCH * T, DFF = 2816, NF1 = 2 * DFF, NU = 2304, DEPTH = 2, NCP = 128;
constexpr float EPS = 1e-6f, LOG2E = 1.4426950408889634f, C2 = 0.125f * LOG2E;
constexpr int UQ = 0, UKS = 256, UKW = 320, UCK = 384, UCQ = 512, UKC = 768, UVC = 832, UVS = 896, UVW = 960, UCV = 1024, UG = 1152, UBB = 1280, UBC = 1536, UBX = 1792, UDV = 2048;
constexpr size_t MiB = 1u << 20;
constexpr size_t WS_CTL = 0, CTL_ZERO_BYTES = 1 * MiB;
constexpr size_t WS_W13 = 1 * MiB, WS_W2 = 45 * MiB, WS_WIN = 67 * MiB, WS_WOUT = 76 * MiB, WS_C1 = 80 * MiB;
constexpr size_t WS_SSQ = 82 * MiB, WS_GATES = 84 * MiB, WS_KC = 86 * MiB, WS_VC = 86 * MiB + 512 * 1024;
constexpr size_t WS_XB = 88 * MiB, WS_QKN = 152 * MiB, WS_YN = 200 * MiB, WS_ACT = 264 * MiB, WS_U = WS_ACT, WS_X8 = 440 * MiB, WS_IMG = 472 * MiB, WS_END = 504 * MiB;
#ifndef UP8_MASK_V
#define UP8_MASK_V 0xE
#endif
#ifndef DN8_MASK_V
#define DN8_MASK_V 0xE
#endif
constexpr unsigned UP8_MASK = UP8_MASK_V, DN8_MASK = DN8_MASK_V;
constexpr float W8_SCALE = 64.0f, ACT8_SCALE = 4.0f; static_assert(W8_SCALE * ACT8_SCALE == 256.0f, "EpiRes mode 1");
constexpr int CW_BAR = 4096;
constexpr int LDS_BYTES = 163840, MISC_OFF = LDS_BYTES - 256;

#define GAS __attribute__((address_space(1)))
#define LAS __attribute__((address_space(3)))
typedef unsigned short bf16;
typedef unsigned v4u __attribute__((ext_vector_type(4)));
typedef unsigned u32x2 __attribute__((ext_vector_type(2)));
typedef float f32x4 __attribute__((ext_vector_type(4)));
typedef float f32x2_t __attribute__((ext_vector_type(2)));
typedef __bf16 bf16x2_t __attribute__((ext_vector_type(2)));
typedef short bf16x8 __attribute__((ext_vector_type(8)));
typedef float f32x16 __attribute__((ext_vector_type(16)));
typedef short v4i16_t __attribute__((ext_vector_type(4)));
#define LDS_WAIT() asm volatile("s_waitcnt lgkmcnt(0)" ::: "memory")
__device__ __forceinline__ unsigned pk2(float lo, float hi) { f32x2_t v = {lo, hi}; bf16x2_t b = __builtin_convertvector(v, bf16x2_t); return __builtin_bit_cast(unsigned, b); }
__device__ __forceinline__ float bflo(unsigned u) { return __builtin_bit_cast(float, u << 16); }
__device__ __forceinline__ float bfhi(unsigned u) { return __builtin_bit_cast(float, u & 0xffff0000u); }
__device__ __forceinline__ f32x4 ld4bf(const bf16* p) { const u32x2 w = *(const u32x2*)p; return (f32x4){bflo(w.x), bfhi(w.x), bflo(w.y), bfhi(w.y)}; }
__device__ __forceinline__ void st4bf(bf16* p, f32x4 v) { u32x2 w; w.x = pk2(v[0], v[1]); w.y = pk2(v[2], v[3]); *(u32x2*)p = w; }
template <int CTRL> __device__ __forceinline__ float dpp_add(float v) { return v + __builtin_bit_cast(float, __builtin_amdgcn_update_dpp(0, __builtin_bit_cast(int, v), CTRL, 0xf, 0xf, true)); }
__device__ __forceinline__ float row16_sum(float v) { v = dpp_add<0xB1>(v); v = dpp_add<0x4E>(v); v = dpp_add<0x141>(v); v = dpp_add<0x140>(v); return v; }
__device__ __forceinline__ float wave_sum(float v) {
    v = row16_sum(v); v += __shfl_xor(v, 16);
    auto rr = __builtin_amdgcn_permlane32_swap(__float_as_uint(v), __float_as_uint(v), false, false); return __uint_as_float(rr[0]) + __uint_as_float(rr[1]);
}
__device__ __forceinline__ f32x4 up4(u32x2 w) { return (f32x4){bflo(w.x), bfhi(w.x), bflo(w.y), bfhi(w.y)}; }
__device__ __forceinline__ float sq4(f32x4 v) { return (v[0] * v[0] + v[1] * v[1]) + (v[2] * v[2] + v[3] * v[3]); }

__device__ __forceinline__ int kimg_off(int r, int d) { return (d >> 3) * 512 + r * 8 + (d & 7); }
__device__ __forceinline__ int vimg_off(int r, int d) { return ((d >> 5) * 4 + (r >> 4)) * 512 + (r & 15) * 32 + (d & 31); }
#define XB_TMO      128
#define XB_XCNT(j)  (256  + 64 * (j))
#define XB_XSUB(j)  (1280 + 64 * (j))
#define XB_XGEN(j)  (2304 + 64 * (j))
#define XB_TOP      3328
#define XB_TOPGEN   3392
#define XCD_BAR_WORDS 3456
#define XB_SPIN_CAP (1u << 18)

__device__ __forceinline__ unsigned xb_ld(unsigned* p)              { return __hip_atomic_load(p, __ATOMIC_RELAXED, __HIP_MEMORY_SCOPE_AGENT); }
__device__ __forceinline__ unsigned xb_add(unsigned* p, unsigned v) { return __hip_atomic_fetch_add(p, v, __ATOMIC_RELAXED, __HIP_MEMORY_SCOPE_AGENT); }
__device__ __forceinline__ unsigned xb_xcc_id() { return (unsigned)__builtin_amdgcn_s_getreg((3 << 11) | 20) & 0xFu; }
#define XB_SPIN(cond, bar) do { unsigned _sp = 0; while (cond) { __builtin_amdgcn_s_sleep(1); \
    if ((++_sp & 255u) == 0u) { if (xb_ld(&(bar)[XB_TMO])) break; if (_sp > XB_SPIN_CAP) { atomicAdd(&(bar)[XB_TMO], 1u); break; } } } } while (0)

struct XcdBarrier {
    unsigned* bar; unsigned x;
    volatile LAS unsigned* st;
};

__device__ __forceinline__ XcdBarrier xcd_barrier_post(unsigned* bar, volatile LAS unsigned* st) {
    XcdBarrier b; b.bar = bar; b.x = xb_xcc_id(); b.st = st;
    if (threadIdx.x == 0) (void)xb_add(&bar[XB_XCNT(b.x)], 1u);
    return b;
}
__device__ __forceinline__ void xcd_barrier_complete(unsigned* bar, unsigned x, unsigned& nloc, unsigned& nx) {
    const unsigned G = gridDim.x * gridDim.y * gridDim.z;
    unsigned sum, cnt, mine, sp = 0u;
    for (;;) {
        sum = 0u; cnt = 0u; mine = 0u;
#pragma unroll
        for (unsigned j = 0; j < 16; ++j) { const unsigned c = xb_ld(&bar[XB_XCNT(j)]); sum += c; cnt += (c > 0u) ? 1u : 0u; mine = (j == x) ? c : mine; }
        if (sum == G) break;
        __builtin_amdgcn_s_sleep(1);
        if ((++sp & 255u) == 0u) { if (xb_ld(&bar[XB_TMO])) break; if (sp > XB_SPIN_CAP) { atomicAdd(&bar[XB_TMO], 1u); break; } }
    }
    nloc = mine > 0u ? mine : 1u; nx = cnt > 0u ? cnt : 1u;
}

__device__ __forceinline__ void xcd_barrier(const XcdBarrier& b) {
    asm volatile("s_waitcnt vmcnt(0)" ::: "memory");
    __syncthreads();
    if (threadIdx.x == 0) {
        unsigned* bar = b.bar;
        __builtin_amdgcn_s_waitcnt(0);
        unsigned nloc = b.st[0], nx = b.st[1];
        if (nloc == 0u) { xcd_barrier_complete(bar, b.x, nloc, nx); b.st[0] = nloc; b.st[1] = nx; }
        const unsigned old = xb_add(&bar[XB_XSUB(b.x)], 1u);
        const unsigned gen = old / nloc;
        if (old + 1u == (gen + 1u) * nloc) {
            __builtin_amdgcn_fence(__ATOMIC_RELEASE, "agent");
            asm volatile("s_waitcnt vmcnt(0)" ::: "memory");
            const unsigned og = xb_add(&bar[XB_TOP], 1u);
            const unsigned tg = og / nx;
            if (og + 1u == (tg + 1u) * nx) xb_add(&bar[XB_TOPGEN], 1u);
            else XB_SPIN(xb_ld(&bar[XB_TOPGEN]) == tg, bar);
            __builtin_amdgcn_fence(__ATOMIC_ACQUIRE, "agent");
            xb_add(&bar[XB_XGEN(b.x)], 1u);
            asm volatile("s_waitcnt vmcnt(0)" ::: "memory");
        } else {
            XB_SPIN(xb_ld(&bar[XB_XGEN(b.x)]) == gen, bar);
            __builtin_amdgcn_fence(__ATOMIC_ACQUIRE, "agent");
            asm volatile("s_waitcnt vmcnt(0)" ::: "memory");
        }
    }
    __syncthreads();
}


typedef KArgs Args;
struct Frame {
    LAS unsigned char* lds;
    int tid, lane, wave, vcu, G;
    const Args* a;
};
#define FIN(i) (F.a->in[i])
#define FOUT (F.a->out)
#define FWS(off, type) ((type*)(F.a->ws + (off)))
#define F_W13T FWS(WS_W13, bf16)
#define F_W2T FWS(WS_W2, bf16)
#define F_WINT FWS(WS_WIN, bf16)
#define F_WOUTT FWS(WS_WOUT, bf16)
#define F_C1T FWS(WS_C1, bf16)
#define F_XB FWS(WS_XB, bf16)
#define F_QA FWS(WS_QKN, bf16)
#define F_QC FWS(WS_QKN + 16 * MiB, bf16)
#define F_KSI FWS(WS_IMG, bf16)
#define F_KWI FWS(WS_IMG + 4 * MiB, bf16)
#define F_CKI FWS(WS_IMG + 8 * MiB, bf16)
#define F_VSI FWS(WS_IMG + 16 * MiB, bf16)
#define F_VWI FWS(WS_IMG + 20 * MiB, bf16)
#define F_CVI FWS(WS_IMG + 24 * MiB, bf16)
#define F_YN FWS(WS_YN, bf16)
#define F_ACT FWS(WS_ACT, bf16)
#define F_U FWS(WS_U, bf16)
#define F_KC FWS(WS_KC, bf16)
#define F_VC FWS(WS_VC, bf16)
#define F_SSQ FWS(WS_SSQ, float)
#define F_GATES FWS(WS_GATES, float)
#define F_X8 FWS(WS_X8, unsigned char)
enum { I_X = 0, I_F1N, I_F1W1, I_F1W3, I_F1W2, I_MIXN, I_WIN, I_NQN, I_NKCN, I_NKSN, I_NKWN, I_POSK, I_C1K, I_C2K, I_POSV, I_C1V, I_C2V, I_CONVW, I_SQN, I_SKN, I_SINK, I_POOLW, I_POOLS, I_GN, I_WOUT,
       I_F2N, I_F2W1, I_F2W3, I_F2W2 };

__device__ __forceinline__ int win_src_col(int dr) {
    if (dr < 256) return dr;
    if (dr < 320) return 384 + (dr - 256);
    if (dr < 384) return 512 + (dr - 320);
    if (dr < 512) return 1676 + (dr - 384);
    if (dr < 768) return 1420 + (dr - 512);
    if (dr < 832) return 256 + (dr - 768);
    if (dr < 896) return 320 + (dr - 832);
    if (dr < 960) return 448 + (dr - 896);
    if (dr < 1024) return 576 + (dr - 960);
    if (dr < 1152) return 1804 + (dr - 1024);
    if (dr < 1164) return 640 + (dr - 1152);
    if (dr < 1280) return -1;
    if (dr < 1536) return 652 + (dr - 1280);
    if (dr < 1792) return 908 + (dr - 1536);
    if (dr < 2048) return 1164 + (dr - 1792);
    return 1932 + (dr - 2048);
}
struct TrItem { const float* src; const float* gain; void* dst; int N, K, k0, srccol, dstrow0; bool f8; };
__device__ __forceinline__ void tr_load(const TrItem& t, f32x4 (&v)[16], int lane) {
    const int kr = lane >> 4;
#pragma unroll
    for (int i = 0; i < 16; ++i) { v[i] = (f32x4){0.f, 0.f, 0.f, 0.f}; if (t.srccol >= 0) v[i] = *(const f32x4*)(t.src + (size_t)(t.k0 + 4 * i + kr) * t.N + t.srccol); }
}
__device__ __forceinline__ void tr_store(const TrItem& t, f32x4 (&v)[16], LAS float* scr, int lane) {
    const int kr = lane >> 4;
    if (t.gain) {
#pragma unroll
        for (int i = 0; i < 16; ++i) v[i] *= t.gain[t.k0 + 4 * i + kr]; }
#pragma unroll
    for (int i = 0; i < 16; ++i) { LAS float* p = scr + (4 * i + kr) * 65 + 4 * (lane & 15); p[0] = v[i][0]; p[1] = v[i][1]; p[2] = v[i][2]; p[3] = v[i][3]; }
    LDS_WAIT(); asm volatile("" ::: "memory");
    if (t.f8) { const int c = lane & 3;
#pragma unroll
        for (int j = 0; j < 4; ++j) { const int n = (lane >> 2) + 16 * j; const LAS float* q = scr + (16 * c) * 65 + n; v4u o;
            o.x = pg8::pk4_fp8(q[0 * 65] * W8_SCALE, q[1 * 65] * W8_SCALE, q[2 * 65] * W8_SCALE, q[3 * 65] * W8_SCALE); o.y = pg8::pk4_fp8(q[4 * 65] * W8_SCALE, q[5 * 65] * W8_SCALE, q[6 * 65] * W8_SCALE, q[7 * 65] * W8_SCALE);
            o.z = pg8::pk4_fp8(q[8 * 65] * W8_SCALE, q[9 * 65] * W8_SCALE, q[10 * 65] * W8_SCALE, q[11 * 65] * W8_SCALE); o.w = pg8::pk4_fp8(q[12 * 65] * W8_SCALE, q[13 * 65] * W8_SCALE, q[14 * 65] * W8_SCALE, q[15 * 65] * W8_SCALE);
            *(v4u*)((unsigned char*)t.dst + (size_t)(t.dstrow0 + n) * t.K + t.k0 + 16 * c) = o; } }
    else { const int c = lane & 7;
#pragma unroll
        for (int j = 0; j < 8; ++j) { const int n = (lane >> 3) + 8 * j; const LAS float* q = scr + (8 * c) * 65 + n;
            v4u o; o.x = pk2(q[0 * 65], q[1 * 65]); o.y = pk2(q[2 * 65], q[3 * 65]); o.z = pk2(q[4 * 65], q[5 * 65]); o.w = pk2(q[6 * 65], q[7 * 65]);
            *(v4u*)((bf16*)t.dst + (size_t)(t.dstrow0 + n) * t.K + t.k0 + 8 * c) = o; } }
    LDS_WAIT(); asm volatile("" ::: "memory");
}
__device__ __forceinline__ void tr_decode(Frame& F, int it, int lane, TrItem& t) {
    constexpr int I_W = 704, I_IN = 16 * 36, I_OUT = 16 * 16, I_C1 = 32 * 2, PER_LAYER = 6 * I_W + I_IN + I_OUT + 2 * I_C1;
    const int L = it / PER_LAYER, l4 = 4 * (lane & 15); int r = it % PER_LAYER;
    t.gain = nullptr; t.f8 = false;
    if (r < 6 * I_W) { const int mat = r / I_W; r %= I_W; const int ffn = mat / 3, w = mat % 3;
        if (w < 2) { const int kb = r / 44, nb = r % 44, n0 = 64 * nb; t.N = DFF; t.K = D; t.k0 = 64 * kb; t.srccol = n0 + l4;
            t.src = FIN(ffn ? (w ? I_F2W3 : I_F2W1) : (w ? I_F1W3 : I_F1W1)) + (size_t)L * D * DFF; t.gain = FIN(ffn ? I_F2N : I_F1N) + L * D;
            t.dst = (unsigned char*)F_W13T + (size_t)(L * 2 + ffn) * NF1 * D * 2; t.dstrow0 = (n0 / 128) * 256 + w * 128 + (n0 % 128); t.f8 = (UP8_MASK >> (L * 2 + ffn)) & 1u; }
        else { const int kb = r / 16, nb = r % 16, n0 = 64 * nb; t.N = D; t.K = DFF; t.k0 = 64 * kb; t.srccol = n0 + l4;
            t.src = FIN(ffn ? I_F2W2 : I_F1W2) + (size_t)L * DFF * D; t.dst = (unsigned char*)F_W2T + (size_t)(L * 2 + ffn) * D * DFF * 2; t.dstrow0 = n0; t.f8 = (DN8_MASK >> (L * 2 + ffn)) & 1u; } }
    else { r -= 6 * I_W;
        if (r < I_IN) { const int kb = r / 36, rb = r % 36; t.N = 2188; t.K = D; t.k0 = 64 * kb; t.srccol = win_src_col(64 * rb + l4);
            t.src = FIN(I_WIN) + (size_t)L * D * 2188; t.gain = FIN(I_MIXN) + L * D; t.dst = F_WINT + (size_t)L * NU * D; t.dstrow0 = 64 * rb; }
        else if (r < I_IN + I_OUT) { r -= I_IN; const int kb = r / 16, nb = r % 16, n0 = 64 * nb; t.N = D; t.K = D; t.k0 = 64 * kb; t.srccol = n0 + l4;
            t.src = FIN(I_WOUT) + (size_t)L * D * D; t.gain = FIN(I_GN) + L * D; t.dst = F_WOUTT + (size_t)L * D * D; t.dstrow0 = n0; }
        else { r -= I_IN + I_OUT; const int kv = r / I_C1; r %= I_C1; const int kb = r / 2, nb = r % 2, n0 = 64 * nb; t.N = 128; t.K = 2048; t.k0 = 64 * kb; t.srccol = n0 + l4;
            t.src = FIN(kv ? I_C1V : I_C1K) + (size_t)L * 2048 * 128; t.dst = F_C1T + (size_t)(L * 2 + kv) * 128 * 2048; t.dstrow0 = n0; } }
}
__device__ __forceinline__ void prologue(Frame& F) {
    int lane = F.lane; asm volatile("" : "+v"(lane));
    LAS float* scr = (LAS float*)(F.lds + F.wave * 16640);
    const int gw = F.vcu * NWAVES + F.wave, NGW = F.G * NWAVES;
    constexpr int NITEMS = DEPTH * (6 * 704 + 16 * 36 + 16 * 16 + 2 * 64);
    if (gw < NITEMS) { TrItem ta, tb; f32x4 va[16], vb[16];
        tr_decode(F, gw, lane, ta); tr_load(ta, va, lane);
        for (int it = gw; it < NITEMS; it += 2 * NGW) {
            const bool hb = it + NGW < NITEMS; if (hb) { tr_decode(F, it + NGW, lane, tb); tr_load(tb, vb, lane); }
            tr_store(ta, va, scr, lane);
            const bool ha = it + 2 * NGW < NITEMS; if (ha) { tr_decode(F, it + 2 * NGW, lane, ta); tr_load(ta, va, lane); }
            if (hb) tr_store(tb, vb, scr, lane);
        } }
    const float* x = FIN(I_X);
    for (int m4 = gw * 4; m4 < M; m4 += NGW * 4) {
        f32x4 v[4][4];
#pragma unroll
        for (int r = 0; r < 4; ++r)
#pragma unroll
            for (int j = 0; j < 4; ++j) v[r][j] = *((const f32x4*)(x + (size_t)(m4 + r) * D) + lane + 64 * j);
#pragma unroll
        for (int r = 0; r < 4; ++r) { float sr = 0.f;
#pragma unroll
            for (int j = 0; j < 4; ++j) { sr += sq4(v[r][j]); st4bf(F_XB + (size_t)(m4 + r) * D + 256 * j + 4 * lane, v[r][j]);
                if (UP8_MASK & 1u) *(unsigned*)(F_X8 + (size_t)(m4 + r) * D + 256 * j + 4 * lane) = pg8::pk4_fp8(v[r][j][0], v[r][j][1], v[r][j][2], v[r][j][3]); }
            sr = wave_sum(sr);
            if (lane < 16) F_SSQ[(size_t)(m4 + r) * 16 + lane] = lane == 0 ? sr : 0.f; }
    }
}

#ifndef PROBE_PREP
#define PROBE_PREP 0
#endif
__device__ __forceinline__ void prep_phase(Frame& F, int L) {
    int tid = F.tid; asm volatile("" : "+v"(tid));
    const int lane = tid & 63, ch = 4 * lane;
    LAS bf16* PWt = (LAS bf16*)F.lds;
    LAS bf16* DTb = (LAS bf16*)(F.lds + 65536) + F.wave * (16 * 264);
    { const float* pw = FIN(I_POOLW) + (size_t)L * 16384;
      for (int i = tid; i < 16384; i += NWAVES * 64) { const int g = i >> 12, c = (i >> 6) & 63, e = i & 63; PWt[(g * 64 + e) * 72 + c] = (bf16)(pk2(pw[i], 0.f) & 0xffffu); } }
    __syncthreads();
    f32x4 g0, g1, g2, cw0, cw1, cw2;
    { const float* nq = FIN(I_NQN) + L * 64; const float* nks = FIN(I_NKSN) + L * 64; const float* nkw = FIN(I_NKWN) + L * 64; const float* sk = FIN(I_SKN) + L * 64; const float* sq = FIN(I_SQN) + L * 64;
      g0 = *(const f32x4*)(nq + (ch & 63)) * C2;
      g1 = ch < 64 ? *(const f32x4*)(nks + ch) : (ch < 128 ? *(const f32x4*)(nkw + (ch - 64)) : *(const f32x4*)(sk + (ch & 63)));
      g2 = *(const f32x4*)(sq + (ch & 63)) * C2;
      const float* cw = FIN(I_CONVW) + L * 768; cw0 = *(const f32x4*)(cw + ch); cw1 = *(const f32x4*)(cw + 256 + ch); cw2 = *(const f32x4*)(cw + 512 + ch);
      }
    const int grp = lane >> 4, win = 2 << grp;
    const int gw = F.vcu * NWAVES + F.wave, NGW = F.G * NWAVES;
    for (int blk = gw; blk < M / 16; blk += NGW) {
        const int m0 = blk * 16, t0 = m0 & (T - 1);
        const bf16* u0 = F_U + (size_t)m0 * NU;
        const int gt = m0 >> 6, rb = m0 & 63, dk = ch & 63;
        bf16* kimg = (ch < 64 ? F_KSI : (ch < 128 ? F_KWI : F_CKI + (size_t)((ch - 128) >> 6) * 512 * 4096)) + (size_t)gt * 4096 + kimg_off(rb, dk);
        bf16* vimg = (ch < 64 ? F_VSI : (ch < 128 ? F_VWI : F_CVI + (size_t)((ch - 128) >> 6) * 512 * 4096)) + (size_t)gt * 4096 + vimg_off(rb, dk);
#pragma nounroll
        for (int i8 = 0; i8 < 16; i8 += 8) { u32x2 raw[8][4];
#pragma unroll
            for (int i = 0; i < 8; ++i) {
#pragma unroll
                for (int k = 0; k < 3; ++k) raw[i][k] = *(const u32x2*)(u0 + (size_t)(i8 + i) * NU + 256 * k + ch);
                raw[i][3] = *(const u32x2*)(u0 + (size_t)(i8 + i) * NU + UVS + ch); }
#pragma unroll
            for (int i = 0; i < 8; ++i) { const f32x4 v0 = up4(raw[i][0]), v1 = up4(raw[i][1]), v2 = up4(raw[i][2]);
                const float s0 = row16_sum(sq4(v0)), s1 = row16_sum(sq4(v1)), s2 = row16_sum(sq4(v2));
                const float r0 = __builtin_amdgcn_rsqf(s0 * (1.f / 64.f) + EPS), r1 = __builtin_amdgcn_rsqf(s1 * (1.f / 64.f) + EPS), r2 = __builtin_amdgcn_rsqf(s2 * (1.f / 64.f) + EPS);
                st4bf(F_QA + (size_t)(m0 + i8 + i) * 256 + ch, v0 * r0 * g0); st4bf(kimg + (i8 + i) * 8, v1 * r1 * g1); st4bf(F_QC + (size_t)(m0 + i8 + i) * 256 + ch, v2 * r2 * g2);
                *(u32x2*)(vimg + (i8 + i) * 32) = raw[i][3]; } }
#pragma unroll
        for (int k = 0; k < 3; ++k) { const int idx = lane + 64 * k, tk = idx / 12, gi = idx - 12 * tk;
            const float a = bflo((unsigned)u0[(size_t)tk * NU + UG + gi]); F_GATES[(size_t)m0 * 12 + idx] = __builtin_amdgcn_rcpf(1.0f + __builtin_amdgcn_exp2f(a * -LOG2E)); }
        { f32x4 zm1 = {0.f, 0.f, 0.f, 0.f}, zm2 = {0.f, 0.f, 0.f, 0.f};
          if (t0 > 0) { zm1 = ld4bf(u0 - NU + UBC + ch) * ld4bf(u0 - NU + UBX + ch); zm2 = ld4bf(u0 - 2 * NU + UBC + ch) * ld4bf(u0 - 2 * NU + UBX + ch); }
#pragma nounroll
          for (int i8 = 0; i8 < 16; i8 += 8) { u32x2 raw[8][3]; f32x4 ob[8]; float ss[8];
#pragma unroll
              for (int i = 0; i < 8; ++i)
#pragma unroll
                  for (int k = 0; k < 3; ++k) raw[i][k] = *(const u32x2*)(u0 + (size_t)(i8 + i) * NU + UBB + 256 * k + ch);
#pragma unroll
              for (int i = 0; i < 8; ++i) { const f32x4 z0 = up4(raw[i][1]) * up4(raw[i][2]);
                  ob[i] = up4(raw[i][0]) * (cw2 * z0 + cw1 * zm1 + cw0 * zm2); zm2 = zm1; zm1 = z0; ss[i] = sq4(ob[i]); }
#pragma unroll
              for (int i = 0; i < 8; ++i) ss[i] = wave_sum(ss[i]);
#pragma unroll
              for (int i = 0; i < 8; ++i) st4bf(F_YN + (size_t)(m0 + i8 + i) * D + 256 + ch, ob[i] * (__builtin_amdgcn_rsqf(ss[i] * (1.f / 256.f) + EPS))); } }
        for (int rep4 = 0; rep4 < ((PROBE_PREP & 4) ? 2 : 1); ++rep4)
        { u32x2 raw[32];
#pragma unroll
          for (int i = 0; i < 16; ++i) { raw[i] = (u32x2){0u, 0u}; if (t0 > 0) raw[i] = *(const u32x2*)(u0 - (size_t)(16 - i) * NU + UDV + ch); }
#pragma unroll
          for (int i = 0; i < 16; ++i) raw[16 + i] = *(const u32x2*)(u0 + (size_t)i * NU + UDV + ch);
          f32x4 S2 = up4(raw[15]) + up4(raw[14]), S4 = S2 + up4(raw[13]) + up4(raw[12]), S8 = S4, S16;
#pragma unroll
          for (int i = 8; i < 12; ++i) S8 += up4(raw[i]);
          S16 = S8;
#pragma unroll
          for (int i = 0; i < 8; ++i) S16 += up4(raw[i]);
#pragma unroll
          for (int ti = 0; ti < 16; ++ti) { const f32x4 v = up4(raw[16 + ti]);
              S2 += v - up4(raw[16 + ti - 2]); S4 += v - up4(raw[16 + ti - 4]); S8 += v - up4(raw[16 + ti - 8]); S16 += v - up4(raw[ti]);
              const f32x4 Sw = grp == 0 ? S2 : (grp == 1 ? S4 : (grp == 2 ? S8 : S16));
              const int cn = (t0 + ti + 1) < win ? (t0 + ti + 1) : win;
              const f32x4 dd = Sw * __builtin_amdgcn_rcpf((float)cn) - v;
              u32x2 w; w.x = pk2(dd[0], dd[1]); w.y = pk2(dd[2], dd[3]); *(LAS u32x2*)(DTb + ti * 264 + ch) = w; }
          const int fr = lane & 15, fq = lane >> 4;
          const float* psp = FIN(I_POOLS) + L * 256 + fr;
          f32x4 acc[4][4];
#pragma unroll
          for (int g = 0; g < 4; ++g) { const bf16x8 a0 = *(const LAS bf16x8*)(DTb + fr * 264 + g * 64 + 8 * fq), a1 = *(const LAS bf16x8*)(DTb + fr * 264 + g * 64 + 32 + 8 * fq);
#pragma unroll
              for (int cb = 0; cb < 4; ++cb) { const LAS bf16* bp = PWt + (g * 64 + 16 * cb + fr) * 72 + 8 * fq;
                  f32x4 c = {0.f, 0.f, 0.f, 0.f};
                  c = __builtin_amdgcn_mfma_f32_16x16x32_bf16(a0, *(const LAS bf16x8*)bp, c, 0, 0, 0);
                  c = __builtin_amdgcn_mfma_f32_16x16x32_bf16(a1, *(const LAS bf16x8*)(bp + 32), c, 0, 0, 0);
                  acc[g][cb] = c * psp[g * 64 + 16 * cb]; } }
          float ss[4];
#pragma unroll
          for (int i = 0; i < 4; ++i) { float q = 0.f;
#pragma unroll
              for (int g = 0; g < 4; ++g)
#pragma unroll
                  for (int cb = 0; cb < 4; ++cb) q += acc[g][cb][i] * acc[g][cb][i];
              ss[i] = __builtin_amdgcn_rsqf(row16_sum(q) * (1.f / 256.f) + EPS); }
          asm volatile("s_waitcnt lgkmcnt(0)" ::: "memory");
#pragma unroll
          for (int g = 0; g < 4; ++g)
#pragma unroll
              for (int cb = 0; cb < 4; ++cb)
#pragma unroll
                  for (int i = 0; i < 4; ++i) DTb[(4 * fq + i) * 264 + g * 64 + 16 * cb + fr] = (bf16)(pk2(acc[g][cb][i] * ss[i], 0.f) & 0xffffu);
#pragma unroll
          for (int ti = 0; ti < 16; ++ti) *(u32x2*)(F_YN + (size_t)(m0 + ti) * D + 768 + ch) = *(const LAS u32x2*)(DTb + ti * 264 + ch); }
    }
    __syncthreads();
    LAS float* PART = (LAS float*)F.lds;
    LAS float* H = (LAS float*)(F.lds + 65536);
    LAS float* O2 = (LAS float*)(F.lds + 65536 + 16384);
    const int fr = lane & 15, fq = lane >> 4, wave = F.wave;
    for (int rep8 = 0; rep8 < ((PROBE_PREP & 8) ? 2 : 1); ++rep8)
    for (int uid = blockIdx.x; uid < 256; uid += F.G) {
        const int b = uid >> 4, kv = (uid >> 3) & 1, n0 = 16 * (uid & 7);
        const bf16* W1t = F_C1T + (size_t)(L * 2 + kv) * 128 * 2048;
        const float* pos = FIN(kv ? I_POSV : I_POSK) + (size_t)L * 2048;
        const float* W2 = FIN(kv ? I_C2V : I_C2K) + (size_t)L * 128 * 64;
        const int nrow = (n0 + fr) < 126 ? (n0 + fr) : 126;
        const bf16* arow = F_U + (size_t)(b * T + 16 * nrow) * NU + UKC + 64 * kv;
        const bf16* brow = W1t + (size_t)fr * 2048;
        f32x4 acc[8];
#pragma unroll
        for (int ct = 0; ct < 8; ++ct) acc[ct] = (f32x4){0.f, 0.f, 0.f, 0.f};
#pragma unroll 2
        for (int ks = 0; ks < 8; ++ks) { const int kk = 8 * wave + ks, l = kk >> 1, c = 32 * (kk & 1) + 8 * fq;
            const v4u ar = *(const v4u*)(arow + (size_t)l * NU + c); const f32x4 p0 = *(const f32x4*)(pos + l * 64 + c), p1 = *(const f32x4*)(pos + l * 64 + c + 4);
            bf16x8 bfr[8];
#pragma unroll
            for (int ct = 0; ct < 8; ++ct) bfr[ct] = *(const bf16x8*)(brow + (size_t)(16 * ct) * 2048 + 32 * kk + 8 * fq);
            v4u aw; aw.x = pk2(bflo(ar.x) + p0[0], bfhi(ar.x) + p0[1]); aw.y = pk2(bflo(ar.y) + p0[2], bfhi(ar.y) + p0[3]); aw.z = pk2(bflo(ar.z) + p1[0], bfhi(ar.z) + p1[1]); aw.w = pk2(bflo(ar.w) + p1[2], bfhi(ar.w) + p1[3]);
#pragma unroll
            for (int ct = 0; ct < 8; ++ct) acc[ct] = __builtin_amdgcn_mfma_f32_16x16x32_bf16(__builtin_bit_cast(bf16x8, aw), bfr[ct], acc[ct], 0, 0, 0); }
#pragma unroll
        for (int ct = 0; ct < 8; ++ct)
#pragma unroll
            for (int i = 0; i < 4; ++i) PART[(wave * 16 + 4 * fq + i) * 128 + 16 * ct + fr] = acc[ct][i];
        __syncthreads();
        { const int e0 = 4 * tid; f32x4 sum = *(const LAS f32x4*)(PART + e0);
#pragma unroll
          for (int w = 1; w < 8; ++w) sum += *(const LAS f32x4*)(PART + w * 2048 + e0);
          const int hr = e0 >> 7, hc = e0 & 127;
#pragma unroll
          for (int i = 0; i < 4; ++i) { const float xh = sum[i]; const float y2 = 2.0f * 0.7978845608028654f * (xh + 0.044715f * xh * xh * xh); H[hr * 132 + hc + i] = xh * __builtin_amdgcn_rcpf(1.0f + __builtin_amdgcn_exp2f(y2 * -LOG2E)); } }
        __syncthreads();
        if (wave < 4) { f32x4 a2 = {0.f, 0.f, 0.f, 0.f};
#pragma unroll
            for (int s = 0; s < 4; ++s) { const LAS float* hp = H + fr * 132 + 32 * s + 8 * fq; const float* wp = W2 + (size_t)(32 * s + 8 * fq) * 64 + 16 * wave + fr;
                v4u aw; aw.x = pk2(hp[0], hp[1]); aw.y = pk2(hp[2], hp[3]); aw.z = pk2(hp[4], hp[5]); aw.w = pk2(hp[6], hp[7]);
                v4u bw; bw.x = pk2(wp[0], wp[64]); bw.y = pk2(wp[128], wp[192]); bw.z = pk2(wp[256], wp[320]); bw.w = pk2(wp[384], wp[448]);
                a2 = __builtin_amdgcn_mfma_f32_16x16x32_bf16(__builtin_bit_cast(bf16x8, aw), __builtin_bit_cast(bf16x8, bw), a2, 0, 0, 0); }
#pragma unroll
            for (int i = 0; i < 4; ++i) O2[(4 * fq + i) * 68 + 16 * wave + fr] = a2[i]; }
        __syncthreads();
        if (wave == 0) { const int row = lane >> 2, c0 = (lane & 3) * 16; float v[16]; float ss = 0.f;
#pragma unroll
            for (int e = 0; e < 16; ++e) { v[e] = O2[row * 68 + c0 + e]; ss += v[e] * v[e]; }
            ss += __shfl_xor(ss, 1); ss += __shfl_xor(ss, 2);
            const float rs = __builtin_amdgcn_rsqf(ss * (1.f / 64.f) + EPS); const float* gn = FIN(I_NKCN) + L * 64 + c0;
            const int n = n0 + row; const bool dead = n >= 127;
            v4u w0, w1; float o[16];
#pragma unroll
            for (int e = 0; e < 16; ++e) { o[e] = kv ? v[e] : v[e] * rs * gn[e]; if (dead) o[e] = 0.f; }
            w0.x = pk2(o[0], o[1]); w0.y = pk2(o[2], o[3]); w0.z = pk2(o[4], o[5]); w0.w = pk2(o[6], o[7]); w1.x = pk2(o[8], o[9]); w1.y = pk2(o[10], o[11]); w1.z = pk2(o[12], o[13]); w1.w = pk2(o[14], o[15]);
            const int tl = n >> 6, rr = n & 63;
            if (kv) { bf16* dstp = F_VC + (size_t)(b * 2 + tl) * 4096 + vimg_off(rr, c0); *(v4u*)dstp = w0; *(v4u*)(dstp + 8) = w1; }
            else { bf16* dstp = F_KC + (size_t)(b * 2 + tl) * 4096; *(v4u*)(dstp + kimg_off(rr, c0)) = w0; *(v4u*)(dstp + kimg_off(rr, c0 + 8)) = w1; } }
        __syncthreads();
    }
}

#ifndef PROBE_ATT
#define PROBE_ATT 0
#endif
namespace att {
constexpr int STG = 32768;
constexpr int L_STG = 0, L_IA = 65536, IAB = 4 * 64 * 33 * 4, L_IB = L_IA + IAB, L_SC = L_IB + IAB, L_SEL = L_SC + 64 * 33 * 4, L_UNI = L_SEL + 256, L_WSF = L_UNI + 256, L_END = L_WSF + NWAVES * 256;
static_assert(L_END <= MISC_OFF, "attention LDS map");
constexpr int OSTP = 264;
#define ATT_BAR() asm volatile("s_waitcnt vmcnt(0) lgkmcnt(0)\n\ts_barrier" ::: "memory")
#define ATT_LBAR() asm volatile("s_waitcnt lgkmcnt(0)\n\ts_barrier" ::: "memory")
__device__ __forceinline__ int crow(int r, int hi) { return (r & 3) + 8 * (r >> 2) + 4 * hi; }
__device__ __forceinline__ float pair_max(float v) { auto rr = __builtin_amdgcn_permlane32_swap(__float_as_uint(v), __float_as_uint(v), false, false); return fmaxf(__uint_as_float(rr[0]), __uint_as_float(rr[1])); }
__device__ __forceinline__ float pair_sum(float v) { auto rr = __builtin_amdgcn_permlane32_swap(__float_as_uint(v), __float_as_uint(v), false, false); return __uint_as_float(rr[0]) + __uint_as_float(rr[1]); }
__device__ __forceinline__ void dma_tile(const bf16* tile, LAS unsigned char* slot, int wave, int lane) {
    __builtin_amdgcn_global_load_lds((const unsigned*)(tile + wave * 512 + lane * 8), (LAS unsigned*)(slot + wave * 1024), 16, 0, 0); }
__device__ __forceinline__ void qk_tile(f32x16& p0, f32x16& p1, const LAS unsigned char* kslot, const bf16x8 (&qr)[4], int r32, int hi) {
    const LAS unsigned char* kp = kslot + hi * 1024 + r32 * 16;
    p0 = (f32x16){}; p1 = (f32x16){};
#pragma unroll
    for (int d0 = 0; d0 < 4; ++d0) { const bf16x8 b0 = *(const LAS bf16x8*)(kp + d0 * 2048), b1 = *(const LAS bf16x8*)(kp + d0 * 2048 + 512);
        p0 = __builtin_amdgcn_mfma_f32_32x32x16_bf16(b0, qr[d0], p0, 0, 0, 0); p1 = __builtin_amdgcn_mfma_f32_32x32x16_bf16(b1, qr[d0], p1, 0, 0, 0); }
}
__device__ __forceinline__ v4i16_t vtr(const LAS unsigned char* p) { return __builtin_amdgcn_ds_read_tr16_b64_v4i16((LAS v4i16_t*)p); }
__device__ __forceinline__ void pv_tile(f32x16& o0, f32x16& o1, const LAS unsigned char* vslot, const v4u (&pw)[4], int lane, int hi) {
    const LAS unsigned char* vp = vslot + ((lane >> 4) & 1) * 32 + (lane & 3) * 8 + (4 * hi + ((lane & 15) >> 2)) * 64;
#pragma unroll
    for (int s = 0; s < 4; ++s) {
        const v4i16_t a0 = vtr(vp + s * 1024), a1 = vtr(vp + s * 1024 + 512), b0 = vtr(vp + 4096 + s * 1024), b1 = vtr(vp + 4096 + s * 1024 + 512);
        const bf16x8 v0 = (bf16x8){a0[0], a0[1], a0[2], a0[3], a1[0], a1[1], a1[2], a1[3]}, v1 = (bf16x8){b0[0], b0[1], b0[2], b0[3], b1[0], b1[1], b1[2], b1[3]};
        const bf16x8 pa = __builtin_bit_cast(bf16x8, pw[s]);
        o0 = __builtin_amdgcn_mfma_f32_32x32x16_bf16(pa, v0, o0, 0, 0, 0); o1 = __builtin_amdgcn_mfma_f32_32x32x16_bf16(pa, v1, o1, 0, 0, 0); }
}
__device__ __forceinline__ void pack_p(v4u (&pw)[4], const f32x16& p0, const f32x16& p1) {
    pw[0] = (v4u){pk2(p0[0], p0[1]), pk2(p0[2], p0[3]), pk2(p0[4], p0[5]), pk2(p0[6], p0[7])};
    pw[1] = (v4u){pk2(p0[8], p0[9]), pk2(p0[10], p0[11]), pk2(p0[12], p0[13]), pk2(p0[14], p0[15])};
    pw[2] = (v4u){pk2(p1[0], p1[1]), pk2(p1[2], p1[3]), pk2(p1[4], p1[5]), pk2(p1[6], p1[7])};
    pw[3] = (v4u){pk2(p1[8], p1[9]), pk2(p1[10], p1[11]), pk2(p1[12], p1[13]), pk2(p1[14], p1[15])};
}
__device__ __forceinline__ void softmax_step(float& m, float& l, f32x16& o0, f32x16& o1, f32x16& p0, f32x16& p1, v4u (&pw)[4], LAS float* wsf, int r32, int hi) {
    float mt = fmaxf(p0[0], p1[0]);
#pragma unroll
    for (int r = 1; r < 16; ++r) mt = fmaxf(mt, fmaxf(p0[r], p1[r]));
    mt = pair_max(mt);
    if (__any(mt > m + 8.0f)) {
        const float mn = fmaxf(m, mt);
        const float al = __builtin_amdgcn_exp2f(m - mn); l *= al; m = mn;
        if (hi == 0) wsf[r32] = al;
        f32x4 a[4];
#pragma unroll
        for (int g = 0; g < 4; ++g) a[g] = *(const LAS f32x4*)(wsf + 8 * g + 4 * hi);
#pragma unroll
        for (int r = 0; r < 16; ++r) { o0[r] *= a[r >> 2][r & 3]; o1[r] *= a[r >> 2][r & 3]; }
    }
    float rs = 0.f;
#pragma unroll
    for (int r = 0; r < 16; ++r) { p0[r] = __builtin_amdgcn_exp2f(p0[r] - m); p1[r] = __builtin_amdgcn_exp2f(p1[r] - m); rs += p0[r] + p1[r]; }
    l += rs;
    pack_p(pw, p0, p1);
}
__device__ __forceinline__ void scale_rows(f32x16& a0, f32x16& a1, const f32x16& o0, const f32x16& o1, float fac, LAS float* wsf, int r32, int hi) {
    if (hi == 0) wsf[32 + r32] = fac;
    f32x4 f[4];
#pragma unroll
    for (int g = 0; g < 4; ++g) f[g] = *(const LAS f32x4*)(wsf + 32 + 8 * g + 4 * hi);
#pragma unroll
    for (int r = 0; r < 16; ++r) { a0[r] += o0[r] * f[r >> 2][r & 3]; a1[r] += o1[r] * f[r >> 2][r & 3]; }
}
template <int MODE>
__device__ __forceinline__ void run_branch(unsigned tiles, const bf16* Kg  , const bf16* Vg, int kvsel, unsigned selm, int tq, const bf16x8 (&qr)[4],
                                           float& m, float& l, f32x16& o0, f32x16& o1, LAS unsigned char* lds, LAS float* wsf, int wave, int lane) {
    constexpr int NKV = MODE == 2 ? 2 : 1, SLOT = 16384 * NKV, NS = MODE == 2 ? 4 : 8;
    const int r32 = lane & 31, hi = lane >> 5;
    m = -1e30f; l = 0.f; o0 = (f32x16){}; o1 = (f32x16){};
    unsigned remc = (unsigned)__builtin_amdgcn_readfirstlane((int)tiles), remi = remc;
    int nleft = __builtin_popcount(remc), slot_i = 0, slot_c = 0;
    ATT_LBAR();
#define ATT_ISSUE() do { const int ji = __builtin_ctz(remi); remi &= remi - 1; LAS unsigned char* st_ = lds + L_STG + slot_i * SLOT; slot_i = (slot_i + 1) & (NS - 1); \
        _Pragma("unroll") for (int g = 0; g < NKV; ++g) { dma_tile(Kg + (size_t)(g * 512 + ji) * 4096, st_ + g * 8192, wave, lane); dma_tile(Vg + (size_t)(g * 512 + ji) * 4096, st_ + NKV * 8192 + g * 8192, wave, lane); } } while (0)
#define ATT_WB(n) asm volatile("s_waitcnt vmcnt(" #n ") lgkmcnt(0)\n\ts_barrier" ::: "memory")
#pragma nounroll
    for (int k = 0; k < NS - 1; ++k) if (remi) ATT_ISSUE();
    for (;;) {
        const int pend = (nleft - 1 < NS - 2 ? nleft - 1 : NS - 2) * NKV;
        switch (pend) { case 0: ATT_WB(0); break; case 1: ATT_WB(2); break; case 2: ATT_WB(4); break; case 3: ATT_WB(6); break; case 4: ATT_WB(8); break; case 5: ATT_WB(10); break; default: ATT_WB(12); break; }
        if (remi) ATT_ISSUE();
        const int j = __builtin_ctz(remc); remc &= remc - 1; --nleft;
        const LAS unsigned char* st = lds + L_STG + slot_c * SLOT; slot_c = (slot_c + 1) & (NS - 1);
        f32x16 p0, p1; qk_tile(p0, p1, st + kvsel * 8192, qr, r32, hi);
        const int kb = 64 * j + 4 * hi; const bool sel = MODE != 0 || ((selm >> j) & 1u);
        constexpr int W = MODE == 1 ? 512 : 128;
        const int curt = __builtin_amdgcn_readfirstlane(tq) >> 6;
        const bool edge = MODE == 3 || j == curt || (MODE != 0 && j + W / 64 == curt);
        if (edge) {
#pragma unroll
            for (int r = 0; r < 16; ++r) { const int kp = kb + (r & 3) + 8 * (r >> 2);
                bool v0, v1;
                if (MODE == 0) { v0 = sel && kp <= tq; v1 = sel && kp + 32 <= tq; }
                else if (MODE == 3) { v0 = 16 * kp + 31 <= tq; v1 = 16 * (kp + 32) + 31 <= tq; }
                else { v0 = kp <= tq && kp + W > tq; v1 = kp + 32 <= tq && kp + 32 + W > tq; }
                p0[r] = v0 ? p0[r] : -INFINITY; p1[r] = v1 ? p1[r] : -INFINITY; }
        } else if (MODE == 0) {
#pragma unroll
            for (int r = 0; r < 16; ++r) { p0[r] = sel ? p0[r] : -INFINITY; p1[r] = sel ? p1[r] : -INFINITY; }
        }
        v4u pw[4]; softmax_step(m, l, o0, o1, p0, p1, pw, wsf, r32, hi);
        pv_tile(o0, o1, st + NKV * 8192 + kvsel * 8192, pw, lane, hi);
        if (nleft == 0) break;
    }
#undef ATT_ISSUE
#undef ATT_WB
}
__device__ __forceinline__ void stage_norm_store(const f32x16& o0, const f32x16& o1, bf16* ynb  , LAS unsigned char* lds, int wave, int lane) {
    const int r32 = lane & 31, hi = lane >> 5, h = wave & 3, th = wave >> 2;
    LAS bf16* OST = (LAS bf16*)(lds + L_STG);
    ATT_LBAR();
#pragma unroll
    for (int r = 0; r < 16; ++r) { LAS bf16* p = OST + (32 * th + crow(r, hi)) * OSTP + h * 64 + r32;
        p[0] = (bf16)(pk2(o0[r], 0.f) & 0xffffu); p[32] = (bf16)(pk2(o1[r], 0.f) & 0xffffu); }
    ATT_LBAR();
    f32x4 vv[8]; float ssn[8];
#pragma unroll
    for (int i = 0; i < 8; ++i) { const u32x2 w = *(const LAS u32x2*)(OST + (8 * wave + i) * OSTP + 4 * lane); vv[i] = (f32x4){bflo(w.x), bfhi(w.x), bflo(w.y), bfhi(w.y)}; ssn[i] = sq4(vv[i]); }
#pragma unroll
    for (int i = 0; i < 8; ++i) ssn[i] = wave_sum(ssn[i]);
#pragma unroll
    for (int i = 0; i < 8; ++i) st4bf(ynb + (size_t)(8 * wave + i) * D + 4 * lane, vv[i] * __builtin_amdgcn_rsqf(ssn[i] * (1.f / 256.f) + EPS));
}
__device__ __forceinline__ void attn_unit(Frame& F, int L, int b, int qt) {
    LAS unsigned char* lds = F.lds;
    int tid = F.tid; asm volatile("" : "+v"(tid));
    const int wave = F.wave, lane = tid & 63, r32 = lane & 31, hi = lane >> 5, h = wave & 3, th = wave >> 2;
    const int t0 = qt * 64, cur = qt, qrow = 32 * th + r32, tq = t0 + qrow;
    const size_t mrow = (size_t)b * T + tq;
    LAS float* wsf = (LAS float*)(lds + L_WSF) + wave * 64;
    LAS float* IA = (LAS float*)(lds + L_IA); LAS float* IB = (LAS float*)(lds + L_IB); LAS float* SC = (LAS float*)(lds + L_SC);
    LAS unsigned* SEL = (LAS unsigned*)(lds + L_SEL); LAS unsigned* UNI = (LAS unsigned*)(lds + L_UNI);
    const size_t tb = (size_t)b * 32 * 4096;
    bf16x8 qr[4];
#pragma unroll
    for (int d0 = 0; d0 < 4; ++d0) qr[d0] = *(const bf16x8*)(F_QA + mrow * 256 + h * 64 + d0 * 16 + hi * 8);
    const float* gp = F_GATES + mrow * 12 + h * 3; const float g0 = gp[0], g1 = gp[1], g2 = gp[2];
    f32x16 ot0 = (f32x16){}, ot1 = (f32x16){};
    float mb, lb; f32x16 ob0, ob1;
    for (int rep = 0; rep < ((PROBE_ATT & 4) ? 2 : 1); ++rep) {
        if (rep) { ATT_LBAR(); ot0 = (f32x16){}; ot1 = (f32x16){}; }
        if (tid == 0) UNI[0] = 0u;
        run_branch<3>(3u, F_KC + (size_t)b * 2 * 4096, F_VC + (size_t)b * 2 * 4096, 0, 0u, tq, qr, mb, lb, ob0, ob1, lds, wsf, wave, lane);
        const float lt = pair_sum(lb); const float inv = lt > 0.f ? 1.0f / lt : 0.f;
        scale_rows(ot0, ot1, ob0, ob1, g0 * inv, wsf, r32, hi);
        LAS float* ia = IA + (h * 64 + qrow) * 33; LAS float* ib = IB + (h * 64 + qrow) * 33;
#pragma unroll
        for (int tl = 0; tl < 2; ++tl) { f32x16 p0, p1; qk_tile(p0, p1, lds + L_STG + tl * 16384, qr, r32, hi);
#pragma unroll
            for (int r = 0; r < 16; ++r) { const int n = 64 * tl + crow(r, hi);
                p0[r] = 16 * n + 31 <= tq ? __builtin_amdgcn_exp2f(p0[r] - mb) * inv : 0.f; p1[r] = 16 * (n + 32) + 31 <= tq ? __builtin_amdgcn_exp2f(p1[r] - mb) * inv : 0.f; }
#pragma unroll
            for (int G = 0; G < 4; ++G) {
                ia[hi + 2 * (G + 8 * tl)] = (p0[4 * G] + p0[4 * G + 1]) + (p0[4 * G + 2] + p0[4 * G + 3]); ib[hi + 2 * (G + 8 * tl)] = p0[4 * G + 3];
                ia[hi + 2 * (G + 4 + 8 * tl)] = (p1[4 * G] + p1[4 * G + 1]) + (p1[4 * G + 2] + p1[4 * G + 3]); ib[hi + 2 * (G + 4 + 8 * tl)] = p1[4 * G + 3]; } }
        ATT_LBAR();
        const int q = tid >> 3, jg = tid & 7, tqq = t0 + q;
#pragma unroll
        for (int i = 0; i < 4; ++i) { const int j = 4 * jg + i; float imp = 0.f;
#pragma unroll
            for (int hh = 0; hh < 4; ++hh) { imp += IA[(hh * 64 + q) * 33 + j]; if (j > 0) imp += IB[(hh * 64 + q) * 33 + j - 1]; }
            const bool forced = j == 0 || j == cur || j == cur - 1, future = j * 64 > tqq;
            SC[q * 33 + j] = forced ? 1e4f : (future ? -1.0f : imp); }
        ATT_LBAR();
        unsigned bits = 0u;
#pragma unroll
        for (int i = 0; i < 4; ++i) { const int j = 4 * jg + i; const float sj = SC[q * 33 + j]; int rank = 0;
#pragma unroll 8
            for (int k = 0; k < 32; ++k) { const float sk = SC[q * 33 + k]; rank += (sk > sj || (sk == sj && k < j)) ? 1 : 0; }
            if (rank < 8) bits |= 1u << j; }
        bits |= __shfl_xor(bits, 1); bits |= __shfl_xor(bits, 2); bits |= __shfl_xor(bits, 4);
        if (jg == 0) { SEL[q] = bits; atomicOr((unsigned*)UNI, bits); }
        ATT_LBAR();
    }
    { const unsigned selm = SEL[qrow]; const unsigned uni = UNI[0] & ((2u << cur) - 1u);
      if (PROBE_ATT & 1) run_branch<0>(uni, F_KSI + tb, F_VSI + tb, 0, selm, tq, qr, mb, lb, ob0, ob1, lds, wsf, wave, lane);
      run_branch<0>(uni, F_KSI + tb, F_VSI + tb, 0, selm, tq, qr, mb, lb, ob0, ob1, lds, wsf, wave, lane);
      const float lt = pair_sum(lb); scale_rows(ot0, ot1, ob0, ob1, g1 / lt, wsf, r32, hi); }
    { const int lo = cur >= 8 ? cur - 8 : 0; const unsigned tiles = ((2u << cur) - 1u) & ~((1u << lo) - 1u);
      if (PROBE_ATT & 2) run_branch<1>(tiles, F_KWI + tb, F_VWI + tb, 0, 0u, tq, qr, mb, lb, ob0, ob1, lds, wsf, wave, lane);
      run_branch<1>(tiles, F_KWI + tb, F_VWI + tb, 0, 0u, tq, qr, mb, lb, ob0, ob1, lds, wsf, wave, lane);
      const float lt = pair_sum(lb); scale_rows(ot0, ot1, ob0, ob1, g2 / lt, wsf, r32, hi); }
    if (PROBE_ATT & 8) stage_norm_store(ot0, ot1, F_YN + ((size_t)b * T + t0) * D + 0, lds, wave, lane);
    stage_norm_store(ot0, ot1, F_YN + ((size_t)b * T + t0) * D + 0, lds, wave, lane);
    for (int rep = 0; rep < ((PROBE_ATT & 16) ? 2 : 1); ++rep) {
#pragma unroll
        for (int d0 = 0; d0 < 4; ++d0) qr[d0] = *(const bf16x8*)(F_QC + mrow * 256 + h * 64 + d0 * 16 + hi * 8);
        const int lo = cur >= 2 ? cur - 2 : 0; const unsigned tiles = ((2u << cur) - 1u) & ~((1u << lo) - 1u);
        run_branch<2>(tiles, F_CKI + tb, F_CVI + tb, h >> 1, 0u, tq, qr, mb, lb, ob0, ob1, lds, wsf, wave, lane);
        const float sink2 = FIN(I_SINK)[L * 4 + h] * LOG2E;
        const float mf = fmaxf(mb, sink2), sc = __builtin_amdgcn_exp2f(mb - mf);
        const float lt = pair_sum(lb) * sc + __builtin_amdgcn_exp2f(sink2 - mf);
        ot0 = (f32x16){}; ot1 = (f32x16){};
        scale_rows(ot0, ot1, ob0, ob1, sc / lt, wsf, r32, hi);
        stage_norm_store(ot0, ot1, F_YN + ((size_t)b * T + t0) * D + 512, lds, wave, lane);
    }
}
__device__ __forceinline__ void attn_phase(Frame& F, int L) {
    for (int w = F.vcu; w < 256; w += F.G) { const int b = w >> 4, i = w & 15;
#pragma nounroll
        for (int u2 = 0; u2 < 2; ++u2) attn_unit(F, L, b, u2 ? 31 - i : i); }
    ATT_LBAR();
}
}

__global__ void __launch_bounds__(NWAVES * 64, 2) fwd(Args args) {
    extern __shared__ __attribute__((aligned(16))) unsigned char lds[];
    Frame F;
    F.lds = (LAS unsigned char*)lds;
    F.tid = threadIdx.x; F.lane = F.tid & 63; F.wave = __builtin_amdgcn_readfirstlane(F.tid >> 6);
    F.G = gridDim.x; { const int bx = blockIdx.x; F.vcu = (F.G % 8 == 0) ? (bx % 8) * (F.G / 8) + bx / 8 : bx; }
    F.a = &args;
    unsigned char* ws = args.ws;
    volatile LAS unsigned* MISC = (volatile LAS unsigned*)(F.lds + MISC_OFF);
    if (F.tid < 64) MISC[F.tid] = 0u;
    __syncthreads();
#define GRID_BAR() do { XcdBarrier b2_ = bar; { unsigned xx_ = b2_.x; asm volatile("" : "+s"(xx_)); b2_.x = xx_; }     \
        xcd_barrier(b2_); __builtin_amdgcn_s_waitcnt(0); } while (0)
    XcdBarrier bar = xcd_barrier_post((unsigned*)(ws + WS_CTL) + CW_BAR, MISC + 8);

#ifndef PH_MASK
#define PH_MASK 127
#endif
#ifndef PROBE_DUP
#define PROBE_DUP 0
#endif
    if (PH_MASK & 1) prologue(F);
    if (PROBE_DUP & 1) prologue(F);
    GRID_BAR();
    for (int s = 0; s < 2 * DEPTH; ++s) {
        const int L = s >> 1, which = s & 1;
        const bool up8 = (UP8_MASK >> s) & 1u, dn8 = (DN8_MASK >> s) & 1u;
        if (PH_MASK & 2) {
            const bf16* wt = (const bf16*)((unsigned char*)F_W13T + (size_t)s * NF1 * D * 2); pg8::StaticOrder S; S.init(M, NF1, F.G, (int)blockIdx.x);
            if (up8) { pg8::Gemm g{(const bf16*)F_X8, wt, M, NF1, D / 2};
                if (PROBE_DUP & 128) { pg8::EpiNull EN{F_GATES}; pg8::gemm_phase<pg8::EpiNull, pg8::StaticOrder, true, true, true>(F.lds, g, S, EN); }
                if (PROBE_DUP & 256) { pg8::EpiNull EN{F_GATES}; pg8::FixedOrder<1> S2; S2.init(M, NF1, F.G, (int)blockIdx.x); pg8::gemm_phase<pg8::EpiNull, pg8::FixedOrder<1>, true, true, true>(F.lds, g, S2, EN); }
                if (PROBE_DUP & 512) { pg8::EpiNull EN{F_GATES}; pg8::FixedOrder<3> S2; S2.init(M, NF1, F.G, (int)blockIdx.x); pg8::gemm_phase<pg8::EpiNull, pg8::FixedOrder<3>, true, true, true>(F.lds, g, S2, EN); }
                if (dn8) { pg8::EpiSwiglu<true> E{(void*)F_ACT, DFF, F_SSQ, 1.0f / W8_SCALE, ACT8_SCALE, F.lds + pg8::STAGE_BYTES, 0, 0, 0}; for (int rep = 0; rep < ((PROBE_DUP & 2) ? 2 : 1); ++rep) pg8::gemm_phase<pg8::EpiSwiglu<true>, pg8::StaticOrder, true, true, true>(F.lds, g, S, E); }
                else if (((UP8_MASK & ~DN8_MASK) & 0xFu) != 0u) { pg8::EpiSwiglu<false> E{(void*)F_ACT, DFF, F_SSQ, 1.0f / W8_SCALE, 1.0f, F.lds + pg8::STAGE_BYTES, 0, 0, 0}; for (int rep = 0; rep < ((PROBE_DUP & 2) ? 2 : 1); ++rep) pg8::gemm_phase<pg8::EpiSwiglu<false>, pg8::StaticOrder, true, true, true>(F.lds, g, S, E); } }
            else { pg8::Gemm g{F_XB, wt, M, NF1, D};
                if (dn8) { if (((~UP8_MASK & DN8_MASK) & 0xFu) != 0u) { pg8::EpiSwiglu<true> E{(void*)F_ACT, DFF, F_SSQ, 1.0f, ACT8_SCALE, F.lds + pg8::STAGE_BYTES, 0, 0, 0}; for (int rep = 0; rep < ((PROBE_DUP & 2) ? 2 : 1); ++rep) pg8::gemm_phase<pg8::EpiSwiglu<true>, pg8::StaticOrder, true, true, false>(F.lds, g, S, E); } }
                else if (((~UP8_MASK & ~DN8_MASK) & 0xFu) != 0u) { pg8::EpiSwiglu<false> E{(void*)F_ACT, DFF, F_SSQ, 1.0f, 1.0f, F.lds + pg8::STAGE_BYTES, 0, 0, 0}; for (int rep = 0; rep < ((PROBE_DUP & 2) ? 2 : 1); ++rep) pg8::gemm_phase<pg8::EpiSwiglu<false>, pg8::StaticOrder, true, true, false>(F.lds, g, S, E); } }
        }
        GRID_BAR();
        if (PH_MASK & 4) {
            const bf16* wt = (const bf16*)((unsigned char*)F_W2T + (size_t)s * D * DFF * 2); pg8::StaticOrder S; S.init(M, D, F.G, (int)blockIdx.x);
            const int last = (s + 1 == 2 * DEPTH) ? 1 : 0, w8 = ((s & 1) && !last && ((UP8_MASK >> (s + 1)) & 1u)) ? 1 : 0;
            if (dn8) { if (DN8_MASK & 0xFu) { pg8::Gemm g{F_ACT, wt, M, D, DFF / 2}; pg8::EpiRes E{F_XB, F_SSQ, 1, F_X8, FOUT, w8, last}; pg8::gemm_phase<pg8::EpiRes, pg8::StaticOrder, true, true, true>(F.lds, g, S, E); } }
            else if ((~DN8_MASK) & 0xFu) { pg8::Gemm g{F_ACT, wt, M, D, DFF}; pg8::EpiRes E{F_XB, F_SSQ, 0, F_X8, FOUT, w8, last}; pg8::gemm_phase<pg8::EpiRes, pg8::StaticOrder, true, true, false>(F.lds, g, S, E); }
        }
        if (s + 1 < 2 * DEPTH) GRID_BAR();
        if (which == 0) {
            if (PH_MASK & 8) {
                pg8::Gemm g{F_XB, F_WINT + (size_t)L * NU * D, M, NU, D}; pg8::StaticOrder S; S.init(M, NU, F.G, (int)blockIdx.x);
                pg8::EpiScaleBf16 E{F_U, NU, F_SSQ, F.lds + pg8::STAGE_BYTES, 0, 0, 0};
                for (int rep = 0; rep < ((PROBE_DUP & 8) ? 2 : 1); ++rep) pg8::gemm_phase<pg8::EpiScaleBf16, pg8::StaticOrder, true, true>(F.lds, g, S, E);
            }
            GRID_BAR();
            if (PH_MASK & 16) prep_phase(F, L);
            if (PROBE_DUP & 16) prep_phase(F, L);
            GRID_BAR();
            if (PH_MASK & 32) att::attn_phase(F, L);
            if (PROBE_DUP & 32) att::attn_phase(F, L);
            GRID_BAR();
            if (PH_MASK & 64) {
                pg8::Gemm g{F_YN, F_WOUTT + (size_t)L * D * D, M, D, D}; pg8::StaticOrder S; S.init(M, D, F.G, (int)blockIdx.x);
                pg8::EpiRes E{F_XB, F_SSQ, 2, F_X8, FOUT, (int)((UP8_MASK >> (2 * L + 1)) & 1u), 0};
                pg8::gemm_phase<pg8::EpiRes, pg8::StaticOrder, true, true>(F.lds, g, S, E);
            }
            GRID_BAR();
        }
    }
}

extern "C" void kernel_launch(void* const* d_in, const int* in_sizes, int n_in, void* d_out, int out_size, void* d_ws, size_t ws_size, hipStream_t stream) {
    static int grid = 0;
    if (grid == 0) {
        if (n_in != 29 || in_sizes[0] != M * D || out_size != M * D || ws_size < WS_END) { fprintf(stderr, "kernel_launch: unexpected shapes (n_in %d, in0 %d, out %d, ws %zu); nothing launched\n", n_in, n_in > 0 ? in_sizes[0] : -1, out_size, ws_size); grid = -1; return; }
        int dev = 0, cus = 0, per_cu = 0;
        if (hipGetDevice(&dev) != hipSuccess || hipDeviceGetAttribute(&cus, hipDeviceAttributeMultiprocessorCount, dev) != hipSuccess) { grid = -1; return; }
        if (hipFuncSetAttribute((const void*)fwd, hipFuncAttributeMaxDynamicSharedMemorySize, LDS_BYTES) != hipSuccess) { fprintf(stderr, "kernel_launch: hipFuncSetAttribute failed\n"); grid = -1; return; }
        if (hipOccupancyMaxActiveBlocksPerMultiprocessor(&per_cu, (const void*)fwd, NWAVES * 64, LDS_BYTES) != hipSuccess || per_cu < 1) fprintf(stderr, "kernel_launch: occupancy query says %d\n", per_cu);
        (void)hipGetLastError();
        grid = cus;
    }
    if (grid < 0) return;
    if (hipMemsetAsync((char*)d_ws + WS_CTL, 0, CTL_ZERO_BYTES, stream) != hipSuccess) return;
    Args a{};
    for (int i = 0; i < 29; ++i) a.in[i] = (const float*)d_in[i];
    a.out = (float*)d_out; a.ws = (unsigned char*)d_ws;
    hipLaunchKernelGGL(fwd, dim3(grid), dim3(NWAVES * 64), LDS_BYTES, stream, a);
}
```

```cpp
#include <hip/hip_runtime.h>
#include <cstdio>
#include <cstdint>
struct KArgs { const float* in[29]; float* out; unsigned char* ws; };
namespace pg8 {
#define PG8_LAS __attribute__((address_space(3)))
typedef unsigned short bf16_t;
typedef short bf16x8 __attribute__((ext_vector_type(8)));
typedef float f32x4 __attribute__((ext_vector_type(4)));
typedef unsigned u32x4 __attribute__((ext_vector_type(4)));
constexpr int BM = 256, BK = 64, HALF = 128, HTB = HALF * BK * 2  , STAGE_BYTES = 8 * HTB, NXCD = 8, WGM = 8;

__host__ __device__ __forceinline__ int lds_byte(int r, int c) { const int st = (r >> 4) * 2 + (c >> 5), rr = r & 15, cc = c & 31, ob = rr * 64 + cc * 2; return st * 1024 + (ob ^ (((ob >> 9) & 1) << 5)); }
__host__ __device__ __forceinline__ void stage_rc(int b, int& R, int& C) { const int st = b / 1024, sb = b % 1024, swz = sb ^ (((sb >> 9) & 1) << 5); R = (st >> 1) * 16 + swz / 64; C = (st & 1) * 32 + (swz % 64) / 2; }
__host__ __device__ __forceinline__ int perm32(int rho) { const int n = rho >> 4, i = rho & 15; return 8 * (i >> 2) + 4 * n + (i & 3); }

struct Unit { int pm, pn; };
struct Gemm { const bf16_t* A; const bf16_t* Bt; int M, N, K; };

struct StaticOrder {
    int nM, nN, nwg, G, c;
    __host__ __device__ void init(int M, int N, int G_, int c_) { nM = M / BM; nN = N / BM; nwg = nM * nN; G = G_; c = c_; }
    __host__ __device__ bool next(int i, Unit& u) const {
        const long L = (long)i * G + c; if (L >= nwg) return false;
        int wgid = (int)L; { const int q = nwg / NXCD, r = nwg % NXCD, xcd = wgid % NXCD, off = wgid / NXCD; wgid = (xcd < r ? xcd * (q + 1) : r * (q + 1) + (xcd - r) * q) + off; }
        const int nig = WGM * nN, gid = wgid / nig, fm = gid * WGM, gsz = (nM - fm) < WGM ? (nM - fm) : WGM;
        u.pm = fm + ((wgid % nig) % gsz); u.pn = (wgid % nig) / gsz; return true;
    }
    __device__ __forceinline__ void a_ready(const Unit&) const {}
    __device__ __forceinline__ void done(const Unit&) const {}
};

__device__ __forceinline__ unsigned cvt_pk_bf16(float lo, float hi) { unsigned r; asm volatile("v_cvt_pk_bf16_f32 %0, %1, %2" : "=v"(r) : "v"(lo), "v"(hi)); return r; }

typedef unsigned u32x2 __attribute__((ext_vector_type(2)));
typedef int i32x4 __attribute__((ext_vector_type(4)));
typedef int i32x8 __attribute__((ext_vector_type(8)));
#ifndef MFMA8_SCALE
#define MFMA8_SCALE 1
#endif
__device__ __forceinline__ i32x8 cat8(bf16x8 a, bf16x8 b) { return __builtin_shufflevector(__builtin_bit_cast(i32x4, a), __builtin_bit_cast(i32x4, b), 0, 1, 2, 3, 4, 5, 6, 7); }
__device__ __forceinline__ void mfma8(f32x4& acc, const i32x8& b, const i32x8& a, int sc) {
#if MFMA8_SCALE
    asm volatile("v_mfma_scale_f32_16x16x128_f8f6f4 %0, %1, %2, %0, %3, %3 op_sel_hi:[0,0,0]" : "+v"(acc) : "v"(b), "v"(a), "v"(sc));
#else
    asm volatile("v_mfma_f32_16x16x128_f8f6f4 %0, %1, %2, %0" : "+v"(acc) : "v"(b), "v"(a));
#endif
}
__device__ __forceinline__ unsigned pk4_fp8(float a, float b, float c, float d) { int w = 0; w = __builtin_amdgcn_cvt_pk_fp8_f32(a, b, w, false); w = __builtin_amdgcn_cvt_pk_fp8_f32(c, d, w, true); return (unsigned)w; }
__device__ __forceinline__ unsigned pkbf(float lo, float hi) { typedef float f2_t __attribute__((ext_vector_type(2))); typedef __bf16 b2_t __attribute__((ext_vector_type(2))); f2_t v = {lo, hi}; b2_t b = __builtin_convertvector(v, b2_t); return __builtin_bit_cast(unsigned, b); }
__device__ __forceinline__ float bf_lo(unsigned u) { return __builtin_bit_cast(float, u << 16); }
__device__ __forceinline__ float bf_hi(unsigned u) { return __builtin_bit_cast(float, u & 0xffff0000u); }
__device__ __forceinline__ float swap32_add(float v) { auto rr = __builtin_amdgcn_permlane32_swap(__float_as_uint(v), __float_as_uint(v), false, false); return __uint_as_float(rr[0]) + __uint_as_float(rr[1]); }
__device__ __forceinline__ void fill_rstd_tbl(PG8_LAS unsigned char* tblp, const float* ssq, int pm, int wid, int lane) {
    const int r = wid * 32 + (lane >> 1), hf = lane & 1; const float* p = ssq + (size_t)(pm * BM + r) * 16 + 8 * hf;
    const f32x4 a = *(const f32x4*)p, b = *(const f32x4*)(p + 4);
    float s = ((a[0] + a[1]) + (a[2] + a[3])) + ((b[0] + b[1]) + (b[2] + b[3]));
    s += __builtin_bit_cast(float, __builtin_amdgcn_update_dpp(0, __builtin_bit_cast(int, s), 0xB1, 0xf, 0xf, true));
    if (hf == 0) ((PG8_LAS float*)tblp)[r] = __builtin_amdgcn_rsqf(s * (1.0f / 1024.0f) + 1e-6f);
}
__device__ __forceinline__ void rows_rstd(float (&rs)[2][4], const PG8_LAS unsigned char* tblp, int wr, int fr, float scale) {
#pragma unroll
    for (int ai = 0; ai < 2; ++ai)
#pragma unroll
        for (int m = 0; m < 4; ++m) rs[ai][m] = ((const PG8_LAS float*)tblp)[ai * HALF + wr * 64 + m * 16 + fr] * scale;
}
template <bool F8> struct EpiSwiglu {
    static constexpr bool PERM = true, AFTER_DRAIN = false, ROW_RSTD = true;
    void* O; int ldc; const float* ssq; float insc, oscale; PG8_LAS unsigned char* tbl; mutable int pmA, pmB, pmC;
    __device__ __forceinline__ void set_panels(int a, int b, int c) const { pmA = a; pmB = b; pmC = c; }
    __device__ __forceinline__ void fill_rstd(PG8_LAS unsigned char* t, int pm, int wid, int lane) const { fill_rstd_tbl(t, ssq, pm, wid, lane); }
    __device__ __forceinline__ void operator()(const f32x4 (&acc)[2][2][4][2], const Unit& u, int wr, int wc, int fr_, int fq_) const {
        int tl_ = threadIdx.x; asm volatile("" : "+v"(tl_)); const int fr = tl_ & 15, fq = (tl_ >> 4) & 3; (void)fr_; (void)fq_;
        const int row0 = u.pm * BM + wr * 64 + fr, col0 = u.pn * HALF + wc * 32 + 8 * fq;
        float rsv[2][4]; rows_rstd(rsv, tbl + (u.pm == pmA ? 0 : (u.pm == pmB ? 1024 : (u.pm == pmC ? 2048 : 3072))), wr, fr, insc);
#pragma unroll
        for (int ai = 0; ai < 2; ++ai)
#pragma unroll
            for (int m = 0; m < 4; ++m) { const int row = row0 + ai * HALF + m * 16; const float rs = rsv[ai][m], rsb = rs * (F8 ? oscale : 1.0f); f32x4 ov[2];
#pragma unroll
                for (int n = 0; n < 2; ++n) { const f32x4 a = acc[ai][0][m][n] * rs, b = acc[ai][1][m][n] * rsb, tt = a * -1.4426950408889634f; f32x4 r;
#pragma unroll
                    for (int e = 0; e < 4; ++e) r[e] = __builtin_amdgcn_rcpf(1.0f + __builtin_amdgcn_exp2f(tt[e]));
                    ov[n] = (a * b) * r; }
                const float o[8] = {ov[0][0], ov[0][1], ov[0][2], ov[0][3], ov[1][0], ov[1][1], ov[1][2], ov[1][3]};
                if constexpr (F8) { u32x2 w; w.x = pk4_fp8(o[0], o[1], o[2], o[3]); w.y = pk4_fp8(o[4], o[5], o[6], o[7]);
                    *(u32x2*)((unsigned char*)O + (size_t)row * ldc + col0) = w; }
                else { u32x4 w; w.x = pkbf(o[0], o[1]); w.y = pkbf(o[2], o[3]); w.z = pkbf(o[4], o[5]); w.w = pkbf(o[6], o[7]);
                    *(u32x4*)((bf16_t*)O + (size_t)row * ldc + col0) = w; } }
    }
};
struct EpiScaleBf16 {
    static constexpr bool PERM = true, AFTER_DRAIN = false, ROW_RSTD = true;
    bf16_t* O; int ldc; const float* ssq; PG8_LAS unsigned char* tbl; mutable int pmA, pmB, pmC;
    __device__ __forceinline__ void set_panels(int a, int b, int c) const { pmA = a; pmB = b; pmC = c; }
    __device__ __forceinline__ void fill_rstd(PG8_LAS unsigned char* t, int pm, int wid, int lane) const { fill_rstd_tbl(t, ssq, pm, wid, lane); }
    __device__ __forceinline__ void operator()(const f32x4 (&acc)[2][2][4][2], const Unit& u, int wr, int wc, int fr_, int fq_) const {
        int tl_ = threadIdx.x; asm volatile("" : "+v"(tl_)); const int fr = tl_ & 15, fq = (tl_ >> 4) & 3; (void)fr_; (void)fq_;
        const int row0 = u.pm * BM + wr * 64 + fr, col0 = u.pn * BM + wc * 32 + 8 * fq;
        float rsv[2][4]; rows_rstd(rsv, tbl + (u.pm == pmA ? 0 : (u.pm == pmB ? 1024 : (u.pm == pmC ? 2048 : 3072))), wr, fr, 1.0f);
#pragma unroll
        for (int ai = 0; ai < 2; ++ai)
#pragma unroll
            for (int m = 0; m < 4; ++m) { const int row = row0 + ai * HALF + m * 16; const float rs = rsv[ai][m];
#pragma unroll
                for (int bj = 0; bj < 2; ++bj) { const f32x4 v0 = acc[ai][bj][m][0] * rs, v1 = acc[ai][bj][m][1] * rs;
                    u32x4 w; w.x = pkbf(v0[0], v0[1]); w.y = pkbf(v0[2], v0[3]); w.z = pkbf(v1[0], v1[1]); w.w = pkbf(v1[2], v1[3]);
                    *(u32x4*)(O + (size_t)row * ldc + col0 + bj * HALF) = w; } }
    }
};
struct EpiRes {
    static constexpr bool PERM = false, AFTER_DRAIN = false, ROW_RSTD = false;
    bf16_t* xb; float* ssq; int mode; unsigned char* x8p; float* outp; int w8, fin;
    __device__ __forceinline__ void operator()(const f32x4 (&acc)[2][2][4][2], const Unit& u, int wr, int wc, int fr_, int fq_) const {
        int tl_ = threadIdx.x; asm volatile("" : "+v"(tl_)); const int fr = tl_ & 15, fq = (tl_ >> 4) & 3; (void)fr_; (void)fq_;
        const int row0 = u.pm * BM + wr * 64 + fr, col0 = u.pn * BM + wc * 32 + 4 * fq;
        int md_ = __builtin_amdgcn_readfirstlane(mode), w8_ = __builtin_amdgcn_readfirstlane(w8), fin_ = __builtin_amdgcn_readfirstlane(fin); asm volatile("" : "+s"(md_), "+s"(w8_), "+s"(fin_));
        const float alpha = md_ == 0 ? 0.5f : (md_ == 1 ? 0.5f / 256.0f : 1.0f);
        float* const outf = fin_ ? outp : nullptr; unsigned char* const x8 = w8_ ? x8p : nullptr;
#pragma unroll
        for (int ai = 0; ai < 2; ++ai) { u32x2 old[4][2][2];
#pragma unroll
            for (int m = 0; m < 4; ++m)
#pragma unroll
                for (int bj = 0; bj < 2; ++bj)
#pragma unroll
                    for (int n = 0; n < 2; ++n) old[m][bj][n] = *(const u32x2*)(xb + (size_t)(row0 + ai * HALF + m * 16) * 1024 + col0 + bj * HALF + n * 16);
            float ssv[4];
#pragma unroll
            for (int m = 0; m < 4; ++m) { const int row = row0 + ai * HALF + m * 16; const size_t off = (size_t)row * 1024 + col0; float ss = 0.f;
#pragma unroll
                for (int bj = 0; bj < 2; ++bj)
#pragma unroll
                    for (int n = 0; n < 2; ++n) { const u32x2 ow = old[m][bj][n]; const f32x4 xo = (f32x4){bf_lo(ow.x), bf_hi(ow.x), bf_lo(ow.y), bf_hi(ow.y)}; const f32x4 xn = xo + acc[ai][bj][m][n] * alpha;
                        if (outf) *(f32x4*)(outf + off + bj * HALF + n * 16) = xn;
                        else { ss += (xn[0] * xn[0] + xn[1] * xn[1]) + (xn[2] * xn[2] + xn[3] * xn[3]);
                            u32x2 w; w.x = pkbf(xn[0], xn[1]); w.y = pkbf(xn[2], xn[3]); *(u32x2*)(xb + off + bj * HALF + n * 16) = w;
                            if (x8) *(unsigned*)(x8 + off + bj * HALF + n * 16) = pk4_fp8(xn[0], xn[1], xn[2], xn[3]); } }
                ssv[m] = ss; }
            if (!outf) { float tv[4];
#pragma unroll
                for (int m = 0; m < 4; ++m) ssv[m] = swap32_add(ssv[m]);
#pragma unroll
                for (int m = 0; m < 4; ++m) tv[m] = __shfl_xor(ssv[m], 16);
#pragma unroll
                for (int m = 0; m < 4; ++m) if (fq == 0) ssq[(size_t)(row0 + ai * HALF + m * 16) * 16 + u.pn * 4 + wc] = ssv[m] + tv[m]; }
            asm volatile("" ::: "memory"); }
    }
};

struct EpiNull {
    static constexpr bool PERM = true, AFTER_DRAIN = false, ROW_RSTD = false;
    float* sink;
    __device__ __forceinline__ void operator()(const f32x4 (&acc)[2][2][4][2], const Unit& u, int wr, int wc, int fr, int fq) const {
        float s = 0.f;
#pragma unroll
        for (int ai = 0; ai < 2; ++ai)
#pragma unroll
            for (int bj = 0; bj < 2; ++bj)
#pragma unroll
                for (int m = 0; m < 4; ++m)
#pragma unroll
                    for (int n = 0; n < 2; ++n) s += acc[ai][bj][m][n][0];
        if (s == 12345.678f) sink[0] = s;
    }
};
template <int PIN> struct FixedOrder : StaticOrder {
    __device__ bool next(int i, Unit& u) const { const bool ok = StaticOrder::next(i, u); if (PIN & 1) u.pn = 0; if (PIN & 2) u.pm = (int)(blockIdx.x & 7); return ok; }
};
template <class Epi, class Sched, bool ALIGN_EPI = false, bool SP2 = false, bool FP8 = false>
__device__ __forceinline__ void gemm_phase(PG8_LAS unsigned char* lds, const Gemm g, const Sched& S, const Epi& E) {
    int tid = threadIdx.x; asm volatile("" : "+v"(tid));
    const int wid = __builtin_amdgcn_readfirstlane(tid >> 6), lane = tid & 63, wr = wid >> 2, wc = wid & 3, fr = lane & 15, fq = lane >> 4;
    const int K = g.K, nt = K / BK;
    unsigned voffA[2], voffB[2];
#pragma unroll
    for (int i = 0; i < 2; ++i) { int R, C; stage_rc(tid * 16 + i * 8192, R, C); const int Rb = Epi::PERM ? ((R & ~31) + perm32(R & 31)) : R;
        voffA[i] = (unsigned)(R * K + C) * 2u; voffB[i] = (unsigned)(Rb * K + C) * 2u; }
    const size_t kstep = (size_t)(BK * 2);
    const size_t hstep = (size_t)HALF * K * 2;
    const size_t tstep = 2 * hstep;
    const unsigned ldsw = (unsigned)wid * 1024u;
    const int aoff = lds_byte(wr * 64 + fr, fq * 8), boff = lds_byte(wc * 32 + fr, fq * 8);
#define PG8_SA(b, h) (((b) * 2 + (h)) * HTB)
#define PG8_SB(b, h) ((4 + (b) * 2 + (h)) * HTB)
#define PG8_STAGE(bufoff, gbase, voff) do { _Pragma("unroll") for (int _i = 0; _i < 2; ++_i) \
        __builtin_amdgcn_global_load_lds((const unsigned*)((const char*)(gbase) + (voff)[_i]), (PG8_LAS unsigned*)(lds + (bufoff) + ldsw + _i * 8192), 16, 0, 0); } while (0)
#define PG8_LDA(dst, b, h) do { if constexpr (FP8) { _Pragma("unroll") for (int m = 0; m < 4; ++m) dst##8[m] = cat8(*(const PG8_LAS bf16x8*)(lds + PG8_SA(b, h) + aoff + m * 2048), *(const PG8_LAS bf16x8*)(lds + PG8_SA(b, h) + aoff + m * 2048 + 1024)); } \
        else { _Pragma("unroll") for (int m = 0; m < 4; ++m) _Pragma("unroll") for (int k = 0; k < 2; ++k) dst[m][k] = *(const PG8_LAS bf16x8*)(lds + PG8_SA(b, h) + aoff + m * 2048 + k * 1024); } } while (0)
#define PG8_LDB(dst, b, h) do { if constexpr (FP8) { _Pragma("unroll") for (int n = 0; n < 2; ++n) dst##8[n] = cat8(*(const PG8_LAS bf16x8*)(lds + PG8_SB(b, h) + boff + n * 2048), *(const PG8_LAS bf16x8*)(lds + PG8_SB(b, h) + boff + n * 2048 + 1024)); } \
        else { _Pragma("unroll") for (int n = 0; n < 2; ++n) _Pragma("unroll") for (int k = 0; k < 2; ++k) dst[n][k] = *(const PG8_LAS bf16x8*)(lds + PG8_SB(b, h) + boff + n * 2048 + k * 1024); } } while (0)
#define PG8_MMA(ai, bj, At, Bt) do { __builtin_amdgcn_s_setprio(1); \
        if constexpr (FP8) { _Pragma("unroll") for (int m = 0; m < 4; ++m) _Pragma("unroll") for (int n = 0; n < 2; ++n) \
            mfma8(acc[ai][bj][m][n], Bt##8[n], At##8[m], sc8); } \
        else { _Pragma("unroll") for (int m = 0; m < 4; ++m) _Pragma("unroll") for (int n = 0; n < 2; ++n) _Pragma("unroll") for (int k = 0; k < 2; ++k) \
            acc[ai][bj][m][n] = __builtin_amdgcn_mfma_f32_16x16x32_bf16(Bt[n][k], At[m][k], acc[ai][bj][m][n], 0, 0, 0); } \
        __builtin_amdgcn_s_setprio(0); } while (0)
#define PG8_WAIT_V(n) asm volatile("s_waitcnt vmcnt(" #n ")" ::: "memory")
#define PG8_WAIT_L(n) asm volatile("s_waitcnt lgkmcnt(" #n ")" ::: "memory")
#define PG8_BAR __builtin_amdgcn_s_barrier()
#define PG8_SCHED __builtin_amdgcn_sched_barrier(0)
    Unit cur, nxt; int ui = 0;
    if (!S.next(0, cur)) return;
    if constexpr (Epi::ROW_RSTD) {
        int p0 = cur.pm, p1 = -1, p2 = -1, p3 = -1; { Unit t_; for (int n_ = 1; S.next(n_, t_); ++n_) { const int p = t_.pm; if (p != p0 && p != p1 && p != p2 && p != p3) { if (p1 < 0) p1 = p; else if (p2 < 0) p2 = p; else p3 = p; } } }
        E.fill_rstd(lds + STAGE_BYTES, p0, wid, lane); if (p1 >= 0) E.fill_rstd(lds + STAGE_BYTES + 1024, p1, wid, lane); if (p2 >= 0) E.fill_rstd(lds + STAGE_BYTES + 2048, p2, wid, lane); if (p3 >= 0) E.fill_rstd(lds + STAGE_BYTES + 3072, p3, wid, lane);
        E.set_panels(p0, p1, p2);
        PG8_WAIT_L(0); PG8_BAR; asm volatile("" ::: "memory"); }
    f32x4 acc[2][2][4][2];
#pragma unroll
    for (int a = 0; a < 2; ++a)
#pragma unroll
        for (int b = 0; b < 2; ++b)
#pragma unroll
            for (int m = 0; m < 4; ++m)
#pragma unroll
                for (int n = 0; n < 2; ++n) acc[a][b][m][n] = (f32x4){0.f, 0.f, 0.f, 0.f};
    bf16x8 At[4][2], B0[2][2], B1[2][2]; i32x8 At8[4], B08[2], B18[2]; int sc8 = 0x7F7F7F7F; asm volatile("" : "+v"(sc8));
    const char* cA = (const char*)g.A + (size_t)cur.pm * tstep; const char* cB = (const char*)g.Bt + (size_t)cur.pn * tstep;
    S.a_ready(cur);
    if constexpr (SP2) {
        PG8_STAGE(PG8_SB(0, 0), cB, voffB); PG8_STAGE(PG8_SB(0, 1), cB + hstep, voffB); PG8_STAGE(PG8_SA(0, 0), cA, voffA); PG8_STAGE(PG8_SA(0, 1), cA + hstep, voffA);
        if (wr == 1) PG8_BAR;
        PG8_WAIT_V(2); PG8_BAR;
        PG8_STAGE(PG8_SB(1, 0), cB + kstep, voffB); PG8_STAGE(PG8_SA(1, 0), cA + kstep, voffA); PG8_STAGE(PG8_SB(1, 1), cB + hstep + kstep, voffB);
        PG8_WAIT_V(6); PG8_BAR;
    } else {
        PG8_STAGE(PG8_SB(0, 0), cB, voffB); PG8_STAGE(PG8_SA(0, 0), cA, voffA); PG8_STAGE(PG8_SB(0, 1), cB + hstep, voffB); PG8_STAGE(PG8_SA(0, 1), cA + hstep, voffA);
        if (wr == 1) PG8_BAR;
        PG8_WAIT_V(4); PG8_BAR;
        PG8_STAGE(PG8_SB(1, 0), cB + kstep, voffB); PG8_STAGE(PG8_SA(1, 0), cA + kstep, voffA); PG8_STAGE(PG8_SB(1, 1), cB + hstep + kstep, voffB);
        PG8_WAIT_V(6); PG8_BAR;
    }
    for (;;) {
        const bool has_next = S.next(ui + 1, nxt);
        const char* nA = has_next ? (const char*)g.A + (size_t)nxt.pm * tstep : cA; const char* nB = has_next ? (const char*)g.Bt + (size_t)nxt.pn * tstep : cB;
#pragma nounroll
        for (int t = 0; t < nt; t += 2) {
            const bool last = (t == nt - 2);
            const char* a1 = cA + (size_t)(t + 1) * kstep;
            const char* a2 = last ? nA : cA + (size_t)(t + 2) * kstep; const char* b2 = last ? nB : cB + (size_t)(t + 2) * kstep;
            const char* a3 = a2 + kstep; const char* b3 = b2 + kstep;
            if (last && has_next) S.a_ready(nxt);
            if constexpr (SP2) {
            PG8_LDB(B0, 0, 0); PG8_LDB(B1, 0, 1); PG8_SCHED; PG8_LDA(At, 0, 0); PG8_STAGE(PG8_SA(1, 1), a1 + hstep, voffA);
            PG8_WAIT_V(8); PG8_WAIT_L(0); PG8_BAR; PG8_MMA(0, 0, At, B0); PG8_MMA(0, 1, At, B1); PG8_BAR; PG8_SCHED;
            PG8_LDA(At, 0, 1); PG8_STAGE(PG8_SB(0, 0), b2, voffB); PG8_STAGE(PG8_SB(0, 1), b2 + hstep, voffB); PG8_STAGE(PG8_SA(0, 0), a2, voffA);
            PG8_WAIT_V(8); PG8_WAIT_L(0); PG8_BAR; PG8_MMA(1, 0, At, B0); PG8_MMA(1, 1, At, B1); PG8_BAR; PG8_SCHED;
            PG8_LDB(B0, 1, 0); PG8_LDB(B1, 1, 1); PG8_SCHED; PG8_LDA(At, 1, 0); PG8_STAGE(PG8_SA(0, 1), a2 + hstep, voffA);
            PG8_WAIT_V(8); PG8_WAIT_L(0); PG8_BAR; PG8_MMA(0, 0, At, B0); PG8_MMA(0, 1, At, B1); PG8_BAR; PG8_SCHED;
            PG8_LDA(At, 1, 1); PG8_STAGE(PG8_SB(1, 0), b3, voffB); PG8_STAGE(PG8_SB(1, 1), b3 + hstep, voffB); PG8_STAGE(PG8_SA(1, 0), a3, voffA);
            PG8_WAIT_V(8); PG8_WAIT_L(0); PG8_BAR; PG8_MMA(1, 0, At, B0); PG8_MMA(1, 1, At, B1); PG8_BAR; PG8_SCHED;
            } else {
            PG8_LDB(B0, 0, 0); PG8_SCHED; PG8_LDA(At, 0, 0); PG8_STAGE(PG8_SA(1, 1), a1 + hstep, voffA);
            PG8_WAIT_L(8); PG8_BAR; PG8_WAIT_L(0); PG8_MMA(0, 0, At, B0); PG8_BAR; PG8_SCHED;
            PG8_LDB(B1, 0, 1); PG8_STAGE(PG8_SB(0, 0), b2, voffB);
            PG8_BAR; PG8_WAIT_L(0); PG8_MMA(0, 1, At, B1); PG8_BAR;
            PG8_LDA(At, 0, 1); PG8_STAGE(PG8_SA(0, 0), a2, voffA);
            PG8_BAR; PG8_WAIT_L(0); PG8_MMA(1, 0, At, B0); PG8_BAR; PG8_SCHED;
            PG8_STAGE(PG8_SB(0, 1), b2 + hstep, voffB);
            PG8_WAIT_V(6); PG8_BAR; PG8_MMA(1, 1, At, B1); PG8_BAR;
            PG8_LDB(B0, 1, 0); PG8_SCHED; PG8_LDA(At, 1, 0); PG8_STAGE(PG8_SA(0, 1), a2 + hstep, voffA);
            PG8_WAIT_L(8); PG8_BAR; PG8_WAIT_L(0); PG8_MMA(0, 0, At, B0); PG8_BAR; PG8_SCHED;
            PG8_LDB(B1, 1, 1); PG8_STAGE(PG8_SB(1, 0), b3, voffB);
            PG8_BAR; PG8_WAIT_L(0); PG8_MMA(0, 1, At, B1); PG8_BAR;
            PG8_LDA(At, 1, 1); PG8_STAGE(PG8_SA(1, 0), a3, voffA);
            PG8_BAR; PG8_WAIT_L(0); PG8_MMA(1, 0, At, B0); PG8_BAR; PG8_SCHED;
            PG8_STAGE(PG8_SB(1, 1), b3 + hstep, voffB);
            PG8_WAIT_V(6); PG8_BAR; PG8_MMA(1, 1, At, B1); PG8_BAR;
            }
        }
        if constexpr (ALIGN_EPI) { if (wr == 0) PG8_BAR; }
        if constexpr (FP8) asm volatile("s_nop 15\n\ts_nop 15" ::: "memory");
        if constexpr (!Epi::AFTER_DRAIN) { E(acc, cur, wr, wc, fr, fq); S.done(cur); }
        if (!has_next) break;
#pragma unroll
        for (int a = 0; a < 2; ++a)
#pragma unroll
            for (int b = 0; b < 2; ++b)
#pragma unroll
                for (int m = 0; m < 4; ++m)
#pragma unroll
                    for (int n = 0; n < 2; ++n) acc[a][b][m][n] = (f32x4){0.f, 0.f, 0.f, 0.f};
        cur = nxt; cA = nA; cB = nB; ++ui;
        if constexpr (ALIGN_EPI) { if (wr == 1) PG8_BAR; }
    }
    PG8_WAIT_V(0);
    if constexpr (!ALIGN_EPI) { if (wr == 0) PG8_BAR; }
    PG8_BAR;
    if constexpr (Epi::AFTER_DRAIN) { E.fused(acc, cur, wr, wc, fr, fq, lds, wid, lane); S.done(cur); }
#undef PG8_SA
#undef PG8_SB
#undef PG8_STAGE
#undef PG8_LDA
#undef PG8_LDB
#undef PG8_MMA
#undef PG8_WAIT_V
#undef PG8_WAIT_L
#undef PG8_BAR
#undef PG8_SCHED
}
}

constexpr int NWAVES = 8;
constexpr int BATCH = 16, T = 2048, D = 1024, M = BATCH * T, DFF = 2816, NF1 = 2 * DFF, NU = 2304, DEPTH = 2, NCP = 128;
constexpr float EPS = 1e-6f, LOG2E = 1.4426950408889634f, C2 = 0.125f * LOG2E;
constexpr int UQ = 0, UKS = 256, UKW = 320, UCK = 384, UCQ = 512, UKC = 768, UVC = 832, UVS = 896, UVW = 960, UCV = 1024, UG = 1152, UBB = 1280, UBC = 1536, UBX = 1792, UDV = 2048;
constexpr size_t MiB = 1u << 20;
constexpr size_t WS_CTL = 0, CTL_ZERO_BYTES = 1 * MiB;
constexpr size_t WS_W13 = 1 * MiB, WS_W2 = 45 * MiB, WS_WIN = 67 * MiB, WS_WOUT = 76 * MiB, WS_C1 = 80 * MiB;
constexpr size_t WS_SSQ = 82 * MiB, WS_GATES = 84 * MiB, WS_KC = 86 * MiB, WS_VC = 86 * MiB + 512 * 1024;
constexpr size_t WS_XB = 88 * MiB, WS_QKN = 152 * MiB, WS_YN = 200 * MiB, WS_ACT = 264 * MiB, WS_U = WS_ACT, WS_X8 = 440 * MiB, WS_IMG = 472 * MiB, WS_END = 504 * MiB;
#ifndef UP8_MASK_V
#define UP8_MASK_V 0xE
#endif
#ifndef DN8_MASK_V
#define DN8_MASK_V 0xF
#endif
constexpr unsigned UP8_MASK = UP8_MASK_V, DN8_MASK = DN8_MASK_V;
constexpr float W8_SCALE = 64.0f, ACT8_SCALE = 4.0f; static_assert(W8_SCALE * ACT8_SCALE == 256.0f, "EpiRes mode 1");
constexpr int CW_BAR = 4096;
constexpr int LDS_BYTES = 163840, MISC_OFF = LDS_BYTES - 256;

#define GAS __attribute__((address_space(1)))
#define LAS __attribute__((address_space(3)))
typedef unsigned short bf16;
typedef unsigned v4u __attribute__((ext_vector_type(4)));
typedef unsigned u32x2 __attribute__((ext_vector_type(2)));
typedef float f32x4 __attribute__((ext_vector_type(4)));
typedef float f32x2_t __attribute__((ext_vector_type(2)));
typedef __bf16 bf16x2_t __attribute__((ext_vector_type(2)));
typedef short bf16x8 __attribute__((ext_vector_type(8)));
typedef float f32x16 __attribute__((ext_vector_type(16)));
typedef short v4i16_t __attribute__((ext_vector_type(4)));
#define LDS_WAIT() asm volatile("s_waitcnt lgkmcnt(0)" ::: "memory")
__device__ __forceinline__ unsigned pk2(float lo, float hi) { f32x2_t v = {lo, hi}; bf16x2_t b = __builtin_convertvector(v, bf16x2_t); return __builtin_bit_cast(unsigned, b); }
__device__ __forceinline__ float bflo(unsigned u) { return __builtin_bit_cast(float, u << 16); }
__device__ __forceinline__ float bfhi(unsigned u) { return __builtin_bit_cast(float, u & 0xffff0000u); }
__device__ __forceinline__ f32x4 ld4bf(const bf16* p) { const u32x2 w = *(const u32x2*)p; return (f32x4){bflo(w.x), bfhi(w.x), bflo(w.y), bfhi(w.y)}; }
__device__ __forceinline__ void st4bf(bf16* p, f32x4 v) { u32x2 w; w.x = pk2(v[0], v[1]); w.y = pk2(v[2], v[3]); *(u32x2*)p = w; }
template <int CTRL> __device__ __forceinline__ float dpp_add(float v) { return v + __builtin_bit_cast(float, __builtin_amdgcn_update_dpp(0, __builtin_bit_cast(int, v), CTRL, 0xf, 0xf, true)); }
__device__ __forceinline__ float row16_sum(float v) { v = dpp_add<0xB1>(v); v = dpp_add<0x4E>(v); v = dpp_add<0x141>(v); v = dpp_add<0x140>(v); return v; }
__device__ __forceinline__ float wave_sum(float v) {
    v = row16_sum(v); v += __shfl_xor(v, 16);
    auto rr = __builtin_amdgcn_permlane32_swap(__float_as_uint(v), __float_as_uint(v), false, false); return __uint_as_float(rr[0]) + __uint_as_float(rr[1]);
}
__device__ __forceinline__ f32x4 up4(u32x2 w) { return (f32x4){bflo(w.x), bfhi(w.x), bflo(w.y), bfhi(w.y)}; }
__device__ __forceinline__ float sq4(f32x4 v) { return (v[0] * v[0] + v[1] * v[1]) + (v[2] * v[2] + v[3] * v[3]); }

__device__ __forceinline__ int kimg_off(int r, int d) { return (d >> 3) * 512 + r * 8 + (d & 7); }
__device__ __forceinline__ int vimg_off(int r, int d) { return ((d >> 5) * 4 + (r >> 4)) * 512 + (r & 15) * 32 + (d & 31); }
#define XB_TMO      128
#define XB_XCNT(j)  (256  + 64 * (j))
#define XB_XSUB(j)  (1280 + 64 * (j))
#define XB_XGEN(j)  (2304 + 64 * (j))
#define XB_TOP      3328
#define XB_TOPGEN   3392
#define XCD_BAR_WORDS 3456
#define XB_SPIN_CAP (1u << 18)

__device__ __forceinline__ unsigned xb_ld(unsigned* p)              { return __hip_atomic_load(p, __ATOMIC_RELAXED, __HIP_MEMORY_SCOPE_AGENT); }
__device__ __forceinline__ unsigned xb_add(unsigned* p, unsigned v) { return __hip_atomic_fetch_add(p, v, __ATOMIC_RELAXED, __HIP_MEMORY_SCOPE_AGENT); }
__device__ __forceinline__ unsigned xb_xcc_id() { return (unsigned)__builtin_amdgcn_s_getreg((3 << 11) | 20) & 0xFu; }
#define XB_SPIN(cond, bar) do { unsigned _sp = 0; while (cond) { __builtin_amdgcn_s_sleep(1); \
    if ((++_sp & 255u) == 0u) { if (xb_ld(&(bar)[XB_TMO])) break; if (_sp > XB_SPIN_CAP) { atomicAdd(&(bar)[XB_TMO], 1u); break; } } } } while (0)

struct XcdBarrier {
    unsigned* bar; unsigned x;
    volatile LAS unsigned* st;
};

__device__ __forceinline__ XcdBarrier xcd_barrier_post(unsigned* bar, volatile LAS unsigned* st) {
    XcdBarrier b; b.bar = bar; b.x = xb_xcc_id(); b.st = st;
    if (threadIdx.x == 0) (void)xb_add(&bar[XB_XCNT(b.x)], 1u);
    return b;
}
__device__ __forceinline__ void xcd_barrier_complete(unsigned* bar, unsigned x, unsigned& nloc, unsigned& nx) {
    const unsigned G = gridDim.x * gridDim.y * gridDim.z;
    unsigned sum, cnt, mine, sp = 0u;
    for (;;) {
        sum = 0u; cnt = 0u; mine = 0u;
#pragma unroll
        for (unsigned j = 0; j < 16; ++j) { const unsigned c = xb_ld(&bar[XB_XCNT(j)]); sum += c; cnt += (c > 0u) ? 1u : 0u; mine = (j == x) ? c : mine; }
        if (sum == G) break;
        __builtin_amdgcn_s_sleep(1);
        if ((++sp & 255u) == 0u) { if (xb_ld(&bar[XB_TMO])) break; if (sp > XB_SPIN_CAP) { atomicAdd(&bar[XB_TMO], 1u); break; } }
    }
    nloc = mine > 0u ? mine : 1u; nx = cnt > 0u ? cnt : 1u;
}

__device__ __forceinline__ void xcd_barrier(const XcdBarrier& b) {
    asm volatile("s_waitcnt vmcnt(0)" ::: "memory");
    __syncthreads();
    if (threadIdx.x == 0) {
        unsigned* bar = b.bar;
        __builtin_amdgcn_s_waitcnt(0);
        unsigned nloc = b.st[0], nx = b.st[1];
        if (nloc == 0u) { xcd_barrier_complete(bar, b.x, nloc, nx); b.st[0] = nloc; b.st[1] = nx; }
        const unsigned old = xb_add(&bar[XB_XSUB(b.x)], 1u);
        const unsigned gen = old / nloc;
        if (old + 1u == (gen + 1u) * nloc) {
            __builtin_amdgcn_fence(__ATOMIC_RELEASE, "agent");
            asm volatile("s_waitcnt vmcnt(0)" ::: "memory");
            const unsigned og = xb_add(&bar[XB_TOP], 1u);
            const unsigned tg = og / nx;
            if (og + 1u == (tg + 1u) * nx) xb_add(&bar[XB_TOPGEN], 1u);
            else XB_SPIN(xb_ld(&bar[XB_TOPGEN]) == tg, bar);
            __builtin_amdgcn_fence(__ATOMIC_ACQUIRE, "agent");
            xb_add(&bar[XB_XGEN(b.x)], 1u);
            asm volatile("s_waitcnt vmcnt(0)" ::: "memory");
        } else {
            XB_SPIN(xb_ld(&bar[XB_XGEN(b.x)]) == gen, bar);
            __builtin_amdgcn_fence(__ATOMIC_ACQUIRE, "agent");
            asm volatile("s_waitcnt vmcnt(0)" ::: "memory");
        }
    }
    __syncthreads();
}


typedef KArgs Args;
struct Frame {
    LAS unsigned char* lds;
    int tid, lane, wave, vcu, G;
    const Args* a;
};
#define FIN(i) (F.a->in[i])
#define FOUT (F.a->out)
#define FWS(off, type) ((type*)(F.a->ws + (off)))
#define F_W13T FWS(WS_W13, bf16)
#define F_W2T FWS(WS_W2, bf16)
#define F_WINT FWS(WS_WIN, bf16)
#define F_WOUTT FWS(WS_WOUT, bf16)
#define F_C1T FWS(WS_C1, bf16)
#define F_XB FWS(WS_XB, bf16)
#define F_QA FWS(WS_QKN, bf16)
#define F_QC FWS(WS_QKN + 16 * MiB, bf16)
#define F_KSI FWS(WS_IMG, bf16)
#define F_KWI FWS(WS_IMG + 4 * MiB, bf16)
#define F_CKI FWS(WS_IMG + 8 * MiB, bf16)
#define F_VSI FWS(WS_IMG + 16 * MiB, bf16)
#define F_VWI FWS(WS_IMG + 20 * MiB, bf16)
#define F_CVI FWS(WS_IMG + 24 * MiB, bf16)
#define F_YN FWS(WS_YN, bf16)
#define F_ACT FWS(WS_ACT, bf16)
#define F_U FWS(WS_U, bf16)
#define F_KC FWS(WS_KC, bf16)
#define F_VC FWS(WS_VC, bf16)
#define F_SSQ FWS(WS_SSQ, float)
#define F_GATES FWS(WS_GATES, float)
#define F_X8 FWS(WS_X8, unsigned char)
enum { I_X = 0, I_F1N, I_F1W1, I_F1W3, I_F1W2, I_MIXN, I_WIN, I_NQN, I_NKCN, I_NKSN, I_NKWN, I_POSK, I_C1K, I_C2K, I_POSV, I_C1V, I_C2V, I_CONVW, I_SQN, I_SKN, I_SINK, I_POOLW, I_POOLS, I_GN, I_WOUT,
       I_F2N, I_F2W1, I_F2W3, I_F2W2 };

__device__ __forceinline__ int win_src_col(int dr) {
    if (dr < 256) return dr;
    if (dr < 320) return 384 + (dr - 256);
    if (dr < 384) return 512 + (dr - 320);
    if (dr < 512) return 1676 + (dr - 384);
    if (dr < 768) return 1420 + (dr - 512);
    if (dr < 832) return 256 + (dr - 768);
    if (dr < 896) return 320 + (dr - 832);
    if (dr < 960) return 448 + (dr - 896);
    if (dr < 1024) return 576 + (dr - 960);
    if (dr < 1152) return 1804 + (dr - 1024);
    if (dr < 1164) return 640 + (dr - 1152);
    if (dr < 1280) return -1;
    if (dr < 1536) return 652 + (dr - 1280);
    if (dr < 1792) return 908 + (dr - 1536);
    if (dr < 2048) return 1164 + (dr - 1792);
    return 1932 + (dr - 2048);
}
struct TrItem { const float* src; const float* gain; void* dst; int N, K, k0, srccol, dstrow0; bool f8; };
__device__ __forceinline__ void tr_load(const TrItem& t, f32x4 (&v)[16], int lane) {
    const int kr = lane >> 4;
#pragma unroll
    for (int i = 0; i < 16; ++i) { v[i] = (f32x4){0.f, 0.f, 0.f, 0.f}; if (t.srccol >= 0) v[i] = *(const f32x4*)(t.src + (size_t)(t.k0 + 4 * i + kr) * t.N + t.srccol); }
}
__device__ __forceinline__ void tr_store(const TrItem& t, f32x4 (&v)[16], LAS float* scr, int lane) {
    const int kr = lane >> 4;
    if (t.gain) {
#pragma unroll
        for (int i = 0; i < 16; ++i) v[i] *= t.gain[t.k0 + 4 * i + kr]; }
#pragma unroll
    for (int i = 0; i < 16; ++i) { LAS float* p = scr + (4 * i + kr) * 65 + 4 * (lane & 15); p[0] = v[i][0]; p[1] = v[i][1]; p[2] = v[i][2]; p[3] = v[i][3]; }
    LDS_WAIT(); asm volatile("" ::: "memory");
    if (t.f8) { const int c = lane & 3;
#pragma unroll
        for (int j = 0; j < 4; ++j) { const int n = (lane >> 2) + 16 * j; const LAS float* q = scr + (16 * c) * 65 + n; v4u o;
            o.x = pg8::pk4_fp8(q[0 * 65] * W8_SCALE, q[1 * 65] * W8_SCALE, q[2 * 65] * W8_SCALE, q[3 * 65] * W8_SCALE); o.y = pg8::pk4_fp8(q[4 * 65] * W8_SCALE, q[5 * 65] * W8_SCALE, q[6 * 65] * W8_SCALE, q[7 * 65] * W8_SCALE);
            o.z = pg8::pk4_fp8(q[8 * 65] * W8_SCALE, q[9 * 65] * W8_SCALE, q[10 * 65] * W8_SCALE, q[11 * 65] * W8_SCALE); o.w = pg8::pk4_fp8(q[12 * 65] * W8_SCALE, q[13 * 65] * W8_SCALE, q[14 * 65] * W8_SCALE, q[15 * 65] * W8_SCALE);
            *(v4u*)((unsigned char*)t.dst + (size_t)(t.dstrow0 + n) * t.K + t.k0 + 16 * c) = o; } }
    else { const int c = lane & 7;
#pragma unroll
        for (int j = 0; j < 8; ++j) { const int n = (lane >> 3) + 8 * j; const LAS float* q = scr + (8 * c) * 65 + n;
            v4u o; o.x = pk2(q[0 * 65], q[1 * 65]); o.y = pk2(q[2 * 65], q[3 * 65]); o.z = pk2(q[4 * 65], q[5 * 65]); o.w = pk2(q[6 * 65], q[7 * 65]);
            *(v4u*)((bf16*)t.dst + (size_t)(t.dstrow0 + n) * t.K + t.k0 + 8 * c) = o; } }
    LDS_WAIT(); asm volatile("" ::: "memory");
}
__device__ __forceinline__ void tr_decode(Frame& F, int it, int lane, TrItem& t) {
    constexpr int I_W = 704, I_IN = 16 * 36, I_OUT = 16 * 16, I_C1 = 32 * 2, PER_LAYER = 6 * I_W + I_IN + I_OUT + 2 * I_C1;
    const int L = it / PER_LAYER, l4 = 4 * (lane & 15); int r = it % PER_LAYER;
    t.gain = nullptr; t.f8 = false;
    if (r < 6 * I_W) { const int mat = r / I_W; r %= I_W; const int ffn = mat / 3, w = mat % 3;
        if (w < 2) { const int kb = r / 44, nb = r % 44, n0 = 64 * nb; t.N = DFF; t.K = D; t.k0 = 64 * kb; t.srccol = n0 + l4;
            t.src = FIN(ffn ? (w ? I_F2W3 : I_F2W1) : (w ? I_F1W3 : I_F1W1)) + (size_t)L * D * DFF; t.gain = FIN(ffn ? I_F2N : I_F1N) + L * D;
            t.dst = (unsigned char*)F_W13T + (size_t)(L * 2 + ffn) * NF1 * D * 2; t.dstrow0 = (n0 / 128) * 256 + w * 128 + (n0 % 128); t.f8 = (UP8_MASK >> (L * 2 + ffn)) & 1u; }
        else { const int kb = r / 16, nb = r % 16, n0 = 64 * nb; t.N = D; t.K = DFF; t.k0 = 64 * kb; t.srccol = n0 + l4;
            t.src = FIN(ffn ? I_F2W2 : I_F1W2) + (size_t)L * DFF * D; t.dst = (unsigned char*)F_W2T + (size_t)(L * 2 + ffn) * D * DFF * 2; t.dstrow0 = n0; t.f8 = (DN8_MASK >> (L * 2 + ffn)) & 1u; } }
    else { r -= 6 * I_W;
        if (r < I_IN) { const int kb = r / 36, rb = r % 36; t.N = 2188; t.K = D; t.k0 = 64 * kb; t.srccol = win_src_col(64 * rb + l4);
            t.src = FIN(I_WIN) + (size_t)L * D * 2188; t.gain = FIN(I_MIXN) + L * D; t.dst = F_WINT + (size_t)L * NU * D; t.dstrow0 = 64 * rb; }
        else if (r < I_IN + I_OUT) { r -= I_IN; const int kb = r / 16, nb = r % 16, n0 = 64 * nb; t.N = D; t.K = D; t.k0 = 64 * kb; t.srccol = n0 + l4;
            t.src = FIN(I_WOUT) + (size_t)L * D * D; t.gain = FIN(I_GN) + L * D; t.dst = F_WOUTT + (size_t)L * D * D; t.dstrow0 = n0; }
        else { r -= I_IN + I_OUT; const int kv = r / I_C1; r %= I_C1; const int kb = r / 2, nb = r % 2, n0 = 64 * nb; t.N = 128; t.K = 2048; t.k0 = 64 * kb; t.srccol = n0 + l4;
            t.src = FIN(kv ? I_C1V : I_C1K) + (size_t)L * 2048 * 128; t.dst = F_C1T + (size_t)(L * 2 + kv) * 128 * 2048; t.dstrow0 = n0; } }
}
__device__ __forceinline__ void prologue(Frame& F) {
    int lane = F.lane; asm volatile("" : "+v"(lane));
    LAS float* scr = (LAS float*)(F.lds + F.wave * 16640);
    const int gw = F.vcu * NWAVES + F.wave, NGW = F.G * NWAVES;
    constexpr int NITEMS = DEPTH * (6 * 704 + 16 * 36 + 16 * 16 + 2 * 64);
    if (gw < NITEMS) { TrItem ta, tb; f32x4 va[16], vb[16];
        tr_decode(F, gw, lane, ta); tr_load(ta, va, lane);
        for (int it = gw; it < NITEMS; it += 2 * NGW) {
            const bool hb = it + NGW < NITEMS; if (hb) { tr_decode(F, it + NGW, lane, tb); tr_load(tb, vb, lane); }
            tr_store(ta, va, scr, lane);
            const bool ha = it + 2 * NGW < NITEMS; if (ha) { tr_decode(F, it + 2 * NGW, lane, ta); tr_load(ta, va, lane); }
            if (hb) tr_store(tb, vb, scr, lane);
        } }
    const float* x = FIN(I_X);
    for (int m4 = gw * 4; m4 < M; m4 += NGW * 4) {
        f32x4 v[4][4];
#pragma unroll
        for (int r = 0; r < 4; ++r)
#pragma unroll
            for (int j = 0; j < 4; ++j) v[r][j] = *((const f32x4*)(x + (size_t)(m4 + r) * D) + lane + 64 * j);
#pragma unroll
        for (int r = 0; r < 4; ++r) { float sr = 0.f;
#pragma unroll
            for (int j = 0; j < 4; ++j) { sr += sq4(v[r][j]); st4bf(F_XB + (size_t)(m4 + r) * D + 256 * j + 4 * lane, v[r][j]);
                if (UP8_MASK & 1u) *(unsigned*)(F_X8 + (size_t)(m4 + r) * D + 256 * j + 4 * lane) = pg8::pk4_fp8(v[r][j][0], v[r][j][1], v[r][j][2], v[r][j][3]); }
            sr = wave_sum(sr);
            if (lane < 16) F_SSQ[(size_t)(m4 + r) * 16 + lane] = lane == 0 ? sr : 0.f; }
    }
}

#ifndef PROBE_PREP
#define PROBE_PREP 0
#endif
__device__ __forceinline__ void prep_phase(Frame& F, int L) {
    int tid = F.tid; asm volatile("" : "+v"(tid));
    const int lane = tid & 63, ch = 4 * lane;
    LAS bf16* PWt = (LAS bf16*)F.lds;
    LAS bf16* DTb = (LAS bf16*)(F.lds + 65536) + F.wave * (16 * 264);
    { const float* pw = FIN(I_POOLW) + (size_t)L * 16384;
      for (int i = tid; i < 16384; i += NWAVES * 64) { const int g = i >> 12, c = (i >> 6) & 63, e = i & 63; PWt[(g * 64 + e) * 72 + c] = (bf16)(pk2(pw[i], 0.f) & 0xffffu); } }
    __syncthreads();
    f32x4 g0, g1, g2, cw0, cw1, cw2;
    { const float* nq = FIN(I_NQN) + L * 64; const float* nks = FIN(I_NKSN) + L * 64; const float* nkw = FIN(I_NKWN) + L * 64; const float* sk = FIN(I_SKN) + L * 64; const float* sq = FIN(I_SQN) + L * 64;
      g0 = *(const f32x4*)(nq + (ch & 63)) * C2;
      g1 = ch < 64 ? *(const f32x4*)(nks + ch) : (ch < 128 ? *(const f32x4*)(nkw + (ch - 64)) : *(const f32x4*)(sk + (ch & 63)));
      g2 = *(const f32x4*)(sq + (ch & 63)) * C2;
      const float* cw = FIN(I_CONVW) + L * 768; cw0 = *(const f32x4*)(cw + ch); cw1 = *(const f32x4*)(cw + 256 + ch); cw2 = *(const f32x4*)(cw + 512 + ch);
      }
    const int grp = lane >> 4, win = 2 << grp;
    const int gw = F.vcu * NWAVES + F.wave, NGW = F.G * NWAVES;
    for (int blk = gw; blk < M / 16; blk += NGW) {
        const int m0 = blk * 16, t0 = m0 & (T - 1);
        const bf16* u0 = F_U + (size_t)m0 * NU;
        const int gt = m0 >> 6, rb = m0 & 63, dk = ch & 63;
        bf16* kimg = (ch < 64 ? F_KSI : (ch < 128 ? F_KWI : F_CKI + (size_t)((ch - 128) >> 6) * 512 * 4096)) + (size_t)gt * 4096 + kimg_off(rb, dk);
        bf16* vimg = (ch < 64 ? F_VSI : (ch < 128 ? F_VWI : F_CVI + (size_t)((ch - 128) >> 6) * 512 * 4096)) + (size_t)gt * 4096 + vimg_off(rb, dk);
#pragma nounroll
        for (int i8 = 0; i8 < 16; i8 += 8) { u32x2 raw[8][4];
#pragma unroll
            for (int i = 0; i < 8; ++i) {
#pragma unroll
                for (int k = 0; k < 3; ++k) raw[i][k] = *(const u32x2*)(u0 + (size_t)(i8 + i) * NU + 256 * k + ch);
                raw[i][3] = *(const u32x2*)(u0 + (size_t)(i8 + i) * NU + UVS + ch); }
#pragma unroll
            for (int i = 0; i < 8; ++i) { const f32x4 v0 = up4(raw[i][0]), v1 = up4(raw[i][1]), v2 = up4(raw[i][2]);
                const float s0 = row16_sum(sq4(v0)), s1 = row16_sum(sq4(v1)), s2 = row16_sum(sq4(v2));
                const float r0 = __builtin_amdgcn_rsqf(s0 * (1.f / 64.f) + EPS), r1 = __builtin_amdgcn_rsqf(s1 * (1.f / 64.f) + EPS), r2 = __builtin_amdgcn_rsqf(s2 * (1.f / 64.f) + EPS);
                st4bf(F_QA + (size_t)(m0 + i8 + i) * 256 + ch, v0 * r0 * g0); st4bf(kimg + (i8 + i) * 8, v1 * r1 * g1); st4bf(F_QC + (size_t)(m0 + i8 + i) * 256 + ch, v2 * r2 * g2);
                *(u32x2*)(vimg + (i8 + i) * 32) = raw[i][3]; } }
#pragma unroll
        for (int k = 0; k < 3; ++k) { const int idx = lane + 64 * k, tk = idx / 12, gi = idx - 12 * tk;
            const float a = bflo((unsigned)u0[(size_t)tk * NU + UG + gi]); F_GATES[(size_t)m0 * 12 + idx] = __builtin_amdgcn_rcpf(1.0f + __builtin_amdgcn_exp2f(a * -LOG2E)); }
        { f32x4 zm1 = {0.f, 0.f, 0.f, 0.f}, zm2 = {0.f, 0.f, 0.f, 0.f};
          if (t0 > 0) { zm1 = ld4bf(u0 - NU + UBC + ch) * ld4bf(u0 - NU + UBX + ch); zm2 = ld4bf(u0 - 2 * NU + UBC + ch) * ld4bf(u0 - 2 * NU + UBX + ch); }
#pragma nounroll
          for (int i8 = 0; i8 < 16; i8 += 8) { u32x2 raw[8][3]; f32x4 ob[8]; float ss[8];
#pragma unroll
              for (int i = 0; i < 8; ++i)
#pragma unroll
                  for (int k = 0; k < 3; ++k) raw[i][k] = *(const u32x2*)(u0 + (size_t)(i8 + i) * NU + UBB + 256 * k + ch);
#pragma unroll
              for (int i = 0; i < 8; ++i) { const f32x4 z0 = up4(raw[i][1]) * up4(raw[i][2]);
                  ob[i] = up4(raw[i][0]) * (cw2 * z0 + cw1 * zm1 + cw0 * zm2); zm2 = zm1; zm1 = z0; ss[i] = sq4(ob[i]); }
#pragma unroll
              for (int i = 0; i < 8; ++i) ss[i] = wave_sum(ss[i]);
#pragma unroll
              for (int i = 0; i < 8; ++i) st4bf(F_YN + (size_t)(m0 + i8 + i) * D + 256 + ch, ob[i] * (__builtin_amdgcn_rsqf(ss[i] * (1.f / 256.f) + EPS))); } }
        for (int rep4 = 0; rep4 < ((PROBE_PREP & 4) ? 2 : 1); ++rep4)
        { u32x2 raw[32];
#pragma unroll
          for (int i = 0; i < 16; ++i) { raw[i] = (u32x2){0u, 0u}; if (t0 > 0) raw[i] = *(const u32x2*)(u0 - (size_t)(16 - i) * NU + UDV + ch); }
#pragma unroll
          for (int i = 0; i < 16; ++i) raw[16 + i] = *(const u32x2*)(u0 + (size_t)i * NU + UDV + ch);
          f32x4 S2 = up4(raw[15]) + up4(raw[14]), S4 = S2 + up4(raw[13]) + up4(raw[12]), S8 = S4, S16;
#pragma unroll
          for (int i = 8; i < 12; ++i) S8 += up4(raw[i]);
          S16 = S8;
#pragma unroll
          for (int i = 0; i < 8; ++i) S16 += up4(raw[i]);
#pragma unroll
          for (int ti = 0; ti < 16; ++ti) { const f32x4 v = up4(raw[16 + ti]);
              S2 += v - up4(raw[16 + ti - 2]); S4 += v - up4(raw[16 + ti - 4]); S8 += v - up4(raw[16 + ti - 8]); S16 += v - up4(raw[ti]);
              const f32x4 Sw = grp == 0 ? S2 : (grp == 1 ? S4 : (grp == 2 ? S8 : S16));
              const int cn = (t0 + ti + 1) < win ? (t0 + ti + 1) : win;
              const f32x4 dd = Sw * __builtin_amdgcn_rcpf((float)cn) - v;
              u32x2 w; w.x = pk2(dd[0], dd[1]); w.y = pk2(dd[2], dd[3]); *(LAS u32x2*)(DTb + ti * 264 + ch) = w; }
          const int fr = lane & 15, fq = lane >> 4;
          const float* psp = FIN(I_POOLS) + L * 256 + fr;
          f32x4 acc[4][4];
#pragma unroll
          for (int g = 0; g < 4; ++g) { const bf16x8 a0 = *(const LAS bf16x8*)(DTb + fr * 264 + g * 64 + 8 * fq), a1 = *(const LAS bf16x8*)(DTb + fr * 264 + g * 64 + 32 + 8 * fq);
#pragma unroll
              for (int cb = 0; cb < 4; ++cb) { const LAS bf16* bp = PWt + (g * 64 + 16 * cb + fr) * 72 + 8 * fq;
                  f32x4 c = {0.f, 0.f, 0.f, 0.f};
                  c = __builtin_amdgcn_mfma_f32_16x16x32_bf16(a0, *(const LAS bf16x8*)bp, c, 0, 0, 0);
                  c = __builtin_amdgcn_mfma_f32_16x16x32_bf16(a1, *(const LAS bf16x8*)(bp + 32), c, 0, 0, 0);
                  acc[g][cb] = c * psp[g * 64 + 16 * cb]; } }
          float ss[4];
#pragma unroll
          for (int i = 0; i < 4; ++i) { float q = 0.f;
#pragma unroll
              for (int g = 0; g < 4; ++g)
#pragma unroll
                  for (int cb = 0; cb < 4; ++cb) q += acc[g][cb][i] * acc[g][cb][i];
              ss[i] = __builtin_amdgcn_rsqf(row16_sum(q) * (1.f / 256.f) + EPS); }
          asm volatile("s_waitcnt lgkmcnt(0)" ::: "memory");
#pragma unroll
          for (int g = 0; g < 4; ++g)
#pragma unroll
              for (int cb = 0; cb < 4; ++cb)
#pragma unroll
                  for (int i = 0; i < 4; ++i) DTb[(4 * fq + i) * 264 + g * 64 + 16 * cb + fr] = (bf16)(pk2(acc[g][cb][i] * ss[i], 0.f) & 0xffffu);
#pragma unroll
          for (int ti = 0; ti < 16; ++ti) *(u32x2*)(F_YN + (size_t)(m0 + ti) * D + 768 + ch) = *(const LAS u32x2*)(DTb + ti * 264 + ch); }
    }
    __syncthreads();
    LAS float* PART = (LAS float*)F.lds;
    LAS float* H = (LAS float*)(F.lds + 65536);
    LAS float* O2 = (LAS float*)(F.lds + 65536 + 16384);
    const int fr = lane & 15, fq = lane >> 4, wave = F.wave;
    for (int rep8 = 0; rep8 < ((PROBE_PREP & 8) ? 2 : 1); ++rep8)
    for (int uid = blockIdx.x; uid < 256; uid += F.G) {
        const int b = uid >> 4, kv = (uid >> 3) & 1, n0 = 16 * (uid & 7);
        const bf16* W1t = F_C1T + (size_t)(L * 2 + kv) * 128 * 2048;
        const float* pos = FIN(kv ? I_POSV : I_POSK) + (size_t)L * 2048;
        const float* W2 = FIN(kv ? I_C2V : I_C2K) + (size_t)L * 128 * 64;
        const int nrow = (n0 + fr) < 126 ? (n0 + fr) : 126;
        const bf16* arow = F_U + (size_t)(b * T + 16 * nrow) * NU + UKC + 64 * kv;
        const bf16* brow = W1t + (size_t)fr * 2048;
        f32x4 acc[8];
#pragma unroll
        for (int ct = 0; ct < 8; ++ct) acc[ct] = (f32x4){0.f, 0.f, 0.f, 0.f};
#pragma unroll 2
        for (int ks = 0; ks < 8; ++ks) { const int kk = 8 * wave + ks, l = kk >> 1, c = 32 * (kk & 1) + 8 * fq;
            const v4u ar = *(const v4u*)(arow + (size_t)l * NU + c); const f32x4 p0 = *(const f32x4*)(pos + l * 64 + c), p1 = *(const f32x4*)(pos + l * 64 + c + 4);
            bf16x8 bfr[8];
#pragma unroll
            for (int ct = 0; ct < 8; ++ct) bfr[ct] = *(const bf16x8*)(brow + (size_t)(16 * ct) * 2048 + 32 * kk + 8 * fq);
            v4u aw; aw.x = pk2(bflo(ar.x) + p0[0], bfhi(ar.x) + p0[1]); aw.y = pk2(bflo(ar.y) + p0[2], bfhi(ar.y) + p0[3]); aw.z = pk2(bflo(ar.z) + p1[0], bfhi(ar.z) + p1[1]); aw.w = pk2(bflo(ar.w) + p1[2], bfhi(ar.w) + p1[3]);
#pragma unroll
            for (int ct = 0; ct < 8; ++ct) acc[ct] = __builtin_amdgcn_mfma_f32_16x16x32_bf16(__builtin_bit_cast(bf16x8, aw), bfr[ct], acc[ct], 0, 0, 0); }
#pragma unroll
        for (int ct = 0; ct < 8; ++ct)
#pragma unroll
            for (int i = 0; i < 4; ++i) PART[(wave * 16 + 4 * fq + i) * 128 + 16 * ct + fr] = acc[ct][i];
        __syncthreads();
        { const int e0 = 4 * tid; f32x4 sum = *(const LAS f32x4*)(PART + e0);
#pragma unroll
          for (int w = 1; w < 8; ++w) sum += *(const LAS f32x4*)(PART + w * 2048 + e0);
          const int hr = e0 >> 7, hc = e0 & 127;
#pragma unroll
          for (int i = 0; i < 4; ++i) { const float xh = sum[i]; const float y2 = 2.0f * 0.7978845608028654f * (xh + 0.044715f * xh * xh * xh); H[hr * 132 + hc + i] = xh * __builtin_amdgcn_rcpf(1.0f + __builtin_amdgcn_exp2f(y2 * -LOG2E)); } }
        __syncthreads();
        if (wave < 4) { f32x4 a2 = {0.f, 0.f, 0.f, 0.f};
#pragma unroll
            for (int s = 0; s < 4; ++s) { const LAS float* hp = H + fr * 132 + 32 * s + 8 * fq; const float* wp = W2 + (size_t)(32 * s + 8 * fq) * 64 + 16 * wave + fr;
                v4u aw; aw.x = pk2(hp[0], hp[1]); aw.y = pk2(hp[2], hp[3]); aw.z = pk2(hp[4], hp[5]); aw.w = pk2(hp[6], hp[7]);
                v4u bw; bw.x = pk2(wp[0], wp[64]); bw.y = pk2(wp[128], wp[192]); bw.z = pk2(wp[256], wp[320]); bw.w = pk2(wp[384], wp[448]);
                a2 = __builtin_amdgcn_mfma_f32_16x16x32_bf16(__builtin_bit_cast(bf16x8, aw), __builtin_bit_cast(bf16x8, bw), a2, 0, 0, 0); }
#pragma unroll
            for (int i = 0; i < 4; ++i) O2[(4 * fq + i) * 68 + 16 * wave + fr] = a2[i]; }
        __syncthreads();
        if (wave == 0) { const int row = lane >> 2, c0 = (lane & 3) * 16; float v[16]; float ss = 0.f;
#pragma unroll
            for (int e = 0; e < 16; ++e) { v[e] = O2[row * 68 + c0 + e]; ss += v[e] * v[e]; }
            ss += __shfl_xor(ss, 1); ss += __shfl_xor(ss, 2);
            const float rs = __builtin_amdgcn_rsqf(ss * (1.f / 64.f) + EPS); const float* gn = FIN(I_NKCN) + L * 64 + c0;
            const int n = n0 + row; const bool dead = n >= 127;
            v4u w0, w1; float o[16];
#pragma unroll
            for (int e = 0; e < 16; ++e) { o[e] = kv ? v[e] : v[e] * rs * gn[e]; if (dead) o[e] = 0.f; }
            w0.x = pk2(o[0], o[1]); w0.y = pk2(o[2], o[3]); w0.z = pk2(o[4], o[5]); w0.w = pk2(o[6], o[7]); w1.x = pk2(o[8], o[9]); w1.y = pk2(o[10], o[11]); w1.z = pk2(o[12], o[13]); w1.w = pk2(o[14], o[15]);
            const int tl = n >> 6, rr = n & 63;
            if (kv) { bf16* dstp = F_VC + (size_t)(b * 2 + tl) * 4096 + vimg_off(rr, c0); *(v4u*)dstp = w0; *(v4u*)(dstp + 8) = w1; }
            else { bf16* dstp = F_KC + (size_t)(b * 2 + tl) * 4096; *(v4u*)(dstp + kimg_off(rr, c0)) = w0; *(v4u*)(dstp + kimg_off(rr, c0 + 8)) = w1; } }
        __syncthreads();
    }
}

#ifndef PROBE_ATT
#define PROBE_ATT 0
#endif
namespace att {
constexpr int STG = 32768;
constexpr int L_STG = 0, L_IA = 65536, IAB = 4 * 64 * 33 * 4, L_IB = L_IA + IAB, L_SC = L_IB + IAB, L_SEL = L_SC + 64 * 33 * 4, L_UNI = L_SEL + 256, L_WSF = L_UNI + 256, L_END = L_WSF + NWAVES * 256;
static_assert(L_END <= MISC_OFF, "attention LDS map");
constexpr int OSTP = 264;
#define ATT_BAR() asm volatile("s_waitcnt vmcnt(0) lgkmcnt(0)\n\ts_barrier" ::: "memory")
#define ATT_LBAR() asm volatile("s_waitcnt lgkmcnt(0)\n\ts_barrier" ::: "memory")
__device__ __forceinline__ int crow(int r, int hi) { return (r & 3) + 8 * (r >> 2) + 4 * hi; }
__device__ __forceinline__ float pair_max(float v) { auto rr = __builtin_amdgcn_permlane32_swap(__float_as_uint(v), __float_as_uint(v), false, false); return fmaxf(__uint_as_float(rr[0]), __uint_as_float(rr[1])); }
__device__ __forceinline__ float pair_sum(float v) { auto rr = __builtin_amdgcn_permlane32_swap(__float_as_uint(v), __float_as_uint(v), false, false); return __uint_as_float(rr[0]) + __uint_as_float(rr[1]); }
__device__ __forceinline__ void dma_tile(const bf16* tile, LAS unsigned char* slot, int wave, int lane) {
    __builtin_amdgcn_global_load_lds((const unsigned*)(tile + wave * 512 + lane * 8), (LAS unsigned*)(slot + wave * 1024), 16, 0, 0); }
__device__ __forceinline__ void qk_tile(f32x16& p0, f32x16& p1, const LAS unsigned char* kslot, const bf16x8 (&qr)[4], int r32, int hi) {
    const LAS unsigned char* kp = kslot + hi * 1024 + r32 * 16;
    p0 = (f32x16){}; p1 = (f32x16){};
#pragma unroll
    for (int d0 = 0; d0 < 4; ++d0) { const bf16x8 b0 = *(const LAS bf16x8*)(kp + d0 * 2048), b1 = *(const LAS bf16x8*)(kp + d0 * 2048 + 512);
        p0 = __builtin_amdgcn_mfma_f32_32x32x16_bf16(b0, qr[d0], p0, 0, 0, 0); p1 = __builtin_amdgcn_mfma_f32_32x32x16_bf16(b1, qr[d0], p1, 0, 0, 0); }
}
__device__ __forceinline__ v4i16_t vtr(const LAS unsigned char* p) { return __builtin_amdgcn_ds_read_tr16_b64_v4i16((LAS v4i16_t*)p); }
__device__ __forceinline__ void pv_tile(f32x16& o0, f32x16& o1, const LAS unsigned char* vslot, const v4u (&pw)[4], int lane, int hi) {
    const LAS unsigned char* vp = vslot + ((lane >> 4) & 1) * 32 + (lane & 3) * 8 + (4 * hi + ((lane & 15) >> 2)) * 64;
#pragma unroll
    for (int s = 0; s < 4; ++s) {
        const v4i16_t a0 = vtr(vp + s * 1024), a1 = vtr(vp + s * 1024 + 512), b0 = vtr(vp + 4096 + s * 1024), b1 = vtr(vp + 4096 + s * 1024 + 512);
        const bf16x8 v0 = (bf16x8){a0[0], a0[1], a0[2], a0[3], a1[0], a1[1], a1[2], a1[3]}, v1 = (bf16x8){b0[0], b0[1], b0[2], b0[3], b1[0], b1[1], b1[2], b1[3]};
        const bf16x8 pa = __builtin_bit_cast(bf16x8, pw[s]);
        o0 = __builtin_amdgcn_mfma_f32_32x32x16_bf16(pa, v0, o0, 0, 0, 0); o1 = __builtin_amdgcn_mfma_f32_32x32x16_bf16(pa, v1, o1, 0, 0, 0); }
}
__device__ __forceinline__ void pack_p(v4u (&pw)[4], const f32x16& p0, const f32x16& p1) {
    pw[0] = (v4u){pk2(p0[0], p0[1]), pk2(p0[2], p0[3]), pk2(p0[4], p0[5]), pk2(p0[6], p0[7])};
    pw[1] = (v4u){pk2(p0[8], p0[9]), pk2(p0[10], p0[11]), pk2(p0[12], p0[13]), pk2(p0[14], p0[15])};
    pw[2] = (v4u){pk2(p1[0], p1[1]), pk2(p1[2], p1[3]), pk2(p1[4], p1[5]), pk2(p1[6], p1[7])};
    pw[3] = (v4u){pk2(p1[8], p1[9]), pk2(p1[10], p1[11]), pk2(p1[12], p1[13]), pk2(p1[14], p1[15])};
}
__device__ __forceinline__ void softmax_step(float& m, float& l, f32x16& o0, f32x16& o1, f32x16& p0, f32x16& p1, v4u (&pw)[4], LAS float* wsf, int r32, int hi) {
    float mt = fmaxf(p0[0], p1[0]);
#pragma unroll
    for (int r = 1; r < 16; ++r) mt = fmaxf(mt, fmaxf(p0[r], p1[r]));
    mt = pair_max(mt);
    if (__any(mt > m + 8.0f)) {
        const float mn = fmaxf(m, mt);
        const float al = __builtin_amdgcn_exp2f(m - mn); l *= al; m = mn;
        if (hi == 0) wsf[r32] = al;
        f32x4 a[4];
#pragma unroll
        for (int g = 0; g < 4; ++g) a[g] = *(const LAS f32x4*)(wsf + 8 * g + 4 * hi);
#pragma unroll
        for (int r = 0; r < 16; ++r) { o0[r] *= a[r >> 2][r & 3]; o1[r] *= a[r >> 2][r & 3]; }
    }
    float rs = 0.f;
#pragma unroll
    for (int r = 0; r < 16; ++r) { p0[r] = __builtin_amdgcn_exp2f(p0[r] - m); p1[r] = __builtin_amdgcn_exp2f(p1[r] - m); rs += p0[r] + p1[r]; }
    l += rs;
    pack_p(pw, p0, p1);
}
__device__ __forceinline__ void scale_rows(f32x16& a0, f32x16& a1, const f32x16& o0, const f32x16& o1, float fac, LAS float* wsf, int r32, int hi) {
    if (hi == 0) wsf[32 + r32] = fac;
    f32x4 f[4];
#pragma unroll
    for (int g = 0; g < 4; ++g) f[g] = *(const LAS f32x4*)(wsf + 32 + 8 * g + 4 * hi);
#pragma unroll
    for (int r = 0; r < 16; ++r) { a0[r] += o0[r] * f[r >> 2][r & 3]; a1[r] += o1[r] * f[r >> 2][r & 3]; }
}
template <int MODE>
__device__ __forceinline__ void run_branch(unsigned tiles, const bf16* Kg  , const bf16* Vg, int kvsel, unsigned selm, int tq, const bf16x8 (&qr)[4],
                                           float& m, float& l, f32x16& o0, f32x16& o1, LAS unsigned char* lds, LAS float* wsf, int wave, int lane) {
    constexpr int NKV = MODE == 2 ? 2 : 1, SLOT = 16384 * NKV, NS = MODE == 2 ? 4 : 8;
    const int r32 = lane & 31, hi = lane >> 5;
    m = -1e30f; l = 0.f; o0 = (f32x16){}; o1 = (f32x16){};
    unsigned remc = (unsigned)__builtin_amdgcn_readfirstlane((int)tiles), remi = remc;
    int nleft = __builtin_popcount(remc), slot_i = 0, slot_c = 0;
    ATT_LBAR();
#define ATT_ISSUE() do { const int ji = __builtin_ctz(remi); remi &= remi - 1; LAS unsigned char* st_ = lds + L_STG + slot_i * SLOT; slot_i = (slot_i + 1) & (NS - 1); \
        _Pragma("unroll") for (int g = 0; g < NKV; ++g) { dma_tile(Kg + (size_t)(g * 512 + ji) * 4096, st_ + g * 8192, wave, lane); dma_tile(Vg + (size_t)(g * 512 + ji) * 4096, st_ + NKV * 8192 + g * 8192, wave, lane); } } while (0)
#define ATT_WB(n) asm volatile("s_waitcnt vmcnt(" #n ") lgkmcnt(0)\n\ts_barrier" ::: "memory")
#pragma nounroll
    for (int k = 0; k < NS - 1; ++k) if (remi) ATT_ISSUE();
    for (;;) {
        const int pend = (nleft - 1 < NS - 2 ? nleft - 1 : NS - 2) * NKV;
        switch (pend) { case 0: ATT_WB(0); break; case 1: ATT_WB(2); break; case 2: ATT_WB(4); break; case 3: ATT_WB(6); break; case 4: ATT_WB(8); break; case 5: ATT_WB(10); break; default: ATT_WB(12); break; }
        if (remi) ATT_ISSUE();
        const int j = __builtin_ctz(remc); remc &= remc - 1; --nleft;
        const LAS unsigned char* st = lds + L_STG + slot_c * SLOT; slot_c = (slot_c + 1) & (NS - 1);
        f32x16 p0, p1; qk_tile(p0, p1, st + kvsel * 8192, qr, r32, hi);
        const int kb = 64 * j + 4 * hi; const bool sel = MODE != 0 || ((selm >> j) & 1u);
        constexpr int W = MODE == 1 ? 512 : 128;
        const int curt = __builtin_amdgcn_readfirstlane(tq) >> 6;
        const bool edge = MODE == 3 || j == curt || (MODE != 0 && j + W / 64 == curt);
        if (edge) {
#pragma unroll
            for (int r = 0; r < 16; ++r) { const int kp = kb + (r & 3) + 8 * (r >> 2);
                bool v0, v1;
                if (MODE == 0) { v0 = sel && kp <= tq; v1 = sel && kp + 32 <= tq; }
                else if (MODE == 3) { v0 = 16 * kp + 31 <= tq; v1 = 16 * (kp + 32) + 31 <= tq; }
                else { v0 = kp <= tq && kp + W > tq; v1 = kp + 32 <= tq && kp + 32 + W > tq; }
                p0[r] = v0 ? p0[r] : -INFINITY; p1[r] = v1 ? p1[r] : -INFINITY; }
        } else if (MODE == 0) {
#pragma unroll
            for (int r = 0; r < 16; ++r) { p0[r] = sel ? p0[r] : -INFINITY; p1[r] = sel ? p1[r] : -INFINITY; }
        }
        v4u pw[4]; softmax_step(m, l, o0, o1, p0, p1, pw, wsf, r32, hi);
        pv_tile(o0, o1, st + NKV * 8192 + kvsel * 8192, pw, lane, hi);
        if (nleft == 0) break;
    }
#undef ATT_ISSUE
#undef ATT_WB
}
__device__ __forceinline__ void stage_norm_store(const f32x16& o0, const f32x16& o1, bf16* ynb  , LAS unsigned char* lds, int wave, int lane) {
    const int r32 = lane & 31, hi = lane >> 5, h = wave & 3, th = wave >> 2;
    LAS bf16* OST = (LAS bf16*)(lds + L_STG);
    ATT_LBAR();
#pragma unroll
    for (int r = 0; r < 16; ++r) { LAS bf16* p = OST + (32 * th + crow(r, hi)) * OSTP + h * 64 + r32;
        p[0] = (bf16)(pk2(o0[r], 0.f) & 0xffffu); p[32] = (bf16)(pk2(o1[r], 0.f) & 0xffffu); }
    ATT_LBAR();
    f32x4 vv[8]; float ssn[8];
#pragma unroll
    for (int i = 0; i < 8; ++i) { const u32x2 w = *(const LAS u32x2*)(OST + (8 * wave + i) * OSTP + 4 * lane); vv[i] = (f32x4){bflo(w.x), bfhi(w.x), bflo(w.y), bfhi(w.y)}; ssn[i] = sq4(vv[i]); }
#pragma unroll
    for (int i = 0; i < 8; ++i) ssn[i] = wave_sum(ssn[i]);
#pragma unroll
    for (int i = 0; i < 8; ++i) st4bf(ynb + (size_t)(8 * wave + i) * D + 4 * lane, vv[i] * __builtin_amdgcn_rsqf(ssn[i] * (1.f / 256.f) + EPS));
}
__device__ __forceinline__ void attn_unit(Frame& F, int L, int b, int qt) {
    LAS unsigned char* lds = F.lds;
    int tid = F.tid; asm volatile("" : "+v"(tid));
    const int wave = F.wave, lane = tid & 63, r32 = lane & 31, hi = lane >> 5, h = wave & 3, th = wave >> 2;
    const int t0 = qt * 64, cur = qt, qrow = 32 * th + r32, tq = t0 + qrow;
    const size_t mrow = (size_t)b * T + tq;
    LAS float* wsf = (LAS float*)(lds + L_WSF) + wave * 64;
    LAS float* IA = (LAS float*)(lds + L_IA); LAS float* IB = (LAS float*)(lds + L_IB); LAS float* SC = (LAS float*)(lds + L_SC);
    LAS unsigned* SEL = (LAS unsigned*)(lds + L_SEL); LAS unsigned* UNI = (LAS unsigned*)(lds + L_UNI);
    const size_t tb = (size_t)b * 32 * 4096;
    bf16x8 qr[4];
#pragma unroll
    for (int d0 = 0; d0 < 4; ++d0) qr[d0] = *(const bf16x8*)(F_QA + mrow * 256 + h * 64 + d0 * 16 + hi * 8);
    const float* gp = F_GATES + mrow * 12 + h * 3; const float g0 = gp[0], g1 = gp[1], g2 = gp[2];
    f32x16 ot0 = (f32x16){}, ot1 = (f32x16){};
    float mb, lb; f32x16 ob0, ob1;
    for (int rep = 0; rep < ((PROBE_ATT & 4) ? 2 : 1); ++rep) {
        if (rep) { ATT_LBAR(); ot0 = (f32x16){}; ot1 = (f32x16){}; }
        if (tid == 0) UNI[0] = 0u;
        run_branch<3>(3u, F_KC + (size_t)b * 2 * 4096, F_VC + (size_t)b * 2 * 4096, 0, 0u, tq, qr, mb, lb, ob0, ob1, lds, wsf, wave, lane);
        const float lt = pair_sum(lb); const float inv = lt > 0.f ? 1.0f / lt : 0.f;
        scale_rows(ot0, ot1, ob0, ob1, g0 * inv, wsf, r32, hi);
        LAS float* ia = IA + (h * 64 + qrow) * 33; LAS float* ib = IB + (h * 64 + qrow) * 33;
#pragma unroll
        for (int tl = 0; tl < 2; ++tl) { f32x16 p0, p1; qk_tile(p0, p1, lds + L_STG + tl * 16384, qr, r32, hi);
#pragma unroll
            for (int r = 0; r < 16; ++r) { const int n = 64 * tl + crow(r, hi);
                p0[r] = 16 * n + 31 <= tq ? __builtin_amdgcn_exp2f(p0[r] - mb) * inv : 0.f; p1[r] = 16 * (n + 32) + 31 <= tq ? __builtin_amdgcn_exp2f(p1[r] - mb) * inv : 0.f; }
#pragma unroll
            for (int G = 0; G < 4; ++G) {
                ia[hi + 2 * (G + 8 * tl)] = (p0[4 * G] + p0[4 * G + 1]) + (p0[4 * G + 2] + p0[4 * G + 3]); ib[hi + 2 * (G + 8 * tl)] = p0[4 * G + 3];
                ia[hi + 2 * (G + 4 + 8 * tl)] = (p1[4 * G] + p1[4 * G + 1]) + (p1[4 * G + 2] + p1[4 * G + 3]); ib[hi + 2 * (G + 4 + 8 * tl)] = p1[4 * G + 3]; } }
        ATT_LBAR();
        const int q = tid >> 3, jg = tid & 7, tqq = t0 + q;
#pragma unroll
        for (int i = 0; i < 4; ++i) { const int j = 4 * jg + i; float imp = 0.f;
#pragma unroll
            for (int hh = 0; hh < 4; ++hh) { imp += IA[(hh * 64 + q) * 33 + j]; if (j > 0) imp += IB[(hh * 64 + q) * 33 + j - 1]; }
            const bool forced = j == 0 || j == cur || j == cur - 1, future = j * 64 > tqq;
            SC[q * 33 + j] = forced ? 1e4f : (future ? -1.0f : imp); }
        ATT_LBAR();
        unsigned bits = 0u;
#pragma unroll
        for (int i = 0; i < 4; ++i) { const int j = 4 * jg + i; const float sj = SC[q * 33 + j]; int rank = 0;
#pragma unroll 8
            for (int k = 0; k < 32; ++k) { const float sk = SC[q * 33 + k]; rank += (sk > sj || (sk == sj && k < j)) ? 1 : 0; }
            if (rank < 8) bits |= 1u << j; }
        bits |= __shfl_xor(bits, 1); bits |= __shfl_xor(bits, 2); bits |= __shfl_xor(bits, 4);
        if (jg == 0) { SEL[q] = bits; atomicOr((unsigned*)UNI, bits); }
        ATT_LBAR();
    }
    { const unsigned selm = SEL[qrow]; const unsigned uni = UNI[0] & ((2u << cur) - 1u);
      if (PROBE_ATT & 1) run_branch<0>(uni, F_KSI + tb, F_VSI + tb, 0, selm, tq, qr, mb, lb, ob0, ob1, lds, wsf, wave, lane);
      run_branch<0>(uni, F_KSI + tb, F_VSI + tb, 0, selm, tq, qr, mb, lb, ob0, ob1, lds, wsf, wave, lane);
      const float lt = pair_sum(lb); scale_rows(ot0, ot1, ob0, ob1, g1 / lt, wsf, r32, hi); }
    { const int lo = cur >= 8 ? cur - 8 : 0; const unsigned tiles = ((2u << cur) - 1u) & ~((1u << lo) - 1u);
      if (PROBE_ATT & 2) run_branch<1>(tiles, F_KWI + tb, F_VWI + tb, 0, 0u, tq, qr, mb, lb, ob0, ob1, lds, wsf, wave, lane);
      run_branch<1>(tiles, F_KWI + tb, F_VWI + tb, 0, 0u, tq, qr, mb, lb, ob0, ob1, lds, wsf, wave, lane);
      const float lt = pair_sum(lb); scale_rows(ot0, ot1, ob0, ob1, g2 / lt, wsf, r32, hi); }
    if (PROBE_ATT & 8) stage_norm_store(ot0, ot1, F_YN + ((size_t)b * T + t0) * D + 0, lds, wave, lane);
    stage_norm_store(ot0, ot1, F_YN + ((size_t)b * T + t0) * D + 0, lds, wave, lane);
    for (int rep = 0; rep < ((PROBE_ATT & 16) ? 2 : 1); ++rep) {
#pragma unroll
        for (int d0 = 0; d0 < 4; ++d0) qr[d0] = *(const bf16x8*)(F_QC + mrow * 256 + h * 64 + d0 * 16 + hi * 8);
        const int lo = cur >= 2 ? cur - 2 : 0; const unsigned tiles = ((2u << cur) - 1u) & ~((1u << lo) - 1u);
        run_branch<2>(tiles, F_CKI + tb, F_CVI + tb, h >> 1, 0u, tq, qr, mb, lb, ob0, ob1, lds, wsf, wave, lane);
        const float sink2 = FIN(I_SINK)[L * 4 + h] * LOG2E;
        const float mf = fmaxf(mb, sink2), sc = __builtin_amdgcn_exp2f(mb - mf);
        const float lt = pair_sum(lb) * sc + __builtin_amdgcn_exp2f(sink2 - mf);
        ot0 = (f32x16){}; ot1 = (f32x16){};
        scale_rows(ot0, ot1, ob0, ob1, sc / lt, wsf, r32, hi);
        stage_norm_store(ot0, ot1, F_YN + ((size_t)b * T + t0) * D + 512, lds, wave, lane);
    }
}
__device__ __forceinline__ void attn_phase(Frame& F, int L) {
    for (int w = F.vcu; w < 256; w += F.G) { const int b = w >> 4, i = w & 15;
#pragma nounroll
        for (int u2 = 0; u2 < 2; ++u2) attn_unit(F, L, b, u2 ? 31 - i : i); }
    ATT_LBAR();
}
}

__global__ void __launch_bounds__(NWAVES * 64, 2) fwd(Args args) {
    extern __shared__ __attribute__((aligned(16))) unsigned char lds[];
    Frame F;
    F.lds = (LAS unsigned char*)lds;
    F.tid = threadIdx.x; F.lane = F.tid & 63; F.wave = __builtin_amdgcn_readfirstlane(F.tid >> 6);
    F.G = gridDim.x; { const int bx = blockIdx.x; F.vcu = (F.G % 8 == 0) ? (bx % 8) * (F.G / 8) + bx / 8 : bx; }
    F.a = &args;
    unsigned char* ws = args.ws;
    volatile LAS unsigned* MISC = (volatile LAS unsigned*)(F.lds + MISC_OFF);
    if (F.tid < 64) MISC[F.tid] = 0u;
    __syncthreads();
#define GRID_BAR() do { XcdBarrier b2_ = bar; { unsigned xx_ = b2_.x; asm volatile("" : "+s"(xx_)); b2_.x = xx_; }     \
        xcd_barrier(b2_); __builtin_amdgcn_s_waitcnt(0); } while (0)
    XcdBarrier bar = xcd_barrier_post((unsigned*)(ws + WS_CTL) + CW_BAR, MISC + 8);

#ifndef PH_MASK
#define PH_MASK 127
#endif
#ifndef PROBE_DUP
#define PROBE_DUP 0
#endif
    if (PH_MASK & 1) prologue(F);
    if (PROBE_DUP & 1) prologue(F);
    GRID_BAR();
    for (int s = 0; s < 2 * DEPTH; ++s) {
        const int L = s >> 1, which = s & 1;
        const bool up8 = (UP8_MASK >> s) & 1u, dn8 = (DN8_MASK >> s) & 1u;
        if (PH_MASK & 2) {
            const bf16* wt = (const bf16*)((unsigned char*)F_W13T + (size_t)s * NF1 * D * 2); pg8::StaticOrder S; S.init(M, NF1, F.G, (int)blockIdx.x);
            if (up8) { pg8::Gemm g{(const bf16*)F_X8, wt, M, NF1, D / 2};
                if (PROBE_DUP & 128) { pg8::EpiNull EN{F_GATES}; pg8::gemm_phase<pg8::EpiNull, pg8::StaticOrder, true, true, true>(F.lds, g, S, EN); }
                if (PROBE_DUP & 256) { pg8::EpiNull EN{F_GATES}; pg8::FixedOrder<1> S2; S2.init(M, NF1, F.G, (int)blockIdx.x); pg8::gemm_phase<pg8::EpiNull, pg8::FixedOrder<1>, true, true, true>(F.lds, g, S2, EN); }
                if (PROBE_DUP & 512) { pg8::EpiNull EN{F_GATES}; pg8::FixedOrder<3> S2; S2.init(M, NF1, F.G, (int)blockIdx.x); pg8::gemm_phase<pg8::EpiNull, pg8::FixedOrder<3>, true, true, true>(F.lds, g, S2, EN); }
                if (dn8) { pg8::EpiSwiglu<true> E{(void*)F_ACT, DFF, F_SSQ, 1.0f / W8_SCALE, ACT8_SCALE, F.lds + pg8::STAGE_BYTES, 0, 0, 0}; for (int rep = 0; rep < ((PROBE_DUP & 2) ? 2 : 1); ++rep) pg8::gemm_phase<pg8::EpiSwiglu<true>, pg8::StaticOrder, true, true, true>(F.lds, g, S, E); }
                else if (((UP8_MASK & ~DN8_MASK) & 0xFu) != 0u) { pg8::EpiSwiglu<false> E{(void*)F_ACT, DFF, F_SSQ, 1.0f / W8_SCALE, 1.0f, F.lds + pg8::STAGE_BYTES, 0, 0, 0}; for (int rep = 0; rep < ((PROBE_DUP & 2) ? 2 : 1); ++rep) pg8::gemm_phase<pg8::EpiSwiglu<false>, pg8::StaticOrder, true, true, true>(F.lds, g, S, E); } }
            else { pg8::Gemm g{F_XB, wt, M, NF1, D};
                if (dn8) { if (((~UP8_MASK & DN8_MASK) & 0xFu) != 0u) { pg8::EpiSwiglu<true> E{(void*)F_ACT, DFF, F_SSQ, 1.0f, ACT8_SCALE, F.lds + pg8::STAGE_BYTES, 0, 0, 0}; for (int rep = 0; rep < ((PROBE_DUP & 2) ? 2 : 1); ++rep) pg8::gemm_phase<pg8::EpiSwiglu<true>, pg8::StaticOrder, true, true, false>(F.lds, g, S, E); } }
                else if (((~UP8_MASK & ~DN8_MASK) & 0xFu) != 0u) { pg8::EpiSwiglu<false> E{(void*)F_ACT, DFF, F_SSQ, 1.0f, 1.0f, F.lds + pg8::STAGE_BYTES, 0, 0, 0}; for (int rep = 0; rep < ((PROBE_DUP & 2) ? 2 : 1); ++rep) pg8::gemm_phase<pg8::EpiSwiglu<false>, pg8::StaticOrder, true, true, false>(F.lds, g, S, E); } }
        }
        GRID_BAR();
        if (PH_MASK & 4) {
            const bf16* wt = (const bf16*)((unsigned char*)F_W2T + (size_t)s * D * DFF * 2); pg8::StaticOrder S; S.init(M, D, F.G, (int)blockIdx.x);
            const int last = (s + 1 == 2 * DEPTH) ? 1 : 0, w8 = ((s & 1) && !last && ((UP8_MASK >> (s + 1)) & 1u)) ? 1 : 0;
            if (dn8) { if (DN8_MASK & 0xFu) { pg8::Gemm g{F_ACT, wt, M, D, DFF / 2}; pg8::EpiRes E{F_XB, F_SSQ, 1, F_X8, FOUT, w8, last}; pg8::gemm_phase<pg8::EpiRes, pg8::StaticOrder, true, true, true>(F.lds, g, S, E); } }
            else if ((~DN8_MASK) & 0xFu) { pg8::Gemm g{F_ACT, wt, M, D, DFF}; pg8::EpiRes E{F_XB, F_SSQ, 0, F_X8, FOUT, w8, last}; pg8::gemm_phase<pg8::EpiRes, pg8::StaticOrder, true, true, false>(F.lds, g, S, E); }
        }
        if (s + 1 < 2 * DEPTH) GRID_BAR();
        if (which == 0) {
            if (PH_MASK & 8) {
                pg8::Gemm g{F_XB, F_WINT + (size_t)L * NU * D, M, NU, D}; pg8::StaticOrder S; S.init(M, NU, F.G, (int)blockIdx.x);
                pg8::EpiScaleBf16 E{F_U, NU, F_SSQ, F.lds + pg8::STAGE_BYTES, 0, 0, 0};
                for (int rep = 0; rep < ((PROBE_DUP & 8) ? 2 : 1); ++rep) pg8::gemm_phase<pg8::EpiScaleBf16, pg8::StaticOrder, true, true>(F.lds, g, S, E);
            }
            GRID_BAR();
            if (PH_MASK & 16) prep_phase(F, L);
            if (PROBE_DUP & 16) prep_phase(F, L);
            GRID_BAR();
            if (PH_MASK & 32) att::attn_phase(F, L);
            if (PROBE_DUP & 32) att::attn_phase(F, L);
            GRID_BAR();
            if (PH_MASK & 64) {
                pg8::Gemm g{F_YN, F_WOUTT + (size_t)L * D * D, M, D, D}; pg8::StaticOrder S; S.init(M, D, F.G, (int)blockIdx.x);
                pg8::EpiRes E{F_XB, F_SSQ, 2, F_X8, FOUT, (int)((UP8_MASK >> (2 * L + 1)) & 1u), 0};
                pg8::gemm_phase<pg8::EpiRes, pg8::StaticOrder, true, true>(F.lds, g, S, E);
            }
            GRID_BAR();
        }
    }
}

extern "C" void kernel_launch(void* const* d_in, const int* in_sizes, int n_in, void* d_out, int out_size, void* d_ws, size_t ws_size, hipStream_t stream) {
    static int grid = 0;
    if (grid == 0) {
        if (n_in != 29 || in_sizes[0] != M * D || out_size != M * D || ws_size < WS_END) { fprintf(stderr, "kernel_launch: unexpected shapes (n_in %d, in0 %d, out %d, ws %zu); nothing launched\n", n_in, n_in > 0 ? in_sizes[0] : -1, out_size, ws_size); grid = -1; return; }
        int dev = 0, cus = 0, per_cu = 0;
        if (hipGetDevice(&dev) != hipSuccess || hipDeviceGetAttribute(&cus, hipDeviceAttributeMultiprocessorCount, dev) != hipSuccess) { grid = -1; return; }
        if (hipFuncSetAttribute((const void*)fwd, hipFuncAttributeMaxDynamicSharedMemorySize, LDS_BYTES) != hipSuccess) { fprintf(stderr, "kernel_launch: hipFuncSetAttribute failed\n"); grid = -1; return; }
        if (hipOccupancyMaxActiveBlocksPerMultiprocessor(&per_cu, (const void*)fwd, NWAVES * 64, LDS_BYTES) != hipSuccess || per_cu < 1) fprintf(stderr, "kernel_launch: occupancy query says %d\n", per_cu);
        (void)hipGetLastError();
        grid = cus;
    }
    if (grid < 0) return;
    if (hipMemsetAsync((char*)d_ws + WS_CTL, 0, CTL_ZERO_BYTES, stream) != hipSuccess) return;
    Args a{};
    for (int i = 0; i < 29; ++i) a.in[i] = (const float*)d_in[i];
    a.out = (float*)d_out; a.ws = (unsigned char*)d_ws;
    hipLaunchKernelGGL(fwd, dim3(grid), dim3(NWAVES * 64), LDS_BYTES, stream, a);
}
```

```cpp
#include <hip/hip_runtime.h>
#include <cstdio>
#include <cstdint>
#ifndef PROBE_TS
#define PROBE_TS 0
#endif
#define TS_AMP 4u
#define TS(ldsbase, k) do { if (PROBE_TS && blockIdx.x == 0 && threadIdx.x == 0) { volatile __attribute__((address_space(3))) unsigned* m_ = (volatile __attribute__((address_space(3))) unsigned*)((ldsbase) + 163648); \
        const unsigned t_ = (unsigned)__builtin_amdgcn_s_memrealtime(); if ((k) == PROBE_TS) m_[1] += t_ - m_[0]; m_[0] = t_; } } while (0)
struct KArgs { const float* in[29]; float* out; unsigned char* ws; };
namespace pg8 {
#define PG8_LAS __attribute__((address_space(3)))
typedef unsigned short bf16_t;
typedef short bf16x8 __attribute__((ext_vector_type(8)));
typedef float f32x4 __attribute__((ext_vector_type(4)));
typedef unsigned u32x4 __attribute__((ext_vector_type(4)));
constexpr int BM = 256, BK = 64, HALF = 128, HTB = HALF * BK * 2  , STAGE_BYTES = 8 * HTB, NXCD = 8, WGM = 8;

__host__ __device__ __forceinline__ int lds_byte(int r, int c) { const int st = (r >> 4) * 2 + (c >> 5), rr = r & 15, cc = c & 31, ob = rr * 64 + cc * 2; return st * 1024 + (ob ^ (((ob >> 9) & 1) << 5)); }
__host__ __device__ __forceinline__ void stage_rc(int b, int& R, int& C) { const int st = b / 1024, sb = b % 1024, swz = sb ^ (((sb >> 9) & 1) << 5); R = (st >> 1) * 16 + swz / 64; C = (st & 1) * 32 + (swz % 64) / 2; }
__host__ __device__ __forceinline__ int perm32(int rho) { const int n = rho >> 4, i = rho & 15; return 8 * (i >> 2) + 4 * n + (i & 3); }

struct Unit { int pm, pn; };
struct Gemm { const bf16_t* A; const bf16_t* Bt; int M, N, K; };

struct StaticOrder {
    int nM, nN, nwg, G, c;
    __host__ __device__ void init(int M, int N, int G_, int c_) { nM = M / BM; nN = N / BM; nwg = nM * nN; G = G_; c = c_; }
    __host__ __device__ bool next(int i, Unit& u) const {
        const long L = (long)i * G + c; if (L >= nwg) return false;
        int wgid = (int)L; { const int q = nwg / NXCD, r = nwg % NXCD, xcd = wgid % NXCD, off = wgid / NXCD; wgid = (xcd < r ? xcd * (q + 1) : r * (q + 1) + (xcd - r) * q) + off; }
        const int nig = WGM * nN, gid = wgid / nig, fm = gid * WGM, gsz = (nM - fm) < WGM ? (nM - fm) : WGM;
        u.pm = fm + ((wgid % nig) % gsz); u.pn = (wgid % nig) / gsz; return true;
    }
    __device__ __forceinline__ void a_ready(const Unit&) const {}
    __device__ __forceinline__ void done(const Unit&) const {}
};

__device__ __forceinline__ unsigned cvt_pk_bf16(float lo, float hi) { unsigned r; asm volatile("v_cvt_pk_bf16_f32 %0, %1, %2" : "=v"(r) : "v"(lo), "v"(hi)); return r; }

typedef unsigned u32x2 __attribute__((ext_vector_type(2)));
typedef int i32x4 __attribute__((ext_vector_type(4)));
typedef int i32x8 __attribute__((ext_vector_type(8)));
#ifndef MFMA8_SCALE
#define MFMA8_SCALE 1
#endif
__device__ __forceinline__ i32x8 cat8(bf16x8 a, bf16x8 b) { return __builtin_shufflevector(__builtin_bit_cast(i32x4, a), __builtin_bit_cast(i32x4, b), 0, 1, 2, 3, 4, 5, 6, 7); }
__device__ __forceinline__ void mfma8(f32x4& acc, const i32x8& b, const i32x8& a, int sc) {
#if MFMA8_SCALE
    asm volatile("v_mfma_scale_f32_16x16x128_f8f6f4 %0, %1, %2, %0, %3, %3 op_sel_hi:[0,0,0]" : "+v"(acc) : "v"(b), "v"(a), "v"(sc));
#else
    asm volatile("v_mfma_f32_16x16x128_f8f6f4 %0, %1, %2, %0" : "+v"(acc) : "v"(b), "v"(a));
#endif
}
__device__ __forceinline__ unsigned pk4_fp8(float a, float b, float c, float d) { int w = 0; w = __builtin_amdgcn_cvt_pk_fp8_f32(a, b, w, false); w = __builtin_amdgcn_cvt_pk_fp8_f32(c, d, w, true); return (unsigned)w; }
__device__ __forceinline__ unsigned pkbf(float lo, float hi) { typedef float f2_t __attribute__((ext_vector_type(2))); typedef __bf16 b2_t __attribute__((ext_vector_type(2))); f2_t v = {lo, hi}; b2_t b = __builtin_convertvector(v, b2_t); return __builtin_bit_cast(unsigned, b); }
__device__ __forceinline__ float bf_lo(unsigned u) { return __builtin_bit_cast(float, u << 16); }
__device__ __forceinline__ float bf_hi(unsigned u) { return __builtin_bit_cast(float, u & 0xffff0000u); }
__device__ __forceinline__ float swap32_add(float v) { auto rr = __builtin_amdgcn_permlane32_swap(__float_as_uint(v), __float_as_uint(v), false, false); return __uint_as_float(rr[0]) + __uint_as_float(rr[1]); }
__device__ __forceinline__ void fill_rstd_tbl(PG8_LAS unsigned char* tblp, const float* ssq, int pm, int wid, int lane) {
    const int r = wid * 32 + (lane >> 1), hf = lane & 1; const float* p = ssq + (size_t)(pm * BM + r) * 16 + 8 * hf;
    const f32x4 a = *(const f32x4*)p, b = *(const f32x4*)(p + 4);
    float s = ((a[0] + a[1]) + (a[2] + a[3])) + ((b[0] + b[1]) + (b[2] + b[3]));
    s += __builtin_bit_cast(float, __builtin_amdgcn_update_dpp(0, __builtin_bit_cast(int, s), 0xB1, 0xf, 0xf, true));
    if (hf == 0) ((PG8_LAS float*)tblp)[r] = __builtin_amdgcn_rsqf(s * (1.0f / 1024.0f) + 1e-6f);
}
__device__ __forceinline__ void rows_rstd(float (&rs)[2][4], const PG8_LAS unsigned char* tblp, int wr, int fr, float scale) {
#pragma unroll
    for (int ai = 0; ai < 2; ++ai)
#pragma unroll
        for (int m = 0; m < 4; ++m) rs[ai][m] = ((const PG8_LAS float*)tblp)[ai * HALF + wr * 64 + m * 16 + fr] * scale;
}
template <bool F8> struct EpiSwiglu {
    static constexpr bool PERM = true, AFTER_DRAIN = false, ROW_RSTD = true;
    void* O; int ldc; const float* ssq; float insc, oscale; PG8_LAS unsigned char* tbl; mutable int pmA, pmB, pmC;
    __device__ __forceinline__ void set_panels(int a, int b, int c) const { pmA = a; pmB = b; pmC = c; }
    __device__ __forceinline__ void fill_rstd(PG8_LAS unsigned char* t, int pm, int wid, int lane) const { fill_rstd_tbl(t, ssq, pm, wid, lane); }
    __device__ __forceinline__ void operator()(const f32x4 (&acc)[2][2][4][2], const Unit& u, int wr, int wc, int fr_, int fq_) const {
        int tl_ = threadIdx.x; asm volatile("" : "+v"(tl_)); const int fr = tl_ & 15, fq = (tl_ >> 4) & 3; (void)fr_; (void)fq_;
        const int row0 = u.pm * BM + wr * 64 + fr, col0 = u.pn * HALF + wc * 32 + 8 * fq;
        float rsv[2][4]; rows_rstd(rsv, tbl + (u.pm == pmA ? 0 : (u.pm == pmB ? 1024 : (u.pm == pmC ? 2048 : 3072))), wr, fr, insc);
#pragma unroll
        for (int ai = 0; ai < 2; ++ai)
#pragma unroll
            for (int m = 0; m < 4; ++m) { const int row = row0 + ai * HALF + m * 16; const float rs = rsv[ai][m], rsb = rs * (F8 ? oscale : 1.0f); f32x4 ov[2];
#pragma unroll
                for (int n = 0; n < 2; ++n) { const f32x4 a = acc[ai][0][m][n] * rs, b = acc[ai][1][m][n] * rsb, tt = a * -1.4426950408889634f; f32x4 r;
#pragma unroll
                    for (int e = 0; e < 4; ++e) r[e] = __builtin_amdgcn_rcpf(1.0f + __builtin_amdgcn_exp2f(tt[e]));
                    ov[n] = (a * b) * r; }
                const float o[8] = {ov[0][0], ov[0][1], ov[0][2], ov[0][3], ov[1][0], ov[1][1], ov[1][2], ov[1][3]};
                if constexpr (F8) { u32x2 w; w.x = pk4_fp8(o[0], o[1], o[2], o[3]); w.y = pk4_fp8(o[4], o[5], o[6], o[7]);
                    *(u32x2*)((unsigned char*)O + (size_t)row * ldc + col0) = w; }
                else { u32x4 w; w.x = pkbf(o[0], o[1]); w.y = pkbf(o[2], o[3]); w.z = pkbf(o[4], o[5]); w.w = pkbf(o[6], o[7]);
                    *(u32x4*)((bf16_t*)O + (size_t)row * ldc + col0) = w; } }
    }
};
struct EpiScaleBf16 {
    static constexpr bool PERM = true, AFTER_DRAIN = false, ROW_RSTD = true;
    bf16_t* O; int ldc; const float* ssq; PG8_LAS unsigned char* tbl; mutable int pmA, pmB, pmC;
    __device__ __forceinline__ void set_panels(int a, int b, int c) const { pmA = a; pmB = b; pmC = c; }
    __device__ __forceinline__ void fill_rstd(PG8_LAS unsigned char* t, int pm, int wid, int lane) const { fill_rstd_tbl(t, ssq, pm, wid, lane); }
    __device__ __forceinline__ void operator()(const f32x4 (&acc)[2][2][4][2], const Unit& u, int wr, int wc, int fr_, int fq_) const {
        int tl_ = threadIdx.x; asm volatile("" : "+v"(tl_)); const int fr = tl_ & 15, fq = (tl_ >> 4) & 3; (void)fr_; (void)fq_;
        const int row0 = u.pm * BM + wr * 64 + fr, col0 = u.pn * BM + wc * 32 + 8 * fq;
        float rsv[2][4]; rows_rstd(rsv, tbl + (u.pm == pmA ? 0 : (u.pm == pmB ? 1024 : (u.pm == pmC ? 2048 : 3072))), wr, fr, 1.0f);
#pragma unroll
        for (int ai = 0; ai < 2; ++ai)
#pragma unroll
            for (int m = 0; m < 4; ++m) { const int row = row0 + ai * HALF + m * 16; const float rs = rsv[ai][m];
#pragma unroll
                for (int bj = 0; bj < 2; ++bj) { const f32x4 v0 = acc[ai][bj][m][0] * rs, v1 = acc[ai][bj][m][1] * rs;
                    u32x4 w; w.x = pkbf(v0[0], v0[1]); w.y = pkbf(v0[2], v0[3]); w.z = pkbf(v1[0], v1[1]); w.w = pkbf(v1[2], v1[3]);
                    *(u32x4*)(O + (size_t)row * ldc + col0 + bj * HALF) = w; } }
    }
};
struct EpiRes {
    static constexpr bool PERM = false, AFTER_DRAIN = false, ROW_RSTD = false;
    bf16_t* xb; float* ssq; int mode; unsigned char* x8p; float* outp; int w8, fin;
    __device__ __forceinline__ void operator()(const f32x4 (&acc)[2][2][4][2], const Unit& u, int wr, int wc, int fr_, int fq_) const {
        int tl_ = threadIdx.x; asm volatile("" : "+v"(tl_)); const int fr = tl_ & 15, fq = (tl_ >> 4) & 3; (void)fr_; (void)fq_;
        const int row0 = u.pm * BM + wr * 64 + fr, col0 = u.pn * BM + wc * 32 + 4 * fq;
        int md_ = __builtin_amdgcn_readfirstlane(mode), w8_ = __builtin_amdgcn_readfirstlane(w8), fin_ = __builtin_amdgcn_readfirstlane(fin); asm volatile("" : "+s"(md_), "+s"(w8_), "+s"(fin_));
        const float alpha = md_ == 0 ? 0.5f : (md_ == 1 ? 0.5f / 256.0f : 1.0f);
        float* const outf = fin_ ? outp : nullptr; unsigned char* const x8 = w8_ ? x8p : nullptr;
#pragma unroll
        for (int ai = 0; ai < 2; ++ai) { u32x2 old[4][2][2];
#pragma unroll
            for (int m = 0; m < 4; ++m)
#pragma unroll
                for (int bj = 0; bj < 2; ++bj)
#pragma unroll
                    for (int n = 0; n < 2; ++n) old[m][bj][n] = *(const u32x2*)(xb + (size_t)(row0 + ai * HALF + m * 16) * 1024 + col0 + bj * HALF + n * 16);
            float ssv[4];
#pragma unroll
            for (int m = 0; m < 4; ++m) { const int row = row0 + ai * HALF + m * 16; const size_t off = (size_t)row * 1024 + col0; float ss = 0.f;
#pragma unroll
                for (int bj = 0; bj < 2; ++bj)
#pragma unroll
                    for (int n = 0; n < 2; ++n) { const u32x2 ow = old[m][bj][n]; const f32x4 xo = (f32x4){bf_lo(ow.x), bf_hi(ow.x), bf_lo(ow.y), bf_hi(ow.y)}; const f32x4 xn = xo + acc[ai][bj][m][n] * alpha;
                        if (outf) *(f32x4*)(outf + off + bj * HALF + n * 16) = xn;
                        else { ss += (xn[0] * xn[0] + xn[1] * xn[1]) + (xn[2] * xn[2] + xn[3] * xn[3]);
                            u32x2 w; w.x = pkbf(xn[0], xn[1]); w.y = pkbf(xn[2], xn[3]); *(u32x2*)(xb + off + bj * HALF + n * 16) = w;
                            if (x8) *(unsigned*)(x8 + off + bj * HALF + n * 16) = pk4_fp8(xn[0], xn[1], xn[2], xn[3]); } }
                ssv[m] = ss; }
            if (!outf) { float tv[4];
#pragma unroll
                for (int m = 0; m < 4; ++m) ssv[m] = swap32_add(ssv[m]);
#pragma unroll
                for (int m = 0; m < 4; ++m) tv[m] = __shfl_xor(ssv[m], 16);
#pragma unroll
                for (int m = 0; m < 4; ++m) if (fq == 0) ssq[(size_t)(row0 + ai * HALF + m * 16) * 16 + u.pn * 4 + wc] = ssv[m] + tv[m]; }
            asm volatile("" ::: "memory"); }
    }
};

struct EpiNull {
    static constexpr bool PERM = true, AFTER_DRAIN = false, ROW_RSTD = false;
    float* sink;
    __device__ __forceinline__ void operator()(const f32x4 (&acc)[2][2][4][2], const Unit& u, int wr, int wc, int fr, int fq) const {
        float s = 0.f;
#pragma unroll
        for (int ai = 0; ai < 2; ++ai)
#pragma unroll
            for (int bj = 0; bj < 2; ++bj)
#pragma unroll
                for (int m = 0; m < 4; ++m)
#pragma unroll
                    for (int n = 0; n < 2; ++n) s += acc[ai][bj][m][n][0];
        if (s == 12345.678f) sink[0] = s;
    }
};
template <int PIN> struct FixedOrder : StaticOrder {
    __device__ bool next(int i, Unit& u) const { const bool ok = StaticOrder::next(i, u); if (PIN & 1) u.pn = 0; if (PIN & 2) u.pm = (int)(blockIdx.x & 7); return ok; }
};
template <class Epi, class Sched, bool ALIGN_EPI = false, bool SP2 = false, bool FP8 = false, int GID = 0>
__device__ __forceinline__ void gemm_phase(PG8_LAS unsigned char* lds, const Gemm g, const Sched& S, const Epi& E) {
    int tid = threadIdx.x; asm volatile("" : "+v"(tid));
    const int wid = __builtin_amdgcn_readfirstlane(tid >> 6), lane = tid & 63, wr = wid >> 2, wc = wid & 3, fr = lane & 15, fq = lane >> 4;
    const int K = g.K, nt = K / BK;
    unsigned voffA[2], voffB[2];
#pragma unroll
    for (int i = 0; i < 2; ++i) { int R, C; stage_rc(tid * 16 + i * 8192, R, C); const int Rb = Epi::PERM ? ((R & ~31) + perm32(R & 31)) : R;
        voffA[i] = (unsigned)(R * K + C) * 2u; voffB[i] = (unsigned)(Rb * K + C) * 2u; }
    const size_t kstep = (size_t)(BK * 2);
    const size_t hstep = (size_t)HALF * K * 2;
    const size_t tstep = 2 * hstep;
    const unsigned ldsw = (unsigned)wid * 1024u;
    const int aoff = lds_byte(wr * 64 + fr, fq * 8), boff = lds_byte(wc * 32 + fr, fq * 8);
#define PG8_SA(b, h) (((b) * 2 + (h)) * HTB)
#define PG8_SB(b, h) ((4 + (b) * 2 + (h)) * HTB)
#define PG8_STAGE(bufoff, gbase, voff) do { _Pragma("unroll") for (int _i = 0; _i < 2; ++_i) \
        __builtin_amdgcn_global_load_lds((const unsigned*)((const char*)(gbase) + (voff)[_i]), (PG8_LAS unsigned*)(lds + (bufoff) + ldsw + _i * 8192), 16, 0, 0); } while (0)
#define PG8_LDA(dst, b, h) do { if constexpr (FP8) { _Pragma("unroll") for (int m = 0; m < 4; ++m) dst##8[m] = cat8(*(const PG8_LAS bf16x8*)(lds + PG8_SA(b, h) + aoff + m * 2048), *(const PG8_LAS bf16x8*)(lds + PG8_SA(b, h) + aoff + m * 2048 + 1024)); } \
        else { _Pragma("unroll") for (int m = 0; m < 4; ++m) _Pragma("unroll") for (int k = 0; k < 2; ++k) dst[m][k] = *(const PG8_LAS bf16x8*)(lds + PG8_SA(b, h) + aoff + m * 2048 + k * 1024); } } while (0)
#define PG8_LDB(dst, b, h) do { if constexpr (FP8) { _Pragma("unroll") for (int n = 0; n < 2; ++n) dst##8[n] = cat8(*(const PG8_LAS bf16x8*)(lds + PG8_SB(b, h) + boff + n * 2048), *(const PG8_LAS bf16x8*)(lds + PG8_SB(b, h) + boff + n * 2048 + 1024)); } \
        else { _Pragma("unroll") for (int n = 0; n < 2; ++n) _Pragma("unroll") for (int k = 0; k < 2; ++k) dst[n][k] = *(const PG8_LAS bf16x8*)(lds + PG8_SB(b, h) + boff + n * 2048 + k * 1024); } } while (0)
#define PG8_MMA(ai, bj, At, Bt) do { __builtin_amdgcn_s_setprio(1); \
        if constexpr (FP8) { _Pragma("unroll") for (int m = 0; m < 4; ++m) _Pragma("unroll") for (int n = 0; n < 2; ++n) \
            mfma8(acc[ai][bj][m][n], Bt##8[n], At##8[m], sc8); } \
        else { _Pragma("unroll") for (int m = 0; m < 4; ++m) _Pragma("unroll") for (int n = 0; n < 2; ++n) _Pragma("unroll") for (int k = 0; k < 2; ++k) \
            acc[ai][bj][m][n] = __builtin_amdgcn_mfma_f32_16x16x32_bf16(Bt[n][k], At[m][k], acc[ai][bj][m][n], 0, 0, 0); } \
        __builtin_amdgcn_s_setprio(0); } while (0)
#define PG8_WAIT_V(n) asm volatile("s_waitcnt vmcnt(" #n ")" ::: "memory")
#define PG8_WAIT_L(n) asm volatile("s_waitcnt lgkmcnt(" #n ")" ::: "memory")
#define PG8_BAR __builtin_amdgcn_s_barrier()
#define PG8_SCHED __builtin_amdgcn_sched_barrier(0)
    Unit cur, nxt; int ui = 0;
    if (!S.next(0, cur)) return;
    if constexpr (Epi::ROW_RSTD) {
        int p0 = cur.pm, p1 = -1, p2 = -1, p3 = -1; { Unit t_; for (int n_ = 1; S.next(n_, t_); ++n_) { const int p = t_.pm; if (p != p0 && p != p1 && p != p2 && p != p3) { if (p1 < 0) p1 = p; else if (p2 < 0) p2 = p; else p3 = p; } } }
        E.fill_rstd(lds + STAGE_BYTES, p0, wid, lane); if (p1 >= 0) E.fill_rstd(lds + STAGE_BYTES + 1024, p1, wid, lane); if (p2 >= 0) E.fill_rstd(lds + STAGE_BYTES + 2048, p2, wid, lane); if (p3 >= 0) E.fill_rstd(lds + STAGE_BYTES + 3072, p3, wid, lane);
        E.set_panels(p0, p1, p2);
        PG8_WAIT_L(0); PG8_BAR; asm volatile("" ::: "memory"); }
    f32x4 acc[2][2][4][2];
#pragma unroll
    for (int a = 0; a < 2; ++a)
#pragma unroll
        for (int b = 0; b < 2; ++b)
#pragma unroll
            for (int m = 0; m < 4; ++m)
#pragma unroll
                for (int n = 0; n < 2; ++n) acc[a][b][m][n] = (f32x4){0.f, 0.f, 0.f, 0.f};
    bf16x8 At[4][2], B0[2][2], B1[2][2]; i32x8 At8[4], B08[2], B18[2]; int sc8 = 0x7F7F7F7F; asm volatile("" : "+v"(sc8));
    const char* cA = (const char*)g.A + (size_t)cur.pm * tstep; const char* cB = (const char*)g.Bt + (size_t)cur.pn * tstep;
    S.a_ready(cur);
    if constexpr (SP2) {
        PG8_STAGE(PG8_SB(0, 0), cB, voffB); PG8_STAGE(PG8_SB(0, 1), cB + hstep, voffB); PG8_STAGE(PG8_SA(0, 0), cA, voffA); PG8_STAGE(PG8_SA(0, 1), cA + hstep, voffA);
        if (wr == 1) PG8_BAR;
        PG8_WAIT_V(2); PG8_BAR;
        PG8_STAGE(PG8_SB(1, 0), cB + kstep, voffB); PG8_STAGE(PG8_SA(1, 0), cA + kstep, voffA); PG8_STAGE(PG8_SB(1, 1), cB + hstep + kstep, voffB);
        PG8_WAIT_V(6); PG8_BAR;
    } else {
        PG8_STAGE(PG8_SB(0, 0), cB, voffB); PG8_STAGE(PG8_SA(0, 0), cA, voffA); PG8_STAGE(PG8_SB(0, 1), cB + hstep, voffB); PG8_STAGE(PG8_SA(0, 1), cA + hstep, voffA);
        if (wr == 1) PG8_BAR;
        PG8_WAIT_V(4); PG8_BAR;
        PG8_STAGE(PG8_SB(1, 0), cB + kstep, voffB); PG8_STAGE(PG8_SA(1, 0), cA + kstep, voffA); PG8_STAGE(PG8_SB(1, 1), cB + hstep + kstep, voffB);
        PG8_WAIT_V(6); PG8_BAR;
    }
    for (;;) {
        const bool has_next = S.next(ui + 1, nxt);
        const char* nA = has_next ? (const char*)g.A + (size_t)nxt.pm * tstep : cA; const char* nB = has_next ? (const char*)g.Bt + (size_t)nxt.pn * tstep : cB;
#pragma nounroll
        for (int t = 0; t < nt; t += 2) {
            const bool last = (t == nt - 2);
            const char* a1 = cA + (size_t)(t + 1) * kstep;
            const char* a2 = last ? nA : cA + (size_t)(t + 2) * kstep; const char* b2 = last ? nB : cB + (size_t)(t + 2) * kstep;
            const char* a3 = a2 + kstep; const char* b3 = b2 + kstep;
            if (last && has_next) S.a_ready(nxt);
            if constexpr (SP2) {
            PG8_LDB(B0, 0, 0); PG8_LDB(B1, 0, 1); PG8_SCHED; PG8_LDA(At, 0, 0); PG8_STAGE(PG8_SA(1, 1), a1 + hstep, voffA);
            PG8_WAIT_V(8); PG8_WAIT_L(0); PG8_BAR; PG8_MMA(0, 0, At, B0); PG8_MMA(0, 1, At, B1); PG8_BAR; PG8_SCHED;
            PG8_LDA(At, 0, 1); PG8_STAGE(PG8_SB(0, 0), b2, voffB); PG8_STAGE(PG8_SB(0, 1), b2 + hstep, voffB); PG8_STAGE(PG8_SA(0, 0), a2, voffA);
            PG8_WAIT_V(8); PG8_WAIT_L(0); PG8_BAR; PG8_MMA(1, 0, At, B0); PG8_MMA(1, 1, At, B1); PG8_BAR; PG8_SCHED;
            PG8_LDB(B0, 1, 0); PG8_LDB(B1, 1, 1); PG8_SCHED; PG8_LDA(At, 1, 0); PG8_STAGE(PG8_SA(0, 1), a2 + hstep, voffA);
            PG8_WAIT_V(8); PG8_WAIT_L(0); PG8_BAR; PG8_MMA(0, 0, At, B0); PG8_MMA(0, 1, At, B1); PG8_BAR; PG8_SCHED;
            PG8_LDA(At, 1, 1); PG8_STAGE(PG8_SB(1, 0), b3, voffB); PG8_STAGE(PG8_SB(1, 1), b3 + hstep, voffB); PG8_STAGE(PG8_SA(1, 0), a3, voffA);
            PG8_WAIT_V(8); PG8_WAIT_L(0); PG8_BAR; PG8_MMA(1, 0, At, B0); PG8_MMA(1, 1, At, B1); PG8_BAR; PG8_SCHED;
            } else {
            PG8_LDB(B0, 0, 0); PG8_SCHED; PG8_LDA(At, 0, 0); PG8_STAGE(PG8_SA(1, 1), a1 + hstep, voffA);
            PG8_WAIT_L(8); PG8_BAR; PG8_WAIT_L(0); PG8_MMA(0, 0, At, B0); PG8_BAR; PG8_SCHED;
            PG8_LDB(B1, 0, 1); PG8_STAGE(PG8_SB(0, 0), b2, voffB);
            PG8_BAR; PG8_WAIT_L(0); PG8_MMA(0, 1, At, B1); PG8_BAR;
            PG8_LDA(At, 0, 1); PG8_STAGE(PG8_SA(0, 0), a2, voffA);
            PG8_BAR; PG8_WAIT_L(0); PG8_MMA(1, 0, At, B0); PG8_BAR; PG8_SCHED;
            PG8_STAGE(PG8_SB(0, 1), b2 + hstep, voffB);
            PG8_WAIT_V(6); PG8_BAR; PG8_MMA(1, 1, At, B1); PG8_BAR;
            PG8_LDB(B0, 1, 0); PG8_SCHED; PG8_LDA(At, 1, 0); PG8_STAGE(PG8_SA(0, 1), a2 + hstep, voffA);
            PG8_WAIT_L(8); PG8_BAR; PG8_WAIT_L(0); PG8_MMA(0, 0, At, B0); PG8_BAR; PG8_SCHED;
            PG8_LDB(B1, 1, 1); PG8_STAGE(PG8_SB(1, 0), b3, voffB);
            PG8_BAR; PG8_WAIT_L(0); PG8_MMA(0, 1, At, B1); PG8_BAR;
            PG8_LDA(At, 1, 1); PG8_STAGE(PG8_SA(1, 0), a3, voffA);
            PG8_BAR; PG8_WAIT_L(0); PG8_MMA(1, 0, At, B0); PG8_BAR; PG8_SCHED;
            PG8_STAGE(PG8_SB(1, 1), b3 + hstep, voffB);
            PG8_WAIT_V(6); PG8_BAR; PG8_MMA(1, 1, At, B1); PG8_BAR;
            }
        }
        if constexpr (ALIGN_EPI) { if (wr == 0) PG8_BAR; }
        TS(lds, 40 + 2 * GID);
        if constexpr (FP8) asm volatile("s_nop 15\n\ts_nop 15" ::: "memory");
        if constexpr (!Epi::AFTER_DRAIN) { E(acc, cur, wr, wc, fr, fq); S.done(cur); }
        TS(lds, 41 + 2 * GID);
        if (!has_next) break;
#pragma unroll
        for (int a = 0; a < 2; ++a)
#pragma unroll
            for (int b = 0; b < 2; ++b)
#pragma unroll
                for (int m = 0; m < 4; ++m)
#pragma unroll
                    for (int n = 0; n < 2; ++n) acc[a][b][m][n] = (f32x4){0.f, 0.f, 0.f, 0.f};
        cur = nxt; cA = nA; cB = nB; ++ui;
        if constexpr (ALIGN_EPI) { if (wr == 1) PG8_BAR; }
    }
    PG8_WAIT_V(0);
    if constexpr (!ALIGN_EPI) { if (wr == 0) PG8_BAR; }
    PG8_BAR;
    if constexpr (Epi::AFTER_DRAIN) { E.fused(acc, cur, wr, wc, fr, fq, lds, wid, lane); S.done(cur); }
#undef PG8_SA
#undef PG8_SB
#undef PG8_STAGE
#undef PG8_LDA
#undef PG8_LDB
#undef PG8_MMA
#undef PG8_WAIT_V
#undef PG8_WAIT_L
#undef PG8_BAR
#undef PG8_SCHED
}
}

constexpr int NWAVES = 8;
constexpr int BATCH = 16, T = 2048, D = 1024, M = BATCH * T, DFF = 2816, NF1 = 2 * DFF, NU = 2304, DEPTH = 2, NCP = 128;
constexpr float EPS = 1e-6f, LOG2E = 1.4426950408889634f, C2 = 0.125f * LOG2E;
constexpr int UQ = 0, UKS = 256, UKW = 320, UCK = 384, UCQ = 512, UKC = 768, UVC = 832, UVS = 896, UVW = 960, UCV = 1024, UG = 1152, UBB = 1280, UBC = 1536, UBX = 1792, UDV = 2048;
constexpr size_t MiB = 1u << 20;
constexpr size_t WS_CTL = 0, CTL_ZERO_BYTES = 1 * MiB;
constexpr size_t WS_W13 = 1 * MiB, WS_W2 = 45 * MiB, WS_WIN = 67 * MiB, WS_WOUT = 76 * MiB, WS_C1 = 80 * MiB;
constexpr size_t WS_SSQ = 82 * MiB, WS_GATES = 84 * MiB, WS_KC = 86 * MiB, WS_VC = 86 * MiB + 512 * 1024;
constexpr size_t WS_XB = 88 * MiB, WS_QKN = 152 * MiB, WS_YN = 200 * MiB, WS_ACT = 264 * MiB, WS_U = WS_ACT, WS_X8 = 440 * MiB, WS_IMG = 472 * MiB, WS_END = 504 * MiB;
#ifndef UP8_MASK_V
#define UP8_MASK_V 0xE
#endif
#ifndef DN8_MASK_V
#define DN8_MASK_V 0xF
#endif
constexpr unsigned UP8_MASK = UP8_MASK_V, DN8_MASK = DN8_MASK_V;
constexpr float W8_SCALE = 64.0f, ACT8_SCALE = 4.0f; static_assert(W8_SCALE * ACT8_SCALE == 256.0f, "EpiRes mode 1");
constexpr int CW_BAR = 4096;
constexpr int LDS_BYTES = 163840, MISC_OFF = LDS_BYTES - 256;

#define GAS __attribute__((address_space(1)))
#define LAS __attribute__((address_space(3)))
typedef unsigned short bf16;
typedef unsigned v4u __attribute__((ext_vector_type(4)));
typedef unsigned u32x2 __attribute__((ext_vector_type(2)));
typedef float f32x4 __attribute__((ext_vector_type(4)));
typedef float f32x2_t __attribute__((ext_vector_type(2)));
typedef __bf16 bf16x2_t __attribute__((ext_vector_type(2)));
typedef short bf16x8 __attribute__((ext_vector_type(8)));
typedef float f32x16 __attribute__((ext_vector_type(16)));
typedef short v4i16_t __attribute__((ext_vector_type(4)));
#define LDS_WAIT() asm volatile("s_waitcnt lgkmcnt(0)" ::: "memory")
__device__ __forceinline__ unsigned pk2(float lo, float hi) { f32x2_t v = {lo, hi}; bf16x2_t b = __builtin_convertvector(v, bf16x2_t); return __builtin_bit_cast(unsigned, b); }
__device__ __forceinline__ float bflo(unsigned u) { return __builtin_bit_cast(float, u << 16); }
__device__ __forceinline__ float bfhi(unsigned u) { return __builtin_bit_cast(float, u & 0xffff0000u); }
__device__ __forceinline__ f32x4 ld4bf(const bf16* p) { const u32x2 w = *(const u32x2*)p; return (f32x4){bflo(w.x), bfhi(w.x), bflo(w.y), bfhi(w.y)}; }
__device__ __forceinline__ void st4bf(bf16* p, f32x4 v) { u32x2 w; w.x = pk2(v[0], v[1]); w.y = pk2(v[2], v[3]); *(u32x2*)p = w; }
template <int CTRL> __device__ __forceinline__ float dpp_add(float v) { return v + __builtin_bit_cast(float, __builtin_amdgcn_update_dpp(0, __builtin_bit_cast(int, v), CTRL, 0xf, 0xf, true)); }
__device__ __forceinline__ float row16_sum(float v) { v = dpp_add<0xB1>(v); v = dpp_add<0x4E>(v); v = dpp_add<0x141>(v); v = dpp_add<0x140>(v); return v; }
__device__ __forceinline__ float wave_sum(float v) {
    v = row16_sum(v); v += __shfl_xor(v, 16);
    auto rr = __builtin_amdgcn_permlane32_swap(__float_as_uint(v), __float_as_uint(v), false, false); return __uint_as_float(rr[0]) + __uint_as_float(rr[1]);
}
__device__ __forceinline__ f32x4 up4(u32x2 w) { return (f32x4){bflo(w.x), bfhi(w.x), bflo(w.y), bfhi(w.y)}; }
__device__ __forceinline__ float sq4(f32x4 v) { return (v[0] * v[0] + v[1] * v[1]) + (v[2] * v[2] + v[3] * v[3]); }

__device__ __forceinline__ int kimg_off(int r, int d) { return (d >> 3) * 512 + r * 8 + (d & 7); }
__device__ __forceinline__ int vimg_off(int r, int d) { return ((d >> 5) * 4 + (r >> 4)) * 512 + (r & 15) * 32 + (d & 31); }
#define XB_TMO      128
#define XB_XCNT(j)  (256  + 64 * (j))
#define XB_XSUB(j)  (1280 + 64 * (j))
#define XB_XGEN(j)  (2304 + 64 * (j))
#define XB_TOP      3328
#define XB_TOPGEN   3392
#define XCD_BAR_WORDS 3456
#define XB_SPIN_CAP (1u << 18)

__device__ __forceinline__ unsigned xb_ld(unsigned* p)              { return __hip_atomic_load(p, __ATOMIC_RELAXED, __HIP_MEMORY_SCOPE_AGENT); }
__device__ __forceinline__ unsigned xb_add(unsigned* p, unsigned v) { return __hip_atomic_fetch_add(p, v, __ATOMIC_RELAXED, __HIP_MEMORY_SCOPE_AGENT); }
__device__ __forceinline__ unsigned xb_xcc_id() { return (unsigned)__builtin_amdgcn_s_getreg((3 << 11) | 20) & 0xFu; }
#define XB_SPIN(cond, bar) do { unsigned _sp = 0; while (cond) { __builtin_amdgcn_s_sleep(1); \
    if ((++_sp & 255u) == 0u) { if (xb_ld(&(bar)[XB_TMO])) break; if (_sp > XB_SPIN_CAP) { atomicAdd(&(bar)[XB_TMO], 1u); break; } } } } while (0)

struct XcdBarrier {
    unsigned* bar; unsigned x;
    volatile LAS unsigned* st;
};

__device__ __forceinline__ XcdBarrier xcd_barrier_post(unsigned* bar, volatile LAS unsigned* st) {
    XcdBarrier b; b.bar = bar; b.x = xb_xcc_id(); b.st = st;
    if (threadIdx.x == 0) (void)xb_add(&bar[XB_XCNT(b.x)], 1u);
    return b;
}
__device__ __forceinline__ void xcd_barrier_complete(unsigned* bar, unsigned x, unsigned& nloc, unsigned& nx) {
    const unsigned G = gridDim.x * gridDim.y * gridDim.z;
    unsigned sum, cnt, mine, sp = 0u;
    for (;;) {
        sum = 0u; cnt = 0u; mine = 0u;
#pragma unroll
        for (unsigned j = 0; j < 16; ++j) { const unsigned c = xb_ld(&bar[XB_XCNT(j)]); sum += c; cnt += (c > 0u) ? 1u : 0u; mine = (j == x) ? c : mine; }
        if (sum == G) break;
        __builtin_amdgcn_s_sleep(1);
        if ((++sp & 255u) == 0u) { if (xb_ld(&bar[XB_TMO])) break; if (sp > XB_SPIN_CAP) { atomicAdd(&bar[XB_TMO], 1u); break; } }
    }
    nloc = mine > 0u ? mine : 1u; nx = cnt > 0u ? cnt : 1u;
}

__device__ __forceinline__ void xcd_barrier(const XcdBarrier& b) {
    asm volatile("s_waitcnt vmcnt(0)" ::: "memory");
    __syncthreads();
    if (threadIdx.x == 0) {
        unsigned* bar = b.bar;
        __builtin_amdgcn_s_waitcnt(0);
        unsigned nloc = b.st[0], nx = b.st[1];
        if (nloc == 0u) { xcd_barrier_complete(bar, b.x, nloc, nx); b.st[0] = nloc; b.st[1] = nx; }
        const unsigned old = xb_add(&bar[XB_XSUB(b.x)], 1u);
        const unsigned gen = old / nloc;
        if (old + 1u == (gen + 1u) * nloc) {
            __builtin_amdgcn_fence(__ATOMIC_RELEASE, "agent");
            asm volatile("s_waitcnt vmcnt(0)" ::: "memory");
            const unsigned og = xb_add(&bar[XB_TOP], 1u);
            const unsigned tg = og / nx;
            if (og + 1u == (tg + 1u) * nx) xb_add(&bar[XB_TOPGEN], 1u);
            else XB_SPIN(xb_ld(&bar[XB_TOPGEN]) == tg, bar);
            __builtin_amdgcn_fence(__ATOMIC_ACQUIRE, "agent");
            xb_add(&bar[XB_XGEN(b.x)], 1u);
            asm volatile("s_waitcnt vmcnt(0)" ::: "memory");
        } else {
            XB_SPIN(xb_ld(&bar[XB_XGEN(b.x)]) == gen, bar);
            __builtin_amdgcn_fence(__ATOMIC_ACQUIRE, "agent");
            asm volatile("s_waitcnt vmcnt(0)" ::: "memory");
        }
    }
    __syncthreads();
}


typedef KArgs Args;
struct Frame {
    LAS unsigned char* lds;
    int tid, lane, wave, vcu, G;
    const Args* a;
};
#define FIN(i) (F.a->in[i])
#define FOUT (F.a->out)
#define FWS(off, type) ((type*)(F.a->ws + (off)))
#define F_W13T FWS(WS_W13, bf16)
#define F_W2T FWS(WS_W2, bf16)
#define F_WINT FWS(WS_WIN, bf16)
#define F_WOUTT FWS(WS_WOUT, bf16)
#define F_C1T FWS(WS_C1, bf16)
#define F_XB FWS(WS_XB, bf16)
#define F_QA FWS(WS_QKN, bf16)
#define F_QC FWS(WS_QKN + 16 * MiB, bf16)
#define F_KSI FWS(WS_IMG, bf16)
#define F_KWI FWS(WS_IMG + 4 * MiB, bf16)
#define F_CKI FWS(WS_IMG + 8 * MiB, bf16)
#define F_VSI FWS(WS_IMG + 16 * MiB, bf16)
#define F_VWI FWS(WS_IMG + 20 * MiB, bf16)
#define F_CVI FWS(WS_IMG + 24 * MiB, bf16)
#define F_YN FWS(WS_YN, bf16)
#define F_ACT FWS(WS_ACT, bf16)
#define F_U FWS(WS_U, bf16)
#define F_KC FWS(WS_KC, bf16)
#define F_VC FWS(WS_VC, bf16)
#define F_SSQ FWS(WS_SSQ, float)
#define F_GATES FWS(WS_GATES, float)
#define F_X8 FWS(WS_X8, unsigned char)
enum { I_X = 0, I_F1N, I_F1W1, I_F1W3, I_F1W2, I_MIXN, I_WIN, I_NQN, I_NKCN, I_NKSN, I_NKWN, I_POSK, I_C1K, I_C2K, I_POSV, I_C1V, I_C2V, I_CONVW, I_SQN, I_SKN, I_SINK, I_POOLW, I_POOLS, I_GN, I_WOUT,
       I_F2N, I_F2W1, I_F2W3, I_F2W2 };

__device__ __forceinline__ int win_src_col(int dr) {
    if (dr < 256) return dr;
    if (dr < 320) return 384 + (dr - 256);
    if (dr < 384) return 512 + (dr - 320);
    if (dr < 512) return 1676 + (dr - 384);
    if (dr < 768) return 1420 + (dr - 512);
    if (dr < 832) return 256 + (dr - 768);
    if (dr < 896) return 320 + (dr - 832);
    if (dr < 960) return 448 + (dr - 896);
    if (dr < 1024) return 576 + (dr - 960);
    if (dr < 1152) return 1804 + (dr - 1024);
    if (dr < 1164) return 640 + (dr - 1152);
    if (dr < 1280) return -1;
    if (dr < 1536) return 652 + (dr - 1280);
    if (dr < 1792) return 908 + (dr - 1536);
    if (dr < 2048) return 1164 + (dr - 1792);
    return 1932 + (dr - 2048);
}
struct TrItem { const float* src; const float* gain; void* dst; int N, K, k0, n0, srcmode, dstmode, w, ncols; bool f8; };
__device__ __forceinline__ void tr_decode(Frame& F, int it, TrItem& t) {
    constexpr int PER_LAYER = 6 * 176 + 144 + 64 + 64;
    const int L = it / PER_LAYER; int r = it % PER_LAYER;
    t.gain = nullptr; t.f8 = false; t.srcmode = 0; t.dstmode = 0; t.w = 0; t.ncols = 256;
    if (r < 6 * 176) { const int mat = r / 176, rr = r % 176, ffn = mat / 3, w = mat % 3;
        if (w < 2) { t.k0 = 64 * (rr / 11); t.n0 = 256 * (rr % 11); t.N = DFF; t.K = D; t.dstmode = 1; t.w = w;
            t.src = FIN(ffn ? (w ? I_F2W3 : I_F2W1) : (w ? I_F1W3 : I_F1W1)) + (size_t)L * D * DFF; t.gain = FIN(ffn ? I_F2N : I_F1N) + L * D;
            t.dst = (unsigned char*)F_W13T + (size_t)(L * 2 + ffn) * NF1 * D * 2; t.f8 = (UP8_MASK >> (L * 2 + ffn)) & 1u; }
        else { t.k0 = 64 * (rr / 4); t.n0 = 256 * (rr % 4); t.N = D; t.K = DFF;
            t.src = FIN(ffn ? I_F2W2 : I_F1W2) + (size_t)L * DFF * D; t.dst = (unsigned char*)F_W2T + (size_t)(L * 2 + ffn) * D * DFF * 2; t.f8 = (DN8_MASK >> (L * 2 + ffn)) & 1u; } }
    else { r -= 6 * 176;
        if (r < 144) { t.k0 = 64 * (r / 9); t.n0 = 256 * (r % 9); t.N = 2188; t.K = D; t.srcmode = 1;
            t.src = FIN(I_WIN) + (size_t)L * D * 2188; t.gain = FIN(I_MIXN) + L * D; t.dst = F_WINT + (size_t)L * NU * D; }
        else if (r < 144 + 64) { r -= 144; t.k0 = 64 * (r / 4); t.n0 = 256 * (r % 4); t.N = D; t.K = D;
            t.src = FIN(I_WOUT) + (size_t)L * D * D; t.gain = FIN(I_GN) + L * D; t.dst = F_WOUTT + (size_t)L * D * D; }
        else { r -= 144 + 64; const int kv = r / 32; t.k0 = 64 * (r % 32); t.n0 = 0; t.N = 128; t.K = 2048; t.ncols = 128;
            t.src = FIN(kv ? I_C1V : I_C1K) + (size_t)L * 2048 * 128; t.dst = F_C1T + (size_t)(L * 2 + kv) * 128 * 2048; } }
}
__device__ __forceinline__ void tr_load(const TrItem& t, f32x4 (&v)[8], int wave, int lane) {
    const int c = 4 * lane; const int sc = t.srcmode ? win_src_col(t.n0 + c) : (c < t.ncols ? t.n0 + c : -1);
#pragma unroll
    for (int i = 0; i < 8; ++i) { v[i] = (f32x4){0.f, 0.f, 0.f, 0.f}; if (sc >= 0) v[i] = *(const f32x4*)(t.src + (size_t)(t.k0 + 8 * wave + i) * t.N + sc); }
}
__device__ __forceinline__ void tr_to_lds(const TrItem& t, const f32x4 (&v)[8], LAS float* T, int wave, int lane) {
#pragma unroll
    for (int i = 0; i < 8; ++i) { const int k = 8 * wave + i; const float g = t.gain ? t.gain[t.k0 + k] : 1.0f; LAS float* p = T + k * 257 + 4 * lane;
        p[0] = v[i][0] * g; p[1] = v[i][1] * g; p[2] = v[i][2] * g; p[3] = v[i][3] * g; }
}
__device__ __forceinline__ void tr_out(const TrItem& t, const LAS float* T, int wave, int lane) {
    if (t.f8) { const int c = lane & 3;
#pragma unroll
        for (int j = 0; j < 2; ++j) { const int row = 32 * wave + 16 * j + (lane >> 2); if (row < t.ncols) { const int n = t.n0 + row; const int dr = t.dstmode ? ((n >> 7) * 256 + t.w * 128 + (n & 127)) : n;
            const LAS float* q = T + (16 * c) * 257 + row; v4u o;
            o.x = pg8::pk4_fp8(q[0 * 257] * W8_SCALE, q[1 * 257] * W8_SCALE, q[2 * 257] * W8_SCALE, q[3 * 257] * W8_SCALE); o.y = pg8::pk4_fp8(q[4 * 257] * W8_SCALE, q[5 * 257] * W8_SCALE, q[6 * 257] * W8_SCALE, q[7 * 257] * W8_SCALE);
            o.z = pg8::pk4_fp8(q[8 * 257] * W8_SCALE, q[9 * 257] * W8_SCALE, q[10 * 257] * W8_SCALE, q[11 * 257] * W8_SCALE); o.w = pg8::pk4_fp8(q[12 * 257] * W8_SCALE, q[13 * 257] * W8_SCALE, q[14 * 257] * W8_SCALE, q[15 * 257] * W8_SCALE);
            *(v4u*)((unsigned char*)t.dst + (size_t)dr * t.K + t.k0 + 16 * c) = o; } } }
    else { const int c = lane & 7;
#pragma unroll
        for (int j = 0; j < 4; ++j) { const int row = 32 * wave + 8 * j + (lane >> 3); if (row < t.ncols) { const int n = t.n0 + row; const int dr = t.dstmode ? ((n >> 7) * 256 + t.w * 128 + (n & 127)) : n;
            const LAS float* q = T + (8 * c) * 257 + row;
            v4u o; o.x = pk2(q[0 * 257], q[1 * 257]); o.y = pk2(q[2 * 257], q[3 * 257]); o.z = pk2(q[4 * 257], q[5 * 257]); o.w = pk2(q[6 * 257], q[7 * 257]);
            *(v4u*)((bf16*)t.dst + (size_t)dr * t.K + t.k0 + 8 * c) = o; } } }
}
__device__ __forceinline__ void prologue(Frame& F) {
    int lane = F.lane; asm volatile("" : "+v"(lane));
    LAS float* TT = (LAS float*)F.lds;
    const int wave = F.wave, gw = F.vcu * NWAVES + F.wave, NGW = F.G * NWAVES;
    constexpr int NITEMS = DEPTH * (6 * 176 + 144 + 64 + 64);
    { TrItem ta, tb; f32x4 va[8];
      int it = F.vcu; bool have = it < NITEMS;
      if (have) { tr_decode(F, it, ta); tr_load(ta, va, wave, lane); }
      while (have) {
          tr_to_lds(ta, va, TT, wave, lane);
          __syncthreads();
          const int nx = it + F.G; const bool hn = nx < NITEMS; tb = ta;
          if (hn) { tr_decode(F, nx, ta); tr_load(ta, va, wave, lane); }
          tr_out(tb, TT, wave, lane);
          __syncthreads();
          it = nx; have = hn;
      } }
    const float* x = FIN(I_X);
    for (int m4 = gw * 4; m4 < M; m4 += NGW * 4) {
        f32x4 v[4][4];
#pragma unroll
        for (int r = 0; r < 4; ++r)
#pragma unroll
            for (int j = 0; j < 4; ++j) v[r][j] = *((const f32x4*)(x + (size_t)(m4 + r) * D) + lane + 64 * j);
#pragma unroll
        for (int r = 0; r < 4; ++r) { float sr = 0.f;
#pragma unroll
            for (int j = 0; j < 4; ++j) { sr += sq4(v[r][j]); st4bf(F_XB + (size_t)(m4 + r) * D + 256 * j + 4 * lane, v[r][j]);
                if (UP8_MASK & 1u) *(unsigned*)(F_X8 + (size_t)(m4 + r) * D + 256 * j + 4 * lane) = pg8::pk4_fp8(v[r][j][0], v[r][j][1], v[r][j][2], v[r][j][3]); }
            sr = wave_sum(sr);
            if (lane < 16) F_SSQ[(size_t)(m4 + r) * 16 + lane] = lane == 0 ? sr : 0.f; }
    }
}

#ifndef PROBE_PREP
#define PROBE_PREP 0
#endif
__device__ __forceinline__ void prep_phase(Frame& F, int L) {
    int tid = F.tid; asm volatile("" : "+v"(tid));
    const int lane = tid & 63, ch = 4 * lane;
    LAS bf16* PWt = (LAS bf16*)F.lds;
    LAS bf16* DTb = (LAS bf16*)(F.lds + 65536) + F.wave * (16 * 264);
    { const float* pw = FIN(I_POOLW) + (size_t)L * 16384;
      for (int i = tid; i < 16384; i += NWAVES * 64) { const int g = i >> 12, c = (i >> 6) & 63, e = i & 63; PWt[(g * 64 + e) * 72 + c] = (bf16)(pk2(pw[i], 0.f) & 0xffffu); } }
    __syncthreads();
    f32x4 g0, g1, g2, cw0, cw1, cw2;
    { const float* nq = FIN(I_NQN) + L * 64; const float* nks = FIN(I_NKSN) + L * 64; const float* nkw = FIN(I_NKWN) + L * 64; const float* sk = FIN(I_SKN) + L * 64; const float* sq = FIN(I_SQN) + L * 64;
      g0 = *(const f32x4*)(nq + (ch & 63)) * C2;
      g1 = ch < 64 ? *(const f32x4*)(nks + ch) : (ch < 128 ? *(const f32x4*)(nkw + (ch - 64)) : *(const f32x4*)(sk + (ch & 63)));
      g2 = *(const f32x4*)(sq + (ch & 63)) * C2;
      const float* cw = FIN(I_CONVW) + L * 768; cw0 = *(const f32x4*)(cw + ch); cw1 = *(const f32x4*)(cw + 256 + ch); cw2 = *(const f32x4*)(cw + 512 + ch);
      }
    const int grp = lane >> 4, win = 2 << grp;
    const int gw = F.vcu * NWAVES + F.wave, NGW = F.G * NWAVES;
    TS(F.lds, 30);
    for (int blk = gw; blk < M / 16; blk += NGW) {
        const int m0 = blk * 16, t0 = m0 & (T - 1);
        const bf16* u0 = F_U + (size_t)m0 * NU;
        const int gt = m0 >> 6, rb = m0 & 63, dk = ch & 63;
        bf16* kimg = (ch < 64 ? F_KSI : (ch < 128 ? F_KWI : F_CKI + (size_t)((ch - 128) >> 6) * 512 * 4096)) + (size_t)gt * 4096 + kimg_off(rb, dk);
        bf16* vimg = (ch < 64 ? F_VSI : (ch < 128 ? F_VWI : F_CVI + (size_t)((ch - 128) >> 6) * 512 * 4096)) + (size_t)gt * 4096 + vimg_off(rb, dk);
#pragma nounroll
        for (int i8 = 0; i8 < 16; i8 += 8) { u32x2 raw[8][4];
#pragma unroll
            for (int i = 0; i < 8; ++i) {
#pragma unroll
                for (int k = 0; k < 3; ++k) raw[i][k] = *(const u32x2*)(u0 + (size_t)(i8 + i) * NU + 256 * k + ch);
                raw[i][3] = *(const u32x2*)(u0 + (size_t)(i8 + i) * NU + UVS + ch); }
#pragma unroll
            for (int i = 0; i < 8; ++i) { const f32x4 v0 = up4(raw[i][0]), v1 = up4(raw[i][1]), v2 = up4(raw[i][2]);
                const float s0 = row16_sum(sq4(v0)), s1 = row16_sum(sq4(v1)), s2 = row16_sum(sq4(v2));
                const float r0 = __builtin_amdgcn_rsqf(s0 * (1.f / 64.f) + EPS), r1 = __builtin_amdgcn_rsqf(s1 * (1.f / 64.f) + EPS), r2 = __builtin_amdgcn_rsqf(s2 * (1.f / 64.f) + EPS);
                st4bf(F_QA + (size_t)(m0 + i8 + i) * 256 + ch, v0 * r0 * g0); st4bf(kimg + (i8 + i) * 8, v1 * r1 * g1); st4bf(F_QC + (size_t)(m0 + i8 + i) * 256 + ch, v2 * r2 * g2);
                *(u32x2*)(vimg + (i8 + i) * 32) = raw[i][3]; } }
        TS(F.lds, 31);
#pragma unroll
        for (int k = 0; k < 3; ++k) { const int idx = lane + 64 * k, tk = idx / 12, gi = idx - 12 * tk;
            const float a = bflo((unsigned)u0[(size_t)tk * NU + UG + gi]); F_GATES[(size_t)m0 * 12 + idx] = __builtin_amdgcn_rcpf(1.0f + __builtin_amdgcn_exp2f(a * -LOG2E)); }
        TS(F.lds, 32);
        { f32x4 zm1 = {0.f, 0.f, 0.f, 0.f}, zm2 = {0.f, 0.f, 0.f, 0.f};
          if (t0 > 0) { zm1 = ld4bf(u0 - NU + UBC + ch) * ld4bf(u0 - NU + UBX + ch); zm2 = ld4bf(u0 - 2 * NU + UBC + ch) * ld4bf(u0 - 2 * NU + UBX + ch); }
#pragma nounroll
          for (int i8 = 0; i8 < 16; i8 += 8) { u32x2 raw[8][3]; f32x4 ob[8]; float ss[8];
#pragma unroll
              for (int i = 0; i < 8; ++i)
#pragma unroll
                  for (int k = 0; k < 3; ++k) raw[i][k] = *(const u32x2*)(u0 + (size_t)(i8 + i) * NU + UBB + 256 * k + ch);
#pragma unroll
              for (int i = 0; i < 8; ++i) { const f32x4 z0 = up4(raw[i][1]) * up4(raw[i][2]);
                  ob[i] = up4(raw[i][0]) * (cw2 * z0 + cw1 * zm1 + cw0 * zm2); zm2 = zm1; zm1 = z0; ss[i] = sq4(ob[i]); }
#pragma unroll
              for (int i = 0; i < 8; ++i) ss[i] = wave_sum(ss[i]);
#pragma unroll
              for (int i = 0; i < 8; ++i) st4bf(F_YN + (size_t)(m0 + i8 + i) * D + 256 + ch, ob[i] * (__builtin_amdgcn_rsqf(ss[i] * (1.f / 256.f) + EPS))); } }
        TS(F.lds, 33);
        { u32x2 raw[32];
#pragma unroll
          for (int i = 0; i < 16; ++i) { raw[i] = (u32x2){0u, 0u}; if (t0 > 0) raw[i] = *(const u32x2*)(u0 - (size_t)(16 - i) * NU + UDV + ch); }
#pragma unroll
          for (int i = 0; i < 16; ++i) raw[16 + i] = *(const u32x2*)(u0 + (size_t)i * NU + UDV + ch);
          f32x4 S2 = up4(raw[15]) + up4(raw[14]), S4 = S2 + up4(raw[13]) + up4(raw[12]), S8 = S4, S16;
#pragma unroll
          for (int i = 8; i < 12; ++i) S8 += up4(raw[i]);
          S16 = S8;
#pragma unroll
          for (int i = 0; i < 8; ++i) S16 += up4(raw[i]);
#pragma unroll
          for (int ti = 0; ti < 16; ++ti) { const f32x4 v = up4(raw[16 + ti]);
              S2 += v - up4(raw[16 + ti - 2]); S4 += v - up4(raw[16 + ti - 4]); S8 += v - up4(raw[16 + ti - 8]); S16 += v - up4(raw[ti]);
              const f32x4 Sw = grp == 0 ? S2 : (grp == 1 ? S4 : (grp == 2 ? S8 : S16));
              const int cn = (t0 + ti + 1) < win ? (t0 + ti + 1) : win;
              const f32x4 dd = Sw * __builtin_amdgcn_rcpf((float)cn) - v;
              u32x2 w; w.x = pk2(dd[0], dd[1]); w.y = pk2(dd[2], dd[3]); *(LAS u32x2*)(DTb + ti * 264 + ch) = w; }
          const int fr = lane & 15, fq = lane >> 4;
          const float* psp = FIN(I_POOLS) + L * 256 + fr;
          f32x4 acc[4][4];
#pragma unroll
          for (int g = 0; g < 4; ++g) { const bf16x8 a0 = *(const LAS bf16x8*)(DTb + fr * 264 + g * 64 + 8 * fq), a1 = *(const LAS bf16x8*)(DTb + fr * 264 + g * 64 + 32 + 8 * fq);
#pragma unroll
              for (int cb = 0; cb < 4; ++cb) { const LAS bf16* bp = PWt + (g * 64 + 16 * cb + fr) * 72 + 8 * fq;
                  f32x4 c = {0.f, 0.f, 0.f, 0.f};
                  c = __builtin_amdgcn_mfma_f32_16x16x32_bf16(a0, *(const LAS bf16x8*)bp, c, 0, 0, 0);
                  c = __builtin_amdgcn_mfma_f32_16x16x32_bf16(a1, *(const LAS bf16x8*)(bp + 32), c, 0, 0, 0);
                  acc[g][cb] = c * psp[g * 64 + 16 * cb]; } }
          float ss[4];
#pragma unroll
          for (int i = 0; i < 4; ++i) { float q = 0.f;
#pragma unroll
              for (int g = 0; g < 4; ++g)
#pragma unroll
                  for (int cb = 0; cb < 4; ++cb) q += acc[g][cb][i] * acc[g][cb][i];
              ss[i] = __builtin_amdgcn_rsqf(row16_sum(q) * (1.f / 256.f) + EPS); }
          asm volatile("s_waitcnt lgkmcnt(0)" ::: "memory");
#pragma unroll
          for (int g = 0; g < 4; ++g)
#pragma unroll
              for (int cb = 0; cb < 4; ++cb)
#pragma unroll
                  for (int i = 0; i < 4; ++i) DTb[(4 * fq + i) * 264 + g * 64 + 16 * cb + fr] = (bf16)(pk2(acc[g][cb][i] * ss[i], 0.f) & 0xffffu);
#pragma unroll
          for (int ti = 0; ti < 16; ++ti) *(u32x2*)(F_YN + (size_t)(m0 + ti) * D + 768 + ch) = *(const LAS u32x2*)(DTb + ti * 264 + ch); }
        TS(F.lds, 34);
    }
    __syncthreads();
    TS(F.lds, 35);
    LAS float* PART = (LAS float*)F.lds;
    LAS float* H = (LAS float*)(F.lds + 65536);
    LAS float* O2 = (LAS float*)(F.lds + 65536 + 16384);
    const int fr = lane & 15, fq = lane >> 4, wave = F.wave;
    for (int rep8 = 0; rep8 < ((PROBE_PREP & 8) ? 2 : 1); ++rep8)
    for (int uid = blockIdx.x; uid < 256; uid += F.G) {
        const int b = uid >> 4, kv = (uid >> 3) & 1, n0 = 16 * (uid & 7);
        const bf16* W1t = F_C1T + (size_t)(L * 2 + kv) * 128 * 2048;
        const float* pos = FIN(kv ? I_POSV : I_POSK) + (size_t)L * 2048;
        const float* W2 = FIN(kv ? I_C2V : I_C2K) + (size_t)L * 128 * 64;
        const int nrow = (n0 + fr) < 126 ? (n0 + fr) : 126;
        const bf16* arow = F_U + (size_t)(b * T + 16 * nrow) * NU + UKC + 64 * kv;
        const bf16* brow = W1t + (size_t)fr * 2048;
        f32x4 acc[8];
#pragma unroll
        for (int ct = 0; ct < 8; ++ct) acc[ct] = (f32x4){0.f, 0.f, 0.f, 0.f};
        v4u car[3]; f32x4 cp0[3], cp1[3]; bf16x8 cb[3][8];
#define CMP_LOAD(bi, ks) do { const int kk_ = 8 * wave + (ks), l_ = kk_ >> 1, c_ = 32 * (kk_ & 1) + 8 * fq; \
            car[bi] = *(const v4u*)(arow + (size_t)l_ * NU + c_); cp0[bi] = *(const f32x4*)(pos + l_ * 64 + c_); cp1[bi] = *(const f32x4*)(pos + l_ * 64 + c_ + 4); \
            _Pragma("unroll") for (int ct = 0; ct < 8; ++ct) cb[bi][ct] = *(const bf16x8*)(brow + (size_t)(16 * ct) * 2048 + 32 * kk_ + 8 * fq); } while (0)
#define CMP_MMA(bi) do { const v4u ar = car[bi]; const f32x4 p0 = cp0[bi], p1 = cp1[bi]; v4u aw; \
            aw.x = pk2(bflo(ar.x) + p0[0], bfhi(ar.x) + p0[1]); aw.y = pk2(bflo(ar.y) + p0[2], bfhi(ar.y) + p0[3]); aw.z = pk2(bflo(ar.z) + p1[0], bfhi(ar.z) + p1[1]); aw.w = pk2(bflo(ar.w) + p1[2], bfhi(ar.w) + p1[3]); \
            _Pragma("unroll") for (int ct = 0; ct < 8; ++ct) acc[ct] = __builtin_amdgcn_mfma_f32_16x16x32_bf16(__builtin_bit_cast(bf16x8, aw), cb[bi][ct], acc[ct], 0, 0, 0); } while (0)
        CMP_LOAD(0, 0); CMP_LOAD(1, 1); CMP_LOAD(2, 2);
        CMP_MMA(0); CMP_LOAD(0, 3); CMP_MMA(1); CMP_LOAD(1, 4); CMP_MMA(2); CMP_LOAD(2, 5);
        CMP_MMA(0); CMP_LOAD(0, 6); CMP_MMA(1); CMP_LOAD(1, 7); CMP_MMA(2); CMP_MMA(0); CMP_MMA(1);
#undef CMP_LOAD
#undef CMP_MMA
#pragma unroll
        for (int ct = 0; ct < 8; ++ct)
#pragma unroll
            for (int i = 0; i < 4; ++i) PART[(wave * 16 + 4 * fq + i) * 128 + 16 * ct + fr] = acc[ct][i];
        __syncthreads();
        { const int e0 = 4 * tid; f32x4 sum = *(const LAS f32x4*)(PART + e0);
#pragma unroll
          for (int w = 1; w < 8; ++w) sum += *(const LAS f32x4*)(PART + w * 2048 + e0);
          const int hr = e0 >> 7, hc = e0 & 127;
#pragma unroll
          for (int i = 0; i < 4; ++i) { const float xh = sum[i]; const float y2 = 2.0f * 0.7978845608028654f * (xh + 0.044715f * xh * xh * xh); H[hr * 132 + hc + i] = xh * __builtin_amdgcn_rcpf(1.0f + __builtin_amdgcn_exp2f(y2 * -LOG2E)); } }
        __syncthreads();
        if (wave < 4) { f32x4 a2 = {0.f, 0.f, 0.f, 0.f};
#pragma unroll
            for (int s = 0; s < 4; ++s) { const LAS float* hp = H + fr * 132 + 32 * s + 8 * fq; const float* wp = W2 + (size_t)(32 * s + 8 * fq) * 64 + 16 * wave + fr;
                v4u aw; aw.x = pk2(hp[0], hp[1]); aw.y = pk2(hp[2], hp[3]); aw.z = pk2(hp[4], hp[5]); aw.w = pk2(hp[6], hp[7]);
                v4u bw; bw.x = pk2(wp[0], wp[64]); bw.y = pk2(wp[128], wp[192]); bw.z = pk2(wp[256], wp[320]); bw.w = pk2(wp[384], wp[448]);
                a2 = __builtin_amdgcn_mfma_f32_16x16x32_bf16(__builtin_bit_cast(bf16x8, aw), __builtin_bit_cast(bf16x8, bw), a2, 0, 0, 0); }
#pragma unroll
            for (int i = 0; i < 4; ++i) O2[(4 * fq + i) * 68 + 16 * wave + fr] = a2[i]; }
        __syncthreads();
        if (wave == 0) { const int row = lane >> 2, c0 = (lane & 3) * 16; float v[16]; float ss = 0.f;
#pragma unroll
            for (int e = 0; e < 16; ++e) { v[e] = O2[row * 68 + c0 + e]; ss += v[e] * v[e]; }
            ss += __shfl_xor(ss, 1); ss += __shfl_xor(ss, 2);
            const float rs = __builtin_amdgcn_rsqf(ss * (1.f / 64.f) + EPS); const float* gn = FIN(I_NKCN) + L * 64 + c0;
            const int n = n0 + row; const bool dead = n >= 127;
            v4u w0, w1; float o[16];
#pragma unroll
            for (int e = 0; e < 16; ++e) { o[e] = kv ? v[e] : v[e] * rs * gn[e]; if (dead) o[e] = 0.f; }
            w0.x = pk2(o[0], o[1]); w0.y = pk2(o[2], o[3]); w0.z = pk2(o[4], o[5]); w0.w = pk2(o[6], o[7]); w1.x = pk2(o[8], o[9]); w1.y = pk2(o[10], o[11]); w1.z = pk2(o[12], o[13]); w1.w = pk2(o[14], o[15]);
            const int tl = n >> 6, rr = n & 63;
            if (kv) { bf16* dstp = F_VC + (size_t)(b * 2 + tl) * 4096 + vimg_off(rr, c0); *(v4u*)dstp = w0; *(v4u*)(dstp + 8) = w1; }
            else { bf16* dstp = F_KC + (size_t)(b * 2 + tl) * 4096; *(v4u*)(dstp + kimg_off(rr, c0)) = w0; *(v4u*)(dstp + kimg_off(rr, c0 + 8)) = w1; } }
        __syncthreads();
    }
}

#ifndef PROBE_ATT
#define PROBE_ATT 0
#endif
#define TSA(l_, k_) do { if (PROBE_TS >= 20 && PROBE_TS < 80 && !(PROBE_TS >= 30 && PROBE_TS < 60)) TS(l_, k_); } while (0)
namespace att {
constexpr int STG = 32768;
constexpr int L_STG = 0, L_IA = 65536, IAB = 4 * 64 * 33 * 4, L_IB = L_IA + IAB, L_SC = L_IB + IAB, L_SEL = L_SC + 64 * 36 * 4, L_UNI = L_SEL + 256, L_WSF = L_UNI + 256, L_END = L_WSF + NWAVES * 256;
static_assert(L_END <= MISC_OFF, "attention LDS map");
constexpr int OSTP = 264;
#define ATT_BAR() asm volatile("s_waitcnt vmcnt(0) lgkmcnt(0)\n\ts_barrier" ::: "memory")
#define ATT_LBAR() asm volatile("s_waitcnt lgkmcnt(0)\n\ts_barrier" ::: "memory")
__device__ __forceinline__ int crow(int r, int hi) { return (r & 3) + 8 * (r >> 2) + 4 * hi; }
__device__ __forceinline__ float pair_max(float v) { auto rr = __builtin_amdgcn_permlane32_swap(__float_as_uint(v), __float_as_uint(v), false, false); return fmaxf(__uint_as_float(rr[0]), __uint_as_float(rr[1])); }
__device__ __forceinline__ float pair_sum(float v) { auto rr = __builtin_amdgcn_permlane32_swap(__float_as_uint(v), __float_as_uint(v), false, false); return __uint_as_float(rr[0]) + __uint_as_float(rr[1]); }
__device__ __forceinline__ void dma_tile(const bf16* tile, LAS unsigned char* slot, int wave, int lane) {
    __builtin_amdgcn_global_load_lds((const unsigned*)(tile + wave * 512 + lane * 8), (LAS unsigned*)(slot + wave * 1024), 16, 0, 0); }
__device__ __forceinline__ void qk_tile(f32x16& p0, f32x16& p1, const LAS unsigned char* kslot, const bf16x8 (&qr)[4], const f32x16& cin, int r32, int hi) {
    const LAS unsigned char* kp = kslot + hi * 1024 + r32 * 16;
#pragma unroll
    for (int d0 = 0; d0 < 4; ++d0) { const bf16x8 b0 = *(const LAS bf16x8*)(kp + d0 * 2048), b1 = *(const LAS bf16x8*)(kp + d0 * 2048 + 512);
        if (d0 == 0) { p0 = __builtin_amdgcn_mfma_f32_32x32x16_bf16(b0, qr[0], cin, 0, 0, 0); p1 = __builtin_amdgcn_mfma_f32_32x32x16_bf16(b1, qr[0], cin, 0, 0, 0); }
        else { p0 = __builtin_amdgcn_mfma_f32_32x32x16_bf16(b0, qr[d0], p0, 0, 0, 0); p1 = __builtin_amdgcn_mfma_f32_32x32x16_bf16(b1, qr[d0], p1, 0, 0, 0); } }
}
__device__ __forceinline__ v4i16_t vtr(const LAS unsigned char* p) { return __builtin_amdgcn_ds_read_tr16_b64_v4i16((LAS v4i16_t*)p); }
__device__ __forceinline__ void pv_tile(f32x16& o0, f32x16& o1, const LAS unsigned char* vslot, const v4u (&pw)[4], int lane, int hi) {
    const unsigned vb = (unsigned)(uintptr_t)(vslot + ((lane >> 4) & 1) * 32 + (lane & 3) * 8 + (4 * hi + ((lane & 15) >> 2)) * 64);
#define PV_HALF(o_, OFF) do { v4i16_t a0[4], a1[4]; \
        _Pragma("unroll") for (int s_ = 0; s_ < 4; ++s_) { \
            asm volatile("ds_read_b64_tr_b16 %0, %1 offset:%c2" : "=&v"(a0[s_]) : "v"(vb), "i"((OFF) + s_ * 1024) : "memory"); \
            asm volatile("ds_read_b64_tr_b16 %0, %1 offset:%c2" : "=&v"(a1[s_]) : "v"(vb), "i"((OFF) + s_ * 1024 + 512) : "memory"); } \
        PV_STEP(o_, 0, 6); PV_STEP(o_, 1, 4); PV_STEP(o_, 2, 2); PV_STEP(o_, 3, 0); } while (0)
#define PV_STEP(o_, s_, N) do { asm volatile("s_waitcnt lgkmcnt(" #N ")" : "+v"(a0[s_]), "+v"(a1[s_]) :: "memory"); \
        const bf16x8 v0 = (bf16x8){a0[s_][0], a0[s_][1], a0[s_][2], a0[s_][3], a1[s_][0], a1[s_][1], a1[s_][2], a1[s_][3]}; \
        o_ = __builtin_amdgcn_mfma_f32_32x32x16_bf16(__builtin_bit_cast(bf16x8, pw[s_]), v0, o_, 0, 0, 0); } while (0)
    PV_HALF(o0, 0); PV_HALF(o1, 4096);
#undef PV_STEP
#undef PV_HALF
}
__device__ __forceinline__ void pack_p(v4u (&pw)[4], const f32x16& p0, const f32x16& p1) {
    pw[0] = (v4u){pk2(p0[0], p0[1]), pk2(p0[2], p0[3]), pk2(p0[4], p0[5]), pk2(p0[6], p0[7])};
    pw[1] = (v4u){pk2(p0[8], p0[9]), pk2(p0[10], p0[11]), pk2(p0[12], p0[13]), pk2(p0[14], p0[15])};
    pw[2] = (v4u){pk2(p1[0], p1[1]), pk2(p1[2], p1[3]), pk2(p1[4], p1[5]), pk2(p1[6], p1[7])};
    pw[3] = (v4u){pk2(p1[8], p1[9]), pk2(p1[10], p1[11]), pk2(p1[12], p1[13]), pk2(p1[14], p1[15])};
}
#define MX3(a, b, c) __builtin_fmaxf(__builtin_fmaxf((a), (b)), (c))
__device__ __forceinline__ void softmax_step(float& m, f32x16& negm, float& l, f32x16& o0, f32x16& o1, f32x16& p0, f32x16& p1, v4u (&pw)[4], LAS float* wsf, int r32, int hi) {
    float xa = MX3(p0[0], p0[1], p1[0]), xb = MX3(p0[2], p0[3], p1[1]); xa = MX3(xa, p1[2], p1[3]);
#pragma unroll
    for (int r = 4; r < 16; r += 4) { xa = MX3(xa, p0[r], p0[r + 1]); xb = MX3(xb, p0[r + 2], p0[r + 3]); xa = MX3(xa, p1[r], p1[r + 1]); xb = MX3(xb, p1[r + 2], p1[r + 3]); }
    const float mt = pair_max(__builtin_fmaxf(xa, xb));
    if (__any(mt > 8.0f)) {
        const float dl = __builtin_fmaxf(mt, 0.f), al = __builtin_amdgcn_exp2f(-dl); l *= al; m += dl;
        if (hi == 0) wsf[r32] = al;
        f32x4 a[4];
#pragma unroll
        for (int g = 0; g < 4; ++g) a[g] = *(const LAS f32x4*)(wsf + 8 * g + 4 * hi);
#pragma unroll
        for (int r = 0; r < 16; ++r) { o0[r] *= a[r >> 2][r & 3]; o1[r] *= a[r >> 2][r & 3]; p0[r] -= dl; p1[r] -= dl; negm[r] = -m; }
    }
    float rs0 = 0.f, rs1 = 0.f;
#pragma unroll
    for (int r = 0; r < 16; ++r) { p0[r] = __builtin_amdgcn_exp2f(p0[r]); p1[r] = __builtin_amdgcn_exp2f(p1[r]); rs0 += p0[r]; rs1 += p1[r]; }
    l += rs0 + rs1;
    pack_p(pw, p0, p1);
}
__device__ __forceinline__ void scale_rows(f32x16& a0, f32x16& a1, const f32x16& o0, const f32x16& o1, float fac, LAS float* wsf, int r32, int hi) {
    if (hi == 0) wsf[32 + r32] = fac;
    f32x4 f[4];
#pragma unroll
    for (int g = 0; g < 4; ++g) f[g] = *(const LAS f32x4*)(wsf + 32 + 8 * g + 4 * hi);
#pragma unroll
    for (int r = 0; r < 16; ++r) { a0[r] += o0[r] * f[r >> 2][r & 3]; a1[r] += o1[r] * f[r >> 2][r & 3]; }
}
constexpr int L_OTS = 65536;
__device__ __forceinline__ void ots_put(const f32x16& a0, const f32x16& a1, LAS unsigned char* lds, int wave, int lane) {
    LAS float* S = (LAS float*)(lds + L_OTS) + wave * 2048 + lane;
#pragma unroll
    for (int r = 0; r < 16; ++r) { S[r * 64] = a0[r]; S[(16 + r) * 64] = a1[r]; }
}
__device__ __forceinline__ void ots_get(f32x16& a0, f32x16& a1, const LAS unsigned char* lds, int wave, int lane) {
    const LAS float* S = (const LAS float*)(lds + L_OTS) + wave * 2048 + lane;
#pragma unroll
    for (int r = 0; r < 16; ++r) { a0[r] = S[r * 64]; a1[r] = S[(16 + r) * 64]; }
}
template <int MODE>
__device__ __forceinline__ void run_branch(unsigned tiles, const bf16* Kg  , const bf16* Vg, int kvsel, unsigned selm, int tq, const bf16x8 (&qr)[4],
                                           float& m, float& l, f32x16& o0, f32x16& o1, LAS unsigned char* lds, LAS float* wsf, int wave, int lane) {
    constexpr int NKV = MODE == 2 ? 2 : 1, SLOT = 16384 * NKV, NS = 4;
    const int r32 = lane & 31, hi = lane >> 5;
    m = 0.f; l = 0.f; o0 = (f32x16){}; o1 = (f32x16){}; f32x16 negm = (f32x16){};
    unsigned remc = (unsigned)__builtin_amdgcn_readfirstlane((int)tiles), remi = remc;
    int nleft = __builtin_popcount(remc), slot_i = 0, slot_c = 0;
    ATT_LBAR();
#define ATT_ISSUE() do { const int ji = __builtin_ctz(remi); remi &= remi - 1; LAS unsigned char* st_ = lds + L_STG + slot_i * SLOT; slot_i = (slot_i + 1) & (NS - 1); \
        _Pragma("unroll") for (int g = 0; g < NKV; ++g) { dma_tile(Kg + (size_t)(g * 512 + ji) * 4096, st_ + g * 8192, wave, lane); dma_tile(Vg + (size_t)(g * 512 + ji) * 4096, st_ + NKV * 8192 + g * 8192, wave, lane); } } while (0)
#define ATT_WB(n) asm volatile("s_waitcnt vmcnt(" #n ") lgkmcnt(0)\n\ts_barrier" ::: "memory")
#pragma nounroll
    for (int k = 0; k < NS - 2; ++k) if (remi) ATT_ISSUE();
    TSA(lds, 70 + MODE);
    const bool lead = true; v4u pw[4] = {}; const LAS unsigned char* stp = lds + L_STG;
    bool havep = false;
    constexpr int W = MODE == 1 ? 512 : 128;
    const int curt = __builtin_amdgcn_readfirstlane(tq) >> 6;
#define ATT_QS(j_, st_) do { const int kb = 64 * (j_) + 4 * hi; const bool sel = MODE != 0 || ((selm >> (j_)) & 1u); \
        const bool edge = MODE == 3 || (j_) == curt || (MODE != 0 && (j_) + W / 64 == curt);     \
        f32x16 p0, p1; \
        if (MODE == 0) { f32x16 cin;     \
            _Pragma("unroll") for (int r = 0; r < 16; ++r) cin[r] = sel ? negm[r] : -INFINITY; \
            qk_tile(p0, p1, (st_) + kvsel * 8192, qr, cin, r32, hi); } \
        else qk_tile(p0, p1, (st_) + kvsel * 8192, qr, negm, r32, hi); \
        if (edge) { _Pragma("unroll") for (int r = 0; r < 16; ++r) { const int kp = kb + (r & 3) + 8 * (r >> 2); bool v0, v1; \
                if (MODE == 0) { v0 = kp <= tq; v1 = kp + 32 <= tq; } \
                else if (MODE == 3) { v0 = 16 * kp + 31 <= tq; v1 = 16 * (kp + 32) + 31 <= tq; } \
                else { v0 = kp <= tq && kp + W > tq; v1 = kp + 32 <= tq && kp + 32 + W > tq; } \
                p0[r] = v0 ? p0[r] : -INFINITY; p1[r] = v1 ? p1[r] : -INFINITY; } } \
        softmax_step(m, negm, l, o0, o1, p0, p1, pw, wsf, r32, hi); } while (0)
    for (;;) {
        const int pend = (nleft - 1 < NS - 3 ? nleft - 1 : NS - 3) * NKV;
        switch (pend) { case 0: ATT_WB(0); break; case 1: ATT_WB(2); break; case 2: ATT_WB(4); break; case 3: ATT_WB(6); break; case 4: ATT_WB(8); break; default: ATT_WB(10); break; }
        if (remi) ATT_ISSUE();
        const int j = __builtin_ctz(remc); remc &= remc - 1; --nleft;
        const LAS unsigned char* st = lds + L_STG + slot_c * SLOT; slot_c = (slot_c + 1) & (NS - 1);
        if (lead) { ATT_QS(j, st); pv_tile(o0, o1, st + NKV * 8192 + kvsel * 8192, pw, lane, hi); }
        else { if (havep) pv_tile(o0, o1, stp + NKV * 8192 + kvsel * 8192, pw, lane, hi); ATT_QS(j, st); }
        stp = st; havep = true;
        TSA(lds, 60 + MODE);
        if (nleft == 0) break;
    }
    if (!lead) pv_tile(o0, o1, stp + NKV * 8192 + kvsel * 8192, pw, lane, hi);
#undef ATT_QS
#undef ATT_ISSUE
#undef ATT_WB
}
__device__ __forceinline__ void stage_norm_store(const f32x16& o0, const f32x16& o1, bf16* ynb  , LAS unsigned char* lds, int wave, int lane) {
    const int r32 = lane & 31, hi = lane >> 5, h = wave & 3, th = wave >> 2;
    LAS bf16* OST = (LAS bf16*)(lds + L_STG);
    ATT_LBAR();
#pragma unroll
    for (int r = 0; r < 16; ++r) { LAS bf16* p = OST + (32 * th + crow(r, hi)) * OSTP + h * 64 + r32;
        p[0] = (bf16)(pk2(o0[r], 0.f) & 0xffffu); p[32] = (bf16)(pk2(o1[r], 0.f) & 0xffffu); }
    ATT_LBAR();
    f32x4 vv[8]; float ssn[8];
#pragma unroll
    for (int i = 0; i < 8; ++i) { const u32x2 w = *(const LAS u32x2*)(OST + (8 * wave + i) * OSTP + 4 * lane); vv[i] = (f32x4){bflo(w.x), bfhi(w.x), bflo(w.y), bfhi(w.y)}; ssn[i] = sq4(vv[i]); }
#pragma unroll
    for (int i = 0; i < 8; ++i) ssn[i] = wave_sum(ssn[i]);
#pragma unroll
    for (int i = 0; i < 8; ++i) st4bf(ynb + (size_t)(8 * wave + i) * D + 4 * lane, vv[i] * __builtin_amdgcn_rsqf(ssn[i] * (1.f / 256.f) + EPS));
}
__device__ __forceinline__ void attn_unit(Frame& F, int L, int b, int qt) {
    LAS unsigned char* lds = F.lds;
    int tid = F.tid; asm volatile("" : "+v"(tid));
    const int wave = F.wave, lane = tid & 63, r32 = lane & 31, hi = lane >> 5, h = wave & 3, th = wave >> 2;
    const int t0 = qt * 64, cur = qt, qrow = 32 * th + r32, tq = t0 + qrow;
    const size_t mrow = (size_t)b * T + tq;
    LAS float* wsf = (LAS float*)(lds + L_WSF) + wave * 64;
    LAS float* IA = (LAS float*)(lds + L_IA); LAS float* IB = (LAS float*)(lds + L_IB); LAS float* SC = (LAS float*)(lds + L_SC);
    LAS unsigned* SEL = (LAS unsigned*)(lds + L_SEL); LAS unsigned* UNI = (LAS unsigned*)(lds + L_UNI);
    const size_t tb = (size_t)b * 32 * 4096;
    bf16x8 qr[4];
#pragma unroll
    for (int d0 = 0; d0 < 4; ++d0) qr[d0] = *(const bf16x8*)(F_QA + mrow * 256 + h * 64 + d0 * 16 + hi * 8);
    const float* gp = F_GATES + mrow * 12 + h * 3; const float g0 = gp[0], g1 = gp[1], g2 = gp[2];
    float mb, lb; f32x16 ob0, ob1;
    for (int rep = 0; rep < ((PROBE_ATT & 4) ? 2 : 1); ++rep) {
        if (rep) { ATT_LBAR(); }
        if (tid == 0) UNI[0] = 0u;
        run_branch<3>(3u, F_KC + (size_t)b * 2 * 4096, F_VC + (size_t)b * 2 * 4096, 0, 0u, tq, qr, mb, lb, ob0, ob1, lds, wsf, wave, lane);
        TSA(lds, 20);
        const float lt = pair_sum(lb); const float inv = lt > 0.f ? 1.0f / lt : 0.f;
        f32x16 oc0 = (f32x16){}, oc1 = (f32x16){}; scale_rows(oc0, oc1, ob0, ob1, g0 * inv, wsf, r32, hi);
        LAS float* ia = IA + (h * 64 + qrow) * 33; LAS float* ib = IB + (h * 64 + qrow) * 33;
#pragma unroll
        for (int tl = 0; tl < 2; ++tl) { f32x16 p0, p1; const f32x16 z16 = (f32x16){}; qk_tile(p0, p1, lds + L_STG + tl * 16384, qr, z16, r32, hi);
#pragma unroll
            for (int r = 0; r < 16; ++r) { const int n = 64 * tl + crow(r, hi);
                p0[r] = 16 * n + 31 <= tq ? __builtin_amdgcn_exp2f(p0[r] - mb) * inv : 0.f; p1[r] = 16 * (n + 32) + 31 <= tq ? __builtin_amdgcn_exp2f(p1[r] - mb) * inv : 0.f; }
#pragma unroll
            for (int G = 0; G < 4; ++G) {
                ia[hi + 2 * (G + 8 * tl)] = (p0[4 * G] + p0[4 * G + 1]) + (p0[4 * G + 2] + p0[4 * G + 3]); ib[hi + 2 * (G + 8 * tl)] = p0[4 * G + 3];
                ia[hi + 2 * (G + 4 + 8 * tl)] = (p1[4 * G] + p1[4 * G + 1]) + (p1[4 * G + 2] + p1[4 * G + 3]); ib[hi + 2 * (G + 4 + 8 * tl)] = p1[4 * G + 3]; } }
        ATT_LBAR();
        const int q = tid >> 3, jg = tid & 7, tqq = t0 + q;
#pragma unroll
        for (int i = 0; i < 4; ++i) { const int j = 4 * jg + i; float imp = 0.f;
#pragma unroll
            for (int hh = 0; hh < 4; ++hh) { imp += IA[(hh * 64 + q) * 33 + j]; if (j > 0) imp += IB[(hh * 64 + q) * 33 + j - 1]; }
            const bool forced = j == 0 || j == cur || j == cur - 1, future = j * 64 > tqq;
            SC[q * 36 + j] = forced ? 1e4f : (future ? -1.0f : imp); }
        ATT_LBAR();
        unsigned bits = 0u;
        { f32x4 sc4[8];
#pragma unroll
          for (int g = 0; g < 8; ++g) sc4[g] = *(const LAS f32x4*)(SC + q * 36 + 4 * g);
          const f32x4 mine = *(const LAS f32x4*)(SC + q * 36 + 4 * jg);
#pragma unroll
          for (int i = 0; i < 4; ++i) { const int j = 4 * jg + i; const float sj = mine[i]; int rank = 0;
#pragma unroll
              for (int k = 0; k < 32; ++k) { const float sk = sc4[k >> 2][k & 3]; rank += (sk > sj || (sk == sj && k < j)) ? 1 : 0; }
              if (rank < 8) bits |= 1u << j; } }
        bits |= __shfl_xor(bits, 1); bits |= __shfl_xor(bits, 2); bits |= __shfl_xor(bits, 4);
        if (jg == 0) { SEL[q] = bits; atomicOr((unsigned*)UNI, bits); }
        ATT_LBAR();
        ots_put(oc0, oc1, lds, wave, lane);
    }
    TSA(lds, 21);
    { const unsigned selm = SEL[qrow]; const unsigned uni = UNI[0] & ((2u << cur) - 1u);
      if (PROBE_ATT & 1) run_branch<0>(uni, F_KSI + tb, F_VSI + tb, 0, selm, tq, qr, mb, lb, ob0, ob1, lds, wsf, wave, lane);
      run_branch<0>(uni, F_KSI + tb, F_VSI + tb, 0, selm, tq, qr, mb, lb, ob0, ob1, lds, wsf, wave, lane);
      const float lt = pair_sum(lb); f32x16 ot0, ot1; ots_get(ot0, ot1, lds, wave, lane); scale_rows(ot0, ot1, ob0, ob1, g1 / lt, wsf, r32, hi); ots_put(ot0, ot1, lds, wave, lane); }
    TSA(lds, 22);
    { const int lo = cur >= 8 ? cur - 8 : 0; const unsigned tiles = ((2u << cur) - 1u) & ~((1u << lo) - 1u);
      if (PROBE_ATT & 2) run_branch<1>(tiles, F_KWI + tb, F_VWI + tb, 0, 0u, tq, qr, mb, lb, ob0, ob1, lds, wsf, wave, lane);
      run_branch<1>(tiles, F_KWI + tb, F_VWI + tb, 0, 0u, tq, qr, mb, lb, ob0, ob1, lds, wsf, wave, lane);
      const float lt = pair_sum(lb); f32x16 ot0, ot1; ots_get(ot0, ot1, lds, wave, lane); scale_rows(ot0, ot1, ob0, ob1, g2 / lt, wsf, r32, hi);
      stage_norm_store(ot0, ot1, F_YN + ((size_t)b * T + t0) * D + 0, lds, wave, lane); }
    for (int rep = 0; rep < ((PROBE_ATT & 16) ? 2 : 1); ++rep) {
#pragma unroll
        for (int d0 = 0; d0 < 4; ++d0) qr[d0] = *(const bf16x8*)(F_QC + mrow * 256 + h * 64 + d0 * 16 + hi * 8);
        const int lo = cur >= 2 ? cur - 2 : 0; const unsigned tiles = ((2u << cur) - 1u) & ~((1u << lo) - 1u);
        run_branch<2>(tiles, F_CKI + tb, F_CVI + tb, h >> 1, 0u, tq, qr, mb, lb, ob0, ob1, lds, wsf, wave, lane);
        TSA(lds, 25);
        const float sink2 = FIN(I_SINK)[L * 4 + h] * LOG2E;
        const float mf = fmaxf(mb, sink2), sc = __builtin_amdgcn_exp2f(mb - mf);
        const float lt = pair_sum(lb) * sc + __builtin_amdgcn_exp2f(sink2 - mf);
        f32x16 ot0 = (f32x16){}, ot1 = (f32x16){};
        scale_rows(ot0, ot1, ob0, ob1, sc / lt, wsf, r32, hi);
        stage_norm_store(ot0, ot1, F_YN + ((size_t)b * T + t0) * D + 512, lds, wave, lane);
        TSA(lds, 26);
    }
}
__device__ __forceinline__ void attn_phase(Frame& F, int L) {
    for (int w = F.vcu; w < 256; w += F.G) { const int b = w >> 4, i = w & 15;
#pragma nounroll
        for (int u2 = 0; u2 < 2; ++u2) attn_unit(F, L, b, u2 ? 31 - i : i); }
    ATT_LBAR();
}
}

__global__ void __launch_bounds__(NWAVES * 64, 2) fwd(Args args) {
    extern __shared__ __attribute__((aligned(16))) unsigned char lds[];
    Frame F;
    F.lds = (LAS unsigned char*)lds;
    F.tid = threadIdx.x; F.lane = F.tid & 63; F.wave = __builtin_amdgcn_readfirstlane(F.tid >> 6);
    F.G = gridDim.x; { const int bx = blockIdx.x; F.vcu = (F.G % 8 == 0) ? (bx % 8) * (F.G / 8) + bx / 8 : bx; }
    F.a = &args;
    unsigned char* ws = args.ws;
    volatile LAS unsigned* MISC = (volatile LAS unsigned*)(F.lds + MISC_OFF);
    if (F.tid < 64) MISC[F.tid] = 0u;
    __syncthreads();
#define GRID_BAR() do { XcdBarrier b2_ = bar; { unsigned xx_ = b2_.x; asm volatile("" : "+s"(xx_)); b2_.x = xx_; }     \
        xcd_barrier(b2_); if (PROBE_DUP & 1024) xcd_barrier(b2_); __builtin_amdgcn_s_waitcnt(0); } while (0)
    XcdBarrier bar = xcd_barrier_post((unsigned*)(ws + WS_CTL) + CW_BAR, MISC + 8);

#ifndef PH_MASK
#define PH_MASK 127
#endif
#ifndef PROBE_DUP
#define PROBE_DUP 0
#endif
    TS(F.lds, 0);
    if (PH_MASK & 1) prologue(F);
    TS(F.lds, 1);
    if (PROBE_DUP & 1) prologue(F);
    GRID_BAR(); TS(F.lds, 14);
    for (int s = 0; s < 2 * DEPTH; ++s) {
        const int L = s >> 1, which = s & 1;
        const bool up8 = (UP8_MASK >> s) & 1u, dn8 = (DN8_MASK >> s) & 1u;
        if (PH_MASK & 2) {
            const bf16* wt = (const bf16*)((unsigned char*)F_W13T + (size_t)s * NF1 * D * 2); pg8::StaticOrder S; S.init(M, NF1, F.G, (int)blockIdx.x);
            if (up8) { pg8::Gemm g{(const bf16*)F_X8, wt, M, NF1, D / 2};
                if (PROBE_DUP & 128) { pg8::EpiNull EN{F_GATES}; pg8::gemm_phase<pg8::EpiNull, pg8::StaticOrder, true, true, true>(F.lds, g, S, EN); }
                if (PROBE_DUP & 256) { pg8::EpiNull EN{F_GATES}; pg8::FixedOrder<1> S2; S2.init(M, NF1, F.G, (int)blockIdx.x); pg8::gemm_phase<pg8::EpiNull, pg8::FixedOrder<1>, true, true, true>(F.lds, g, S2, EN); }
                if (PROBE_DUP & 512) { pg8::EpiNull EN{F_GATES}; pg8::FixedOrder<3> S2; S2.init(M, NF1, F.G, (int)blockIdx.x); pg8::gemm_phase<pg8::EpiNull, pg8::FixedOrder<3>, true, true, true>(F.lds, g, S2, EN); }
                if (dn8) { pg8::EpiSwiglu<true> E{(void*)F_ACT, DFF, F_SSQ, 1.0f / W8_SCALE, ACT8_SCALE, F.lds + pg8::STAGE_BYTES, 0, 0, 0}; for (int rep = 0; rep < ((PROBE_DUP & 2) ? 2 : 1); ++rep) pg8::gemm_phase<pg8::EpiSwiglu<true>, pg8::StaticOrder, true, true, true, 1>(F.lds, g, S, E); }
                else if (((UP8_MASK & ~DN8_MASK) & 0xFu) != 0u) { pg8::EpiSwiglu<false> E{(void*)F_ACT, DFF, F_SSQ, 1.0f / W8_SCALE, 1.0f, F.lds + pg8::STAGE_BYTES, 0, 0, 0}; for (int rep = 0; rep < ((PROBE_DUP & 2) ? 2 : 1); ++rep) pg8::gemm_phase<pg8::EpiSwiglu<false>, pg8::StaticOrder, true, true, true>(F.lds, g, S, E); } }
            else { pg8::Gemm g{F_XB, wt, M, NF1, D};
                if (dn8) { if (((~UP8_MASK & DN8_MASK) & 0xFu) != 0u) { pg8::EpiSwiglu<true> E{(void*)F_ACT, DFF, F_SSQ, 1.0f, ACT8_SCALE, F.lds + pg8::STAGE_BYTES, 0, 0, 0}; for (int rep = 0; rep < ((PROBE_DUP & 2) ? 2 : 1); ++rep) pg8::gemm_phase<pg8::EpiSwiglu<true>, pg8::StaticOrder, true, true, false, 2>(F.lds, g, S, E); } }
                else if (((~UP8_MASK & ~DN8_MASK) & 0xFu) != 0u) { pg8::EpiSwiglu<false> E{(void*)F_ACT, DFF, F_SSQ, 1.0f, 1.0f, F.lds + pg8::STAGE_BYTES, 0, 0, 0}; for (int rep = 0; rep < ((PROBE_DUP & 2) ? 2 : 1); ++rep) pg8::gemm_phase<pg8::EpiSwiglu<false>, pg8::StaticOrder, true, true, false>(F.lds, g, S, E); } }
        }
        TS(F.lds, 2); GRID_BAR(); TS(F.lds, 3);
        if (PH_MASK & 4) {
            const bf16* wt = (const bf16*)((unsigned char*)F_W2T + (size_t)s * D * DFF * 2); pg8::StaticOrder S; S.init(M, D, F.G, (int)blockIdx.x);
            const int last = (s + 1 == 2 * DEPTH) ? 1 : 0, w8 = ((s & 1) && !last && ((UP8_MASK >> (s + 1)) & 1u)) ? 1 : 0;
            if (dn8) { if (DN8_MASK & 0xFu) { pg8::Gemm g{F_ACT, wt, M, D, DFF / 2}; pg8::EpiRes E{F_XB, F_SSQ, 1, F_X8, FOUT, w8, last}; pg8::gemm_phase<pg8::EpiRes, pg8::StaticOrder, true, true, true, 3>(F.lds, g, S, E); } }
            else if ((~DN8_MASK) & 0xFu) { pg8::Gemm g{F_ACT, wt, M, D, DFF}; pg8::EpiRes E{F_XB, F_SSQ, 0, F_X8, FOUT, w8, last}; pg8::gemm_phase<pg8::EpiRes, pg8::StaticOrder, true, true, false, 4>(F.lds, g, S, E); }
        }
        TS(F.lds, 4); if (s + 1 < 2 * DEPTH) GRID_BAR(); TS(F.lds, 5);
        if (which == 0) {
            if (PH_MASK & 8) {
                pg8::Gemm g{F_XB, F_WINT + (size_t)L * NU * D, M, NU, D}; pg8::StaticOrder S; S.init(M, NU, F.G, (int)blockIdx.x);
                pg8::EpiScaleBf16 E{F_U, NU, F_SSQ, F.lds + pg8::STAGE_BYTES, 0, 0, 0};
                for (int rep = 0; rep < ((PROBE_DUP & 8) ? 2 : 1); ++rep) pg8::gemm_phase<pg8::EpiScaleBf16, pg8::StaticOrder, true, true, false, 5>(F.lds, g, S, E);
            }
            TS(F.lds, 6); GRID_BAR(); TS(F.lds, 7);
            if (PH_MASK & 16) prep_phase(F, L);
            if (PROBE_DUP & 16) prep_phase(F, L);
            TS(F.lds, 8); GRID_BAR(); TS(F.lds, 9);
            if (PH_MASK & 32) att::attn_phase(F, L);
            if (PROBE_DUP & 32) att::attn_phase(F, L);
            TS(F.lds, 10); GRID_BAR(); TS(F.lds, 11);
            if (PH_MASK & 64) {
                pg8::Gemm g{F_YN, F_WOUTT + (size_t)L * D * D, M, D, D}; pg8::StaticOrder S; S.init(M, D, F.G, (int)blockIdx.x);
                pg8::EpiRes E{F_XB, F_SSQ, 2, F_X8, FOUT, (int)((UP8_MASK >> (2 * L + 1)) & 1u), 0};
                pg8::gemm_phase<pg8::EpiRes, pg8::StaticOrder, true, true, false, 6>(F.lds, g, S, E);
            }
            TS(F.lds, 12); GRID_BAR(); TS(F.lds, 13);
        }
    }
    if (PROBE_TS && blockIdx.x == 0 && threadIdx.x == 0) {
        volatile LAS unsigned* m_ = (volatile LAS unsigned*)(F.lds + 163648); const unsigned long long t0_ = __builtin_amdgcn_s_memrealtime(), d_ = (unsigned long long)m_[1] * TS_AMP;
        while (__builtin_amdgcn_s_memrealtime() - t0_ < d_) __builtin_amdgcn_s_sleep(8); }
}

extern "C" void kernel_launch(void* const* d_in, const int* in_sizes, int n_in, void* d_out, int out_size, void* d_ws, size_t ws_size, hipStream_t stream) {
    static int grid = 0;
    if (grid == 0) {
        if (n_in != 29 || in_sizes[0] != M * D || out_size != M * D || ws_size < WS_END) { fprintf(stderr, "kernel_launch: unexpected shapes (n_in %d, in0 %d, out %d, ws %zu); nothing launched\n", n_in, n_in > 0 ? in_sizes[0] : -1, out_size, ws_size); grid = -1; return; }
        int dev = 0, cus = 0, per_cu = 0;
        if (hipGetDevice(&dev) != hipSuccess || hipDeviceGetAttribute(&cus, hipDeviceAttributeMultiprocessorCount, dev) != hipSuccess) { grid = -1; return; }
        if (hipFuncSetAttribute((const void*)fwd, hipFuncAttributeMaxDynamicSharedMemorySize, LDS_BYTES) != hipSuccess) { fprintf(stderr, "kernel_launch: hipFuncSetAttribute failed\n"); grid = -1; return; }
        if (hipOccupancyMaxActiveBlocksPerMultiprocessor(&per_cu, (const void*)fwd, NWAVES * 64, LDS_BYTES) != hipSuccess || per_cu < 1) fprintf(stderr, "kernel_launch: occupancy query says %d\n", per_cu);
        (void)hipGetLastError();
        grid = cus;
    }
    if (grid < 0) return;
    if (hipMemsetAsync((char*)d_ws + WS_CTL, 0, CTL_ZERO_BYTES, stream) != hipSuccess) return;
    Args a{};
    for (int i = 0; i < 29; ++i) a.in[i] = (const float*)d_in[i];
    a.out = (float*)d_out; a.ws = (unsigned char*)d_ws;
    hipLaunchKernelGGL(fwd, dim3(grid), dim3(NWAVES * 64), LDS_BYTES, stream, a);
}
```

```cpp
#include <hip/hip_runtime.h>
#include <cstdio>
#include <cstdint>
#ifndef PROBE_TS
#define PROBE_TS 0
#endif
#define TS_AMP 4u
#define TS(ldsbase, k) do { if (PROBE_TS && blockIdx.x == 0 && threadIdx.x == 0) { volatile __attribute__((address_space(3))) unsigned* m_ = (volatile __attribute__((address_space(3))) unsigned*)((ldsbase) + 163648); \
        const unsigned t_ = (unsigned)__builtin_amdgcn_s_memrealtime(); if ((k) == PROBE_TS) m_[1] += t_ - m_[0]; m_[0] = t_; } } while (0)
struct KArgs { const float* in[29]; float* out; unsigned char* ws; };
namespace pg8 {
#define PG8_LAS __attribute__((address_space(3)))
typedef unsigned short bf16_t;
typedef short bf16x8 __attribute__((ext_vector_type(8)));
typedef float f32x4 __attribute__((ext_vector_type(4)));
typedef unsigned u32x4 __attribute__((ext_vector_type(4)));
constexpr int BM = 256, BK = 64, HALF = 128, HTB = HALF * BK * 2  , STAGE_BYTES = 8 * HTB, NXCD = 8, WGM = 8;

__host__ __device__ __forceinline__ int lds_byte(int r, int c) { const int st = (r >> 4) * 2 + (c >> 5), rr = r & 15, cc = c & 31, ob = rr * 64 + cc * 2; return st * 1024 + (ob ^ (((ob >> 9) & 1) << 5)); }
__host__ __device__ __forceinline__ void stage_rc(int b, int& R, int& C) { const int st = b / 1024, sb = b % 1024, swz = sb ^ (((sb >> 9) & 1) << 5); R = (st >> 1) * 16 + swz / 64; C = (st & 1) * 32 + (swz % 64) / 2; }
__host__ __device__ __forceinline__ int perm32(int rho) { const int n = rho >> 4, i = rho & 15; return 8 * (i >> 2) + 4 * n + (i & 3); }

struct Unit { int pm, pn; };
struct Gemm { const bf16_t* A; const bf16_t* Bt; int M, N, K; };

struct StaticOrder {
    int nM, nN, nwg, G, c;
    __host__ __device__ void init(int M, int N, int G_, int c_) { nM = M / BM; nN = N / BM; nwg = nM * nN; G = G_; c = c_; }
    __host__ __device__ bool next(int i, Unit& u) const {
        const long L = (long)i * G + c; if (L >= nwg) return false;
        int wgid = (int)L; { const int q = nwg / NXCD, r = nwg % NXCD, xcd = wgid % NXCD, off = wgid / NXCD; wgid = (xcd < r ? xcd * (q + 1) : r * (q + 1) + (xcd - r) * q) + off; }
        const int nig = WGM * nN, gid = wgid / nig, fm = gid * WGM, gsz = (nM - fm) < WGM ? (nM - fm) : WGM;
        u.pm = fm + ((wgid % nig) % gsz); u.pn = (wgid % nig) / gsz; return true;
    }
    __device__ __forceinline__ void a_ready(const Unit&) const {}
    __device__ __forceinline__ void done(const Unit&) const {}
};

__device__ __forceinline__ unsigned cvt_pk_bf16(float lo, float hi) { unsigned r; asm volatile("v_cvt_pk_bf16_f32 %0, %1, %2" : "=v"(r) : "v"(lo), "v"(hi)); return r; }

typedef unsigned u32x2 __attribute__((ext_vector_type(2)));
typedef int i32x4 __attribute__((ext_vector_type(4)));
typedef int i32x8 __attribute__((ext_vector_type(8)));
#ifndef MFMA8_SCALE
#define MFMA8_SCALE 1
#endif
__device__ __forceinline__ i32x8 cat8(bf16x8 a, bf16x8 b) { return __builtin_shufflevector(__builtin_bit_cast(i32x4, a), __builtin_bit_cast(i32x4, b), 0, 1, 2, 3, 4, 5, 6, 7); }
__device__ __forceinline__ void mfma8(f32x4& acc, const i32x8& b, const i32x8& a, int sc) {
#if MFMA8_SCALE
    asm volatile("v_mfma_scale_f32_16x16x128_f8f6f4 %0, %1, %2, %0, %3, %3 op_sel_hi:[0,0,0]" : "+v"(acc) : "v"(b), "v"(a), "v"(sc));
#else
    asm volatile("v_mfma_f32_16x16x128_f8f6f4 %0, %1, %2, %0" : "+v"(acc) : "v"(b), "v"(a));
#endif
}
__device__ __forceinline__ unsigned pk4_fp8(float a, float b, float c, float d) { int w = 0; w = __builtin_amdgcn_cvt_pk_fp8_f32(a, b, w, false); w = __builtin_amdgcn_cvt_pk_fp8_f32(c, d, w, true); return (unsigned)w; }
__device__ __forceinline__ unsigned pkbf(float lo, float hi) { typedef float f2_t __attribute__((ext_vector_type(2))); typedef __bf16 b2_t __attribute__((ext_vector_type(2))); f2_t v = {lo, hi}; b2_t b = __builtin_convertvector(v, b2_t); return __builtin_bit_cast(unsigned, b); }
__device__ __forceinline__ float bf_lo(unsigned u) { return __builtin_bit_cast(float, u << 16); }
__device__ __forceinline__ float bf_hi(unsigned u) { return __builtin_bit_cast(float, u & 0xffff0000u); }
__device__ __forceinline__ float swap32_add(float v) { auto rr = __builtin_amdgcn_permlane32_swap(__float_as_uint(v), __float_as_uint(v), false, false); return __uint_as_float(rr[0]) + __uint_as_float(rr[1]); }
__device__ __forceinline__ void fill_rstd_tbl(PG8_LAS unsigned char* tblp, const float* ssq, int pm, int wid, int lane) {
    const int r = wid * 32 + (lane >> 1), hf = lane & 1; const float* p = ssq + (size_t)(pm * BM + r) * 16 + 8 * hf;
    const f32x4 a = *(const f32x4*)p, b = *(const f32x4*)(p + 4);
    float s = ((a[0] + a[1]) + (a[2] + a[3])) + ((b[0] + b[1]) + (b[2] + b[3]));
    s += __builtin_bit_cast(float, __builtin_amdgcn_update_dpp(0, __builtin_bit_cast(int, s), 0xB1, 0xf, 0xf, true));
    if (hf == 0) ((PG8_LAS float*)tblp)[r] = __builtin_amdgcn_rsqf(s * (1.0f / 1024.0f) + 1e-6f);
}
__device__ __forceinline__ void rows_rstd(float (&rs)[2][4], const PG8_LAS unsigned char* tblp, int wr, int fr, float scale) {
#pragma unroll
    for (int ai = 0; ai < 2; ++ai)
#pragma unroll
        for (int m = 0; m < 4; ++m) rs[ai][m] = ((const PG8_LAS float*)tblp)[ai * HALF + wr * 64 + m * 16 + fr] * scale;
}
template <bool F8> struct EpiSwiglu {
    static constexpr bool PERM = true, AFTER_DRAIN = false, ROW_RSTD = true;
    void* O; int ldc; const float* ssq; float insc, oscale; PG8_LAS unsigned char* tbl; mutable int pmA, pmB, pmC;
    __device__ __forceinline__ void set_panels(int a, int b, int c) const { pmA = a; pmB = b; pmC = c; }
    __device__ __forceinline__ void fill_rstd(PG8_LAS unsigned char* t, int pm, int wid, int lane) const { fill_rstd_tbl(t, ssq, pm, wid, lane); }
    __device__ __forceinline__ void operator()(const f32x4 (&acc)[2][2][4][2], const Unit& u, int wr, int wc, int fr_, int fq_) const {
        int tl_ = threadIdx.x; asm volatile("" : "+v"(tl_)); const int fr = tl_ & 15, fq = (tl_ >> 4) & 3; (void)fr_; (void)fq_;
        const int row0 = u.pm * BM + wr * 64 + fr, col0 = u.pn * HALF + wc * 32 + 8 * fq;
        float rsv[2][4]; rows_rstd(rsv, tbl + (u.pm == pmA ? 0 : (u.pm == pmB ? 1024 : (u.pm == pmC ? 2048 : 3072))), wr, fr, insc);
#pragma unroll
        for (int ai = 0; ai < 2; ++ai)
#pragma unroll
            for (int m = 0; m < 4; ++m) { const int row = row0 + ai * HALF + m * 16; const float rs = rsv[ai][m], rsb = rs * (F8 ? oscale : 1.0f); f32x4 ov[2];
#pragma unroll
                for (int n = 0; n < 2; ++n) { const f32x4 a = acc[ai][0][m][n] * rs, b = acc[ai][1][m][n] * rsb, tt = a * -1.4426950408889634f; f32x4 r;
#pragma unroll
                    for (int e = 0; e < 4; ++e) r[e] = __builtin_amdgcn_rcpf(1.0f + __builtin_amdgcn_exp2f(tt[e]));
                    ov[n] = (a * b) * r; }
                const float o[8] = {ov[0][0], ov[0][1], ov[0][2], ov[0][3], ov[1][0], ov[1][1], ov[1][2], ov[1][3]};
                if constexpr (F8) { u32x2 w; w.x = pk4_fp8(o[0], o[1], o[2], o[3]); w.y = pk4_fp8(o[4], o[5], o[6], o[7]);
                    *(u32x2*)((unsigned char*)O + (size_t)row * ldc + col0) = w; }
                else { u32x4 w; w.x = pkbf(o[0], o[1]); w.y = pkbf(o[2], o[3]); w.z = pkbf(o[4], o[5]); w.w = pkbf(o[6], o[7]);
                    *(u32x4*)((bf16_t*)O + (size_t)row * ldc + col0) = w; } }
    }
};
struct EpiScaleBf16 {
    static constexpr bool PERM = true, AFTER_DRAIN = false, ROW_RSTD = true;
    bf16_t* O; int ldc; const float* ssq; PG8_LAS unsigned char* tbl; mutable int pmA, pmB, pmC;
    __device__ __forceinline__ void set_panels(int a, int b, int c) const { pmA = a; pmB = b; pmC = c; }
    __device__ __forceinline__ void fill_rstd(PG8_LAS unsigned char* t, int pm, int wid, int lane) const { fill_rstd_tbl(t, ssq, pm, wid, lane); }
    __device__ __forceinline__ void operator()(const f32x4 (&acc)[2][2][4][2], const Unit& u, int wr, int wc, int fr_, int fq_) const {
        int tl_ = threadIdx.x; asm volatile("" : "+v"(tl_)); const int fr = tl_ & 15, fq = (tl_ >> 4) & 3; (void)fr_; (void)fq_;
        const int row0 = u.pm * BM + wr * 64 + fr, col0 = u.pn * BM + wc * 32 + 8 * fq;
        float rsv[2][4]; rows_rstd(rsv, tbl + (u.pm == pmA ? 0 : (u.pm == pmB ? 1024 : (u.pm == pmC ? 2048 : 3072))), wr, fr, 1.0f);
#pragma unroll
        for (int ai = 0; ai < 2; ++ai)
#pragma unroll
            for (int m = 0; m < 4; ++m) { const int row = row0 + ai * HALF + m * 16; const float rs = rsv[ai][m];
#pragma unroll
                for (int bj = 0; bj < 2; ++bj) { const f32x4 v0 = acc[ai][bj][m][0] * rs, v1 = acc[ai][bj][m][1] * rs;
                    u32x4 w; w.x = pkbf(v0[0], v0[1]); w.y = pkbf(v0[2], v0[3]); w.z = pkbf(v1[0], v1[1]); w.w = pkbf(v1[2], v1[3]);
                    *(u32x4*)(O + (size_t)row * ldc + col0 + bj * HALF) = w; } }
    }
};
struct EpiRes {
    static constexpr bool PERM = false, AFTER_DRAIN = false, ROW_RSTD = false;
    bf16_t* xb; float* ssq; int mode; unsigned char* x8p; float* outp; int w8, fin;
    __device__ __forceinline__ void operator()(const f32x4 (&acc)[2][2][4][2], const Unit& u, int wr, int wc, int fr_, int fq_) const {
        int tl_ = threadIdx.x; asm volatile("" : "+v"(tl_)); const int fr = tl_ & 15, fq = (tl_ >> 4) & 3; (void)fr_; (void)fq_;
        const int row0 = u.pm * BM + wr * 64 + fr, col0 = u.pn * BM + wc * 32 + 4 * fq;
        int md_ = __builtin_amdgcn_readfirstlane(mode), w8_ = __builtin_amdgcn_readfirstlane(w8), fin_ = __builtin_amdgcn_readfirstlane(fin); asm volatile("" : "+s"(md_), "+s"(w8_), "+s"(fin_));
        const float alpha = md_ == 0 ? 0.5f : (md_ == 1 ? 0.5f / 256.0f : 1.0f);
        float* const outf = fin_ ? outp : nullptr; unsigned char* const x8 = w8_ ? x8p : nullptr;
#pragma unroll
        for (int ai = 0; ai < 2; ++ai) { u32x2 old[4][2][2];
#pragma unroll
            for (int m = 0; m < 4; ++m)
#pragma unroll
                for (int bj = 0; bj < 2; ++bj)
#pragma unroll
                    for (int n = 0; n < 2; ++n) old[m][bj][n] = *(const u32x2*)(xb + (size_t)(row0 + ai * HALF + m * 16) * 1024 + col0 + bj * HALF + n * 16);
            float ssv[4];
#pragma unroll
            for (int m = 0; m < 4; ++m) { const int row = row0 + ai * HALF + m * 16; const size_t off = (size_t)row * 1024 + col0; float ss = 0.f;
#pragma unroll
                for (int bj = 0; bj < 2; ++bj)
#pragma unroll
                    for (int n = 0; n < 2; ++n) { const u32x2 ow = old[m][bj][n]; const f32x4 xo = (f32x4){bf_lo(ow.x), bf_hi(ow.x), bf_lo(ow.y), bf_hi(ow.y)}; const f32x4 xn = xo + acc[ai][bj][m][n] * alpha;
                        if (outf) *(f32x4*)(outf + off + bj * HALF + n * 16) = xn;
                        else { ss += (xn[0] * xn[0] + xn[1] * xn[1]) + (xn[2] * xn[2] + xn[3] * xn[3]);
                            u32x2 w; w.x = pkbf(xn[0], xn[1]); w.y = pkbf(xn[2], xn[3]); *(u32x2*)(xb + off + bj * HALF + n * 16) = w;
                            if (x8) *(unsigned*)(x8 + off + bj * HALF + n * 16) = pk4_fp8(xn[0], xn[1], xn[2], xn[3]); } }
                ssv[m] = ss; }
            if (!outf) { float tv[4];
#pragma unroll
                for (int m = 0; m < 4; ++m) ssv[m] = swap32_add(ssv[m]);
#pragma unroll
                for (int m = 0; m < 4; ++m) tv[m] = __shfl_xor(ssv[m], 16);
#pragma unroll
                for (int m = 0; m < 4; ++m) if (fq == 0) ssq[(size_t)(row0 + ai * HALF + m * 16) * 16 + u.pn * 4 + wc] = ssv[m] + tv[m]; }
            asm volatile("" ::: "memory"); }
    }
};

struct EpiNull {
    static constexpr bool PERM = true, AFTER_DRAIN = false, ROW_RSTD = false;
    float* sink;
    __device__ __forceinline__ void operator()(const f32x4 (&acc)[2][2][4][2], const Unit& u, int wr, int wc, int fr, int fq) const {
        float s = 0.f;
#pragma unroll
        for (int ai = 0; ai < 2; ++ai)
#pragma unroll
            for (int bj = 0; bj < 2; ++bj)
#pragma unroll
                for (int m = 0; m < 4; ++m)
#pragma unroll
                    for (int n = 0; n < 2; ++n) s += acc[ai][bj][m][n][0];
        if (s == 12345.678f) sink[0] = s;
    }
};
template <int PIN> struct FixedOrder : StaticOrder {
    __device__ bool next(int i, Unit& u) const { const bool ok = StaticOrder::next(i, u); if (PIN & 1) u.pn = 0; if (PIN & 2) u.pm = (int)(blockIdx.x & 7); return ok; }
};
template <class Epi, class Sched, bool ALIGN_EPI = false, bool SP2 = false, bool FP8 = false, int GID = 0>
__device__ __forceinline__ void gemm_phase(PG8_LAS unsigned char* lds, const Gemm g, const Sched& S, const Epi& E) {
    int tid = threadIdx.x; asm volatile("" : "+v"(tid));
    const int wid = __builtin_amdgcn_readfirstlane(tid >> 6), lane = tid & 63, wr = wid >> 2, wc = wid & 3, fr = lane & 15, fq = lane >> 4;
    const int K = g.K, nt = K / BK;
    unsigned voffA[2], voffB[2];
#pragma unroll
    for (int i = 0; i < 2; ++i) { int R, C; stage_rc(tid * 16 + i * 8192, R, C); const int Rb = Epi::PERM ? ((R & ~31) + perm32(R & 31)) : R;
        voffA[i] = (unsigned)(R * K + C) * 2u; voffB[i] = (unsigned)(Rb * K + C) * 2u; }
    const size_t kstep = (size_t)(BK * 2);
    const size_t hstep = (size_t)HALF * K * 2;
    const size_t tstep = 2 * hstep;
    const unsigned ldsw = (unsigned)wid * 1024u;
    const int aoff = lds_byte(wr * 64 + fr, fq * 8), boff = lds_byte(wc * 32 + fr, fq * 8);
#define PG8_SA(b, h) (((b) * 2 + (h)) * HTB)
#define PG8_SB(b, h) ((4 + (b) * 2 + (h)) * HTB)
#define PG8_STAGE(bufoff, gbase, voff) do { _Pragma("unroll") for (int _i = 0; _i < 2; ++_i) \
        __builtin_amdgcn_global_load_lds((const unsigned*)((const char*)(gbase) + (voff)[_i]), (PG8_LAS unsigned*)(lds + (bufoff) + ldsw + _i * 8192), 16, 0, 0); } while (0)
#define PG8_LDA(dst, b, h) do { if constexpr (FP8) { _Pragma("unroll") for (int m = 0; m < 4; ++m) dst##8[m] = cat8(*(const PG8_LAS bf16x8*)(lds + PG8_SA(b, h) + aoff + m * 2048), *(const PG8_LAS bf16x8*)(lds + PG8_SA(b, h) + aoff + m * 2048 + 1024)); } \
        else { _Pragma("unroll") for (int m = 0; m < 4; ++m) _Pragma("unroll") for (int k = 0; k < 2; ++k) dst[m][k] = *(const PG8_LAS bf16x8*)(lds + PG8_SA(b, h) + aoff + m * 2048 + k * 1024); } } while (0)
#define PG8_LDB(dst, b, h) do { if constexpr (FP8) { _Pragma("unroll") for (int n = 0; n < 2; ++n) dst##8[n] = cat8(*(const PG8_LAS bf16x8*)(lds + PG8_SB(b, h) + boff + n * 2048), *(const PG8_LAS bf16x8*)(lds + PG8_SB(b, h) + boff + n * 2048 + 1024)); } \
        else { _Pragma("unroll") for (int n = 0; n < 2; ++n) _Pragma("unroll") for (int k = 0; k < 2; ++k) dst[n][k] = *(const PG8_LAS bf16x8*)(lds + PG8_SB(b, h) + boff + n * 2048 + k * 1024); } } while (0)
#define PG8_MMA(ai, bj, At, Bt) do { __builtin_amdgcn_s_setprio(1); \
        if constexpr (FP8) { _Pragma("unroll") for (int m = 0; m < 4; ++m) _Pragma("unroll") for (int n = 0; n < 2; ++n) \
            mfma8(acc[ai][bj][m][n], Bt##8[n], At##8[m], sc8); } \
        else { _Pragma("unroll") for (int m = 0; m < 4; ++m) _Pragma("unroll") for (int n = 0; n < 2; ++n) _Pragma("unroll") for (int k = 0; k < 2; ++k) \
            acc[ai][bj][m][n] = __builtin_amdgcn_mfma_f32_16x16x32_bf16(Bt[n][k], At[m][k], acc[ai][bj][m][n], 0, 0, 0); } \
        __builtin_amdgcn_s_setprio(0); } while (0)
#define PG8_WAIT_V(n) asm volatile("s_waitcnt vmcnt(" #n ")" ::: "memory")
#define PG8_WAIT_L(n) asm volatile("s_waitcnt lgkmcnt(" #n ")" ::: "memory")
#define PG8_BAR __builtin_amdgcn_s_barrier()
#define PG8_SCHED __builtin_amdgcn_sched_barrier(0)
    Unit cur, nxt; int ui = 0;
    if (!S.next(0, cur)) return;
    if constexpr (Epi::ROW_RSTD) {
        int p0 = cur.pm, p1 = -1, p2 = -1, p3 = -1; { Unit t_; for (int n_ = 1; S.next(n_, t_); ++n_) { const int p = t_.pm; if (p != p0 && p != p1 && p != p2 && p != p3) { if (p1 < 0) p1 = p; else if (p2 < 0) p2 = p; else p3 = p; } } }
        E.fill_rstd(lds + STAGE_BYTES, p0, wid, lane); if (p1 >= 0) E.fill_rstd(lds + STAGE_BYTES + 1024, p1, wid, lane); if (p2 >= 0) E.fill_rstd(lds + STAGE_BYTES + 2048, p2, wid, lane); if (p3 >= 0) E.fill_rstd(lds + STAGE_BYTES + 3072, p3, wid, lane);
        E.set_panels(p0, p1, p2);
        PG8_WAIT_L(0); PG8_BAR; asm volatile("" ::: "memory"); }
    f32x4 acc[2][2][4][2];
#pragma unroll
    for (int a = 0; a < 2; ++a)
#pragma unroll
        for (int b = 0; b < 2; ++b)
#pragma unroll
            for (int m = 0; m < 4; ++m)
#pragma unroll
                for (int n = 0; n < 2; ++n) acc[a][b][m][n] = (f32x4){0.f, 0.f, 0.f, 0.f};
    bf16x8 At[4][2], B0[2][2], B1[2][2]; i32x8 At8[4], B08[2], B18[2]; int sc8 = 0x7F7F7F7F; asm volatile("" : "+v"(sc8));
    const char* cA = (const char*)g.A + (size_t)cur.pm * tstep; const char* cB = (const char*)g.Bt + (size_t)cur.pn * tstep;
    S.a_ready(cur);
    if constexpr (SP2) {
        PG8_STAGE(PG8_SB(0, 0), cB, voffB); PG8_STAGE(PG8_SB(0, 1), cB + hstep, voffB); PG8_STAGE(PG8_SA(0, 0), cA, voffA); PG8_STAGE(PG8_SA(0, 1), cA + hstep, voffA);
        if (wr == 1) PG8_BAR;
        PG8_WAIT_V(2); PG8_BAR;
        PG8_STAGE(PG8_SB(1, 0), cB + kstep, voffB); PG8_STAGE(PG8_SA(1, 0), cA + kstep, voffA); PG8_STAGE(PG8_SB(1, 1), cB + hstep + kstep, voffB);
        PG8_WAIT_V(6); PG8_BAR;
    } else {
        PG8_STAGE(PG8_SB(0, 0), cB, voffB); PG8_STAGE(PG8_SA(0, 0), cA, voffA); PG8_STAGE(PG8_SB(0, 1), cB + hstep, voffB); PG8_STAGE(PG8_SA(0, 1), cA + hstep, voffA);
        if (wr == 1) PG8_BAR;
        PG8_WAIT_V(4); PG8_BAR;
        PG8_STAGE(PG8_SB(1, 0), cB + kstep, voffB); PG8_STAGE(PG8_SA(1, 0), cA + kstep, voffA); PG8_STAGE(PG8_SB(1, 1), cB + hstep + kstep, voffB);
        PG8_WAIT_V(6); PG8_BAR;
    }
    for (;;) {
        const bool has_next = S.next(ui + 1, nxt);
        const char* nA = has_next ? (const char*)g.A + (size_t)nxt.pm * tstep : cA; const char* nB = has_next ? (const char*)g.Bt + (size_t)nxt.pn * tstep : cB;
#pragma nounroll
        for (int t = 0; t < nt; t += 2) {
            const bool last = (t == nt - 2);
            const char* a1 = cA + (size_t)(t + 1) * kstep;
            const char* a2 = last ? nA : cA + (size_t)(t + 2) * kstep; const char* b2 = last ? nB : cB + (size_t)(t + 2) * kstep;
            const char* a3 = a2 + kstep; const char* b3 = b2 + kstep;
            if (last && has_next) S.a_ready(nxt);
            if constexpr (SP2) {
            PG8_LDB(B0, 0, 0); PG8_LDB(B1, 0, 1); PG8_SCHED; PG8_LDA(At, 0, 0); PG8_STAGE(PG8_SA(1, 1), a1 + hstep, voffA);
            PG8_WAIT_V(8); PG8_WAIT_L(0); PG8_BAR; PG8_MMA(0, 0, At, B0); PG8_MMA(0, 1, At, B1); PG8_BAR; PG8_SCHED;
            PG8_LDA(At, 0, 1); PG8_STAGE(PG8_SB(0, 0), b2, voffB); PG8_STAGE(PG8_SB(0, 1), b2 + hstep, voffB); PG8_STAGE(PG8_SA(0, 0), a2, voffA);
            PG8_WAIT_V(8); PG8_WAIT_L(0); PG8_BAR; PG8_MMA(1, 0, At, B0); PG8_MMA(1, 1, At, B1); PG8_BAR; PG8_SCHED;
            PG8_LDB(B0, 1, 0); PG8_LDB(B1, 1, 1); PG8_SCHED; PG8_LDA(At, 1, 0); PG8_STAGE(PG8_SA(0, 1), a2 + hstep, voffA);
            PG8_WAIT_V(8); PG8_WAIT_L(0); PG8_BAR; PG8_MMA(0, 0, At, B0); PG8_MMA(0, 1, At, B1); PG8_BAR; PG8_SCHED;
            PG8_LDA(At, 1, 1); PG8_STAGE(PG8_SB(1, 0), b3, voffB); PG8_STAGE(PG8_SB(1, 1), b3 + hstep, voffB); PG8_STAGE(PG8_SA(1, 0), a3, voffA);
            PG8_WAIT_V(8); PG8_WAIT_L(0); PG8_BAR; PG8_MMA(1, 0, At, B0); PG8_MMA(1, 1, At, B1); PG8_BAR; PG8_SCHED;
            } else {
            PG8_LDB(B0, 0, 0); PG8_SCHED; PG8_LDA(At, 0, 0); PG8_STAGE(PG8_SA(1, 1), a1 + hstep, voffA);
            PG8_WAIT_L(8); PG8_BAR; PG8_WAIT_L(0); PG8_MMA(0, 0, At, B0); PG8_BAR; PG8_SCHED;
            PG8_LDB(B1, 0, 1); PG8_STAGE(PG8_SB(0, 0), b2, voffB);
            PG8_BAR; PG8_WAIT_L(0); PG8_MMA(0, 1, At, B1); PG8_BAR;
            PG8_LDA(At, 0, 1); PG8_STAGE(PG8_SA(0, 0), a2, voffA);
            PG8_BAR; PG8_WAIT_L(0); PG8_MMA(1, 0, At, B0); PG8_BAR; PG8_SCHED;
            PG8_STAGE(PG8_SB(0, 1), b2 + hstep, voffB);
            PG8_WAIT_V(6); PG8_BAR; PG8_MMA(1, 1, At, B1); PG8_BAR;
            PG8_LDB(B0, 1, 0); PG8_SCHED; PG8_LDA(At, 1, 0); PG8_STAGE(PG8_SA(0, 1), a2 + hstep, voffA);
            PG8_WAIT_L(8); PG8_BAR; PG8_WAIT_L(0); PG8_MMA(0, 0, At, B0); PG8_BAR; PG8_SCHED;
            PG8_LDB(B1, 1, 1); PG8_STAGE(PG8_SB(1, 0), b3, voffB);
            PG8_BAR; PG8_WAIT_L(0); PG8_MMA(0, 1, At, B1); PG8_BAR;
            PG8_LDA(At, 1, 1); PG8_STAGE(PG8_SA(1, 0), a3, voffA);
            PG8_BAR; PG8_WAIT_L(0); PG8_MMA(1, 0, At, B0); PG8_BAR; PG8_SCHED;
            PG8_STAGE(PG8_SB(1, 1), b3 + hstep, voffB);
            PG8_WAIT_V(6); PG8_BAR; PG8_MMA(1, 1, At, B1); PG8_BAR;
            }
        }
        if constexpr (ALIGN_EPI) { if (wr == 0) PG8_BAR; }
        TS(lds, 40 + 2 * GID);
        if constexpr (FP8) asm volatile("s_nop 15\n\ts_nop 15" ::: "memory");
        if constexpr (!Epi::AFTER_DRAIN) { E(acc, cur, wr, wc, fr, fq); S.done(cur); }
        TS(lds, 41 + 2 * GID);
        if (!has_next) break;
#pragma unroll
        for (int a = 0; a < 2; ++a)
#pragma unroll
            for (int b = 0; b < 2; ++b)
#pragma unroll
                for (int m = 0; m < 4; ++m)
#pragma unroll
                    for (int n = 0; n < 2; ++n) acc[a][b][m][n] = (f32x4){0.f, 0.f, 0.f, 0.f};
        cur = nxt; cA = nA; cB = nB; ++ui;
        if constexpr (ALIGN_EPI) { if (wr == 1) PG8_BAR; }
    }
    PG8_WAIT_V(0);
    if constexpr (!ALIGN_EPI) { if (wr == 0) PG8_BAR; }
    PG8_BAR;
    if constexpr (Epi::AFTER_DRAIN) { E.fused(acc, cur, wr, wc, fr, fq, lds, wid, lane); S.done(cur); }
#undef PG8_SA
#undef PG8_SB
#undef PG8_STAGE
#undef PG8_LDA
#undef PG8_LDB
#undef PG8_MMA
#undef PG8_WAIT_V
#undef PG8_WAIT_L
#undef PG8_BAR
#undef PG8_SCHED
}
}

constexpr int NWAVES = 8;
constexpr int BATCH = 16, T = 2048, D = 1024, M = BATCH * T, DFF = 2816, NF1 = 2 * DFF, NU = 2304, DEPTH = 2, NCP = 128;
constexpr float EPS = 1e-6f, LOG2E = 1.4426950408889634f, C2 = 0.125f * LOG2E;
constexpr int UQ = 0, UKS = 256, UKW = 320, UCK = 384, UCQ = 512, UKC = 768, UVC = 832, UVS = 896, UVW = 960, UCV = 1024, UG = 1152, UBB = 1280, UBC = 1536, UBX = 1792, UDV = 2048;
constexpr size_t MiB = 1u << 20;
constexpr size_t WS_CTL = 0, CTL_ZERO_BYTES = 1 * MiB;
constexpr size_t WS_W13 = 1 * MiB, WS_W2 = 45 * MiB, WS_WIN = 67 * MiB, WS_WOUT = 76 * MiB, WS_C1 = 80 * MiB;
constexpr size_t WS_SSQ = 82 * MiB, WS_GATES = 84 * MiB, WS_KC = 86 * MiB, WS_VC = 86 * MiB + 512 * 1024;
constexpr size_t WS_XB = 88 * MiB, WS_QKN = 152 * MiB, WS_YN = 200 * MiB, WS_ACT = 264 * MiB, WS_U = WS_ACT, WS_X8 = 440 * MiB, WS_IMG = 472 * MiB, WS_END = 504 * MiB;
#ifndef UP8_MASK_V
#define UP8_MASK_V 0xE
#endif
#ifndef DN8_MASK_V
#define DN8_MASK_V 0xF
#endif
constexpr unsigned UP8_MASK = UP8_MASK_V, DN8_MASK = DN8_MASK_V;
constexpr float W8_SCALE = 64.0f, ACT8_SCALE = 4.0f; static_assert(W8_SCALE * ACT8_SCALE == 256.0f, "EpiRes mode 1");
constexpr int CW_BAR = 4096;
constexpr int LDS_BYTES = 163840, MISC_OFF = LDS_BYTES - 256;

#define GAS __attribute__((address_space(1)))
#define LAS __attribute__((address_space(3)))
typedef unsigned short bf16;
typedef unsigned v4u __attribute__((ext_vector_type(4)));
typedef unsigned u32x2 __attribute__((ext_vector_type(2)));
typedef float f32x4 __attribute__((ext_vector_type(4)));
typedef float f32x2_t __attribute__((ext_vector_type(2)));
typedef __bf16 bf16x2_t __attribute__((ext_vector_type(2)));
typedef short bf16x8 __attribute__((ext_vector_type(8)));
typedef float f32x16 __attribute__((ext_vector_type(16)));
typedef short v4i16_t __attribute__((ext_vector_type(4)));
#define LDS_WAIT() asm volatile("s_waitcnt lgkmcnt(0)" ::: "memory")
__device__ __forceinline__ unsigned pk2(float lo, float hi) { f32x2_t v = {lo, hi}; bf16x2_t b = __builtin_convertvector(v, bf16x2_t); return __builtin_bit_cast(unsigned, b); }
__device__ __forceinline__ float bflo(unsigned u) { return __builtin_bit_cast(float, u << 16); }
__device__ __forceinline__ float bfhi(unsigned u) { return __builtin_bit_cast(float, u & 0xffff0000u); }
__device__ __forceinline__ f32x4 ld4bf(const bf16* p) { const u32x2 w = *(const u32x2*)p; return (f32x4){bflo(w.x), bfhi(w.x), bflo(w.y), bfhi(w.y)}; }
__device__ __forceinline__ void st4bf(bf16* p, f32x4 v) { u32x2 w; w.x = pk2(v[0], v[1]); w.y = pk2(v[2], v[3]); *(u32x2*)p = w; }
template <int CTRL> __device__ __forceinline__ float dpp_add(float v) { return v + __builtin_bit_cast(float, __builtin_amdgcn_update_dpp(0, __builtin_bit_cast(int, v), CTRL, 0xf, 0xf, true)); }
__device__ __forceinline__ float row16_sum(float v) { v = dpp_add<0xB1>(v); v = dpp_add<0x4E>(v); v = dpp_add<0x141>(v); v = dpp_add<0x140>(v); return v; }
__device__ __forceinline__ float wave_sum(float v) {
    v = row16_sum(v); v += __shfl_xor(v, 16);
    auto rr = __builtin_amdgcn_permlane32_swap(__float_as_uint(v), __float_as_uint(v), false, false); return __uint_as_float(rr[0]) + __uint_as_float(rr[1]);
}
__device__ __forceinline__ f32x4 up4(u32x2 w) { return (f32x4){bflo(w.x), bfhi(w.x), bflo(w.y), bfhi(w.y)}; }
__device__ __forceinline__ float sq4(f32x4 v) { return (v[0] * v[0] + v[1] * v[1]) + (v[2] * v[2] + v[3] * v[3]); }

__device__ __forceinline__ int kimg_off(int r, int d) { return (d >> 3) * 512 + r * 8 + (d & 7); }
__device__ __forceinline__ int vimg_off(int r, int d) { return ((d >> 5) * 4 + (r >> 4)) * 512 + (r & 15) * 32 + (d & 31); }
#define XB_TMO      128
#define XB_XCNT(j)  (256  + 64 * (j))
#define XB_XSUB(j)  (1280 + 64 * (j))
#define XB_XGEN(j)  (2304 + 64 * (j))
#define XB_TOP      3328
#define XB_TOPGEN   3392
#define XCD_BAR_WORDS 3456
#define XB_SPIN_CAP (1u << 18)

__device__ __forceinline__ unsigned xb_ld(unsigned* p)              { return __hip_atomic_load(p, __ATOMIC_RELAXED, __HIP_MEMORY_SCOPE_AGENT); }
__device__ __forceinline__ unsigned xb_add(unsigned* p, unsigned v) { return __hip_atomic_fetch_add(p, v, __ATOMIC_RELAXED, __HIP_MEMORY_SCOPE_AGENT); }
__device__ __forceinline__ unsigned xb_xcc_id() { return (unsigned)__builtin_amdgcn_s_getreg((3 << 11) | 20) & 0xFu; }
#define XB_SPIN(cond, bar) do { unsigned _sp = 0; while (cond) { __builtin_amdgcn_s_sleep(1); \
    if ((++_sp & 255u) == 0u) { if (xb_ld(&(bar)[XB_TMO])) break; if (_sp > XB_SPIN_CAP) { atomicAdd(&(bar)[XB_TMO], 1u); break; } } } } while (0)

struct XcdBarrier {
    unsigned* bar; unsigned x;
    volatile LAS unsigned* st;
};

__device__ __forceinline__ XcdBarrier xcd_barrier_post(unsigned* bar, volatile LAS unsigned* st) {
    XcdBarrier b; b.bar = bar; b.x = xb_xcc_id(); b.st = st;
    if (threadIdx.x == 0) (void)xb_add(&bar[XB_XCNT(b.x)], 1u);
    return b;
}
__device__ __forceinline__ void xcd_barrier_complete(unsigned* bar, unsigned x, unsigned& nloc, unsigned& nx) {
    const unsigned G = gridDim.x * gridDim.y * gridDim.z;
    unsigned sum, cnt, mine, sp = 0u;
    for (;;) {
        sum = 0u; cnt = 0u; mine = 0u;
#pragma unroll
        for (unsigned j = 0; j < 16; ++j) { const unsigned c = xb_ld(&bar[XB_XCNT(j)]); sum += c; cnt += (c > 0u) ? 1u : 0u; mine = (j == x) ? c : mine; }
        if (sum == G) break;
        __builtin_amdgcn_s_sleep(1);
        if ((++sp & 255u) == 0u) { if (xb_ld(&bar[XB_TMO])) break; if (sp > XB_SPIN_CAP) { atomicAdd(&bar[XB_TMO], 1u); break; } }
    }
    nloc = mine > 0u ? mine : 1u; nx = cnt > 0u ? cnt : 1u;
}

__device__ __forceinline__ void xcd_barrier(const XcdBarrier& b) {
    asm volatile("s_waitcnt vmcnt(0)" ::: "memory");
    __syncthreads();
    if (threadIdx.x == 0) {
        unsigned* bar = b.bar;
        __builtin_amdgcn_s_waitcnt(0);
        unsigned nloc = b.st[0], nx = b.st[1];
        if (nloc == 0u) { xcd_barrier_complete(bar, b.x, nloc, nx); b.st[0] = nloc; b.st[1] = nx; }
        const unsigned old = xb_add(&bar[XB_XSUB(b.x)], 1u);
        const unsigned gen = old / nloc;
        if (old + 1u == (gen + 1u) * nloc) {
            __builtin_amdgcn_fence(__ATOMIC_RELEASE, "agent");
            asm volatile("s_waitcnt vmcnt(0)" ::: "memory");
            const unsigned og = xb_add(&bar[XB_TOP], 1u);
            const unsigned tg = og / nx;
            if (og + 1u == (tg + 1u) * nx) xb_add(&bar[XB_TOPGEN], 1u);
            else XB_SPIN(xb_ld(&bar[XB_TOPGEN]) == tg, bar);
            __builtin_amdgcn_fence(__ATOMIC_ACQUIRE, "agent");
            xb_add(&bar[XB_XGEN(b.x)], 1u);
            asm volatile("s_waitcnt vmcnt(0)" ::: "memory");
        } else {
            XB_SPIN(xb_ld(&bar[XB_XGEN(b.x)]) == gen, bar);
            __builtin_amdgcn_fence(__ATOMIC_ACQUIRE, "agent");
            asm volatile("s_waitcnt vmcnt(0)" ::: "memory");
        }
    }
    __syncthreads();
}


typedef KArgs Args;
struct Frame {
    LAS unsigned char* lds;
    int tid, lane, wave, vcu, G;
    const Args* a;
};
#define FIN(i) (F.a->in[i])
#define FOUT (F.a->out)
#define FWS(off, type) ((type*)(F.a->ws + (off)))
#define F_W13T FWS(WS_W13, bf16)
#define F_W2T FWS(WS_W2, bf16)
#define F_WINT FWS(WS_WIN, bf16)
#define F_WOUTT FWS(WS_WOUT, bf16)
#define F_C1T FWS(WS_C1, bf16)
#define F_XB FWS(WS_XB, bf16)
#define F_QA FWS(WS_QKN, bf16)
#define F_QC FWS(WS_QKN + 16 * MiB, bf16)
#define F_KSI FWS(WS_IMG, bf16)
#define F_KWI FWS(WS_IMG + 4 * MiB, bf16)
#define F_CKI FWS(WS_IMG + 8 * MiB, bf16)
#define F_VSI FWS(WS_IMG + 16 * MiB, bf16)
#define F_VWI FWS(WS_IMG + 20 * MiB, bf16)
#define F_CVI FWS(WS_IMG + 24 * MiB, bf16)
#define F_YN FWS(WS_YN, bf16)
#define F_ACT FWS(WS_ACT, bf16)
#define F_U FWS(WS_U, bf16)
#define F_KC FWS(WS_KC, bf16)
#define F_VC FWS(WS_VC, bf16)
#define F_SSQ FWS(WS_SSQ, float)
#define F_GATES FWS(WS_GATES, float)
#define F_X8 FWS(WS_X8, unsigned char)
enum { I_X = 0, I_F1N, I_F1W1, I_F1W3, I_F1W2, I_MIXN, I_WIN, I_NQN, I_NKCN, I_NKSN, I_NKWN, I_POSK, I_C1K, I_C2K, I_POSV, I_C1V, I_C2V, I_CONVW, I_SQN, I_SKN, I_SINK, I_POOLW, I_POOLS, I_GN, I_WOUT,
       I_F2N, I_F2W1, I_F2W3, I_F2W2 };

__device__ __forceinline__ int win_src_col(int dr) {
    if (dr < 256) return dr;
    if (dr < 320) return 384 + (dr - 256);
    if (dr < 384) return 512 + (dr - 320);
    if (dr < 512) return 1676 + (dr - 384);
    if (dr < 768) return 1420 + (dr - 512);
    if (dr < 832) return 256 + (dr - 768);
    if (dr < 896) return 320 + (dr - 832);
    if (dr < 960) return 448 + (dr - 896);
    if (dr < 1024) return 576 + (dr - 960);
    if (dr < 1152) return 1804 + (dr - 1024);
    if (dr < 1164) return 640 + (dr - 1152);
    if (dr < 1280) return -1;
    if (dr < 1536) return 652 + (dr - 1280);
    if (dr < 1792) return 908 + (dr - 1536);
    if (dr < 2048) return 1164 + (dr - 1792);
    return 1932 + (dr - 2048);
}
struct TrItem { const float* src; const float* gain; void* dst; int N, K, k0, n0, srcmode, dstmode, w, ncols; bool f8; };
__device__ __forceinline__ void tr_decode(Frame& F, int it, TrItem& t) {
    constexpr int PER_LAYER = 6 * 176 + 144 + 64 + 64;
    const int L = it / PER_LAYER; int r = it % PER_LAYER;
    t.gain = nullptr; t.f8 = false; t.srcmode = 0; t.dstmode = 0; t.w = 0; t.ncols = 256;
    if (r < 6 * 176) { const int mat = r / 176, rr = r % 176, ffn = mat / 3, w = mat % 3;
        if (w < 2) { t.k0 = 64 * (rr / 11); t.n0 = 256 * (rr % 11); t.N = DFF; t.K = D; t.dstmode = 1; t.w = w;
            t.src = FIN(ffn ? (w ? I_F2W3 : I_F2W1) : (w ? I_F1W3 : I_F1W1)) + (size_t)L * D * DFF; t.gain = FIN(ffn ? I_F2N : I_F1N) + L * D;
            t.dst = (unsigned char*)F_W13T + (size_t)(L * 2 + ffn) * NF1 * D * 2; t.f8 = (UP8_MASK >> (L * 2 + ffn)) & 1u; }
        else { t.k0 = 64 * (rr / 4); t.n0 = 256 * (rr % 4); t.N = D; t.K = DFF;
            t.src = FIN(ffn ? I_F2W2 : I_F1W2) + (size_t)L * DFF * D; t.dst = (unsigned char*)F_W2T + (size_t)(L * 2 + ffn) * D * DFF * 2; t.f8 = (DN8_MASK >> (L * 2 + ffn)) & 1u; } }
    else { r -= 6 * 176;
        if (r < 144) { t.k0 = 64 * (r / 9); t.n0 = 256 * (r % 9); t.N = 2188; t.K = D; t.srcmode = 1;
            t.src = FIN(I_WIN) + (size_t)L * D * 2188; t.gain = FIN(I_MIXN) + L * D; t.dst = F_WINT + (size_t)L * NU * D; }
        else if (r < 144 + 64) { r -= 144; t.k0 = 64 * (r / 4); t.n0 = 256 * (r % 4); t.N = D; t.K = D;
            t.src = FIN(I_WOUT) + (size_t)L * D * D; t.gain = FIN(I_GN) + L * D; t.dst = F_WOUTT + (size_t)L * D * D; }
        else { r -= 144 + 64; const int kv = r / 32; t.k0 = 64 * (r % 32); t.n0 = 0; t.N = 128; t.K = 2048; t.ncols = 128;
            t.src = FIN(kv ? I_C1V : I_C1K) + (size_t)L * 2048 * 128; t.dst = F_C1T + (size_t)(L * 2 + kv) * 128 * 2048; } }
}
__device__ __forceinline__ void tr_load(const TrItem& t, f32x4 (&v)[8], int wave, int lane) {
    const int c = 4 * lane; const int sc = t.srcmode ? win_src_col(t.n0 + c) : (c < t.ncols ? t.n0 + c : -1);
#pragma unroll
    for (int i = 0; i < 8; ++i) { v[i] = (f32x4){0.f, 0.f, 0.f, 0.f}; if (sc >= 0) v[i] = *(const f32x4*)(t.src + (size_t)(t.k0 + 8 * wave + i) * t.N + sc); }
}
__device__ __forceinline__ void tr_to_lds(const TrItem& t, const f32x4 (&v)[8], LAS float* T, int wave, int lane) {
#pragma unroll
    for (int i = 0; i < 8; ++i) { const int k = 8 * wave + i; const float g = t.gain ? t.gain[t.k0 + k] : 1.0f; LAS float* p = T + k * 257 + 4 * lane;
        p[0] = v[i][0] * g; p[1] = v[i][1] * g; p[2] = v[i][2] * g; p[3] = v[i][3] * g; }
}
__device__ __forceinline__ void tr_out(const TrItem& t, const LAS float* T, int wave, int lane) {
    if (t.f8) { const int c = lane & 3;
#pragma unroll
        for (int j = 0; j < 2; ++j) { const int row = 32 * wave + 16 * j + (lane >> 2); if (row < t.ncols) { const int n = t.n0 + row; const int dr = t.dstmode ? ((n >> 7) * 256 + t.w * 128 + (n & 127)) : n;
            const LAS float* q = T + (16 * c) * 257 + row; v4u o;
            o.x = pg8::pk4_fp8(q[0 * 257] * W8_SCALE, q[1 * 257] * W8_SCALE, q[2 * 257] * W8_SCALE, q[3 * 257] * W8_SCALE); o.y = pg8::pk4_fp8(q[4 * 257] * W8_SCALE, q[5 * 257] * W8_SCALE, q[6 * 257] * W8_SCALE, q[7 * 257] * W8_SCALE);
            o.z = pg8::pk4_fp8(q[8 * 257] * W8_SCALE, q[9 * 257] * W8_SCALE, q[10 * 257] * W8_SCALE, q[11 * 257] * W8_SCALE); o.w = pg8::pk4_fp8(q[12 * 257] * W8_SCALE, q[13 * 257] * W8_SCALE, q[14 * 257] * W8_SCALE, q[15 * 257] * W8_SCALE);
            *(v4u*)((unsigned char*)t.dst + (size_t)dr * t.K + t.k0 + 16 * c) = o; } } }
    else { const int c = lane & 7;
#pragma unroll
        for (int j = 0; j < 4; ++j) { const int row = 32 * wave + 8 * j + (lane >> 3); if (row < t.ncols) { const int n = t.n0 + row; const int dr = t.dstmode ? ((n >> 7) * 256 + t.w * 128 + (n & 127)) : n;
            const LAS float* q = T + (8 * c) * 257 + row;
            v4u o; o.x = pk2(q[0 * 257], q[1 * 257]); o.y = pk2(q[2 * 257], q[3 * 257]); o.z = pk2(q[4 * 257], q[5 * 257]); o.w = pk2(q[6 * 257], q[7 * 257]);
            *(v4u*)((bf16*)t.dst + (size_t)dr * t.K + t.k0 + 8 * c) = o; } } }
}
__device__ __forceinline__ void prologue(Frame& F) {
    int lane = F.lane; asm volatile("" : "+v"(lane));
    LAS float* TT = (LAS float*)F.lds;
    const int wave = F.wave, gw = F.vcu * NWAVES + F.wave, NGW = F.G * NWAVES;
    constexpr int NITEMS = DEPTH * (6 * 176 + 144 + 64 + 64);
    { TrItem ta, tb; f32x4 va[8];
      int it = F.vcu; bool have = it < NITEMS;
      if (have) { tr_decode(F, it, ta); tr_load(ta, va, wave, lane); }
      while (have) {
          tr_to_lds(ta, va, TT, wave, lane);
          __syncthreads();
          const int nx = it + F.G; const bool hn = nx < NITEMS; tb = ta;
          if (hn) { tr_decode(F, nx, ta); tr_load(ta, va, wave, lane); }
          tr_out(tb, TT, wave, lane);
          __syncthreads();
          it = nx; have = hn;
      } }
    const float* x = FIN(I_X);
    for (int m4 = gw * 4; m4 < M; m4 += NGW * 4) {
        f32x4 v[4][4];
#pragma unroll
        for (int r = 0; r < 4; ++r)
#pragma unroll
            for (int j = 0; j < 4; ++j) v[r][j] = *((const f32x4*)(x + (size_t)(m4 + r) * D) + lane + 64 * j);
#pragma unroll
        for (int r = 0; r < 4; ++r) { float sr = 0.f;
#pragma unroll
            for (int j = 0; j < 4; ++j) { sr += sq4(v[r][j]); st4bf(F_XB + (size_t)(m4 + r) * D + 256 * j + 4 * lane, v[r][j]);
                if (UP8_MASK & 1u) *(unsigned*)(F_X8 + (size_t)(m4 + r) * D + 256 * j + 4 * lane) = pg8::pk4_fp8(v[r][j][0], v[r][j][1], v[r][j][2], v[r][j][3]); }
            sr = wave_sum(sr);
            if (lane < 16) F_SSQ[(size_t)(m4 + r) * 16 + lane] = lane == 0 ? sr : 0.f; }
    }
}

#ifndef PROBE_PREP
#define PROBE_PREP 0
#endif
__device__ __forceinline__ void prep_phase(Frame& F, int L) {
    int tid = F.tid; asm volatile("" : "+v"(tid));
    const int lane = tid & 63, ch = 4 * lane;
    LAS bf16* PWt = (LAS bf16*)F.lds;
    LAS bf16* DTb = (LAS bf16*)(F.lds + 65536) + F.wave * (16 * 264);
    { const float* pw = FIN(I_POOLW) + (size_t)L * 16384;
      for (int i = tid; i < 16384; i += NWAVES * 64) { const int g = i >> 12, c = (i >> 6) & 63, e = i & 63; PWt[(g * 64 + e) * 72 + c] = (bf16)(pk2(pw[i], 0.f) & 0xffffu); } }
    __syncthreads();
    f32x4 g0, g1, g2, cw0, cw1, cw2;
    { const float* nq = FIN(I_NQN) + L * 64; const float* nks = FIN(I_NKSN) + L * 64; const float* nkw = FIN(I_NKWN) + L * 64; const float* sk = FIN(I_SKN) + L * 64; const float* sq = FIN(I_SQN) + L * 64;
      g0 = *(const f32x4*)(nq + (ch & 63)) * C2;
      g1 = ch < 64 ? *(const f32x4*)(nks + ch) : (ch < 128 ? *(const f32x4*)(nkw + (ch - 64)) : *(const f32x4*)(sk + (ch & 63)));
      g2 = *(const f32x4*)(sq + (ch & 63)) * C2;
      const float* cw = FIN(I_CONVW) + L * 768; cw0 = *(const f32x4*)(cw + ch); cw1 = *(const f32x4*)(cw + 256 + ch); cw2 = *(const f32x4*)(cw + 512 + ch);
      }
    const int grp = lane >> 4, win = 2 << grp;
    const int gw = F.vcu * NWAVES + F.wave, NGW = F.G * NWAVES;
    TS(F.lds, 30);
    for (int blk = gw; blk < M / 16; blk += NGW) {
        const int m0 = blk * 16, t0 = m0 & (T - 1);
        const bf16* u0 = F_U + (size_t)m0 * NU;
        const int gt = m0 >> 6, rb = m0 & 63, dk = ch & 63;
        bf16* kimg = (ch < 64 ? F_KSI : (ch < 128 ? F_KWI : F_CKI + (size_t)((ch - 128) >> 6) * 512 * 4096)) + (size_t)gt * 4096 + kimg_off(rb, dk);
        bf16* vimg = (ch < 64 ? F_VSI : (ch < 128 ? F_VWI : F_CVI + (size_t)((ch - 128) >> 6) * 512 * 4096)) + (size_t)gt * 4096 + vimg_off(rb, dk);
#pragma nounroll
        for (int i8 = 0; i8 < 16; i8 += 8) { u32x2 raw[8][4];
#pragma unroll
            for (int i = 0; i < 8; ++i) {
#pragma unroll
                for (int k = 0; k < 3; ++k) raw[i][k] = *(const u32x2*)(u0 + (size_t)(i8 + i) * NU + 256 * k + ch);
                raw[i][3] = *(const u32x2*)(u0 + (size_t)(i8 + i) * NU + UVS + ch); }
#pragma unroll
            for (int i = 0; i < 8; ++i) { const f32x4 v0 = up4(raw[i][0]), v1 = up4(raw[i][1]), v2 = up4(raw[i][2]);
                const float s0 = row16_sum(sq4(v0)), s1 = row16_sum(sq4(v1)), s2 = row16_sum(sq4(v2));
                const float r0 = __builtin_amdgcn_rsqf(s0 * (1.f / 64.f) + EPS), r1 = __builtin_amdgcn_rsqf(s1 * (1.f / 64.f) + EPS), r2 = __builtin_amdgcn_rsqf(s2 * (1.f / 64.f) + EPS);
                st4bf(F_QA + (size_t)(m0 + i8 + i) * 256 + ch, v0 * r0 * g0); st4bf(kimg + (i8 + i) * 8, v1 * r1 * g1); st4bf(F_QC + (size_t)(m0 + i8 + i) * 256 + ch, v2 * r2 * g2);
                *(u32x2*)(vimg + (i8 + i) * 32) = raw[i][3]; } }
        TS(F.lds, 31);
#pragma unroll
        for (int k = 0; k < 3; ++k) { const int idx = lane + 64 * k, tk = idx / 12, gi = idx - 12 * tk;
            const float a = bflo((unsigned)u0[(size_t)tk * NU + UG + gi]); F_GATES[(size_t)m0 * 12 + idx] = __builtin_amdgcn_rcpf(1.0f + __builtin_amdgcn_exp2f(a * -LOG2E)); }
        TS(F.lds, 32);
        { f32x4 zm1 = {0.f, 0.f, 0.f, 0.f}, zm2 = {0.f, 0.f, 0.f, 0.f};
          if (t0 > 0) { zm1 = ld4bf(u0 - NU + UBC + ch) * ld4bf(u0 - NU + UBX + ch); zm2 = ld4bf(u0 - 2 * NU + UBC + ch) * ld4bf(u0 - 2 * NU + UBX + ch); }
#pragma nounroll
          for (int i8 = 0; i8 < 16; i8 += 8) { u32x2 raw[8][3]; f32x4 ob[8]; float ss[8];
#pragma unroll
              for (int i = 0; i < 8; ++i)
#pragma unroll
                  for (int k = 0; k < 3; ++k) raw[i][k] = *(const u32x2*)(u0 + (size_t)(i8 + i) * NU + UBB + 256 * k + ch);
#pragma unroll
              for (int i = 0; i < 8; ++i) { const f32x4 z0 = up4(raw[i][1]) * up4(raw[i][2]);
                  ob[i] = up4(raw[i][0]) * (cw2 * z0 + cw1 * zm1 + cw0 * zm2); zm2 = zm1; zm1 = z0; ss[i] = sq4(ob[i]); }
#pragma unroll
              for (int i = 0; i < 8; ++i) ss[i] = wave_sum(ss[i]);
#pragma unroll
              for (int i = 0; i < 8; ++i) st4bf(F_YN + (size_t)(m0 + i8 + i) * D + 256 + ch, ob[i] * (__builtin_amdgcn_rsqf(ss[i] * (1.f / 256.f) + EPS))); } }
        TS(F.lds, 33);
        { u32x2 raw[32];
#pragma unroll
          for (int i = 0; i < 16; ++i) { raw[i] = (u32x2){0u, 0u}; if (t0 > 0) raw[i] = *(const u32x2*)(u0 - (size_t)(16 - i) * NU + UDV + ch); }
#pragma unroll
          for (int i = 0; i < 16; ++i) raw[16 + i] = *(const u32x2*)(u0 + (size_t)i * NU + UDV + ch);
          f32x4 S2 = up4(raw[15]) + up4(raw[14]), S4 = S2 + up4(raw[13]) + up4(raw[12]), S8 = S4, S16;
#pragma unroll
          for (int i = 8; i < 12; ++i) S8 += up4(raw[i]);
          S16 = S8;
#pragma unroll
          for (int i = 0; i < 8; ++i) S16 += up4(raw[i]);
#pragma unroll
          for (int ti = 0; ti < 16; ++ti) { const f32x4 v = up4(raw[16 + ti]);
              S2 += v - up4(raw[16 + ti - 2]); S4 += v - up4(raw[16 + ti - 4]); S8 += v - up4(raw[16 + ti - 8]); S16 += v - up4(raw[ti]);
              const f32x4 Sw = grp == 0 ? S2 : (grp == 1 ? S4 : (grp == 2 ? S8 : S16));
              const int cn = (t0 + ti + 1) < win ? (t0 + ti + 1) : win;
              const f32x4 dd = Sw * __builtin_amdgcn_rcpf((float)cn) - v;
              u32x2 w; w.x = pk2(dd[0], dd[1]); w.y = pk2(dd[2], dd[3]); *(LAS u32x2*)(DTb + ti * 264 + ch) = w; }
          const int fr = lane & 15, fq = lane >> 4;
          const float* psp = FIN(I_POOLS) + L * 256 + fr;
          f32x4 acc[4][4];
#pragma unroll
          for (int g = 0; g < 4; ++g) { const bf16x8 a0 = *(const LAS bf16x8*)(DTb + fr * 264 + g * 64 + 8 * fq), a1 = *(const LAS bf16x8*)(DTb + fr * 264 + g * 64 + 32 + 8 * fq);
#pragma unroll
              for (int cb = 0; cb < 4; ++cb) { const LAS bf16* bp = PWt + (g * 64 + 16 * cb + fr) * 72 + 8 * fq;
                  f32x4 c = {0.f, 0.f, 0.f, 0.f};
                  c = __builtin_amdgcn_mfma_f32_16x16x32_bf16(a0, *(const LAS bf16x8*)bp, c, 0, 0, 0);
                  c = __builtin_amdgcn_mfma_f32_16x16x32_bf16(a1, *(const LAS bf16x8*)(bp + 32), c, 0, 0, 0);
                  acc[g][cb] = c * psp[g * 64 + 16 * cb]; } }
          float ss[4];
#pragma unroll
          for (int i = 0; i < 4; ++i) { float q = 0.f;
#pragma unroll
              for (int g = 0; g < 4; ++g)
#pragma unroll
                  for (int cb = 0; cb < 4; ++cb) q += acc[g][cb][i] * acc[g][cb][i];
              ss[i] = __builtin_amdgcn_rsqf(row16_sum(q) * (1.f / 256.f) + EPS); }
          asm volatile("s_waitcnt lgkmcnt(0)" ::: "memory");
#pragma unroll
          for (int g = 0; g < 4; ++g)
#pragma unroll
              for (int cb = 0; cb < 4; ++cb)
#pragma unroll
                  for (int i = 0; i < 4; ++i) DTb[(4 * fq + i) * 264 + g * 64 + 16 * cb + fr] = (bf16)(pk2(acc[g][cb][i] * ss[i], 0.f) & 0xffffu);
#pragma unroll
          for (int ti = 0; ti < 16; ++ti) *(u32x2*)(F_YN + (size_t)(m0 + ti) * D + 768 + ch) = *(const LAS u32x2*)(DTb + ti * 264 + ch); }
        TS(F.lds, 34);
    }
    __syncthreads();
    TS(F.lds, 35);
    LAS float* PART = (LAS float*)F.lds;
    LAS float* H = (LAS float*)(F.lds + 65536);
    LAS float* O2 = (LAS float*)(F.lds + 65536 + 16384);
    const int fr = lane & 15, fq = lane >> 4, wave = F.wave;
    for (int rep8 = 0; rep8 < ((PROBE_PREP & 8) ? 2 : 1); ++rep8)
    for (int uid = blockIdx.x; uid < 256; uid += F.G) {
        const int b = uid >> 4, kv = (uid >> 3) & 1, n0 = 16 * (uid & 7);
        const bf16* W1t = F_C1T + (size_t)(L * 2 + kv) * 128 * 2048;
        const float* pos = FIN(kv ? I_POSV : I_POSK) + (size_t)L * 2048;
        const float* W2 = FIN(kv ? I_C2V : I_C2K) + (size_t)L * 128 * 64;
        const int nrow = (n0 + fr) < 126 ? (n0 + fr) : 126;
        const bf16* arow = F_U + (size_t)(b * T + 16 * nrow) * NU + UKC + 64 * kv;
        const bf16* brow = W1t + (size_t)fr * 2048;
        f32x4 acc[8];
#pragma unroll
        for (int ct = 0; ct < 8; ++ct) acc[ct] = (f32x4){0.f, 0.f, 0.f, 0.f};
        v4u car[3]; f32x4 cp0[3], cp1[3]; bf16x8 cb[3][8];
#define CMP_LOAD(bi, ks) do { const int kk_ = 8 * wave + (ks), l_ = kk_ >> 1, c_ = 32 * (kk_ & 1) + 8 * fq; \
            car[bi] = *(const v4u*)(arow + (size_t)l_ * NU + c_); cp0[bi] = *(const f32x4*)(pos + l_ * 64 + c_); cp1[bi] = *(const f32x4*)(pos + l_ * 64 + c_ + 4); \
            _Pragma("unroll") for (int ct = 0; ct < 8; ++ct) cb[bi][ct] = *(const bf16x8*)(brow + (size_t)(16 * ct) * 2048 + 32 * kk_ + 8 * fq); } while (0)
#define CMP_MMA(bi) do { const v4u ar = car[bi]; const f32x4 p0 = cp0[bi], p1 = cp1[bi]; v4u aw; \
            aw.x = pk2(bflo(ar.x) + p0[0], bfhi(ar.x) + p0[1]); aw.y = pk2(bflo(ar.y) + p0[2], bfhi(ar.y) + p0[3]); aw.z = pk2(bflo(ar.z) + p1[0], bfhi(ar.z) + p1[1]); aw.w = pk2(bflo(ar.w) + p1[2], bfhi(ar.w) + p1[3]); \
            _Pragma("unroll") for (int ct = 0; ct < 8; ++ct) acc[ct] = __builtin_amdgcn_mfma_f32_16x16x32_bf16(__builtin_bit_cast(bf16x8, aw), cb[bi][ct], acc[ct], 0, 0, 0); } while (0)
        CMP_LOAD(0, 0); CMP_LOAD(1, 1); CMP_LOAD(2, 2);
        CMP_MMA(0); CMP_LOAD(0, 3); CMP_MMA(1); CMP_LOAD(1, 4); CMP_MMA(2); CMP_LOAD(2, 5);
        CMP_MMA(0); CMP_LOAD(0, 6); CMP_MMA(1); CMP_LOAD(1, 7); CMP_MMA(2); CMP_MMA(0); CMP_MMA(1);
#undef CMP_LOAD
#undef CMP_MMA
        TS(F.lds, 36);
#pragma unroll
        for (int ct = 0; ct < 8; ++ct)
#pragma unroll
            for (int i = 0; i < 4; ++i) PART[(wave * 16 + 4 * fq + i) * 128 + 16 * ct + fr] = acc[ct][i];
        __syncthreads();
        TS(F.lds, 37);
        { const int e0 = 4 * tid; f32x4 sum = *(const LAS f32x4*)(PART + e0);
#pragma unroll
          for (int w = 1; w < 8; ++w) sum += *(const LAS f32x4*)(PART + w * 2048 + e0);
          const int hr = e0 >> 7, hc = e0 & 127;
#pragma unroll
          for (int i = 0; i < 4; ++i) { const float xh = sum[i]; const float y2 = 2.0f * 0.7978845608028654f * (xh + 0.044715f * xh * xh * xh); H[hr * 132 + hc + i] = xh * __builtin_amdgcn_rcpf(1.0f + __builtin_amdgcn_exp2f(y2 * -LOG2E)); } }
        __syncthreads();
        if (wave < 4) { f32x4 a2 = {0.f, 0.f, 0.f, 0.f};
#pragma unroll
            for (int s = 0; s < 4; ++s) { const LAS float* hp = H + fr * 132 + 32 * s + 8 * fq; const float* wp = W2 + (size_t)(32 * s + 8 * fq) * 64 + 16 * wave + fr;
                v4u aw; aw.x = pk2(hp[0], hp[1]); aw.y = pk2(hp[2], hp[3]); aw.z = pk2(hp[4], hp[5]); aw.w = pk2(hp[6], hp[7]);
                v4u bw; bw.x = pk2(wp[0], wp[64]); bw.y = pk2(wp[128], wp[192]); bw.z = pk2(wp[256], wp[320]); bw.w = pk2(wp[384], wp[448]);
                a2 = __builtin_amdgcn_mfma_f32_16x16x32_bf16(__builtin_bit_cast(bf16x8, aw), __builtin_bit_cast(bf16x8, bw), a2, 0, 0, 0); }
#pragma unroll
            for (int i = 0; i < 4; ++i) O2[(4 * fq + i) * 68 + 16 * wave + fr] = a2[i]; }
        __syncthreads();
        if (wave == 0) { const int row = lane >> 2, c0 = (lane & 3) * 16; float v[16]; float ss = 0.f;
#pragma unroll
            for (int e = 0; e < 16; ++e) { v[e] = O2[row * 68 + c0 + e]; ss += v[e] * v[e]; }
            ss += __shfl_xor(ss, 1); ss += __shfl_xor(ss, 2);
            const float rs = __builtin_amdgcn_rsqf(ss * (1.f / 64.f) + EPS); const float* gn = FIN(I_NKCN) + L * 64 + c0;
            const int n = n0 + row; const bool dead = n >= 127;
            v4u w0, w1; float o[16];
#pragma unroll
            for (int e = 0; e < 16; ++e) { o[e] = kv ? v[e] : v[e] * rs * gn[e]; if (dead) o[e] = 0.f; }
            w0.x = pk2(o[0], o[1]); w0.y = pk2(o[2], o[3]); w0.z = pk2(o[4], o[5]); w0.w = pk2(o[6], o[7]); w1.x = pk2(o[8], o[9]); w1.y = pk2(o[10], o[11]); w1.z = pk2(o[12], o[13]); w1.w = pk2(o[14], o[15]);
            const int tl = n >> 6, rr = n & 63;
            if (kv) { bf16* dstp = F_VC + (size_t)(b * 2 + tl) * 4096 + vimg_off(rr, c0); *(v4u*)dstp = w0; *(v4u*)(dstp + 8) = w1; }
            else { bf16* dstp = F_KC + (size_t)(b * 2 + tl) * 4096; *(v4u*)(dstp + kimg_off(rr, c0)) = w0; *(v4u*)(dstp + kimg_off(rr, c0 + 8)) = w1; } }
        __syncthreads();
    }
}

#ifndef PROBE_ATT
#define PROBE_ATT 0
#endif
#define TSA(l_, k_) do { if (PROBE_TS >= 20 && PROBE_TS < 80 && !(PROBE_TS >= 30 && PROBE_TS < 60)) TS(l_, k_); } while (0)
namespace att {
constexpr int STG = 32768;
constexpr int L_STG = 0, L_IA = 65536, IAB = 4 * 64 * 33 * 4, L_IB = L_IA + IAB, L_SC = L_IB + IAB, L_SEL = L_SC + 64 * 36 * 4, L_UNI = L_SEL + 256, L_WSF = L_UNI + 256, L_END = L_WSF + NWAVES * 256;
static_assert(L_END <= MISC_OFF, "attention LDS map");
constexpr int OSTP = 264;
#define ATT_BAR() asm volatile("s_waitcnt vmcnt(0) lgkmcnt(0)\n\ts_barrier" ::: "memory")
#define ATT_LBAR() asm volatile("s_waitcnt lgkmcnt(0)\n\ts_barrier" ::: "memory")
__device__ __forceinline__ int crow(int r, int hi) { return (r & 3) + 8 * (r >> 2) + 4 * hi; }
__device__ __forceinline__ float pair_max(float v) { auto rr = __builtin_amdgcn_permlane32_swap(__float_as_uint(v), __float_as_uint(v), false, false); return fmaxf(__uint_as_float(rr[0]), __uint_as_float(rr[1])); }
__device__ __forceinline__ float pair_sum(float v) { auto rr = __builtin_amdgcn_permlane32_swap(__float_as_uint(v), __float_as_uint(v), false, false); return __uint_as_float(rr[0]) + __uint_as_float(rr[1]); }
__device__ __forceinline__ void dma_tile(const bf16* tile, LAS unsigned char* slot, int wave, int lane) {
    __builtin_amdgcn_global_load_lds((const unsigned*)(tile + wave * 512 + lane * 8), (LAS unsigned*)(slot + wave * 1024), 16, 0, 0); }
__device__ __forceinline__ void qk_tile(f32x16& p0, f32x16& p1, const LAS unsigned char* kslot, const bf16x8 (&qr)[4], const f32x16& cin, int r32, int hi) {
    const LAS unsigned char* kp = kslot + hi * 1024 + r32 * 16;
#pragma unroll
    for (int d0 = 0; d0 < 4; ++d0) { const bf16x8 b0 = *(const LAS bf16x8*)(kp + d0 * 2048), b1 = *(const LAS bf16x8*)(kp + d0 * 2048 + 512);
        if (d0 == 0) { p0 = __builtin_amdgcn_mfma_f32_32x32x16_bf16(b0, qr[0], cin, 0, 0, 0); p1 = __builtin_amdgcn_mfma_f32_32x32x16_bf16(b1, qr[0], cin, 0, 0, 0); }
        else { p0 = __builtin_amdgcn_mfma_f32_32x32x16_bf16(b0, qr[d0], p0, 0, 0, 0); p1 = __builtin_amdgcn_mfma_f32_32x32x16_bf16(b1, qr[d0], p1, 0, 0, 0); } }
}
__device__ __forceinline__ v4i16_t vtr(const LAS unsigned char* p) { return __builtin_amdgcn_ds_read_tr16_b64_v4i16((LAS v4i16_t*)p); }
__device__ __forceinline__ void pv_tile(f32x16& o0, f32x16& o1, const LAS unsigned char* vslot, const v4u (&pw)[4], int lane, int hi) {
    const unsigned vb = (unsigned)(uintptr_t)(vslot + ((lane >> 4) & 1) * 32 + (lane & 3) * 8 + (4 * hi + ((lane & 15) >> 2)) * 64);
#define PV_HALF(o_, OFF) do { v4i16_t a0[4], a1[4]; \
        _Pragma("unroll") for (int s_ = 0; s_ < 4; ++s_) { \
            asm volatile("ds_read_b64_tr_b16 %0, %1 offset:%c2" : "=&v"(a0[s_]) : "v"(vb), "i"((OFF) + s_ * 1024) : "memory"); \
            asm volatile("ds_read_b64_tr_b16 %0, %1 offset:%c2" : "=&v"(a1[s_]) : "v"(vb), "i"((OFF) + s_ * 1024 + 512) : "memory"); } \
        PV_STEP(o_, 0, 6); PV_STEP(o_, 1, 4); PV_STEP(o_, 2, 2); PV_STEP(o_, 3, 0); } while (0)
#define PV_STEP(o_, s_, N) do { asm volatile("s_waitcnt lgkmcnt(" #N ")" : "+v"(a0[s_]), "+v"(a1[s_]) :: "memory"); \
        const bf16x8 v0 = (bf16x8){a0[s_][0], a0[s_][1], a0[s_][2], a0[s_][3], a1[s_][0], a1[s_][1], a1[s_][2], a1[s_][3]}; \
        o_ = __builtin_amdgcn_mfma_f32_32x32x16_bf16(__builtin_bit_cast(bf16x8, pw[s_]), v0, o_, 0, 0, 0); } while (0)
    PV_HALF(o0, 0); PV_HALF(o1, 4096);
#undef PV_STEP
#undef PV_HALF
}
__device__ __forceinline__ void pack_p(v4u (&pw)[4], const f32x16& p0, const f32x16& p1) {
    pw[0] = (v4u){pk2(p0[0], p0[1]), pk2(p0[2], p0[3]), pk2(p0[4], p0[5]), pk2(p0[6], p0[7])};
    pw[1] = (v4u){pk2(p0[8], p0[9]), pk2(p0[10], p0[11]), pk2(p0[12], p0[13]), pk2(p0[14], p0[15])};
    pw[2] = (v4u){pk2(p1[0], p1[1]), pk2(p1[2], p1[3]), pk2(p1[4], p1[5]), pk2(p1[6], p1[7])};
    pw[3] = (v4u){pk2(p1[8], p1[9]), pk2(p1[10], p1[11]), pk2(p1[12], p1[13]), pk2(p1[14], p1[15])};
}
#define MX3(a, b, c) __builtin_fmaxf(__builtin_fmaxf((a), (b)), (c))
__device__ __forceinline__ void softmax_step(float& m, f32x16& negm, float& l, f32x16& o0, f32x16& o1, f32x16& p0, f32x16& p1, v4u (&pw)[4], LAS float* wsf, int r32, int hi) {
    float xa = MX3(p0[0], p0[1], p1[0]), xb = MX3(p0[2], p0[3], p1[1]); xa = MX3(xa, p1[2], p1[3]);
#pragma unroll
    for (int r = 4; r < 16; r += 4) { xa = MX3(xa, p0[r], p0[r + 1]); xb = MX3(xb, p0[r + 2], p0[r + 3]); xa = MX3(xa, p1[r], p1[r + 1]); xb = MX3(xb, p1[r + 2], p1[r + 3]); }
    const float mt = pair_max(__builtin_fmaxf(xa, xb));
    if (__any(mt > 8.0f)) {
        const float dl = __builtin_fmaxf(mt, 0.f), al = __builtin_amdgcn_exp2f(-dl); l *= al; m += dl;
        if (hi == 0) wsf[r32] = al;
        f32x4 a[4];
#pragma unroll
        for (int g = 0; g < 4; ++g) a[g] = *(const LAS f32x4*)(wsf + 8 * g + 4 * hi);
#pragma unroll
        for (int r = 0; r < 16; ++r) { o0[r] *= a[r >> 2][r & 3]; o1[r] *= a[r >> 2][r & 3]; p0[r] -= dl; p1[r] -= dl; negm[r] = -m; }
    }
    float rs0 = 0.f, rs1 = 0.f;
#pragma unroll
    for (int r = 0; r < 16; ++r) { p0[r] = __builtin_amdgcn_exp2f(p0[r]); p1[r] = __builtin_amdgcn_exp2f(p1[r]); rs0 += p0[r]; rs1 += p1[r]; }
    l += rs0 + rs1;
    pack_p(pw, p0, p1);
}
__device__ __forceinline__ void scale_rows(f32x16& a0, f32x16& a1, const f32x16& o0, const f32x16& o1, float fac, LAS float* wsf, int r32, int hi) {
    if (hi == 0) wsf[32 + r32] = fac;
    f32x4 f[4];
#pragma unroll
    for (int g = 0; g < 4; ++g) f[g] = *(const LAS f32x4*)(wsf + 32 + 8 * g + 4 * hi);
#pragma unroll
    for (int r = 0; r < 16; ++r) { a0[r] += o0[r] * f[r >> 2][r & 3]; a1[r] += o1[r] * f[r >> 2][r & 3]; }
}
constexpr int L_OTS = 65536;
__device__ __forceinline__ void ots_put(const f32x16& a0, const f32x16& a1, LAS unsigned char* lds, int wave, int lane) {
    LAS float* S = (LAS float*)(lds + L_OTS) + wave * 2048 + lane;
#pragma unroll
    for (int r = 0; r < 16; ++r) { S[r * 64] = a0[r]; S[(16 + r) * 64] = a1[r]; }
}
__device__ __forceinline__ void ots_get(f32x16& a0, f32x16& a1, const LAS unsigned char* lds, int wave, int lane) {
    const LAS float* S = (const LAS float*)(lds + L_OTS) + wave * 2048 + lane;
#pragma unroll
    for (int r = 0; r < 16; ++r) { a0[r] = S[r * 64]; a1[r] = S[(16 + r) * 64]; }
}
template <int MODE>
__device__ __forceinline__ void run_branch(unsigned tiles, const bf16* Kg  , const bf16* Vg, int kvsel, unsigned selm, int tq, const bf16x8 (&qr)[4],
                                           float& m, float& l, f32x16& o0, f32x16& o1, LAS unsigned char* lds, LAS float* wsf, int wave, int lane) {
    constexpr int NKV = MODE == 2 ? 2 : 1, SLOT = 16384 * NKV, NS = 4;
    const int r32 = lane & 31, hi = lane >> 5;
    m = 0.f; l = 0.f; o0 = (f32x16){}; o1 = (f32x16){}; f32x16 negm = (f32x16){};
    unsigned remc = (unsigned)__builtin_amdgcn_readfirstlane((int)tiles), remi = remc;
    int nleft = __builtin_popcount(remc), slot_i = 0, slot_c = 0;
    ATT_LBAR();
#define ATT_ISSUE() do { const int ji = __builtin_ctz(remi); remi &= remi - 1; LAS unsigned char* st_ = lds + L_STG + slot_i * SLOT; slot_i = (slot_i + 1) & (NS - 1); \
        _Pragma("unroll") for (int g = 0; g < NKV; ++g) { dma_tile(Kg + (size_t)(g * 512 + ji) * 4096, st_ + g * 8192, wave, lane); dma_tile(Vg + (size_t)(g * 512 + ji) * 4096, st_ + NKV * 8192 + g * 8192, wave, lane); } } while (0)
#define ATT_WB(n) asm volatile("s_waitcnt vmcnt(" #n ") lgkmcnt(0)\n\ts_barrier" ::: "memory")
#pragma nounroll
    for (int k = 0; k < NS - 2; ++k) if (remi) ATT_ISSUE();
    TSA(lds, 70 + MODE);
    const bool lead = true; v4u pw[4] = {}; const LAS unsigned char* stp = lds + L_STG;
    bool havep = false;
    constexpr int W = MODE == 1 ? 512 : 128;
    const int curt = __builtin_amdgcn_readfirstlane(tq) >> 6;
#define ATT_QS(j_, st_) do { const int kb = 64 * (j_) + 4 * hi; const bool sel = MODE != 0 || ((selm >> (j_)) & 1u); \
        const bool edge = MODE == 3 || (j_) == curt || (MODE != 0 && (j_) + W / 64 == curt);     \
        f32x16 p0, p1; \
        if (MODE == 0) { f32x16 cin;     \
            _Pragma("unroll") for (int r = 0; r < 16; ++r) cin[r] = sel ? negm[r] : -INFINITY; \
            qk_tile(p0, p1, (st_) + kvsel * 8192, qr, cin, r32, hi); } \
        else qk_tile(p0, p1, (st_) + kvsel * 8192, qr, negm, r32, hi); \
        if (edge) { _Pragma("unroll") for (int r = 0; r < 16; ++r) { const int kp = kb + (r & 3) + 8 * (r >> 2); bool v0, v1; \
                if (MODE == 0) { v0 = kp <= tq; v1 = kp + 32 <= tq; } \
                else if (MODE == 3) { v0 = 16 * kp + 31 <= tq; v1 = 16 * (kp + 32) + 31 <= tq; } \
                else { v0 = kp <= tq && kp + W > tq; v1 = kp + 32 <= tq && kp + 32 + W > tq; } \
                p0[r] = v0 ? p0[r] : -INFINITY; p1[r] = v1 ? p1[r] : -INFINITY; } } \
        softmax_step(m, negm, l, o0, o1, p0, p1, pw, wsf, r32, hi); } while (0)
    for (;;) {
        const int pend = (nleft - 1 < NS - 3 ? nleft - 1 : NS - 3) * NKV;
        switch (pend) { case 0: ATT_WB(0); break; case 1: ATT_WB(2); break; case 2: ATT_WB(4); break; case 3: ATT_WB(6); break; case 4: ATT_WB(8); break; default: ATT_WB(10); break; }
        if (remi) ATT_ISSUE();
        const int j = __builtin_ctz(remc); remc &= remc - 1; --nleft;
        const LAS unsigned char* st = lds + L_STG + slot_c * SLOT; slot_c = (slot_c + 1) & (NS - 1);
        if (lead) { ATT_QS(j, st); pv_tile(o0, o1, st + NKV * 8192 + kvsel * 8192, pw, lane, hi); }
        else { if (havep) pv_tile(o0, o1, stp + NKV * 8192 + kvsel * 8192, pw, lane, hi); ATT_QS(j, st); }
        stp = st; havep = true;
        TSA(lds, 60 + MODE);
        if (nleft == 0) break;
    }
    if (!lead) pv_tile(o0, o1, stp + NKV * 8192 + kvsel * 8192, pw, lane, hi);
#undef ATT_QS
#undef ATT_ISSUE
#undef ATT_WB
}
__device__ __forceinline__ void stage_norm_store(const f32x16& o0, const f32x16& o1, bf16* ynb  , LAS unsigned char* lds, int wave, int lane) {
    const int r32 = lane & 31, hi = lane >> 5, h = wave & 3, th = wave >> 2;
    LAS bf16* OST = (LAS bf16*)(lds + L_STG);
    ATT_LBAR();
#pragma unroll
    for (int r = 0; r < 16; ++r) { LAS bf16* p = OST + (32 * th + crow(r, hi)) * OSTP + h * 64 + r32;
        p[0] = (bf16)(pk2(o0[r], 0.f) & 0xffffu); p[32] = (bf16)(pk2(o1[r], 0.f) & 0xffffu); }
    ATT_LBAR();
    f32x4 vv[8]; float ssn[8];
#pragma unroll
    for (int i = 0; i < 8; ++i) { const u32x2 w = *(const LAS u32x2*)(OST + (8 * wave + i) * OSTP + 4 * lane); vv[i] = (f32x4){bflo(w.x), bfhi(w.x), bflo(w.y), bfhi(w.y)}; ssn[i] = sq4(vv[i]); }
#pragma unroll
    for (int i = 0; i < 8; ++i) ssn[i] = wave_sum(ssn[i]);
#pragma unroll
    for (int i = 0; i < 8; ++i) st4bf(ynb + (size_t)(8 * wave + i) * D + 4 * lane, vv[i] * __builtin_amdgcn_rsqf(ssn[i] * (1.f / 256.f) + EPS));
}
__device__ __forceinline__ void attn_unit(Frame& F, int L, int b, int qt) {
    LAS unsigned char* lds = F.lds;
    int tid = F.tid; asm volatile("" : "+v"(tid));
    const int wave = F.wave, lane = tid & 63, r32 = lane & 31, hi = lane >> 5, h = wave & 3, th = wave >> 2;
    const int t0 = qt * 64, cur = qt, qrow = 32 * th + r32, tq = t0 + qrow;
    const size_t mrow = (size_t)b * T + tq;
    LAS float* wsf = (LAS float*)(lds + L_WSF) + wave * 64;
    LAS float* IA = (LAS float*)(lds + L_IA); LAS float* IB = (LAS float*)(lds + L_IB); LAS float* SC = (LAS float*)(lds + L_SC);
    LAS unsigned* SEL = (LAS unsigned*)(lds + L_SEL); LAS unsigned* UNI = (LAS unsigned*)(lds + L_UNI);
    const size_t tb = (size_t)b * 32 * 4096;
    bf16x8 qr[4];
#pragma unroll
    for (int d0 = 0; d0 < 4; ++d0) qr[d0] = *(const bf16x8*)(F_QA + mrow * 256 + h * 64 + d0 * 16 + hi * 8);
    const float* gp = F_GATES + mrow * 12 + h * 3; const float g0 = gp[0], g1 = gp[1], g2 = gp[2];
    float mb, lb; f32x16 ob0, ob1;
    for (int rep = 0; rep < ((PROBE_ATT & 4) ? 2 : 1); ++rep) {
        if (rep) { ATT_LBAR(); }
        if (tid == 0) UNI[0] = 0u;
        run_branch<3>(3u, F_KC + (size_t)b * 2 * 4096, F_VC + (size_t)b * 2 * 4096, 0, 0u, tq, qr, mb, lb, ob0, ob1, lds, wsf, wave, lane);
        TSA(lds, 20);
        const float lt = pair_sum(lb); const float inv = lt > 0.f ? 1.0f / lt : 0.f;
        f32x16 oc0 = (f32x16){}, oc1 = (f32x16){}; scale_rows(oc0, oc1, ob0, ob1, g0 * inv, wsf, r32, hi);
        LAS float* ia = IA + (h * 64 + qrow) * 33; LAS float* ib = IB + (h * 64 + qrow) * 33;
#pragma unroll
        for (int tl = 0; tl < 2; ++tl) { f32x16 p0, p1; const f32x16 z16 = (f32x16){}; qk_tile(p0, p1, lds + L_STG + tl * 16384, qr, z16, r32, hi);
#pragma unroll
            for (int r = 0; r < 16; ++r) { const int n = 64 * tl + crow(r, hi);
                p0[r] = 16 * n + 31 <= tq ? __builtin_amdgcn_exp2f(p0[r] - mb) * inv : 0.f; p1[r] = 16 * (n + 32) + 31 <= tq ? __builtin_amdgcn_exp2f(p1[r] - mb) * inv : 0.f; }
#pragma unroll
            for (int G = 0; G < 4; ++G) {
                ia[hi + 2 * (G + 8 * tl)] = (p0[4 * G] + p0[4 * G + 1]) + (p0[4 * G + 2] + p0[4 * G + 3]); ib[hi + 2 * (G + 8 * tl)] = p0[4 * G + 3];
                ia[hi + 2 * (G + 4 + 8 * tl)] = (p1[4 * G] + p1[4 * G + 1]) + (p1[4 * G + 2] + p1[4 * G + 3]); ib[hi + 2 * (G + 4 + 8 * tl)] = p1[4 * G + 3]; } }
        TSA(lds, 27);
        ATT_LBAR();
        const int q = tid >> 3, jg = tid & 7, tqq = t0 + q;
#pragma unroll
        for (int i = 0; i < 4; ++i) { const int j = 4 * jg + i; float imp = 0.f;
#pragma unroll
            for (int hh = 0; hh < 4; ++hh) { imp += IA[(hh * 64 + q) * 33 + j]; if (j > 0) imp += IB[(hh * 64 + q) * 33 + j - 1]; }
            const bool forced = j == 0 || j == cur || j == cur - 1, future = j * 64 > tqq;
            SC[q * 36 + j] = forced ? 1e4f : (future ? -1.0f : imp); }
        ATT_LBAR();
        TSA(lds, 28);
        unsigned bits = 0u;
        { f32x4 sc4[8];
#pragma unroll
          for (int g = 0; g < 8; ++g) sc4[g] = *(const LAS f32x4*)(SC + q * 36 + 4 * g);
          const f32x4 mine = *(const LAS f32x4*)(SC + q * 36 + 4 * jg);
#pragma unroll
          for (int i = 0; i < 4; ++i) { const int j = 4 * jg + i; const float sj = mine[i]; int rank = 0;
#pragma unroll
              for (int k = 0; k < 32; ++k) { const float sk = sc4[k >> 2][k & 3]; rank += (sk > sj || (sk == sj && k < j)) ? 1 : 0; }
              if (rank < 8) bits |= 1u << j; } }
        TSA(lds, 29);
        bits |= __shfl_xor(bits, 1); bits |= __shfl_xor(bits, 2); bits |= __shfl_xor(bits, 4);
        if (jg == 0) { SEL[q] = bits; atomicOr((unsigned*)UNI, bits); }
        ATT_LBAR();
        ots_put(oc0, oc1, lds, wave, lane);
    }
    TSA(lds, 21);
    { const unsigned selm = SEL[qrow]; const unsigned uni = UNI[0] & ((2u << cur) - 1u);
      if (PROBE_ATT & 1) run_branch<0>(uni, F_KSI + tb, F_VSI + tb, 0, selm, tq, qr, mb, lb, ob0, ob1, lds, wsf, wave, lane);
      run_branch<0>(uni, F_KSI + tb, F_VSI + tb, 0, selm, tq, qr, mb, lb, ob0, ob1, lds, wsf, wave, lane);
      const float lt = pair_sum(lb); f32x16 ot0, ot1; ots_get(ot0, ot1, lds, wave, lane); scale_rows(ot0, ot1, ob0, ob1, g1 / lt, wsf, r32, hi); ots_put(ot0, ot1, lds, wave, lane); }
    TSA(lds, 22);
    { const int lo = cur >= 8 ? cur - 8 : 0; const unsigned tiles = ((2u << cur) - 1u) & ~((1u << lo) - 1u);
      if (PROBE_ATT & 2) run_branch<1>(tiles, F_KWI + tb, F_VWI + tb, 0, 0u, tq, qr, mb, lb, ob0, ob1, lds, wsf, wave, lane);
      run_branch<1>(tiles, F_KWI + tb, F_VWI + tb, 0, 0u, tq, qr, mb, lb, ob0, ob1, lds, wsf, wave, lane);
      const float lt = pair_sum(lb); f32x16 ot0, ot1; ots_get(ot0, ot1, lds, wave, lane); scale_rows(ot0, ot1, ob0, ob1, g2 / lt, wsf, r32, hi);
      stage_norm_store(ot0, ot1, F_YN + ((size_t)b * T + t0) * D + 0, lds, wave, lane); }
    for (int rep = 0; rep < ((PROBE_ATT & 16) ? 2 : 1); ++rep) {
#pragma unroll
        for (int d0 = 0; d0 < 4; ++d0) qr[d0] = *(const bf16x8*)(F_QC + mrow * 256 + h * 64 + d0 * 16 + hi * 8);
        const int lo = cur >= 2 ? cur - 2 : 0; const unsigned tiles = ((2u << cur) - 1u) & ~((1u << lo) - 1u);
        run_branch<2>(tiles, F_CKI + tb, F_CVI + tb, h >> 1, 0u, tq, qr, mb, lb, ob0, ob1, lds, wsf, wave, lane);
        TSA(lds, 25);
        const float sink2 = FIN(I_SINK)[L * 4 + h] * LOG2E;
        const float mf = fmaxf(mb, sink2), sc = __builtin_amdgcn_exp2f(mb - mf);
        const float lt = pair_sum(lb) * sc + __builtin_amdgcn_exp2f(sink2 - mf);
        f32x16 ot0 = (f32x16){}, ot1 = (f32x16){};
        scale_rows(ot0, ot1, ob0, ob1, sc / lt, wsf, r32, hi);
        stage_norm_store(ot0, ot1, F_YN + ((size_t)b * T + t0) * D + 512, lds, wave, lane);
        TSA(lds, 26);
    }
}
__device__ __forceinline__ void attn_phase(Frame& F, int L) {
    for (int w = F.vcu; w < 256; w += F.G) { const int b = w >> 4, i = w & 15;
#pragma nounroll
        for (int u2 = 0; u2 < 2; ++u2) attn_unit(F, L, b, u2 ? 31 - i : i); }
    ATT_LBAR();
}
}

__global__ void __launch_bounds__(NWAVES * 64, 2) fwd(Args args) {
    extern __shared__ __attribute__((aligned(16))) unsigned char lds[];
    Frame F;
    F.lds = (LAS unsigned char*)lds;
    F.tid = threadIdx.x; F.lane = F.tid & 63; F.wave = __builtin_amdgcn_readfirstlane(F.tid >> 6);
    F.G = gridDim.x; { const int bx = blockIdx.x; F.vcu = (F.G % 8 == 0) ? (bx % 8) * (F.G / 8) + bx / 8 : bx; }
    F.a = &args;
    unsigned char* ws = args.ws;
    volatile LAS unsigned* MISC = (volatile LAS unsigned*)(F.lds + MISC_OFF);
    if (F.tid < 64) MISC[F.tid] = 0u;
    __syncthreads();
#define GRID_BAR() do { XcdBarrier b2_ = bar; { unsigned xx_ = b2_.x; asm volatile("" : "+s"(xx_)); b2_.x = xx_; }     \
        xcd_barrier(b2_); if (PROBE_DUP & 1024) xcd_barrier(b2_); __builtin_amdgcn_s_waitcnt(0); } while (0)
    XcdBarrier bar = xcd_barrier_post((unsigned*)(ws + WS_CTL) + CW_BAR, MISC + 8);

#ifndef PH_MASK
#define PH_MASK 127
#endif
#ifndef PROBE_DUP
#define PROBE_DUP 0
#endif
    TS(F.lds, 0);
    if (PH_MASK & 1) prologue(F);
    TS(F.lds, 1);
    if (PROBE_DUP & 1) prologue(F);
    GRID_BAR(); TS(F.lds, 14);
    for (int s = 0; s < 2 * DEPTH; ++s) {
        const int L = s >> 1, which = s & 1;
        const bool up8 = (UP8_MASK >> s) & 1u, dn8 = (DN8_MASK >> s) & 1u;
        if (PH_MASK & 2) {
            const bf16* wt = (const bf16*)((unsigned char*)F_W13T + (size_t)s * NF1 * D * 2); pg8::StaticOrder S; S.init(M, NF1, F.G, (int)blockIdx.x);
            if (up8) { pg8::Gemm g{(const bf16*)F_X8, wt, M, NF1, D / 2};
                if (PROBE_DUP & 128) { pg8::EpiNull EN{F_GATES}; pg8::gemm_phase<pg8::EpiNull, pg8::StaticOrder, true, true, true>(F.lds, g, S, EN); }
                if (PROBE_DUP & 256) { pg8::EpiNull EN{F_GATES}; pg8::FixedOrder<1> S2; S2.init(M, NF1, F.G, (int)blockIdx.x); pg8::gemm_phase<pg8::EpiNull, pg8::FixedOrder<1>, true, true, true>(F.lds, g, S2, EN); }
                if (PROBE_DUP & 512) { pg8::EpiNull EN{F_GATES}; pg8::FixedOrder<3> S2; S2.init(M, NF1, F.G, (int)blockIdx.x); pg8::gemm_phase<pg8::EpiNull, pg8::FixedOrder<3>, true, true, true>(F.lds, g, S2, EN); }
                if (dn8) { pg8::EpiSwiglu<true> E{(void*)F_ACT, DFF, F_SSQ, 1.0f / W8_SCALE, ACT8_SCALE, F.lds + pg8::STAGE_BYTES, 0, 0, 0}; for (int rep = 0; rep < ((PROBE_DUP & 2) ? 2 : 1); ++rep) pg8::gemm_phase<pg8::EpiSwiglu<true>, pg8::StaticOrder, true, true, true, 1>(F.lds, g, S, E); }
                else if (((UP8_MASK & ~DN8_MASK) & 0xFu) != 0u) { pg8::EpiSwiglu<false> E{(void*)F_ACT, DFF, F_SSQ, 1.0f / W8_SCALE, 1.0f, F.lds + pg8::STAGE_BYTES, 0, 0, 0}; for (int rep = 0; rep < ((PROBE_DUP & 2) ? 2 : 1); ++rep) pg8::gemm_phase<pg8::EpiSwiglu<false>, pg8::StaticOrder, true, true, true>(F.lds, g, S, E); } }
            else { pg8::Gemm g{F_XB, wt, M, NF1, D};
                if (dn8) { if (((~UP8_MASK & DN8_MASK) & 0xFu) != 0u) { pg8::EpiSwiglu<true> E{(void*)F_ACT, DFF, F_SSQ, 1.0f, ACT8_SCALE, F.lds + pg8::STAGE_BYTES, 0, 0, 0}; for (int rep = 0; rep < ((PROBE_DUP & 2) ? 2 : 1); ++rep) pg8::gemm_phase<pg8::EpiSwiglu<true>, pg8::StaticOrder, true, true, false, 2>(F.lds, g, S, E); } }
                else if (((~UP8_MASK & ~DN8_MASK) & 0xFu) != 0u) { pg8::EpiSwiglu<false> E{(void*)F_ACT, DFF, F_SSQ, 1.0f, 1.0f, F.lds + pg8::STAGE_BYTES, 0, 0, 0}; for (int rep = 0; rep < ((PROBE_DUP & 2) ? 2 : 1); ++rep) pg8::gemm_phase<pg8::EpiSwiglu<false>, pg8::StaticOrder, true, true, false>(F.lds, g, S, E); } }
        }
        TS(F.lds, 2); GRID_BAR(); TS(F.lds, 3);
        if (PH_MASK & 4) {
            const bf16* wt = (const bf16*)((unsigned char*)F_W2T + (size_t)s * D * DFF * 2); pg8::StaticOrder S; S.init(M, D, F.G, (int)blockIdx.x);
            const int last = (s + 1 == 2 * DEPTH) ? 1 : 0, w8 = ((s & 1) && !last && ((UP8_MASK >> (s + 1)) & 1u)) ? 1 : 0;
            if (dn8) { if (DN8_MASK & 0xFu) { pg8::Gemm g{F_ACT, wt, M, D, DFF / 2}; pg8::EpiRes E{F_XB, F_SSQ, 1, F_X8, FOUT, w8, last}; pg8::gemm_phase<pg8::EpiRes, pg8::StaticOrder, true, true, true, 3>(F.lds, g, S, E); } }
            else if ((~DN8_MASK) & 0xFu) { pg8::Gemm g{F_ACT, wt, M, D, DFF}; pg8::EpiRes E{F_XB, F_SSQ, 0, F_X8, FOUT, w8, last}; pg8::gemm_phase<pg8::EpiRes, pg8::StaticOrder, true, true, false, 4>(F.lds, g, S, E); }
        }
        TS(F.lds, 4); if (s + 1 < 2 * DEPTH) GRID_BAR(); TS(F.lds, 5);
        if (which == 0) {
            if (PH_MASK & 8) {
                pg8::Gemm g{F_XB, F_WINT + (size_t)L * NU * D, M, NU, D}; pg8::StaticOrder S; S.init(M, NU, F.G, (int)blockIdx.x);
                pg8::EpiScaleBf16 E{F_U, NU, F_SSQ, F.lds + pg8::STAGE_BYTES, 0, 0, 0};
                for (int rep = 0; rep < ((PROBE_DUP & 8) ? 2 : 1); ++rep) pg8::gemm_phase<pg8::EpiScaleBf16, pg8::StaticOrder, true, true, false, 5>(F.lds, g, S, E);
            }
            TS(F.lds, 6); GRID_BAR(); TS(F.lds, 7);
            if (PH_MASK & 16) prep_phase(F, L);
            if (PROBE_DUP & 16) prep_phase(F, L);
            TS(F.lds, 8); GRID_BAR(); TS(F.lds, 9);
            if (PH_MASK & 32) att::attn_phase(F, L);
            if (PROBE_DUP & 32) att::attn_phase(F, L);
            TS(F.lds, 10); GRID_BAR(); TS(F.lds, 11);
            if (PH_MASK & 64) {
                pg8::Gemm g{F_YN, F_WOUTT + (size_t)L * D * D, M, D, D}; pg8::StaticOrder S; S.init(M, D, F.G, (int)blockIdx.x);
                pg8::EpiRes E{F_XB, F_SSQ, 2, F_X8, FOUT, (int)((UP8_MASK >> (2 * L + 1)) & 1u), 0};
                pg8::gemm_phase<pg8::EpiRes, pg8::StaticOrder, true, true, false, 6>(F.lds, g, S, E);
            }
            TS(F.lds, 12); GRID_BAR(); TS(F.lds, 13);
        }
    }
    if (PROBE_TS && blockIdx.x == 0 && threadIdx.x == 0) {
        volatile LAS unsigned* m_ = (volatile LAS unsigned*)(F.lds + 163648); const unsigned long long t0_ = __builtin_amdgcn_s_memrealtime(), d_ = (unsigned long long)m_[1] * TS_AMP;
        while (__builtin_amdgcn_s_memrealtime() - t0_ < d_) __builtin_amdgcn_s_sleep(8); }
}

extern "C" void kernel_launch(void* const* d_in, const int* in_sizes, int n_in, void* d_out, int out_size, void* d_ws, size_t ws_size, hipStream_t stream) {
    static int grid = 0;
    if (grid == 0) {
        if (n_in != 29 || in_sizes[0] != M * D || out_size != M * D || ws_size < WS_END) { fprintf(stderr, "kernel_launch: unexpected shapes (n_in %d, in0 %d, out %d, ws %zu); nothing launched\n", n_in, n_in > 0 ? in_sizes[0] : -1, out_size, ws_size); grid = -1; return; }
        int dev = 0, cus = 0, per_cu = 0;
        if (hipGetDevice(&dev) != hipSuccess || hipDeviceGetAttribute(&cus, hipDeviceAttributeMultiprocessorCount, dev) != hipSuccess) { grid = -1; return; }
        if (hipFuncSetAttribute((const void*)fwd, hipFuncAttributeMaxDynamicSharedMemorySize, LDS_BYTES) != hipSuccess) { fprintf(stderr, "kernel_launch: hipFuncSetAttribute failed\n"); grid = -1; return; }
        if (hipOccupancyMaxActiveBlocksPerMultiprocessor(&per_cu, (const void*)fwd, NWAVES * 64, LDS_BYTES) != hipSuccess || per_cu < 1) fprintf(stderr, "kernel_launch: occupancy query says %d\n", per_cu);
        (void)hipGetLastError();
        grid = cus;
    }
    if (grid < 0) return;
    if (hipMemsetAsync((char*)d_ws + WS_CTL, 0, CTL_ZERO_BYTES, stream) != hipSuccess) return;
    Args a{};
    for (int i = 0; i < 29; ++i) a.in[i] = (const float*)d_in[i];
    a.out = (float*)d_out; a.ws = (unsigned char*)d_ws;
    hipLaunchKernelGGL(fwd, dim3(grid), dim3(NWAVES * 64), LDS_BYTES, stream, a);
}
```

```cpp
#include <hip/hip_runtime.h>
#include <cstdio>
#include <cstdint>
#ifndef PROBE_TS
#define PROBE_TS 0
#endif
#define TS_AMP 4u
#define TS(ldsbase, k) do { if (PROBE_TS && blockIdx.x == 0 && threadIdx.x == 0) { volatile __attribute__((address_space(3))) unsigned* m_ = (volatile __attribute__((address_space(3))) unsigned*)((ldsbase) + 163648); \
        const unsigned t_ = (unsigned)__builtin_amdgcn_s_memrealtime(); if ((k) == PROBE_TS) m_[1] += t_ - m_[0]; m_[0] = t_; } } while (0)
struct KArgs { const float* in[29]; float* out; unsigned char* ws; };
namespace pg8 {
#define PG8_LAS __attribute__((address_space(3)))
typedef unsigned short bf16_t;
typedef short bf16x8 __attribute__((ext_vector_type(8)));
typedef float f32x4 __attribute__((ext_vector_type(4)));
typedef unsigned u32x4 __attribute__((ext_vector_type(4)));
constexpr int BM = 256, BK = 64, HALF = 128, HTB = HALF * BK * 2  , STAGE_BYTES = 8 * HTB, NXCD = 8, WGM = 8;

__host__ __device__ __forceinline__ int lds_byte(int r, int c) { const int st = (r >> 4) * 2 + (c >> 5), rr = r & 15, cc = c & 31, ob = rr * 64 + cc * 2; return st * 1024 + (ob ^ (((ob >> 9) & 1) << 5)); }
__host__ __device__ __forceinline__ void stage_rc(int b, int& R, int& C) { const int st = b / 1024, sb = b % 1024, swz = sb ^ (((sb >> 9) & 1) << 5); R = (st >> 1) * 16 + swz / 64; C = (st & 1) * 32 + (swz % 64) / 2; }
__host__ __device__ __forceinline__ int perm32(int rho) { const int n = rho >> 4, i = rho & 15; return 8 * (i >> 2) + 4 * n + (i & 3); }

struct Unit { int pm, pn; };
struct Gemm { const bf16_t* A; const bf16_t* Bt; int M, N, K; };

struct StaticOrder {
    int nM, nN, nwg, G, c;
    __host__ __device__ void init(int M, int N, int G_, int c_) { nM = M / BM; nN = N / BM; nwg = nM * nN; G = G_; c = c_; }
    __host__ __device__ bool next(int i, Unit& u) const {
        const long L = (long)i * G + c; if (L >= nwg) return false;
        int wgid = (int)L; { const int q = nwg / NXCD, r = nwg % NXCD, xcd = wgid % NXCD, off = wgid / NXCD; wgid = (xcd < r ? xcd * (q + 1) : r * (q + 1) + (xcd - r) * q) + off; }
        const int nig = WGM * nN, gid = wgid / nig, fm = gid * WGM, gsz = (nM - fm) < WGM ? (nM - fm) : WGM;
        u.pm = fm + ((wgid % nig) % gsz); u.pn = (wgid % nig) / gsz; return true;
    }
    __device__ __forceinline__ void a_ready(const Unit&) const {}
    __device__ __forceinline__ void done(const Unit&) const {}
};

__device__ __forceinline__ unsigned cvt_pk_bf16(float lo, float hi) { unsigned r; asm volatile("v_cvt_pk_bf16_f32 %0, %1, %2" : "=v"(r) : "v"(lo), "v"(hi)); return r; }

typedef unsigned u32x2 __attribute__((ext_vector_type(2)));
typedef int i32x4 __attribute__((ext_vector_type(4)));
typedef int i32x8 __attribute__((ext_vector_type(8)));
#ifndef MFMA8_SCALE
#define MFMA8_SCALE 1
#endif
__device__ __forceinline__ i32x8 cat8(bf16x8 a, bf16x8 b) { return __builtin_shufflevector(__builtin_bit_cast(i32x4, a), __builtin_bit_cast(i32x4, b), 0, 1, 2, 3, 4, 5, 6, 7); }
__device__ __forceinline__ void mfma8(f32x4& acc, const i32x8& b, const i32x8& a, int sc) {
#if MFMA8_SCALE
    asm volatile("v_mfma_scale_f32_16x16x128_f8f6f4 %0, %1, %2, %0, %3, %3 op_sel_hi:[0,0,0]" : "+v"(acc) : "v"(b), "v"(a), "v"(sc));
#else
    asm volatile("v_mfma_f32_16x16x128_f8f6f4 %0, %1, %2, %0" : "+v"(acc) : "v"(b), "v"(a));
#endif
}
__device__ __forceinline__ unsigned pk4_fp8(float a, float b, float c, float d) { int w = 0; w = __builtin_amdgcn_cvt_pk_fp8_f32(a, b, w, false); w = __builtin_amdgcn_cvt_pk_fp8_f32(c, d, w, true); return (unsigned)w; }
__device__ __forceinline__ unsigned pkbf(float lo, float hi) { typedef float f2_t __attribute__((ext_vector_type(2))); typedef __bf16 b2_t __attribute__((ext_vector_type(2))); f2_t v = {lo, hi}; b2_t b = __builtin_convertvector(v, b2_t); return __builtin_bit_cast(unsigned, b); }
__device__ __forceinline__ float bf_lo(unsigned u) { return __builtin_bit_cast(float, u << 16); }
__device__ __forceinline__ float bf_hi(unsigned u) { return __builtin_bit_cast(float, u & 0xffff0000u); }
__device__ __forceinline__ float swap32_add(float v) { auto rr = __builtin_amdgcn_permlane32_swap(__float_as_uint(v), __float_as_uint(v), false, false); return __uint_as_float(rr[0]) + __uint_as_float(rr[1]); }
__device__ __forceinline__ void fill_rstd_tbl(PG8_LAS unsigned char* tblp, const float* ssq, int pm, int wid, int lane) {
    const int r = wid * 32 + (lane >> 1), hf = lane & 1; const float* p = ssq + (size_t)(pm * BM + r) * 16 + 8 * hf;
    const f32x4 a = *(const f32x4*)p, b = *(const f32x4*)(p + 4);
    float s = ((a[0] + a[1]) + (a[2] + a[3])) + ((b[0] + b[1]) + (b[2] + b[3]));
    s += __builtin_bit_cast(float, __builtin_amdgcn_update_dpp(0, __builtin_bit_cast(int, s), 0xB1, 0xf, 0xf, true));
    if (hf == 0) ((PG8_LAS float*)tblp)[r] = __builtin_amdgcn_rsqf(s * (1.0f / 1024.0f) + 1e-6f);
}
__device__ __forceinline__ void rows_rstd(float (&rs)[2][4], const PG8_LAS unsigned char* tblp, int wr, int fr, float scale) {
#pragma unroll
    for (int ai = 0; ai < 2; ++ai)
#pragma unroll
        for (int m = 0; m < 4; ++m) rs[ai][m] = ((const PG8_LAS float*)tblp)[ai * HALF + wr * 64 + m * 16 + fr] * scale;
}
template <bool F8> struct EpiSwiglu {
    static constexpr bool PERM = true, AFTER_DRAIN = false, ROW_RSTD = true;
    void* O; int ldc; const float* ssq; float insc, oscale; PG8_LAS unsigned char* tbl; mutable int pmA, pmB, pmC;
    __device__ __forceinline__ void set_panels(int a, int b, int c) const { pmA = a; pmB = b; pmC = c; }
    __device__ __forceinline__ void fill_rstd(PG8_LAS unsigned char* t, int pm, int wid, int lane) const { fill_rstd_tbl(t, ssq, pm, wid, lane); }
    __device__ __forceinline__ void operator()(const f32x4 (&acc)[2][2][4][2], const Unit& u, int wr, int wc, int fr_, int fq_) const {
        int tl_ = threadIdx.x; asm volatile("" : "+v"(tl_)); const int fr = tl_ & 15, fq = (tl_ >> 4) & 3; (void)fr_; (void)fq_;
        const int row0 = u.pm * BM + wr * 64 + fr, col0 = u.pn * HALF + wc * 32 + 8 * fq;
        float rsv[2][4]; rows_rstd(rsv, tbl + (u.pm == pmA ? 0 : (u.pm == pmB ? 1024 : (u.pm == pmC ? 2048 : 3072))), wr, fr, insc);
#pragma unroll
        for (int ai = 0; ai < 2; ++ai)
#pragma unroll
            for (int m = 0; m < 4; ++m) { const int row = row0 + ai * HALF + m * 16; const float rs = rsv[ai][m], rsb = rs * (F8 ? oscale : 1.0f); f32x4 ov[2];
#pragma unroll
                for (int n = 0; n < 2; ++n) { const f32x4 a = acc[ai][0][m][n] * rs, b = acc[ai][1][m][n] * rsb, tt = a * -1.4426950408889634f; f32x4 r;
#pragma unroll
                    for (int e = 0; e < 4; ++e) r[e] = __builtin_amdgcn_rcpf(1.0f + __builtin_amdgcn_exp2f(tt[e]));
                    ov[n] = (a * b) * r; }
                const float o[8] = {ov[0][0], ov[0][1], ov[0][2], ov[0][3], ov[1][0], ov[1][1], ov[1][2], ov[1][3]};
                if constexpr (F8) { u32x2 w; w.x = pk4_fp8(o[0], o[1], o[2], o[3]); w.y = pk4_fp8(o[4], o[5], o[6], o[7]);
                    *(u32x2*)((unsigned char*)O + (size_t)row * ldc + col0) = w; }
                else { u32x4 w; w.x = pkbf(o[0], o[1]); w.y = pkbf(o[2], o[3]); w.z = pkbf(o[4], o[5]); w.w = pkbf(o[6], o[7]);
                    *(u32x4*)((bf16_t*)O + (size_t)row * ldc + col0) = w; } }
    }
};
struct EpiScaleBf16 {
    static constexpr bool PERM = true, AFTER_DRAIN = false, ROW_RSTD = true;
    bf16_t* O; int ldc; const float* ssq; PG8_LAS unsigned char* tbl; mutable int pmA, pmB, pmC;
    __device__ __forceinline__ void set_panels(int a, int b, int c) const { pmA = a; pmB = b; pmC = c; }
    __device__ __forceinline__ void fill_rstd(PG8_LAS unsigned char* t, int pm, int wid, int lane) const { fill_rstd_tbl(t, ssq, pm, wid, lane); }
    __device__ __forceinline__ void operator()(const f32x4 (&acc)[2][2][4][2], const Unit& u, int wr, int wc, int fr_, int fq_) const {
        int tl_ = threadIdx.x; asm volatile("" : "+v"(tl_)); const int fr = tl_ & 15, fq = (tl_ >> 4) & 3; (void)fr_; (void)fq_;
        const int row0 = u.pm * BM + wr * 64 + fr, col0 = u.pn * BM + wc * 32 + 8 * fq;
        float rsv[2][4]; rows_rstd(rsv, tbl + (u.pm == pmA ? 0 : (u.pm == pmB ? 1024 : (u.pm == pmC ? 2048 : 3072))), wr, fr, 1.0f);
#pragma unroll
        for (int ai = 0; ai < 2; ++ai)
#pragma unroll
            for (int m = 0; m < 4; ++m) { const int row = row0 + ai * HALF + m * 16; const float rs = rsv[ai][m];
#pragma unroll
                for (int bj = 0; bj < 2; ++bj) { const f32x4 v0 = acc[ai][bj][m][0] * rs, v1 = acc[ai][bj][m][1] * rs;
                    u32x4 w; w.x = pkbf(v0[0], v0[1]); w.y = pkbf(v0[2], v0[3]); w.z = pkbf(v1[0], v1[1]); w.w = pkbf(v1[2], v1[3]);
                    *(u32x4*)(O + (size_t)row * ldc + col0 + bj * HALF) = w; } }
    }
};
struct EpiRes {
    static constexpr bool PERM = false, AFTER_DRAIN = false, ROW_RSTD = false;
    bf16_t* xb; float* ssq; int mode; unsigned char* x8p; float* outp; int w8, fin;
    __device__ __forceinline__ void operator()(const f32x4 (&acc)[2][2][4][2], const Unit& u, int wr, int wc, int fr_, int fq_) const {
        int tl_ = threadIdx.x; asm volatile("" : "+v"(tl_)); const int fr = tl_ & 15, fq = (tl_ >> 4) & 3; (void)fr_; (void)fq_;
        const int row0 = u.pm * BM + wr * 64 + fr, col0 = u.pn * BM + wc * 32 + 4 * fq;
        int md_ = __builtin_amdgcn_readfirstlane(mode), w8_ = __builtin_amdgcn_readfirstlane(w8), fin_ = __builtin_amdgcn_readfirstlane(fin); asm volatile("" : "+s"(md_), "+s"(w8_), "+s"(fin_));
        const float alpha = md_ == 0 ? 0.5f : (md_ == 1 ? 0.5f / 256.0f : 1.0f);
        float* const outf = fin_ ? outp : nullptr; unsigned char* const x8 = w8_ ? x8p : nullptr;
#pragma unroll
        for (int ai = 0; ai < 2; ++ai) { u32x2 old[4][2][2];
#pragma unroll
            for (int m = 0; m < 4; ++m)
#pragma unroll
                for (int bj = 0; bj < 2; ++bj)
#pragma unroll
                    for (int n = 0; n < 2; ++n) old[m][bj][n] = *(const u32x2*)(xb + (size_t)(row0 + ai * HALF + m * 16) * 1024 + col0 + bj * HALF + n * 16);
            float ssv[4];
#pragma unroll
            for (int m = 0; m < 4; ++m) { const int row = row0 + ai * HALF + m * 16; const size_t off = (size_t)row * 1024 + col0; float ss = 0.f;
#pragma unroll
                for (int bj = 0; bj < 2; ++bj)
#pragma unroll
                    for (int n = 0; n < 2; ++n) { const u32x2 ow = old[m][bj][n]; const f32x4 xo = (f32x4){bf_lo(ow.x), bf_hi(ow.x), bf_lo(ow.y), bf_hi(ow.y)}; const f32x4 xn = xo + acc[ai][bj][m][n] * alpha;
                        if (outf) *(f32x4*)(outf + off + bj * HALF + n * 16) = xn;
                        else { ss += (xn[0] * xn[0] + xn[1] * xn[1]) + (xn[2] * xn[2] + xn[3] * xn[3]);
                            u32x2 w; w.x = pkbf(xn[0], xn[1]); w.y = pkbf(xn[2], xn[3]); *(u32x2*)(xb + off + bj * HALF + n * 16) = w;
                            if (x8) *(unsigned*)(x8 + off + bj * HALF + n * 16) = pk4_fp8(xn[0], xn[1], xn[2], xn[3]); } }
                ssv[m] = ss; }
            if (!outf) { float tv[4];
#pragma unroll
                for (int m = 0; m < 4; ++m) ssv[m] = swap32_add(ssv[m]);
#pragma unroll
                for (int m = 0; m < 4; ++m) tv[m] = __shfl_xor(ssv[m], 16);
#pragma unroll
                for (int m = 0; m < 4; ++m) if (fq == 0) ssq[(size_t)(row0 + ai * HALF + m * 16) * 16 + u.pn * 4 + wc] = ssv[m] + tv[m]; }
            asm volatile("" ::: "memory"); }
    }
};

struct EpiNull {
    static constexpr bool PERM = true, AFTER_DRAIN = false, ROW_RSTD = false;
    float* sink;
    __device__ __forceinline__ void operator()(const f32x4 (&acc)[2][2][4][2], const Unit& u, int wr, int wc, int fr, int fq) const {
        float s = 0.f;
#pragma unroll
        for (int ai = 0; ai < 2; ++ai)
#pragma unroll
            for (int bj = 0; bj < 2; ++bj)
#pragma unroll
                for (int m = 0; m < 4; ++m)
#pragma unroll
                    for (int n = 0; n < 2; ++n) s += acc[ai][bj][m][n][0];
        if (s == 12345.678f) sink[0] = s;
    }
};
template <int PIN> struct FixedOrder : StaticOrder {
    __device__ bool next(int i, Unit& u) const { const bool ok = StaticOrder::next(i, u); if (PIN & 1) u.pn = 0; if (PIN & 2) u.pm = (int)(blockIdx.x & 7); return ok; }
};
template <class Epi, class Sched, bool ALIGN_EPI = false, bool SP2 = false, bool FP8 = false, int GID = 0>
__device__ __forceinline__ void gemm_phase(PG8_LAS unsigned char* lds, const Gemm g, const Sched& S, const Epi& E) {
    int tid = threadIdx.x; asm volatile("" : "+v"(tid));
    const int wid = __builtin_amdgcn_readfirstlane(tid >> 6), lane = tid & 63, wr = wid >> 2, wc = wid & 3, fr = lane & 15, fq = lane >> 4;
    const int K = g.K, nt = K / BK;
    unsigned voffA[2], voffB[2];
#pragma unroll
    for (int i = 0; i < 2; ++i) { int R, C; stage_rc(tid * 16 + i * 8192, R, C); const int Rb = Epi::PERM ? ((R & ~31) + perm32(R & 31)) : R;
        voffA[i] = (unsigned)(R * K + C) * 2u; voffB[i] = (unsigned)(Rb * K + C) * 2u; }
    const size_t kstep = (size_t)(BK * 2);
    const size_t hstep = (size_t)HALF * K * 2;
    const size_t tstep = 2 * hstep;
    const unsigned ldsw = (unsigned)wid * 1024u;
    const int aoff = lds_byte(wr * 64 + fr, fq * 8), boff = lds_byte(wc * 32 + fr, fq * 8);
#define PG8_SA(b, h) (((b) * 2 + (h)) * HTB)
#define PG8_SB(b, h) ((4 + (b) * 2 + (h)) * HTB)
#define PG8_STAGE(bufoff, gbase, voff) do { _Pragma("unroll") for (int _i = 0; _i < 2; ++_i) \
        __builtin_amdgcn_global_load_lds((const unsigned*)((const char*)(gbase) + (voff)[_i]), (PG8_LAS unsigned*)(lds + (bufoff) + ldsw + _i * 8192), 16, 0, 0); } while (0)
#define PG8_LDA(dst, b, h) do { if constexpr (FP8) { _Pragma("unroll") for (int m = 0; m < 4; ++m) dst##8[m] = cat8(*(const PG8_LAS bf16x8*)(lds + PG8_SA(b, h) + aoff + m * 2048), *(const PG8_LAS bf16x8*)(lds + PG8_SA(b, h) + aoff + m * 2048 + 1024)); } \
        else { _Pragma("unroll") for (int m = 0; m < 4; ++m) _Pragma("unroll") for (int k = 0; k < 2; ++k) dst[m][k] = *(const PG8_LAS bf16x8*)(lds + PG8_SA(b, h) + aoff + m * 2048 + k * 1024); } } while (0)
#define PG8_LDB(dst, b, h) do { if constexpr (FP8) { _Pragma("unroll") for (int n = 0; n < 2; ++n) dst##8[n] = cat8(*(const PG8_LAS bf16x8*)(lds + PG8_SB(b, h) + boff + n * 2048), *(const PG8_LAS bf16x8*)(lds + PG8_SB(b, h) + boff + n * 2048 + 1024)); } \
        else { _Pragma("unroll") for (int n = 0; n < 2; ++n) _Pragma("unroll") for (int k = 0; k < 2; ++k) dst[n][k] = *(const PG8_LAS bf16x8*)(lds + PG8_SB(b, h) + boff + n * 2048 + k * 1024); } } while (0)
#define PG8_MMA(ai, bj, At, Bt) do { __builtin_amdgcn_s_setprio(1); \
        if constexpr (FP8) { _Pragma("unroll") for (int m = 0; m < 4; ++m) _Pragma("unroll") for (int n = 0; n < 2; ++n) \
            mfma8(acc[ai][bj][m][n], Bt##8[n], At##8[m], sc8); } \
        else { _Pragma("unroll") for (int m = 0; m < 4; ++m) _Pragma("unroll") for (int n = 0; n < 2; ++n) _Pragma("unroll") for (int k = 0; k < 2; ++k) \
            acc[ai][bj][m][n] = __builtin_amdgcn_mfma_f32_16x16x32_bf16(Bt[n][k], At[m][k], acc[ai][bj][m][n], 0, 0, 0); } \
        __builtin_amdgcn_s_setprio(0); } while (0)
#define PG8_WAIT_V(n) asm volatile("s_waitcnt vmcnt(" #n ")" ::: "memory")
#define PG8_WAIT_L(n) asm volatile("s_waitcnt lgkmcnt(" #n ")" ::: "memory")
#define PG8_BAR __builtin_amdgcn_s_barrier()
#define PG8_SCHED __builtin_amdgcn_sched_barrier(0)
    Unit cur, nxt; int ui = 0;
    if (!S.next(0, cur)) return;
    if constexpr (Epi::ROW_RSTD) {
        int p0 = cur.pm, p1 = -1, p2 = -1, p3 = -1; { Unit t_; for (int n_ = 1; S.next(n_, t_); ++n_) { const int p = t_.pm; if (p != p0 && p != p1 && p != p2 && p != p3) { if (p1 < 0) p1 = p; else if (p2 < 0) p2 = p; else p3 = p; } } }
        E.fill_rstd(lds + STAGE_BYTES, p0, wid, lane); if (p1 >= 0) E.fill_rstd(lds + STAGE_BYTES + 1024, p1, wid, lane); if (p2 >= 0) E.fill_rstd(lds + STAGE_BYTES + 2048, p2, wid, lane); if (p3 >= 0) E.fill_rstd(lds + STAGE_BYTES + 3072, p3, wid, lane);
        E.set_panels(p0, p1, p2);
        PG8_WAIT_L(0); PG8_BAR; asm volatile("" ::: "memory"); }
    f32x4 acc[2][2][4][2];
#pragma unroll
    for (int a = 0; a < 2; ++a)
#pragma unroll
        for (int b = 0; b < 2; ++b)
#pragma unroll
            for (int m = 0; m < 4; ++m)
#pragma unroll
                for (int n = 0; n < 2; ++n) acc[a][b][m][n] = (f32x4){0.f, 0.f, 0.f, 0.f};
    bf16x8 At[4][2], B0[2][2], B1[2][2]; i32x8 At8[4], B08[2], B18[2]; int sc8 = 0x7F7F7F7F; asm volatile("" : "+v"(sc8));
    const char* cA = (const char*)g.A + (size_t)cur.pm * tstep; const char* cB = (const char*)g.Bt + (size_t)cur.pn * tstep;
    S.a_ready(cur);
    if constexpr (SP2) {
        PG8_STAGE(PG8_SB(0, 0), cB, voffB); PG8_STAGE(PG8_SB(0, 1), cB + hstep, voffB); PG8_STAGE(PG8_SA(0, 0), cA, voffA); PG8_STAGE(PG8_SA(0, 1), cA + hstep, voffA);
        if (wr == 1) PG8_BAR;
        PG8_WAIT_V(2); PG8_BAR;
        PG8_STAGE(PG8_SB(1, 0), cB + kstep, voffB); PG8_STAGE(PG8_SA(1, 0), cA + kstep, voffA); PG8_STAGE(PG8_SB(1, 1), cB + hstep + kstep, voffB);
        PG8_WAIT_V(6); PG8_BAR;
    } else {
        PG8_STAGE(PG8_SB(0, 0), cB, voffB); PG8_STAGE(PG8_SA(0, 0), cA, voffA); PG8_STAGE(PG8_SB(0, 1), cB + hstep, voffB); PG8_STAGE(PG8_SA(0, 1), cA + hstep, voffA);
        if (wr == 1) PG8_BAR;
        PG8_WAIT_V(4); PG8_BAR;
        PG8_STAGE(PG8_SB(1, 0), cB + kstep, voffB); PG8_STAGE(PG8_SA(1, 0), cA + kstep, voffA); PG8_STAGE(PG8_SB(1, 1), cB + hstep + kstep, voffB);
        PG8_WAIT_V(6); PG8_BAR;
    }
    for (;;) {
        const bool has_next = S.next(ui + 1, nxt);
        const char* nA = has_next ? (const char*)g.A + (size_t)nxt.pm * tstep : cA; const char* nB = has_next ? (const char*)g.Bt + (size_t)nxt.pn * tstep : cB;
#pragma nounroll
        for (int t = 0; t < nt; t += 2) {
            const bool last = (t == nt - 2);
            const char* a1 = cA + (size_t)(t + 1) * kstep;
            const char* a2 = last ? nA : cA + (size_t)(t + 2) * kstep; const char* b2 = last ? nB : cB + (size_t)(t + 2) * kstep;
            const char* a3 = a2 + kstep; const char* b3 = b2 + kstep;
            if (last && has_next) S.a_ready(nxt);
            if constexpr (SP2) {
            PG8_LDB(B0, 0, 0); PG8_LDB(B1, 0, 1); PG8_SCHED; PG8_LDA(At, 0, 0); PG8_STAGE(PG8_SA(1, 1), a1 + hstep, voffA);
            PG8_WAIT_V(8); PG8_WAIT_L(0); PG8_BAR; PG8_MMA(0, 0, At, B0); PG8_MMA(0, 1, At, B1); PG8_BAR; PG8_SCHED;
            PG8_LDA(At, 0, 1); PG8_STAGE(PG8_SB(0, 0), b2, voffB); PG8_STAGE(PG8_SB(0, 1), b2 + hstep, voffB); PG8_STAGE(PG8_SA(0, 0), a2, voffA);
            PG8_WAIT_V(8); PG8_WAIT_L(0); PG8_BAR; PG8_MMA(1, 0, At, B0); PG8_MMA(1, 1, At, B1); PG8_BAR; PG8_SCHED;
            PG8_LDB(B0, 1, 0); PG8_LDB(B1, 1, 1); PG8_SCHED; PG8_LDA(At, 1, 0); PG8_STAGE(PG8_SA(0, 1), a2 + hstep, voffA);
            PG8_WAIT_V(8); PG8_WAIT_L(0); PG8_BAR; PG8_MMA(0, 0, At, B0); PG8_MMA(0, 1, At, B1); PG8_BAR; PG8_SCHED;
            PG8_LDA(At, 1, 1); PG8_STAGE(PG8_SB(1, 0), b3, voffB); PG8_STAGE(PG8_SB(1, 1), b3 + hstep, voffB); PG8_STAGE(PG8_SA(1, 0), a3, voffA);
            PG8_WAIT_V(8); PG8_WAIT_L(0); PG8_BAR; PG8_MMA(1, 0, At, B0); PG8_MMA(1, 1, At, B1); PG8_BAR; PG8_SCHED;
            } else {
            PG8_LDB(B0, 0, 0); PG8_SCHED; PG8_LDA(At, 0, 0); PG8_STAGE(PG8_SA(1, 1), a1 + hstep, voffA);
            PG8_WAIT_L(8); PG8_BAR; PG8_WAIT_L(0); PG8_MMA(0, 0, At, B0); PG8_BAR; PG8_SCHED;
            PG8_LDB(B1, 0, 1); PG8_STAGE(PG8_SB(0, 0), b2, voffB);
            PG8_BAR; PG8_WAIT_L(0); PG8_MMA(0, 1, At, B1); PG8_BAR;
            PG8_LDA(At, 0, 1); PG8_STAGE(PG8_SA(0, 0), a2, voffA);
            PG8_BAR; PG8_WAIT_L(0); PG8_MMA(1, 0, At, B0); PG8_BAR; PG8_SCHED;
            PG8_STAGE(PG8_SB(0, 1), b2 + hstep, voffB);
            PG8_WAIT_V(6); PG8_BAR; PG8_MMA(1, 1, At, B1); PG8_BAR;
            PG8_LDB(B0, 1, 0); PG8_SCHED; PG8_LDA(At, 1, 0); PG8_STAGE(PG8_SA(0, 1), a2 + hstep, voffA);
            PG8_WAIT_L(8); PG8_BAR; PG8_WAIT_L(0); PG8_MMA(0, 0, At, B0); PG8_BAR; PG8_SCHED;
            PG8_LDB(B1, 1, 1); PG8_STAGE(PG8_SB(1, 0), b3, voffB);
            PG8_BAR; PG8_WAIT_L(0); PG8_MMA(0, 1, At, B1); PG8_BAR;
            PG8_LDA(At, 1, 1); PG8_STAGE(PG8_SA(1, 0), a3, voffA);
            PG8_BAR; PG8_WAIT_L(0); PG8_MMA(1, 0, At, B0); PG8_BAR; PG8_SCHED;
            PG8_STAGE(PG8_SB(1, 1), b3 + hstep, voffB);
            PG8_WAIT_V(6); PG8_BAR; PG8_MMA(1, 1, At, B1); PG8_BAR;
            }
        }
        if constexpr (ALIGN_EPI) { if (wr == 0) PG8_BAR; }
        TS(lds, 40 + 2 * GID);
        if constexpr (FP8) asm volatile("s_nop 15\n\ts_nop 15" ::: "memory");
        if constexpr (!Epi::AFTER_DRAIN) { E(acc, cur, wr, wc, fr, fq); S.done(cur); }
        TS(lds, 41 + 2 * GID);
        if (!has_next) break;
#pragma unroll
        for (int a = 0; a < 2; ++a)
#pragma unroll
            for (int b = 0; b < 2; ++b)
#pragma unroll
                for (int m = 0; m < 4; ++m)
#pragma unroll
                    for (int n = 0; n < 2; ++n) acc[a][b][m][n] = (f32x4){0.f, 0.f, 0.f, 0.f};
        cur = nxt; cA = nA; cB = nB; ++ui;
        if constexpr (ALIGN_EPI) { if (wr == 1) PG8_BAR; }
    }
    PG8_WAIT_V(0);
    if constexpr (!ALIGN_EPI) { if (wr == 0) PG8_BAR; }
    PG8_BAR;
    if constexpr (Epi::AFTER_DRAIN) { E.fused(acc, cur, wr, wc, fr, fq, lds, wid, lane); S.done(cur); }
#undef PG8_SA
#undef PG8_SB
#undef PG8_STAGE
#undef PG8_LDA
#undef PG8_LDB
#undef PG8_MMA
#undef PG8_WAIT_V
#undef PG8_WAIT_L
#undef PG8_BAR
#undef PG8_SCHED
}
}

constexpr int NWAVES = 8;
constexpr int BATCH = 16, T = 2048, D = 1024, M = BATCH * T, DFF = 2816, NF1 = 2 * DFF, NU = 2304, DEPTH = 2, NCP = 128;
constexpr float EPS = 1e-6f, LOG2E = 1.4426950408889634f, C2 = 0.125f * LOG2E;
constexpr int UQ = 0, UKS = 256, UKW = 320, UCK = 384, UCQ = 512, UKC = 768, UVC = 832, UVS = 896, UVW = 960, UCV = 1024, UG = 1152, UBB = 1280, UBC = 1536, UBX = 1792, UDV = 2048;
constexpr size_t MiB = 1u << 20;
constexpr size_t WS_CTL = 0, CTL_ZERO_BYTES = 1 * MiB;
constexpr size_t WS_W13 = 1 * MiB, WS_W2 = 45 * MiB, WS_WIN = 67 * MiB, WS_WOUT = 76 * MiB, WS_C1 = 80 * MiB;
constexpr size_t WS_SSQ = 82 * MiB, WS_GATES = 84 * MiB, WS_KC = 86 * MiB, WS_VC = 86 * MiB + 512 * 1024;
constexpr size_t WS_XB = 88 * MiB, WS_QKN = 152 * MiB, WS_YN = 200 * MiB, WS_ACT = 264 * MiB, WS_U = WS_ACT, WS_X8 = 440 * MiB, WS_IMG = 472 * MiB, WS_END = 504 * MiB;
#ifndef UP8_MASK_V
#define UP8_MASK_V 0xE
#endif
#ifndef DN8_MASK_V
#define DN8_MASK_V 0xF
#endif
constexpr unsigned UP8_MASK = UP8_MASK_V, DN8_MASK = DN8_MASK_V;
constexpr float W8_SCALE = 64.0f, ACT8_SCALE = 4.0f; static_assert(W8_SCALE * ACT8_SCALE == 256.0f, "EpiRes mode 1");
constexpr int CW_BAR = 4096;
constexpr int LDS_BYTES = 163840, MISC_OFF = LDS_BYTES - 256;

#define GAS __attribute__((address_space(1)))
#define LAS __attribute__((address_space(3)))
typedef unsigned short bf16;
typedef unsigned v4u __attribute__((ext_vector_type(4)));
typedef unsigned u32x2 __attribute__((ext_vector_type(2)));
typedef float f32x4 __attribute__((ext_vector_type(4)));
typedef float f32x2_t __attribute__((ext_vector_type(2)));
typedef __bf16 bf16x2_t __attribute__((ext_vector_type(2)));
typedef short bf16x8 __attribute__((ext_vector_type(8)));
typedef float f32x16 __attribute__((ext_vector_type(16)));
typedef short v4i16_t __attribute__((ext_vector_type(4)));
#define LDS_WAIT() asm volatile("s_waitcnt lgkmcnt(0)" ::: "memory")
__device__ __forceinline__ unsigned pk2(float lo, float hi) { f32x2_t v = {lo, hi}; bf16x2_t b = __builtin_convertvector(v, bf16x2_t); return __builtin_bit_cast(unsigned, b); }
__device__ __forceinline__ float bflo(unsigned u) { return __builtin_bit_cast(float, u << 16); }
__device__ __forceinline__ float bfhi(unsigned u) { return __builtin_bit_cast(float, u & 0xffff0000u); }
__device__ __forceinline__ f32x4 ld4bf(const bf16* p) { const u32x2 w = *(const u32x2*)p; return (f32x4){bflo(w.x), bfhi(w.x), bflo(w.y), bfhi(w.y)}; }
__device__ __forceinline__ void st4bf(bf16* p, f32x4 v) { u32x2 w; w.x = pk2(v[0], v[1]); w.y = pk2(v[2], v[3]); *(u32x2*)p = w; }
template <int CTRL> __device__ __forceinline__ float dpp_add(float v) { return v + __builtin_bit_cast(float, __builtin_amdgcn_update_dpp(0, __builtin_bit_cast(int, v), CTRL, 0xf, 0xf, true)); }
__device__ __forceinline__ float row16_sum(float v) { v = dpp_add<0xB1>(v); v = dpp_add<0x4E>(v); v = dpp_add<0x141>(v); v = dpp_add<0x140>(v); return v; }
__device__ __forceinline__ float wave_sum(float v) {
    v = row16_sum(v); v += __shfl_xor(v, 16);
    auto rr = __builtin_amdgcn_permlane32_swap(__float_as_uint(v), __float_as_uint(v), false, false); return __uint_as_float(rr[0]) + __uint_as_float(rr[1]);
}
__device__ __forceinline__ f32x4 up4(u32x2 w) { return (f32x4){bflo(w.x), bfhi(w.x), bflo(w.y), bfhi(w.y)}; }
__device__ __forceinline__ float sq4(f32x4 v) { return (v[0] * v[0] + v[1] * v[1]) + (v[2] * v[2] + v[3] * v[3]); }

__device__ __forceinline__ int kimg_off(int r, int d) { return (d >> 3) * 512 + r * 8 + (d & 7); }
__device__ __forceinline__ int vimg_off(int r, int d) { return ((d >> 5) * 4 + (r >> 4)) * 512 + (r & 15) * 32 + (d & 31); }
#define XB_TMO      128
#define XB_XCNT(j)  (256  + 64 * (j))
#define XB_XSUB(j)  (1280 + 64 * (j))
#define XB_XGEN(j)  (2304 + 64 * (j))
#define XB_TOP      3328
#define XB_TOPGEN   3392
#define XCD_BAR_WORDS 3456
#define XB_SPIN_CAP (1u << 18)

__device__ __forceinline__ unsigned xb_ld(unsigned* p)              { return __hip_atomic_load(p, __ATOMIC_RELAXED, __HIP_MEMORY_SCOPE_AGENT); }
__device__ __forceinline__ unsigned xb_add(unsigned* p, unsigned v) { return __hip_atomic_fetch_add(p, v, __ATOMIC_RELAXED, __HIP_MEMORY_SCOPE_AGENT); }
__device__ __forceinline__ unsigned xb_xcc_id() { return (unsigned)__builtin_amdgcn_s_getreg((3 << 11) | 20) & 0xFu; }
#define XB_SPIN(cond, bar) do { unsigned _sp = 0; while (cond) { __builtin_amdgcn_s_sleep(1); \
    if ((++_sp & 255u) == 0u) { if (xb_ld(&(bar)[XB_TMO])) break; if (_sp > XB_SPIN_CAP) { atomicAdd(&(bar)[XB_TMO], 1u); break; } } } } while (0)

struct XcdBarrier {
    unsigned* bar; unsigned x;
    volatile LAS unsigned* st;
};

__device__ __forceinline__ XcdBarrier xcd_barrier_post(unsigned* bar, volatile LAS unsigned* st) {
    XcdBarrier b; b.bar = bar; b.x = xb_xcc_id(); b.st = st;
    if (threadIdx.x == 0) (void)xb_add(&bar[XB_XCNT(b.x)], 1u);
    return b;
}
__device__ __forceinline__ void xcd_barrier_complete(unsigned* bar, unsigned x, unsigned& nloc, unsigned& nx) {
    const unsigned G = gridDim.x * gridDim.y * gridDim.z;
    unsigned sum, cnt, mine, sp = 0u;
    for (;;) {
        sum = 0u; cnt = 0u; mine = 0u;
#pragma unroll
        for (unsigned j = 0; j < 16; ++j) { const unsigned c = xb_ld(&bar[XB_XCNT(j)]); sum += c; cnt += (c > 0u) ? 1u : 0u; mine = (j == x) ? c : mine; }
        if (sum == G) break;
        __builtin_amdgcn_s_sleep(1);
        if ((++sp & 255u) == 0u) { if (xb_ld(&bar[XB_TMO])) break; if (sp > XB_SPIN_CAP) { atomicAdd(&bar[XB_TMO], 1u); break; } }
    }
    nloc = mine > 0u ? mine : 1u; nx = cnt > 0u ? cnt : 1u;
}

__device__ __forceinline__ void xcd_barrier(const XcdBarrier& b) {
    asm volatile("s_waitcnt vmcnt(0)" ::: "memory");
    __syncthreads();
    if (threadIdx.x == 0) {
        unsigned* bar = b.bar;
        __builtin_amdgcn_s_waitcnt(0);
        unsigned nloc = b.st[0], nx = b.st[1];
        if (nloc == 0u) { xcd_barrier_complete(bar, b.x, nloc, nx); b.st[0] = nloc; b.st[1] = nx; }
        const unsigned old = xb_add(&bar[XB_XSUB(b.x)], 1u);
        const unsigned gen = old / nloc;
        if (old + 1u == (gen + 1u) * nloc) {
            __builtin_amdgcn_fence(__ATOMIC_RELEASE, "agent");
            asm volatile("s_waitcnt vmcnt(0)" ::: "memory");
            const unsigned og = xb_add(&bar[XB_TOP], 1u);
            const unsigned tg = og / nx;
            if (og + 1u == (tg + 1u) * nx) xb_add(&bar[XB_TOPGEN], 1u);
            else XB_SPIN(xb_ld(&bar[XB_TOPGEN]) == tg, bar);
            __builtin_amdgcn_fence(__ATOMIC_ACQUIRE, "agent");
            xb_add(&bar[XB_XGEN(b.x)], 1u);
            asm volatile("s_waitcnt vmcnt(0)" ::: "memory");
        } else {
            XB_SPIN(xb_ld(&bar[XB_XGEN(b.x)]) == gen, bar);
            __builtin_amdgcn_fence(__ATOMIC_ACQUIRE, "agent");
            asm volatile("s_waitcnt vmcnt(0)" ::: "memory");
        }
    }
    __syncthreads();
}

#define XL_SUB(j)  (3520 + 64 * (j))
#define XL_GEN(j)  (4608 + 64 * (j))
#define XL_RANK(j) (5696 + 64 * (j))
__device__ __forceinline__ void xcc_local_barrier(unsigned* bar, unsigned x) {
    asm volatile("s_waitcnt vmcnt(0)" ::: "memory");
    __syncthreads();
    if (threadIdx.x == 0) {
        __builtin_amdgcn_s_waitcnt(0);
        const unsigned old = xb_add(&bar[XL_SUB(x)], 1u), gen = old / 32u;
        if (old + 1u == (gen + 1u) * 32u) xb_add(&bar[XL_GEN(x)], 1u);
        else XB_SPIN(xb_ld(&bar[XL_GEN(x)]) == gen, bar);
        __builtin_amdgcn_fence(__ATOMIC_ACQUIRE, "agent");
        asm volatile("s_waitcnt vmcnt(0)" ::: "memory");
    }
    __syncthreads();
}


typedef KArgs Args;
struct Frame {
    LAS unsigned char* lds;
    int tid, lane, wave, vcu, G, cid;
    const Args* a;
};
#define FIN(i) (F.a->in[i])
#define FOUT (F.a->out)
#define FWS(off, type) ((type*)(F.a->ws + (off)))
#define F_W13T FWS(WS_W13, bf16)
#define F_W2T FWS(WS_W2, bf16)
#define F_WINT FWS(WS_WIN, bf16)
#define F_WOUTT FWS(WS_WOUT, bf16)
#define F_C1T FWS(WS_C1, bf16)
#define F_XB FWS(WS_XB, bf16)
#define F_QA FWS(WS_QKN, bf16)
#define F_QC FWS(WS_QKN + 16 * MiB, bf16)
#define F_KSI FWS(WS_IMG, bf16)
#define F_KWI FWS(WS_IMG + 4 * MiB, bf16)
#define F_CKI FWS(WS_IMG + 8 * MiB, bf16)
#define F_VSI FWS(WS_IMG + 16 * MiB, bf16)
#define F_VWI FWS(WS_IMG + 20 * MiB, bf16)
#define F_CVI FWS(WS_IMG + 24 * MiB, bf16)
#define F_YN FWS(WS_YN, bf16)
#define F_ACT FWS(WS_ACT, bf16)
#define F_U FWS(WS_U, bf16)
#define F_KC FWS(WS_KC, bf16)
#define F_VC FWS(WS_VC, bf16)
#define F_SSQ FWS(WS_SSQ, float)
#define F_GATES FWS(WS_GATES, float)
#define F_X8 FWS(WS_X8, unsigned char)
enum { I_X = 0, I_F1N, I_F1W1, I_F1W3, I_F1W2, I_MIXN, I_WIN, I_NQN, I_NKCN, I_NKSN, I_NKWN, I_POSK, I_C1K, I_C2K, I_POSV, I_C1V, I_C2V, I_CONVW, I_SQN, I_SKN, I_SINK, I_POOLW, I_POOLS, I_GN, I_WOUT,
       I_F2N, I_F2W1, I_F2W3, I_F2W2 };

__device__ __forceinline__ int win_src_col(int dr) {
    if (dr < 256) return dr;
    if (dr < 320) return 384 + (dr - 256);
    if (dr < 384) return 512 + (dr - 320);
    if (dr < 512) return 1676 + (dr - 384);
    if (dr < 768) return 1420 + (dr - 512);
    if (dr < 832) return 256 + (dr - 768);
    if (dr < 896) return 320 + (dr - 832);
    if (dr < 960) return 448 + (dr - 896);
    if (dr < 1024) return 576 + (dr - 960);
    if (dr < 1152) return 1804 + (dr - 1024);
    if (dr < 1164) return 640 + (dr - 1152);
    if (dr < 1280) return -1;
    if (dr < 1536) return 652 + (dr - 1280);
    if (dr < 1792) return 908 + (dr - 1536);
    if (dr < 2048) return 1164 + (dr - 1792);
    return 1932 + (dr - 2048);
}
struct TrItem { const float* src; const float* gain; void* dst; int N, K, k0, n0, srcmode, dstmode, w, ncols; bool f8; };
__device__ __forceinline__ void tr_decode(Frame& F, int it, TrItem& t) {
    constexpr int PER_LAYER = 6 * 176 + 144 + 64 + 64;
    const int L = it / PER_LAYER; int r = it % PER_LAYER;
    t.gain = nullptr; t.f8 = false; t.srcmode = 0; t.dstmode = 0; t.w = 0; t.ncols = 256;
    if (r < 6 * 176) { const int mat = r / 176, rr = r % 176, ffn = mat / 3, w = mat % 3;
        if (w < 2) { t.k0 = 64 * (rr / 11); t.n0 = 256 * (rr % 11); t.N = DFF; t.K = D; t.dstmode = 1; t.w = w;
            t.src = FIN(ffn ? (w ? I_F2W3 : I_F2W1) : (w ? I_F1W3 : I_F1W1)) + (size_t)L * D * DFF; t.gain = FIN(ffn ? I_F2N : I_F1N) + L * D;
            t.dst = (unsigned char*)F_W13T + (size_t)(L * 2 + ffn) * NF1 * D * 2; t.f8 = (UP8_MASK >> (L * 2 + ffn)) & 1u; }
        else { t.k0 = 64 * (rr / 4); t.n0 = 256 * (rr % 4); t.N = D; t.K = DFF;
            t.src = FIN(ffn ? I_F2W2 : I_F1W2) + (size_t)L * DFF * D; t.dst = (unsigned char*)F_W2T + (size_t)(L * 2 + ffn) * D * DFF * 2; t.f8 = (DN8_MASK >> (L * 2 + ffn)) & 1u; } }
    else { r -= 6 * 176;
        if (r < 144) { t.k0 = 64 * (r / 9); t.n0 = 256 * (r % 9); t.N = 2188; t.K = D; t.srcmode = 1;
            t.src = FIN(I_WIN) + (size_t)L * D * 2188; t.gain = FIN(I_MIXN) + L * D; t.dst = F_WINT + (size_t)L * NU * D; }
        else if (r < 144 + 64) { r -= 144; t.k0 = 64 * (r / 4); t.n0 = 256 * (r % 4); t.N = D; t.K = D;
            t.src = FIN(I_WOUT) + (size_t)L * D * D; t.gain = FIN(I_GN) + L * D; t.dst = F_WOUTT + (size_t)L * D * D; }
        else { r -= 144 + 64; const int kv = r / 32; t.k0 = 64 * (r % 32); t.n0 = 0; t.N = 128; t.K = 2048; t.ncols = 128;
            t.src = FIN(kv ? I_C1V : I_C1K) + (size_t)L * 2048 * 128; t.dst = F_C1T + (size_t)(L * 2 + kv) * 128 * 2048; } }
}
__device__ __forceinline__ void tr_load(const TrItem& t, f32x4 (&v)[8], int wave, int lane) {
    const int c = 4 * lane; const int sc = t.srcmode ? win_src_col(t.n0 + c) : (c < t.ncols ? t.n0 + c : -1);
#pragma unroll
    for (int i = 0; i < 8; ++i) { v[i] = (f32x4){0.f, 0.f, 0.f, 0.f}; if (sc >= 0) v[i] = *(const f32x4*)(t.src + (size_t)(t.k0 + 8 * wave + i) * t.N + sc); }
}
__device__ __forceinline__ void tr_to_lds(const TrItem& t, const f32x4 (&v)[8], LAS float* T, int wave, int lane) {
#pragma unroll
    for (int i = 0; i < 8; ++i) { const int k = 8 * wave + i; const float g = t.gain ? t.gain[t.k0 + k] : 1.0f; LAS float* p = T + k * 257 + 4 * lane;
        p[0] = v[i][0] * g; p[1] = v[i][1] * g; p[2] = v[i][2] * g; p[3] = v[i][3] * g; }
}
__device__ __forceinline__ void tr_out(const TrItem& t, const LAS float* T, int wave, int lane) {
    if (t.f8) { const int c = lane & 3;
#pragma unroll
        for (int j = 0; j < 2; ++j) { const int row = 32 * wave + 16 * j + (lane >> 2); if (row < t.ncols) { const int n = t.n0 + row; const int dr = t.dstmode ? ((n >> 7) * 256 + t.w * 128 + (n & 127)) : n;
            const LAS float* q = T + (16 * c) * 257 + row; v4u o;
            o.x = pg8::pk4_fp8(q[0 * 257] * W8_SCALE, q[1 * 257] * W8_SCALE, q[2 * 257] * W8_SCALE, q[3 * 257] * W8_SCALE); o.y = pg8::pk4_fp8(q[4 * 257] * W8_SCALE, q[5 * 257] * W8_SCALE, q[6 * 257] * W8_SCALE, q[7 * 257] * W8_SCALE);
            o.z = pg8::pk4_fp8(q[8 * 257] * W8_SCALE, q[9 * 257] * W8_SCALE, q[10 * 257] * W8_SCALE, q[11 * 257] * W8_SCALE); o.w = pg8::pk4_fp8(q[12 * 257] * W8_SCALE, q[13 * 257] * W8_SCALE, q[14 * 257] * W8_SCALE, q[15 * 257] * W8_SCALE);
            *(v4u*)((unsigned char*)t.dst + (size_t)dr * t.K + t.k0 + 16 * c) = o; } } }
    else { const int c = lane & 7;
#pragma unroll
        for (int j = 0; j < 4; ++j) { const int row = 32 * wave + 8 * j + (lane >> 3); if (row < t.ncols) { const int n = t.n0 + row; const int dr = t.dstmode ? ((n >> 7) * 256 + t.w * 128 + (n & 127)) : n;
            const LAS float* q = T + (8 * c) * 257 + row;
            v4u o; o.x = pk2(q[0 * 257], q[1 * 257]); o.y = pk2(q[2 * 257], q[3 * 257]); o.z = pk2(q[4 * 257], q[5 * 257]); o.w = pk2(q[6 * 257], q[7 * 257]);
            *(v4u*)((bf16*)t.dst + (size_t)dr * t.K + t.k0 + 8 * c) = o; } } }
}
__device__ __forceinline__ void prologue(Frame& F) {
    int lane = F.lane; asm volatile("" : "+v"(lane));
    LAS float* TT = (LAS float*)F.lds;
    const int wave = F.wave, gw = F.vcu * NWAVES + F.wave, NGW = F.G * NWAVES;
    constexpr int NITEMS = DEPTH * (6 * 176 + 144 + 64 + 64);
    { TrItem ta, tb; f32x4 va[8];
      int it = F.vcu; bool have = it < NITEMS;
      if (have) { tr_decode(F, it, ta); tr_load(ta, va, wave, lane); }
      while (have) {
          tr_to_lds(ta, va, TT, wave, lane);
          __syncthreads();
          const int nx = it + F.G; const bool hn = nx < NITEMS; tb = ta;
          if (hn) { tr_decode(F, nx, ta); tr_load(ta, va, wave, lane); }
          tr_out(tb, TT, wave, lane);
          __syncthreads();
          it = nx; have = hn;
      } }
    const float* x = FIN(I_X);
    for (int m4 = gw * 4; m4 < M; m4 += NGW * 4) {
        f32x4 v[4][4];
#pragma unroll
        for (int r = 0; r < 4; ++r)
#pragma unroll
            for (int j = 0; j < 4; ++j) v[r][j] = *((const f32x4*)(x + (size_t)(m4 + r) * D) + lane + 64 * j);
#pragma unroll
        for (int r = 0; r < 4; ++r) { float sr = 0.f;
#pragma unroll
            for (int j = 0; j < 4; ++j) { sr += sq4(v[r][j]); st4bf(F_XB + (size_t)(m4 + r) * D + 256 * j + 4 * lane, v[r][j]);
                if (UP8_MASK & 1u) *(unsigned*)(F_X8 + (size_t)(m4 + r) * D + 256 * j + 4 * lane) = pg8::pk4_fp8(v[r][j][0], v[r][j][1], v[r][j][2], v[r][j][3]); }
            sr = wave_sum(sr);
            if (lane < 16) F_SSQ[(size_t)(m4 + r) * 16 + lane] = lane == 0 ? sr : 0.f; }
    }
}

#ifndef PROBE_PREP
#define PROBE_PREP 0
#endif
__device__ __forceinline__ void prep_phase(Frame& F, int L) {
    int tid = F.tid; asm volatile("" : "+v"(tid));
    const int lane = tid & 63, ch = 4 * lane;
    LAS bf16* PWt = (LAS bf16*)F.lds;
    LAS bf16* DTb = (LAS bf16*)(F.lds + 65536) + F.wave * (16 * 264);
    { const float* pw = FIN(I_POOLW) + (size_t)L * 16384;
      for (int i = tid; i < 16384; i += NWAVES * 64) { const int g = i >> 12, c = (i >> 6) & 63, e = i & 63; PWt[(g * 64 + e) * 72 + c] = (bf16)(pk2(pw[i], 0.f) & 0xffffu); } }
    __syncthreads();
    f32x4 g0, g1, g2, cw0, cw1, cw2;
    { const float* nq = FIN(I_NQN) + L * 64; const float* nks = FIN(I_NKSN) + L * 64; const float* nkw = FIN(I_NKWN) + L * 64; const float* sk = FIN(I_SKN) + L * 64; const float* sq = FIN(I_SQN) + L * 64;
      g0 = *(const f32x4*)(nq + (ch & 63)) * C2;
      g1 = ch < 64 ? *(const f32x4*)(nks + ch) : (ch < 128 ? *(const f32x4*)(nkw + (ch - 64)) : *(const f32x4*)(sk + (ch & 63)));
      g2 = *(const f32x4*)(sq + (ch & 63)) * C2;
      const float* cw = FIN(I_CONVW) + L * 768; cw0 = *(const f32x4*)(cw + ch); cw1 = *(const f32x4*)(cw + 256 + ch); cw2 = *(const f32x4*)(cw + 512 + ch);
      }
    const int grp = lane >> 4, win = 2 << grp;
    const int gw = F.vcu * NWAVES + F.wave, NGW = F.G * NWAVES;
    TS(F.lds, 30);
    for (int blk = gw; blk < M / 16; blk += NGW) {
        const int m0 = blk * 16, t0 = m0 & (T - 1);
        const bf16* u0 = F_U + (size_t)m0 * NU;
        const int gt = m0 >> 6, rb = m0 & 63, dk = ch & 63;
        bf16* kimg = (ch < 64 ? F_KSI : (ch < 128 ? F_KWI : F_CKI + (size_t)((ch - 128) >> 6) * 512 * 4096)) + (size_t)gt * 4096 + kimg_off(rb, dk);
        bf16* vimg = (ch < 64 ? F_VSI : (ch < 128 ? F_VWI : F_CVI + (size_t)((ch - 128) >> 6) * 512 * 4096)) + (size_t)gt * 4096 + vimg_off(rb, dk);
#pragma nounroll
        for (int i8 = 0; i8 < 16; i8 += 8) { u32x2 raw[8][4];
#pragma unroll
            for (int i = 0; i < 8; ++i) {
#pragma unroll
                for (int k = 0; k < 3; ++k) raw[i][k] = *(const u32x2*)(u0 + (size_t)(i8 + i) * NU + 256 * k + ch);
                raw[i][3] = *(const u32x2*)(u0 + (size_t)(i8 + i) * NU + UVS + ch); }
#pragma unroll
            for (int i = 0; i < 8; ++i) { const f32x4 v0 = up4(raw[i][0]), v1 = up4(raw[i][1]), v2 = up4(raw[i][2]);
                const float s0 = row16_sum(sq4(v0)), s1 = row16_sum(sq4(v1)), s2 = row16_sum(sq4(v2));
                const float r0 = __builtin_amdgcn_rsqf(s0 * (1.f / 64.f) + EPS), r1 = __builtin_amdgcn_rsqf(s1 * (1.f / 64.f) + EPS), r2 = __builtin_amdgcn_rsqf(s2 * (1.f / 64.f) + EPS);
                st4bf(F_QA + (size_t)(m0 + i8 + i) * 256 + ch, v0 * r0 * g0); st4bf(kimg + (i8 + i) * 8, v1 * r1 * g1); st4bf(F_QC + (size_t)(m0 + i8 + i) * 256 + ch, v2 * r2 * g2);
                *(u32x2*)(vimg + (i8 + i) * 32) = raw[i][3]; } }
        TS(F.lds, 31);
#pragma unroll
        for (int k = 0; k < 3; ++k) { const int idx = lane + 64 * k, tk = idx / 12, gi = idx - 12 * tk;
            const float a = bflo((unsigned)u0[(size_t)tk * NU + UG + gi]); F_GATES[(size_t)m0 * 12 + idx] = __builtin_amdgcn_rcpf(1.0f + __builtin_amdgcn_exp2f(a * -LOG2E)); }
        TS(F.lds, 32);
        { f32x4 zm1 = {0.f, 0.f, 0.f, 0.f}, zm2 = {0.f, 0.f, 0.f, 0.f};
          if (t0 > 0) { zm1 = ld4bf(u0 - NU + UBC + ch) * ld4bf(u0 - NU + UBX + ch); zm2 = ld4bf(u0 - 2 * NU + UBC + ch) * ld4bf(u0 - 2 * NU + UBX + ch); }
#pragma nounroll
          for (int i8 = 0; i8 < 16; i8 += 8) { u32x2 raw[8][3]; f32x4 ob[8]; float ss[8];
#pragma unroll
              for (int i = 0; i < 8; ++i)
#pragma unroll
                  for (int k = 0; k < 3; ++k) raw[i][k] = *(const u32x2*)(u0 + (size_t)(i8 + i) * NU + UBB + 256 * k + ch);
#pragma unroll
              for (int i = 0; i < 8; ++i) { const f32x4 z0 = up4(raw[i][1]) * up4(raw[i][2]);
                  ob[i] = up4(raw[i][0]) * (cw2 * z0 + cw1 * zm1 + cw0 * zm2); zm2 = zm1; zm1 = z0; ss[i] = sq4(ob[i]); }
#pragma unroll
              for (int i = 0; i < 8; ++i) ss[i] = wave_sum(ss[i]);
#pragma unroll
              for (int i = 0; i < 8; ++i) st4bf(F_YN + (size_t)(m0 + i8 + i) * D + 256 + ch, ob[i] * (__builtin_amdgcn_rsqf(ss[i] * (1.f / 256.f) + EPS))); } }
        TS(F.lds, 33);
        { u32x2 raw[32];
#pragma unroll
          for (int i = 0; i < 16; ++i) { raw[i] = (u32x2){0u, 0u}; if (t0 > 0) raw[i] = *(const u32x2*)(u0 - (size_t)(16 - i) * NU + UDV + ch); }
#pragma unroll
          for (int i = 0; i < 16; ++i) raw[16 + i] = *(const u32x2*)(u0 + (size_t)i * NU + UDV + ch);
          f32x4 S2 = up4(raw[15]) + up4(raw[14]), S4 = S2 + up4(raw[13]) + up4(raw[12]), S8 = S4, S16;
#pragma unroll
          for (int i = 8; i < 12; ++i) S8 += up4(raw[i]);
          S16 = S8;
#pragma unroll
          for (int i = 0; i < 8; ++i) S16 += up4(raw[i]);
#pragma unroll
          for (int ti = 0; ti < 16; ++ti) { const f32x4 v = up4(raw[16 + ti]);
              S2 += v - up4(raw[16 + ti - 2]); S4 += v - up4(raw[16 + ti - 4]); S8 += v - up4(raw[16 + ti - 8]); S16 += v - up4(raw[ti]);
              const f32x4 Sw = grp == 0 ? S2 : (grp == 1 ? S4 : (grp == 2 ? S8 : S16));
              const int cn = (t0 + ti + 1) < win ? (t0 + ti + 1) : win;
              const f32x4 dd = Sw * __builtin_amdgcn_rcpf((float)cn) - v;
              u32x2 w; w.x = pk2(dd[0], dd[1]); w.y = pk2(dd[2], dd[3]); *(LAS u32x2*)(DTb + ti * 264 + ch) = w; }
          const int fr = lane & 15, fq = lane >> 4;
          const float* psp = FIN(I_POOLS) + L * 256 + fr;
          f32x4 acc[4][4];
#pragma unroll
          for (int g = 0; g < 4; ++g) { const bf16x8 a0 = *(const LAS bf16x8*)(DTb + fr * 264 + g * 64 + 8 * fq), a1 = *(const LAS bf16x8*)(DTb + fr * 264 + g * 64 + 32 + 8 * fq);
#pragma unroll
              for (int cb = 0; cb < 4; ++cb) { const LAS bf16* bp = PWt + (g * 64 + 16 * cb + fr) * 72 + 8 * fq;
                  f32x4 c = {0.f, 0.f, 0.f, 0.f};
                  c = __builtin_amdgcn_mfma_f32_16x16x32_bf16(a0, *(const LAS bf16x8*)bp, c, 0, 0, 0);
                  c = __builtin_amdgcn_mfma_f32_16x16x32_bf16(a1, *(const LAS bf16x8*)(bp + 32), c, 0, 0, 0);
                  acc[g][cb] = c * psp[g * 64 + 16 * cb]; } }
          float ss[4];
#pragma unroll
          for (int i = 0; i < 4; ++i) { float q = 0.f;
#pragma unroll
              for (int g = 0; g < 4; ++g)
#pragma unroll
                  for (int cb = 0; cb < 4; ++cb) q += acc[g][cb][i] * acc[g][cb][i];
              ss[i] = __builtin_amdgcn_rsqf(row16_sum(q) * (1.f / 256.f) + EPS); }
          asm volatile("s_waitcnt lgkmcnt(0)" ::: "memory");
#pragma unroll
          for (int g = 0; g < 4; ++g)
#pragma unroll
              for (int cb = 0; cb < 4; ++cb)
#pragma unroll
                  for (int i = 0; i < 4; ++i) DTb[(4 * fq + i) * 264 + g * 64 + 16 * cb + fr] = (bf16)(pk2(acc[g][cb][i] * ss[i], 0.f) & 0xffffu);
#pragma unroll
          for (int ti = 0; ti < 16; ++ti) *(u32x2*)(F_YN + (size_t)(m0 + ti) * D + 768 + ch) = *(const LAS u32x2*)(DTb + ti * 264 + ch); }
        TS(F.lds, 34);
    }
    __syncthreads();
    TS(F.lds, 35);
    LAS float* PART = (LAS float*)F.lds;
    LAS float* H = (LAS float*)(F.lds + 65536);
    LAS float* O2 = (LAS float*)(F.lds + 65536 + 16384);
    const int fr = lane & 15, fq = lane >> 4, wave = F.wave;
    for (int rep8 = 0; rep8 < ((PROBE_PREP & 8) ? 2 : 1); ++rep8)
    for (int uid = F.vcu; uid < 256; uid += F.G) {
        const int b = uid >> 4, kv = (uid >> 3) & 1, n0 = 16 * (uid & 7);
        const bf16* W1t = F_C1T + (size_t)(L * 2 + kv) * 128 * 2048;
        const float* pos = FIN(kv ? I_POSV : I_POSK) + (size_t)L * 2048;
        const float* W2 = FIN(kv ? I_C2V : I_C2K) + (size_t)L * 128 * 64;
        const int nrow = (n0 + fr) < 126 ? (n0 + fr) : 126;
        const bf16* arow = F_U + (size_t)(b * T + 16 * nrow) * NU + UKC + 64 * kv;
        const bf16* brow = W1t + (size_t)fr * 2048;
        f32x4 acc[8];
#pragma unroll
        for (int ct = 0; ct < 8; ++ct) acc[ct] = (f32x4){0.f, 0.f, 0.f, 0.f};
        v4u car[3]; f32x4 cp0[3], cp1[3]; bf16x8 cb[3][8];
#define CMP_LOAD(bi, ks) do { const int kk_ = 8 * wave + (ks), l_ = kk_ >> 1, c_ = 32 * (kk_ & 1) + 8 * fq; \
            car[bi] = *(const v4u*)(arow + (size_t)l_ * NU + c_); cp0[bi] = *(const f32x4*)(pos + l_ * 64 + c_); cp1[bi] = *(const f32x4*)(pos + l_ * 64 + c_ + 4); \
            _Pragma("unroll") for (int ct = 0; ct < 8; ++ct) cb[bi][ct] = *(const bf16x8*)(brow + (size_t)(16 * ct) * 2048 + 32 * kk_ + 8 * fq); } while (0)
#define CMP_MMA(bi) do { const v4u ar = car[bi]; const f32x4 p0 = cp0[bi], p1 = cp1[bi]; v4u aw; \
            aw.x = pk2(bflo(ar.x) + p0[0], bfhi(ar.x) + p0[1]); aw.y = pk2(bflo(ar.y) + p0[2], bfhi(ar.y) + p0[3]); aw.z = pk2(bflo(ar.z) + p1[0], bfhi(ar.z) + p1[1]); aw.w = pk2(bflo(ar.w) + p1[2], bfhi(ar.w) + p1[3]); \
            _Pragma("unroll") for (int ct = 0; ct < 8; ++ct) acc[ct] = __builtin_amdgcn_mfma_f32_16x16x32_bf16(__builtin_bit_cast(bf16x8, aw), cb[bi][ct], acc[ct], 0, 0, 0); } while (0)
        CMP_LOAD(0, 0); CMP_LOAD(1, 1); CMP_LOAD(2, 2);
        CMP_MMA(0); CMP_LOAD(0, 3); CMP_MMA(1); CMP_LOAD(1, 4); CMP_MMA(2); CMP_LOAD(2, 5);
        CMP_MMA(0); CMP_LOAD(0, 6); CMP_MMA(1); CMP_LOAD(1, 7); CMP_MMA(2); CMP_MMA(0); CMP_MMA(1);
#undef CMP_LOAD
#undef CMP_MMA
        TS(F.lds, 36);
#pragma unroll
        for (int ct = 0; ct < 8; ++ct)
#pragma unroll
            for (int i = 0; i < 4; ++i) PART[(wave * 16 + 4 * fq + i) * 128 + 16 * ct + fr] = acc[ct][i];
        __syncthreads();
        TS(F.lds, 37);
        { const int e0 = 4 * tid; f32x4 sum = *(const LAS f32x4*)(PART + e0);
#pragma unroll
          for (int w = 1; w < 8; ++w) sum += *(const LAS f32x4*)(PART + w * 2048 + e0);
          const int hr = e0 >> 7, hc = e0 & 127;
#pragma unroll
          for (int i = 0; i < 4; ++i) { const float xh = sum[i]; const float y2 = 2.0f * 0.7978845608028654f * (xh + 0.044715f * xh * xh * xh); H[hr * 132 + hc + i] = xh * __builtin_amdgcn_rcpf(1.0f + __builtin_amdgcn_exp2f(y2 * -LOG2E)); } }
        __syncthreads();
        if (wave < 4) { f32x4 a2 = {0.f, 0.f, 0.f, 0.f};
#pragma unroll
            for (int s = 0; s < 4; ++s) { const LAS float* hp = H + fr * 132 + 32 * s + 8 * fq; const float* wp = W2 + (size_t)(32 * s + 8 * fq) * 64 + 16 * wave + fr;
                v4u aw; aw.x = pk2(hp[0], hp[1]); aw.y = pk2(hp[2], hp[3]); aw.z = pk2(hp[4], hp[5]); aw.w = pk2(hp[6], hp[7]);
                v4u bw; bw.x = pk2(wp[0], wp[64]); bw.y = pk2(wp[128], wp[192]); bw.z = pk2(wp[256], wp[320]); bw.w = pk2(wp[384], wp[448]);
                a2 = __builtin_amdgcn_mfma_f32_16x16x32_bf16(__builtin_bit_cast(bf16x8, aw), __builtin_bit_cast(bf16x8, bw), a2, 0, 0, 0); }
#pragma unroll
            for (int i = 0; i < 4; ++i) O2[(4 * fq + i) * 68 + 16 * wave + fr] = a2[i]; }
        __syncthreads();
        if (wave == 0) { const int row = lane >> 2, c0 = (lane & 3) * 16; float v[16]; float ss = 0.f;
#pragma unroll
            for (int e = 0; e < 16; ++e) { v[e] = O2[row * 68 + c0 + e]; ss += v[e] * v[e]; }
            ss += __shfl_xor(ss, 1); ss += __shfl_xor(ss, 2);
            const float rs = __builtin_amdgcn_rsqf(ss * (1.f / 64.f) + EPS); const float* gn = FIN(I_NKCN) + L * 64 + c0;
            const int n = n0 + row; const bool dead = n >= 127;
            v4u w0, w1; float o[16];
#pragma unroll
            for (int e = 0; e < 16; ++e) { o[e] = kv ? v[e] : v[e] * rs * gn[e]; if (dead) o[e] = 0.f; }
            w0.x = pk2(o[0], o[1]); w0.y = pk2(o[2], o[3]); w0.z = pk2(o[4], o[5]); w0.w = pk2(o[6], o[7]); w1.x = pk2(o[8], o[9]); w1.y = pk2(o[10], o[11]); w1.z = pk2(o[12], o[13]); w1.w = pk2(o[14], o[15]);
            const int tl = n >> 6, rr = n & 63;
            if (kv) { bf16* dstp = F_VC + (size_t)(b * 2 + tl) * 4096 + vimg_off(rr, c0); *(v4u*)dstp = w0; *(v4u*)(dstp + 8) = w1; }
            else { bf16* dstp = F_KC + (size_t)(b * 2 + tl) * 4096; *(v4u*)(dstp + kimg_off(rr, c0)) = w0; *(v4u*)(dstp + kimg_off(rr, c0 + 8)) = w1; } }
        __syncthreads();
    }
}

#ifndef PROBE_ATT
#define PROBE_ATT 0
#endif
#define TSA(l_, k_) do { if (PROBE_TS >= 20 && PROBE_TS < 80 && !(PROBE_TS >= 30 && PROBE_TS < 60)) TS(l_, k_); } while (0)
namespace att {
constexpr int STG = 32768;
constexpr int L_STG = 0, L_IA = 65536, IAB = 4 * 64 * 33 * 4, L_IB = L_IA + IAB, L_SC = L_IB + IAB, L_SEL = L_SC + 64 * 36 * 4, L_UNI = L_SEL + 256, L_WSF = L_UNI + 256, L_END = L_WSF + NWAVES * 256;
static_assert(L_END <= MISC_OFF, "attention LDS map");
constexpr int OSTP = 264;
#define ATT_BAR() asm volatile("s_waitcnt vmcnt(0) lgkmcnt(0)\n\ts_barrier" ::: "memory")
#define ATT_LBAR() asm volatile("s_waitcnt lgkmcnt(0)\n\ts_barrier" ::: "memory")
__device__ __forceinline__ int crow(int r, int hi) { return (r & 3) + 8 * (r >> 2) + 4 * hi; }
__device__ __forceinline__ float pair_max(float v) { auto rr = __builtin_amdgcn_permlane32_swap(__float_as_uint(v), __float_as_uint(v), false, false); return fmaxf(__uint_as_float(rr[0]), __uint_as_float(rr[1])); }
__device__ __forceinline__ float pair_sum(float v) { auto rr = __builtin_amdgcn_permlane32_swap(__float_as_uint(v), __float_as_uint(v), false, false); return __uint_as_float(rr[0]) + __uint_as_float(rr[1]); }
__device__ __forceinline__ void dma_tile(const bf16* tile, LAS unsigned char* slot, int wave, int lane) {
    __builtin_amdgcn_global_load_lds((const unsigned*)(tile + wave * 512 + lane * 8), (LAS unsigned*)(slot + wave * 1024), 16, 0, 0); }
__device__ __forceinline__ void qk_tile(f32x16& p0, f32x16& p1, const LAS unsigned char* kslot, const bf16x8 (&qr)[4], const f32x16& cin, int r32, int hi) {
    const LAS unsigned char* kp = kslot + hi * 1024 + r32 * 16;
#pragma unroll
    for (int d0 = 0; d0 < 4; ++d0) { const bf16x8 b0 = *(const LAS bf16x8*)(kp + d0 * 2048), b1 = *(const LAS bf16x8*)(kp + d0 * 2048 + 512);
        if (d0 == 0) { p0 = __builtin_amdgcn_mfma_f32_32x32x16_bf16(b0, qr[0], cin, 0, 0, 0); p1 = __builtin_amdgcn_mfma_f32_32x32x16_bf16(b1, qr[0], cin, 0, 0, 0); }
        else { p0 = __builtin_amdgcn_mfma_f32_32x32x16_bf16(b0, qr[d0], p0, 0, 0, 0); p1 = __builtin_amdgcn_mfma_f32_32x32x16_bf16(b1, qr[d0], p1, 0, 0, 0); } }
}
__device__ __forceinline__ v4i16_t vtr(const LAS unsigned char* p) { return __builtin_amdgcn_ds_read_tr16_b64_v4i16((LAS v4i16_t*)p); }
__device__ __forceinline__ void pv_tile(f32x16& o0, f32x16& o1, const LAS unsigned char* vslot, const v4u (&pw)[4], int lane, int hi) {
    const unsigned vb = (unsigned)(uintptr_t)(vslot + ((lane >> 4) & 1) * 32 + (lane & 3) * 8 + (4 * hi + ((lane & 15) >> 2)) * 64);
#define PV_HALF(o_, OFF) do { v4i16_t a0[4], a1[4]; \
        _Pragma("unroll") for (int s_ = 0; s_ < 4; ++s_) { \
            asm volatile("ds_read_b64_tr_b16 %0, %1 offset:%c2" : "=&v"(a0[s_]) : "v"(vb), "i"((OFF) + s_ * 1024) : "memory"); \
            asm volatile("ds_read_b64_tr_b16 %0, %1 offset:%c2" : "=&v"(a1[s_]) : "v"(vb), "i"((OFF) + s_ * 1024 + 512) : "memory"); } \
        PV_STEP(o_, 0, 6); PV_STEP(o_, 1, 4); PV_STEP(o_, 2, 2); PV_STEP(o_, 3, 0); } while (0)
#define PV_STEP(o_, s_, N) do { asm volatile("s_waitcnt lgkmcnt(" #N ")" : "+v"(a0[s_]), "+v"(a1[s_]) :: "memory"); \
        const bf16x8 v0 = (bf16x8){a0[s_][0], a0[s_][1], a0[s_][2], a0[s_][3], a1[s_][0], a1[s_][1], a1[s_][2], a1[s_][3]}; \
        o_ = __builtin_amdgcn_mfma_f32_32x32x16_bf16(__builtin_bit_cast(bf16x8, pw[s_]), v0, o_, 0, 0, 0); } while (0)
    PV_HALF(o0, 0); PV_HALF(o1, 4096);
#undef PV_STEP
#undef PV_HALF
}
__device__ __forceinline__ void pack_p(v4u (&pw)[4], const f32x16& p0, const f32x16& p1) {
    pw[0] = (v4u){pk2(p0[0], p0[1]), pk2(p0[2], p0[3]), pk2(p0[4], p0[5]), pk2(p0[6], p0[7])};
    pw[1] = (v4u){pk2(p0[8], p0[9]), pk2(p0[10], p0[11]), pk2(p0[12], p0[13]), pk2(p0[14], p0[15])};
    pw[2] = (v4u){pk2(p1[0], p1[1]), pk2(p1[2], p1[3]), pk2(p1[4], p1[5]), pk2(p1[6], p1[7])};
    pw[3] = (v4u){pk2(p1[8], p1[9]), pk2(p1[10], p1[11]), pk2(p1[12], p1[13]), pk2(p1[14], p1[15])};
}
#define MX3(a, b, c) __builtin_fmaxf(__builtin_fmaxf((a), (b)), (c))
__device__ __forceinline__ void softmax_step(float& m, f32x16& negm, float& l, f32x16& o0, f32x16& o1, f32x16& p0, f32x16& p1, v4u (&pw)[4], LAS float* wsf, int r32, int hi) {
    float xa = MX3(p0[0], p0[1], p1[0]), xb = MX3(p0[2], p0[3], p1[1]); xa = MX3(xa, p1[2], p1[3]);
#pragma unroll
    for (int r = 4; r < 16; r += 4) { xa = MX3(xa, p0[r], p0[r + 1]); xb = MX3(xb, p0[r + 2], p0[r + 3]); xa = MX3(xa, p1[r], p1[r + 1]); xb = MX3(xb, p1[r + 2], p1[r + 3]); }
    const float mt = pair_max(__builtin_fmaxf(xa, xb));
    if (__any(mt > 8.0f)) {
        const float dl = __builtin_fmaxf(mt, 0.f), al = __builtin_amdgcn_exp2f(-dl); l *= al; m += dl;
        if (hi == 0) wsf[r32] = al;
        f32x4 a[4];
#pragma unroll
        for (int g = 0; g < 4; ++g) a[g] = *(const LAS f32x4*)(wsf + 8 * g + 4 * hi);
#pragma unroll
        for (int r = 0; r < 16; ++r) { o0[r] *= a[r >> 2][r & 3]; o1[r] *= a[r >> 2][r & 3]; p0[r] -= dl; p1[r] -= dl; negm[r] = -m; }
    }
    float rs0 = 0.f, rs1 = 0.f;
#pragma unroll
    for (int r = 0; r < 16; ++r) { p0[r] = __builtin_amdgcn_exp2f(p0[r]); p1[r] = __builtin_amdgcn_exp2f(p1[r]); rs0 += p0[r]; rs1 += p1[r]; }
    l += rs0 + rs1;
    pack_p(pw, p0, p1);
}
__device__ __forceinline__ void scale_rows(f32x16& a0, f32x16& a1, const f32x16& o0, const f32x16& o1, float fac, LAS float* wsf, int r32, int hi) {
    if (hi == 0) wsf[32 + r32] = fac;
    f32x4 f[4];
#pragma unroll
    for (int g = 0; g < 4; ++g) f[g] = *(const LAS f32x4*)(wsf + 32 + 8 * g + 4 * hi);
#pragma unroll
    for (int r = 0; r < 16; ++r) { a0[r] += o0[r] * f[r >> 2][r & 3]; a1[r] += o1[r] * f[r >> 2][r & 3]; }
}
constexpr int L_OTS = 65536;
__device__ __forceinline__ void ots_put(const f32x16& a0, const f32x16& a1, LAS unsigned char* lds, int wave, int lane) {
    LAS float* S = (LAS float*)(lds + L_OTS) + wave * 2048 + lane;
#pragma unroll
    for (int r = 0; r < 16; ++r) { S[r * 64] = a0[r]; S[(16 + r) * 64] = a1[r]; }
}
__device__ __forceinline__ void ots_get(f32x16& a0, f32x16& a1, const LAS unsigned char* lds, int wave, int lane) {
    const LAS float* S = (const LAS float*)(lds + L_OTS) + wave * 2048 + lane;
#pragma unroll
    for (int r = 0; r < 16; ++r) { a0[r] = S[r * 64]; a1[r] = S[(16 + r) * 64]; }
}
template <int MODE>
__device__ __forceinline__ void run_branch(unsigned tiles, const bf16* Kg  , const bf16* Vg, int kvsel, unsigned selm, int tq, const bf16x8 (&qr)[4],
                                           float& m, float& l, f32x16& o0, f32x16& o1, LAS unsigned char* lds, LAS float* wsf, int wave, int lane) {
    constexpr int NKV = MODE == 2 ? 2 : 1, SLOT = 16384 * NKV, NS = 4;
    const int r32 = lane & 31, hi = lane >> 5;
    m = 0.f; l = 0.f; o0 = (f32x16){}; o1 = (f32x16){}; f32x16 negm = (f32x16){};
    unsigned remc = (unsigned)__builtin_amdgcn_readfirstlane((int)tiles), remi = remc;
    int nleft = __builtin_popcount(remc), slot_i = 0, slot_c = 0;
    ATT_LBAR();
#define ATT_ISSUE() do { const int ji = __builtin_ctz(remi); remi &= remi - 1; LAS unsigned char* st_ = lds + L_STG + slot_i * SLOT; slot_i = (slot_i + 1) & (NS - 1); \
        _Pragma("unroll") for (int g = 0; g < NKV; ++g) { dma_tile(Kg + (size_t)(g * 512 + ji) * 4096, st_ + g * 8192, wave, lane); dma_tile(Vg + (size_t)(g * 512 + ji) * 4096, st_ + NKV * 8192 + g * 8192, wave, lane); } } while (0)
#define ATT_WB(n) asm volatile("s_waitcnt vmcnt(" #n ") lgkmcnt(0)\n\ts_barrier" ::: "memory")
#pragma nounroll
    for (int k = 0; k < NS - 2; ++k) if (remi) ATT_ISSUE();
    TSA(lds, 70 + MODE);
    const bool lead = true; v4u pw[4] = {}; const LAS unsigned char* stp = lds + L_STG;
    bool havep = false;
    constexpr int W = MODE == 1 ? 512 : 128;
    const int curt = __builtin_amdgcn_readfirstlane(tq) >> 6;
#define ATT_QS(j_, st_) do { const int kb = 64 * (j_) + 4 * hi; const bool sel = MODE != 0 || ((selm >> (j_)) & 1u); \
        const bool edge = MODE == 3 || (j_) == curt || (MODE != 0 && (j_) + W / 64 == curt);     \
        f32x16 p0, p1; \
        if (MODE == 0) { f32x16 cin;     \
            _Pragma("unroll") for (int r = 0; r < 16; ++r) cin[r] = sel ? negm[r] : -INFINITY; \
            qk_tile(p0, p1, (st_) + kvsel * 8192, qr, cin, r32, hi); } \
        else qk_tile(p0, p1, (st_) + kvsel * 8192, qr, negm, r32, hi); \
        if (edge) { _Pragma("unroll") for (int r = 0; r < 16; ++r) { const int kp = kb + (r & 3) + 8 * (r >> 2); bool v0, v1; \
                if (MODE == 0) { v0 = kp <= tq; v1 = kp + 32 <= tq; } \
                else if (MODE == 3) { v0 = 16 * kp + 31 <= tq; v1 = 16 * (kp + 32) + 31 <= tq; } \
                else { v0 = kp <= tq && kp + W > tq; v1 = kp + 32 <= tq && kp + 32 + W > tq; } \
                p0[r] = v0 ? p0[r] : -INFINITY; p1[r] = v1 ? p1[r] : -INFINITY; } } \
        softmax_step(m, negm, l, o0, o1, p0, p1, pw, wsf, r32, hi); } while (0)
    for (;;) {
        const int pend = (nleft - 1 < NS - 3 ? nleft - 1 : NS - 3) * NKV;
        switch (pend) { case 0: ATT_WB(0); break; case 1: ATT_WB(2); break; case 2: ATT_WB(4); break; case 3: ATT_WB(6); break; case 4: ATT_WB(8); break; default: ATT_WB(10); break; }
        if (remi) ATT_ISSUE();
        const int j = __builtin_ctz(remc); remc &= remc - 1; --nleft;
        const LAS unsigned char* st = lds + L_STG + slot_c * SLOT; slot_c = (slot_c + 1) & (NS - 1);
        if (lead) { ATT_QS(j, st); pv_tile(o0, o1, st + NKV * 8192 + kvsel * 8192, pw, lane, hi); }
        else { if (havep) pv_tile(o0, o1, stp + NKV * 8192 + kvsel * 8192, pw, lane, hi); ATT_QS(j, st); }
        stp = st; havep = true;
        TSA(lds, 60 + MODE);
        if (nleft == 0) break;
    }
    if (!lead) pv_tile(o0, o1, stp + NKV * 8192 + kvsel * 8192, pw, lane, hi);
#undef ATT_QS
#undef ATT_ISSUE
#undef ATT_WB
}
__device__ __forceinline__ void stage_norm_store(const f32x16& o0, const f32x16& o1, bf16* ynb  , LAS unsigned char* lds, int wave, int lane) {
    const int r32 = lane & 31, hi = lane >> 5, h = wave & 3, th = wave >> 2;
    LAS bf16* OST = (LAS bf16*)(lds + L_STG);
    ATT_LBAR();
#pragma unroll
    for (int r = 0; r < 16; ++r) { LAS bf16* p = OST + (32 * th + crow(r, hi)) * OSTP + h * 64 + r32;
        p[0] = (bf16)(pk2(o0[r], 0.f) & 0xffffu); p[32] = (bf16)(pk2(o1[r], 0.f) & 0xffffu); }
    ATT_LBAR();
    f32x4 vv[8]; float ssn[8];
#pragma unroll
    for (int i = 0; i < 8; ++i) { const u32x2 w = *(const LAS u32x2*)(OST + (8 * wave + i) * OSTP + 4 * lane); vv[i] = (f32x4){bflo(w.x), bfhi(w.x), bflo(w.y), bfhi(w.y)}; ssn[i] = sq4(vv[i]); }
#pragma unroll
    for (int i = 0; i < 8; ++i) ssn[i] = wave_sum(ssn[i]);
#pragma unroll
    for (int i = 0; i < 8; ++i) st4bf(ynb + (size_t)(8 * wave + i) * D + 4 * lane, vv[i] * __builtin_amdgcn_rsqf(ssn[i] * (1.f / 256.f) + EPS));
}
__device__ __forceinline__ void attn_unit(Frame& F, int L, int b, int qt) {
    LAS unsigned char* lds = F.lds;
    int tid = F.tid; asm volatile("" : "+v"(tid));
    const int wave = F.wave, lane = tid & 63, r32 = lane & 31, hi = lane >> 5, h = wave & 3, th = wave >> 2;
    const int t0 = qt * 64, cur = qt, qrow = 32 * th + r32, tq = t0 + qrow;
    const size_t mrow = (size_t)b * T + tq;
    LAS float* wsf = (LAS float*)(lds + L_WSF) + wave * 64;
    LAS float* IA = (LAS float*)(lds + L_IA); LAS float* IB = (LAS float*)(lds + L_IB); LAS float* SC = (LAS float*)(lds + L_SC);
    LAS unsigned* SEL = (LAS unsigned*)(lds + L_SEL); LAS unsigned* UNI = (LAS unsigned*)(lds + L_UNI);
    const size_t tb = (size_t)b * 32 * 4096;
    bf16x8 qr[4];
#pragma unroll
    for (int d0 = 0; d0 < 4; ++d0) qr[d0] = *(const bf16x8*)(F_QA + mrow * 256 + h * 64 + d0 * 16 + hi * 8);
    const float* gp = F_GATES + mrow * 12 + h * 3; const float g0 = gp[0], g1 = gp[1], g2 = gp[2];
    float mb, lb; f32x16 ob0, ob1;
    for (int rep = 0; rep < ((PROBE_ATT & 4) ? 2 : 1); ++rep) {
        if (rep) { ATT_LBAR(); }
        if (tid == 0) UNI[0] = 0u;
        run_branch<3>(3u, F_KC + (size_t)b * 2 * 4096, F_VC + (size_t)b * 2 * 4096, 0, 0u, tq, qr, mb, lb, ob0, ob1, lds, wsf, wave, lane);
        TSA(lds, 20);
        const float lt = pair_sum(lb); const float inv = lt > 0.f ? 1.0f / lt : 0.f;
        f32x16 oc0 = (f32x16){}, oc1 = (f32x16){}; scale_rows(oc0, oc1, ob0, ob1, g0 * inv, wsf, r32, hi);
        LAS float* ia = IA + (h * 64 + qrow) * 33; LAS float* ib = IB + (h * 64 + qrow) * 33;
#pragma unroll
        for (int tl = 0; tl < 2; ++tl) { f32x16 p0, p1; const f32x16 z16 = (f32x16){}; qk_tile(p0, p1, lds + L_STG + tl * 16384, qr, z16, r32, hi);
#pragma unroll
            for (int r = 0; r < 16; ++r) { const int n = 64 * tl + crow(r, hi);
                p0[r] = 16 * n + 31 <= tq ? __builtin_amdgcn_exp2f(p0[r] - mb) * inv : 0.f; p1[r] = 16 * (n + 32) + 31 <= tq ? __builtin_amdgcn_exp2f(p1[r] - mb) * inv : 0.f; }
#pragma unroll
            for (int G = 0; G < 4; ++G) {
                ia[hi + 2 * (G + 8 * tl)] = (p0[4 * G] + p0[4 * G + 1]) + (p0[4 * G + 2] + p0[4 * G + 3]); ib[hi + 2 * (G + 8 * tl)] = p0[4 * G + 3];
                ia[hi + 2 * (G + 4 + 8 * tl)] = (p1[4 * G] + p1[4 * G + 1]) + (p1[4 * G + 2] + p1[4 * G + 3]); ib[hi + 2 * (G + 4 + 8 * tl)] = p1[4 * G + 3]; } }
        TSA(lds, 27);
        ATT_LBAR();
        const int q = tid >> 3, jg = tid & 7, tqq = t0 + q;
#pragma unroll
        for (int i = 0; i < 4; ++i) { const int j = 4 * jg + i; float imp = 0.f;
#pragma unroll
            for (int hh = 0; hh < 4; ++hh) { imp += IA[(hh * 64 + q) * 33 + j]; if (j > 0) imp += IB[(hh * 64 + q) * 33 + j - 1]; }
            const bool forced = j == 0 || j == cur || j == cur - 1, future = j * 64 > tqq;
            SC[q * 36 + j] = forced ? 1e4f : (future ? -1.0f : imp); }
        ATT_LBAR();
        TSA(lds, 28);
        unsigned bits = 0u;
        { f32x4 sc4[8];
#pragma unroll
          for (int g = 0; g < 8; ++g) sc4[g] = *(const LAS f32x4*)(SC + q * 36 + 4 * g);
          const f32x4 mine = *(const LAS f32x4*)(SC + q * 36 + 4 * jg);
#pragma unroll
          for (int i = 0; i < 4; ++i) { const int j = 4 * jg + i; const float sj = mine[i]; int rank = 0;
#pragma unroll
              for (int k = 0; k < 32; ++k) { const float sk = sc4[k >> 2][k & 3]; rank += (sk > sj || (sk == sj && k < j)) ? 1 : 0; }
              if (rank < 8) bits |= 1u << j; } }
        TSA(lds, 29);
        bits |= __shfl_xor(bits, 1); bits |= __shfl_xor(bits, 2); bits |= __shfl_xor(bits, 4);
        if (jg == 0) { SEL[q] = bits; atomicOr((unsigned*)UNI, bits); }
        ATT_LBAR();
        ots_put(oc0, oc1, lds, wave, lane);
    }
    TSA(lds, 21);
    { const unsigned selm = SEL[qrow]; const unsigned uni = UNI[0] & ((2u << cur) - 1u);
      if (PROBE_ATT & 1) run_branch<0>(uni, F_KSI + tb, F_VSI + tb, 0, selm, tq, qr, mb, lb, ob0, ob1, lds, wsf, wave, lane);
      run_branch<0>(uni, F_KSI + tb, F_VSI + tb, 0, selm, tq, qr, mb, lb, ob0, ob1, lds, wsf, wave, lane);
      const float lt = pair_sum(lb); f32x16 ot0, ot1; ots_get(ot0, ot1, lds, wave, lane); scale_rows(ot0, ot1, ob0, ob1, g1 / lt, wsf, r32, hi); ots_put(ot0, ot1, lds, wave, lane); }
    TSA(lds, 22);
    { const int lo = cur >= 8 ? cur - 8 : 0; const unsigned tiles = ((2u << cur) - 1u) & ~((1u << lo) - 1u);
      if (PROBE_ATT & 2) run_branch<1>(tiles, F_KWI + tb, F_VWI + tb, 0, 0u, tq, qr, mb, lb, ob0, ob1, lds, wsf, wave, lane);
      run_branch<1>(tiles, F_KWI + tb, F_VWI + tb, 0, 0u, tq, qr, mb, lb, ob0, ob1, lds, wsf, wave, lane);
      const float lt = pair_sum(lb); f32x16 ot0, ot1; ots_get(ot0, ot1, lds, wave, lane); scale_rows(ot0, ot1, ob0, ob1, g2 / lt, wsf, r32, hi);
      stage_norm_store(ot0, ot1, F_YN + ((size_t)b * T + t0) * D + 0, lds, wave, lane); }
    for (int rep = 0; rep < ((PROBE_ATT & 16) ? 2 : 1); ++rep) {
#pragma unroll
        for (int d0 = 0; d0 < 4; ++d0) qr[d0] = *(const bf16x8*)(F_QC + mrow * 256 + h * 64 + d0 * 16 + hi * 8);
        const int lo = cur >= 2 ? cur - 2 : 0; const unsigned tiles = ((2u << cur) - 1u) & ~((1u << lo) - 1u);
        run_branch<2>(tiles, F_CKI + tb, F_CVI + tb, h >> 1, 0u, tq, qr, mb, lb, ob0, ob1, lds, wsf, wave, lane);
        TSA(lds, 25);
        const float sink2 = FIN(I_SINK)[L * 4 + h] * LOG2E;
        const float mf = fmaxf(mb, sink2), sc = __builtin_amdgcn_exp2f(mb - mf);
        const float lt = pair_sum(lb) * sc + __builtin_amdgcn_exp2f(sink2 - mf);
        f32x16 ot0 = (f32x16){}, ot1 = (f32x16){};
        scale_rows(ot0, ot1, ob0, ob1, sc / lt, wsf, r32, hi);
        stage_norm_store(ot0, ot1, F_YN + ((size_t)b * T + t0) * D + 512, lds, wave, lane);
        TSA(lds, 26);
    }
}
__device__ __forceinline__ void attn_phase(Frame& F, int L) {
    for (int w = F.vcu; w < 256; w += F.G) { const int b = w >> 4, i = w & 15;
#pragma nounroll
        for (int u2 = 0; u2 < 2; ++u2) attn_unit(F, L, b, u2 ? 31 - i : i); }
    ATT_LBAR();
}
}

__global__ void __launch_bounds__(NWAVES * 64, 2) fwd(Args args) {
    extern __shared__ __attribute__((aligned(16))) unsigned char lds[];
    Frame F;
    F.lds = (LAS unsigned char*)lds;
    F.tid = threadIdx.x; F.lane = F.tid & 63; F.wave = __builtin_amdgcn_readfirstlane(F.tid >> 6);
    F.G = gridDim.x; { const int bx = blockIdx.x; F.vcu = (F.G % 8 == 0) ? (bx % 8) * (F.G / 8) + bx / 8 : bx; }
    F.a = &args;
    unsigned char* ws = args.ws;
    volatile LAS unsigned* MISC = (volatile LAS unsigned*)(F.lds + MISC_OFF);
    if (F.tid < 64) MISC[F.tid] = 0u;
    __syncthreads();
#define GRID_BAR() do { if (fastp) { xcc_local_barrier(bar.bar, bar.x); __builtin_amdgcn_s_waitcnt(0); break; } XcdBarrier b2_ = bar; { unsigned xx_ = b2_.x; asm volatile("" : "+s"(xx_)); b2_.x = xx_; }     \
        xcd_barrier(b2_); if (PROBE_DUP & 1024) xcd_barrier(b2_); __builtin_amdgcn_s_waitcnt(0); } while (0)
    XcdBarrier bar = xcd_barrier_post((unsigned*)(ws + WS_CTL) + CW_BAR, MISC + 8);
    bool fastp = false;
    if (F.tid == 0) MISC[12] = xb_add(&bar.bar[XL_RANK(bar.x)], 1u);
    __syncthreads();
    const unsigned myrank = MISC[12];
    F.cid = (int)blockIdx.x;

#ifndef PH_MASK
#define PH_MASK 127
#endif
#ifndef PROBE_DUP
#define PROBE_DUP 0
#endif
    TS(F.lds, 0);
    if (PH_MASK & 1) prologue(F);
    TS(F.lds, 1);
    if (PROBE_DUP & 1) prologue(F);
    GRID_BAR(); TS(F.lds, 14);
#ifndef XCC_PARTITION
#define XCC_PARTITION 1
#endif
    if (XCC_PARTITION) {
        if (F.tid == 0) { unsigned cnt = 0u, ok = 1u, xi = 0u;
            for (unsigned j = 0; j < 16; ++j) { const unsigned c = xb_ld(&bar.bar[XB_XCNT(j)]); if (c) { if (c != 32u) ok = 0u; if (j < bar.x) ++xi; ++cnt; } }
            if (cnt != 8u || F.G != 256 || myrank >= 32u) ok = 0u;
            MISC[13] = ok; MISC[14] = xi; }
        __syncthreads();
        fastp = MISC[13] != 0u;
        if (fastp) { const int xidx = (int)MISC[14]; F.cid = (int)myrank * 8 + xidx; F.vcu = xidx * 32 + (int)myrank; }
    }
    for (int s = 0; s < 2 * DEPTH; ++s) {
        const int L = s >> 1, which = s & 1;
        const bool up8 = (UP8_MASK >> s) & 1u, dn8 = (DN8_MASK >> s) & 1u;
        if (PH_MASK & 2) {
            const bf16* wt = (const bf16*)((unsigned char*)F_W13T + (size_t)s * NF1 * D * 2); pg8::StaticOrder S; S.init(M, NF1, F.G, F.cid);
            if (up8) { pg8::Gemm g{(const bf16*)F_X8, wt, M, NF1, D / 2};
                if (PROBE_DUP & 128) { pg8::EpiNull EN{F_GATES}; pg8::gemm_phase<pg8::EpiNull, pg8::StaticOrder, true, true, true>(F.lds, g, S, EN); }
                if (PROBE_DUP & 256) { pg8::EpiNull EN{F_GATES}; pg8::FixedOrder<1> S2; S2.init(M, NF1, F.G, F.cid); pg8::gemm_phase<pg8::EpiNull, pg8::FixedOrder<1>, true, true, true>(F.lds, g, S2, EN); }
                if (PROBE_DUP & 512) { pg8::EpiNull EN{F_GATES}; pg8::FixedOrder<3> S2; S2.init(M, NF1, F.G, F.cid); pg8::gemm_phase<pg8::EpiNull, pg8::FixedOrder<3>, true, true, true>(F.lds, g, S2, EN); }
                if (dn8) { pg8::EpiSwiglu<true> E{(void*)F_ACT, DFF, F_SSQ, 1.0f / W8_SCALE, ACT8_SCALE, F.lds + pg8::STAGE_BYTES, 0, 0, 0}; for (int rep = 0; rep < ((PROBE_DUP & 2) ? 2 : 1); ++rep) pg8::gemm_phase<pg8::EpiSwiglu<true>, pg8::StaticOrder, true, true, true, 1>(F.lds, g, S, E); }
                else if (((UP8_MASK & ~DN8_MASK) & 0xFu) != 0u) { pg8::EpiSwiglu<false> E{(void*)F_ACT, DFF, F_SSQ, 1.0f / W8_SCALE, 1.0f, F.lds + pg8::STAGE_BYTES, 0, 0, 0}; for (int rep = 0; rep < ((PROBE_DUP & 2) ? 2 : 1); ++rep) pg8::gemm_phase<pg8::EpiSwiglu<false>, pg8::StaticOrder, true, true, true>(F.lds, g, S, E); } }
            else { pg8::Gemm g{F_XB, wt, M, NF1, D};
                if (dn8) { if (((~UP8_MASK & DN8_MASK) & 0xFu) != 0u) { pg8::EpiSwiglu<true> E{(void*)F_ACT, DFF, F_SSQ, 1.0f, ACT8_SCALE, F.lds + pg8::STAGE_BYTES, 0, 0, 0}; for (int rep = 0; rep < ((PROBE_DUP & 2) ? 2 : 1); ++rep) pg8::gemm_phase<pg8::EpiSwiglu<true>, pg8::StaticOrder, true, true, false, 2>(F.lds, g, S, E); } }
                else if (((~UP8_MASK & ~DN8_MASK) & 0xFu) != 0u) { pg8::EpiSwiglu<false> E{(void*)F_ACT, DFF, F_SSQ, 1.0f, 1.0f, F.lds + pg8::STAGE_BYTES, 0, 0, 0}; for (int rep = 0; rep < ((PROBE_DUP & 2) ? 2 : 1); ++rep) pg8::gemm_phase<pg8::EpiSwiglu<false>, pg8::StaticOrder, true, true, false>(F.lds, g, S, E); } }
        }
        TS(F.lds, 2); GRID_BAR(); TS(F.lds, 3);
        if (PH_MASK & 4) {
            const bf16* wt = (const bf16*)((unsigned char*)F_W2T + (size_t)s * D * DFF * 2); pg8::StaticOrder S; S.init(M, D, F.G, F.cid);
            const int last = (s + 1 == 2 * DEPTH) ? 1 : 0, w8 = ((s & 1) && !last && ((UP8_MASK >> (s + 1)) & 1u)) ? 1 : 0;
            if (dn8) { if (DN8_MASK & 0xFu) { pg8::Gemm g{F_ACT, wt, M, D, DFF / 2}; pg8::EpiRes E{F_XB, F_SSQ, 1, F_X8, FOUT, w8, last}; pg8::gemm_phase<pg8::EpiRes, pg8::StaticOrder, true, true, true, 3>(F.lds, g, S, E); } }
            else if ((~DN8_MASK) & 0xFu) { pg8::Gemm g{F_ACT, wt, M, D, DFF}; pg8::EpiRes E{F_XB, F_SSQ, 0, F_X8, FOUT, w8, last}; pg8::gemm_phase<pg8::EpiRes, pg8::StaticOrder, true, true, false, 4>(F.lds, g, S, E); }
        }
        TS(F.lds, 4); if (s + 1 < 2 * DEPTH) GRID_BAR(); TS(F.lds, 5);
        if (which == 0) {
            if (PH_MASK & 8) {
                pg8::Gemm g{F_XB, F_WINT + (size_t)L * NU * D, M, NU, D}; pg8::StaticOrder S; S.init(M, NU, F.G, F.cid);
                pg8::EpiScaleBf16 E{F_U, NU, F_SSQ, F.lds + pg8::STAGE_BYTES, 0, 0, 0};
                for (int rep = 0; rep < ((PROBE_DUP & 8) ? 2 : 1); ++rep) pg8::gemm_phase<pg8::EpiScaleBf16, pg8::StaticOrder, true, true, false, 5>(F.lds, g, S, E);
            }
            TS(F.lds, 6); GRID_BAR(); TS(F.lds, 7);
            if (PH_MASK & 16) prep_phase(F, L);
            if (PROBE_DUP & 16) prep_phase(F, L);
            TS(F.lds, 8); GRID_BAR(); TS(F.lds, 9);
            if (PH_MASK & 32) att::attn_phase(F, L);
            if (PROBE_DUP & 32) att::attn_phase(F, L);
            TS(F.lds, 10); GRID_BAR(); TS(F.lds, 11);
            if (PH_MASK & 64) {
                pg8::Gemm g{F_YN, F_WOUTT + (size_t)L * D * D, M, D, D}; pg8::StaticOrder S; S.init(M, D, F.G, F.cid);
                pg8::EpiRes E{F_XB, F_SSQ, 2, F_X8, FOUT, (int)((UP8_MASK >> (2 * L + 1)) & 1u), 0};
                pg8::gemm_phase<pg8::EpiRes, pg8::StaticOrder, true, true, false, 6>(F.lds, g, S, E);
            }
            TS(F.lds, 12); GRID_BAR(); TS(F.lds, 13);
        }
    }
    if (PROBE_TS && blockIdx.x == 0 && threadIdx.x == 0) {
        volatile LAS unsigned* m_ = (volatile LAS unsigned*)(F.lds + 163648); const unsigned long long t0_ = __builtin_amdgcn_s_memrealtime(), d_ = (unsigned long long)m_[1] * TS_AMP;
        while (__builtin_amdgcn_s_memrealtime() - t0_ < d_) __builtin_amdgcn_s_sleep(8); }
}

extern "C" void kernel_launch(void* const* d_in, const int* in_sizes, int n_in, void* d_out, int out_size, void* d_ws, size_t ws_size, hipStream_t stream) {
    static int grid = 0;
    if (grid == 0) {
        if (n_in != 29 || in_sizes[0] != M * D || out_size != M * D || ws_size < WS_END) { fprintf(stderr, "kernel_launch: unexpected shapes (n_in %d, in0 %d, out %d, ws %zu); nothing launched\n", n_in, n_in > 0 ? in_sizes[0] : -1, out_size, ws_size); grid = -1; return; }
        int dev = 0, cus = 0, per_cu = 0;
        if (hipGetDevice(&dev) != hipSuccess || hipDeviceGetAttribute(&cus, hipDeviceAttributeMultiprocessorCount, dev) != hipSuccess) { grid = -1; return; }
        if (hipFuncSetAttribute((const void*)fwd, hipFuncAttributeMaxDynamicSharedMemorySize, LDS_BYTES) != hipSuccess) { fprintf(stderr, "kernel_launch: hipFuncSetAttribute failed\n"); grid = -1; return; }
        if (hipOccupancyMaxActiveBlocksPerMultiprocessor(&per_cu, (const void*)fwd, NWAVES * 64, LDS_BYTES) != hipSuccess || per_cu < 1) fprintf(stderr, "kernel_launch: occupancy query says %d\n", per_cu);
        (void)hipGetLastError();
        grid = cus;
    }
    if (grid < 0) return;
    if (hipMemsetAsync((char*)d_ws + WS_CTL, 0, CTL_ZERO_BYTES, stream) != hipSuccess) return;
    Args a{};
    for (int i = 0; i < 29; ++i) a.in[i] = (const float*)d_in[i];
    a.out = (float*)d_out; a.ws = (unsigned char*)d_ws;
    hipLaunchKernelGGL(fwd, dim3(grid), dim3(NWAVES * 64), LDS_BYTES, stream, a);
}
```

```cpp
#include <hip/hip_runtime.h>
#include <cstdio>
#include <cstdint>
#ifndef PROBE_TS
#define PROBE_TS 0
#endif
#define TS_AMP 4u
#define TS(ldsbase, k) do { if (PROBE_TS && blockIdx.x == 0 && threadIdx.x == 0) { volatile __attribute__((address_space(3))) unsigned* m_ = (volatile __attribute__((address_space(3))) unsigned*)((ldsbase) + 163648); \
        const unsigned t_ = (unsigned)__builtin_amdgcn_s_memrealtime(); if ((k) == PROBE_TS) m_[1] += t_ - m_[0]; m_[0] = t_; } } while (0)
struct KArgs { const float* in[29]; float* out; unsigned char* ws; };
namespace pg8 {
#define PG8_LAS __attribute__((address_space(3)))
typedef unsigned short bf16_t;
typedef short bf16x8 __attribute__((ext_vector_type(8)));
typedef float f32x4 __attribute__((ext_vector_type(4)));
typedef unsigned u32x4 __attribute__((ext_vector_type(4)));
constexpr int BM = 256, BK = 64, HALF = 128, HTB = HALF * BK * 2  , STAGE_BYTES = 8 * HTB, NXCD = 8, WGM = 8;

__host__ __device__ __forceinline__ int lds_byte(int r, int c) { const int st = (r >> 4) * 2 + (c >> 5), rr = r & 15, cc = c & 31, ob = rr * 64 + cc * 2; return st * 1024 + (ob ^ (((ob >> 9) & 1) << 5)); }
__host__ __device__ __forceinline__ void stage_rc(int b, int& R, int& C) { const int st = b / 1024, sb = b % 1024, swz = sb ^ (((sb >> 9) & 1) << 5); R = (st >> 1) * 16 + swz / 64; C = (st & 1) * 32 + (swz % 64) / 2; }
__host__ __device__ __forceinline__ int perm32(int rho) { const int n = rho >> 4, i = rho & 15; return 8 * (i >> 2) + 4 * n + (i & 3); }

struct Unit { int pm, pn; };
struct Gemm { const bf16_t* A; const bf16_t* Bt; int M, N, K; long apad = 0; };

struct StaticOrder {
    int nM, nN, nwg, G, c; int rot = 0;
    __host__ __device__ void init(int M, int N, int G_, int c_) { nM = M / BM; nN = N / BM; nwg = nM * nN; G = G_; c = c_; }
    __host__ __device__ bool next(int i, Unit& u) const {
        const long L = (long)i * G + c; if (L >= nwg) return false;
        int wgid = (int)L; { const int q = nwg / NXCD, r = nwg % NXCD, xcd = wgid % NXCD, off = wgid / NXCD; wgid = (xcd < r ? xcd * (q + 1) : r * (q + 1) + (xcd - r) * q) + off; }
        const int nig = WGM * nN, gid = wgid / nig, fm = gid * WGM, gsz = (nM - fm) < WGM ? (nM - fm) : WGM;
        u.pm = fm + ((wgid % nig) % gsz); { int pn_ = (wgid % nig) / gsz + rot; u.pn = pn_ >= nN ? pn_ - nN : pn_; } return true;
    }
    __device__ __forceinline__ void a_ready(const Unit&) const {}
    __device__ __forceinline__ void done(const Unit&) const {}
};

__device__ __forceinline__ unsigned cvt_pk_bf16(float lo, float hi) { unsigned r; asm volatile("v_cvt_pk_bf16_f32 %0, %1, %2" : "=v"(r) : "v"(lo), "v"(hi)); return r; }

typedef unsigned u32x2 __attribute__((ext_vector_type(2)));
typedef int i32x4 __attribute__((ext_vector_type(4)));
typedef int i32x8 __attribute__((ext_vector_type(8)));
#ifndef MFMA8_SCALE
#define MFMA8_SCALE 1
#endif
__device__ __forceinline__ i32x8 cat8(bf16x8 a, bf16x8 b) { return __builtin_shufflevector(__builtin_bit_cast(i32x4, a), __builtin_bit_cast(i32x4, b), 0, 1, 2, 3, 4, 5, 6, 7); }
__device__ __forceinline__ void mfma8(f32x4& acc, const i32x8& b, const i32x8& a, int sc) {
#if MFMA8_SCALE
    asm volatile("v_mfma_scale_f32_16x16x128_f8f6f4 %0, %1, %2, %0, %3, %3 op_sel_hi:[0,0,0]" : "+v"(acc) : "v"(b), "v"(a), "v"(sc));
#else
    asm volatile("v_mfma_f32_16x16x128_f8f6f4 %0, %1, %2, %0" : "+v"(acc) : "v"(b), "v"(a));
#endif
}
__device__ __forceinline__ unsigned pk4_fp8(float a, float b, float c, float d) { int w = 0; w = __builtin_amdgcn_cvt_pk_fp8_f32(a, b, w, false); w = __builtin_amdgcn_cvt_pk_fp8_f32(c, d, w, true); return (unsigned)w; }
__device__ __forceinline__ unsigned pkbf(float lo, float hi) { typedef float f2_t __attribute__((ext_vector_type(2))); typedef __bf16 b2_t __attribute__((ext_vector_type(2))); f2_t v = {lo, hi}; b2_t b = __builtin_convertvector(v, b2_t); return __builtin_bit_cast(unsigned, b); }
__device__ __forceinline__ float bf_lo(unsigned u) { return __builtin_bit_cast(float, u << 16); }
__device__ __forceinline__ float bf_hi(unsigned u) { return __builtin_bit_cast(float, u & 0xffff0000u); }
__device__ __forceinline__ float swap32_add(float v) { auto rr = __builtin_amdgcn_permlane32_swap(__float_as_uint(v), __float_as_uint(v), false, false); return __uint_as_float(rr[0]) + __uint_as_float(rr[1]); }
__device__ __forceinline__ void fill_rstd_tbl(PG8_LAS unsigned char* tblp, const float* ssq, int pm, int wid, int lane) {
    const int r = wid * 32 + (lane >> 1), hf = lane & 1; const float* p = ssq + (size_t)(pm * BM + r) * 16 + 8 * hf;
    const f32x4 a = *(const f32x4*)p, b = *(const f32x4*)(p + 4);
    float s = ((a[0] + a[1]) + (a[2] + a[3])) + ((b[0] + b[1]) + (b[2] + b[3]));
    s += __builtin_bit_cast(float, __builtin_amdgcn_update_dpp(0, __builtin_bit_cast(int, s), 0xB1, 0xf, 0xf, true));
    if (hf == 0) ((PG8_LAS float*)tblp)[r] = __builtin_amdgcn_rsqf(s * (1.0f / 1024.0f) + 1e-6f);
}
__device__ __forceinline__ void rows_rstd(float (&rs)[2][4], const PG8_LAS unsigned char* tblp, int wr, int fr, float scale) {
#pragma unroll
    for (int ai = 0; ai < 2; ++ai)
#pragma unroll
        for (int m = 0; m < 4; ++m) rs[ai][m] = ((const PG8_LAS float*)tblp)[ai * HALF + wr * 64 + m * 16 + fr] * scale;
}
template <bool F8> struct EpiSwiglu {
    static constexpr bool PERM = true, AFTER_DRAIN = false, ROW_RSTD = true;
    void* O; int ldc; const float* ssq; float insc, oscale; PG8_LAS unsigned char* tbl; mutable int pmA, pmB, pmC; long ppad = 0;
    __device__ __forceinline__ void set_panels(int a, int b, int c) const { pmA = a; pmB = b; pmC = c; }
    __device__ __forceinline__ void fill_rstd(PG8_LAS unsigned char* t, int pm, int wid, int lane) const { fill_rstd_tbl(t, ssq, pm, wid, lane); }
    __device__ __forceinline__ void operator()(const f32x4 (&acc)[2][2][4][2], const Unit& u, int wr, int wc, int fr_, int fq_) const {
        int tl_ = threadIdx.x; asm volatile("" : "+v"(tl_)); const int fr = tl_ & 15, fq = (tl_ >> 4) & 3; (void)fr_; (void)fq_;
        const int row0 = u.pm * BM + wr * 64 + fr, col0 = u.pn * HALF + wc * 32 + 8 * fq;
        float rsv[2][4]; rows_rstd(rsv, tbl + (u.pm == pmA ? 0 : (u.pm == pmB ? 1024 : (u.pm == pmC ? 2048 : 3072))), wr, fr, insc);
#pragma unroll
        for (int ai = 0; ai < 2; ++ai)
#pragma unroll
            for (int m = 0; m < 4; ++m) { const int row = row0 + ai * HALF + m * 16; const float rs = rsv[ai][m], rsb = rs * (F8 ? oscale : 1.0f); f32x4 ov[2];
#pragma unroll
                for (int n = 0; n < 2; ++n) { const f32x4 a = acc[ai][0][m][n] * rs, b = acc[ai][1][m][n] * rsb, tt = a * -1.4426950408889634f; f32x4 r;
#pragma unroll
                    for (int e = 0; e < 4; ++e) r[e] = __builtin_amdgcn_rcpf(1.0f + __builtin_amdgcn_exp2f(tt[e]));
                    ov[n] = (a * b) * r; }
                const float o[8] = {ov[0][0], ov[0][1], ov[0][2], ov[0][3], ov[1][0], ov[1][1], ov[1][2], ov[1][3]};
                if constexpr (F8) { u32x2 w; w.x = pk4_fp8(o[0], o[1], o[2], o[3]); w.y = pk4_fp8(o[4], o[5], o[6], o[7]);
                    *(u32x2*)((unsigned char*)O + (size_t)u.pm * (size_t)ppad + (size_t)row * ldc + col0) = w; }
                else { u32x4 w; w.x = pkbf(o[0], o[1]); w.y = pkbf(o[2], o[3]); w.z = pkbf(o[4], o[5]); w.w = pkbf(o[6], o[7]);
                    *(u32x4*)((bf16_t*)O + (size_t)row * ldc + col0) = w; } }
    }
};
struct EpiScaleBf16 {
    static constexpr bool PERM = true, AFTER_DRAIN = false, ROW_RSTD = true;
    bf16_t* O; int ldc; const float* ssq; PG8_LAS unsigned char* tbl; mutable int pmA, pmB, pmC;
    bf16_t* ksi = nullptr; bf16_t* kwi = nullptr; bf16_t* cki = nullptr; const float* gks = nullptr; const float* gkw = nullptr; const float* gck = nullptr; PG8_LAS float* xch = nullptr;
    bf16_t* vs = nullptr; bf16_t* vw = nullptr; bf16_t* cv = nullptr;
    __device__ __forceinline__ void set_panels(int a, int b, int c) const { pmA = a; pmB = b; pmC = c; }
    __device__ __forceinline__ void fill_rstd(PG8_LAS unsigned char* t, int pm, int wid, int lane) const { fill_rstd_tbl(t, ssq, pm, wid, lane); }
    __device__ __forceinline__ void operator()(const f32x4 (&acc)[2][2][4][2], const Unit& u, int wr, int wc, int fr_, int fq_) const {
        int tl_ = threadIdx.x; asm volatile("" : "+v"(tl_)); const int fr = tl_ & 15, fq = (tl_ >> 4) & 3; (void)fr_; (void)fq_;
        const int row0 = u.pm * BM + wr * 64 + fr, col0 = u.pn * BM + wc * 32 + 8 * fq;
        float rsv[2][4]; rows_rstd(rsv, tbl + (u.pm == pmA ? 0 : (u.pm == pmB ? 1024 : (u.pm == pmC ? 2048 : 3072))), wr, fr, 1.0f);
        if (ksi != nullptr && u.pn == 1) {
            float ssq_[2][4][2];
#pragma unroll
            for (int ai = 0; ai < 2; ++ai)
#pragma unroll
                for (int m = 0; m < 4; ++m)
#pragma unroll
                    for (int bj = 0; bj < 2; ++bj) { const f32x4 v0 = acc[ai][bj][m][0] * rsv[ai][m], v1 = acc[ai][bj][m][1] * rsv[ai][m];
                        float s = ((v0[0] * v0[0] + v0[1] * v0[1]) + (v0[2] * v0[2] + v0[3] * v0[3])) + ((v1[0] * v1[0] + v1[1] * v1[1]) + (v1[2] * v1[2] + v1[3] * v1[3]));
                        s += __shfl_xor(s, 16); s = swap32_add(s); ssq_[ai][m][bj] = s;
                        if (fq == 0) xch[((bj * 4 + wc) * 2 + wr) * 128 + ai * 64 + m * 16 + fr] = s; }
            asm volatile("s_waitcnt lgkmcnt(0)\n\ts_barrier" ::: "memory");
#pragma unroll
            for (int ai = 0; ai < 2; ++ai)
#pragma unroll
                for (int m = 0; m < 4; ++m) { const int row = row0 + ai * HALF + m * 16;
#pragma unroll
                    for (int bj = 0; bj < 2; ++bj) { const float tot = ssq_[ai][m][bj] + xch[((bj * 4 + (wc ^ 1)) * 2 + wr) * 128 + ai * 64 + m * 16 + fr];
                        const float r = __builtin_amdgcn_rsqf(tot * (1.0f / 64.0f) + 1e-6f) * rsv[ai][m];
                        const int hid = bj * 2 + (wc >> 1), dk = (wc & 1) * 32 + 8 * fq;
                        const float* gp = (hid == 0 ? gks : (hid == 1 ? gkw : gck)) + dk; const f32x4 ga = *(const f32x4*)gp, gb = *(const f32x4*)(gp + 4);
                        const f32x4 v0 = acc[ai][bj][m][0] * r * ga, v1 = acc[ai][bj][m][1] * r * gb;
                        u32x4 w; w.x = pkbf(v0[0], v0[1]); w.y = pkbf(v0[2], v0[3]); w.z = pkbf(v1[0], v1[1]); w.w = pkbf(v1[2], v1[3]);
                        bf16_t* base = hid == 0 ? ksi : (hid == 1 ? kwi : cki + (size_t)(hid - 2) * 512 * 4096);
                        *(u32x4*)(base + (size_t)(row >> 6) * 4096 + ((wc & 1) * 4 + fq) * 512 + (row & 63) * 8) = w; } }
            return; }
#pragma unroll
        for (int ai = 0; ai < 2; ++ai)
#pragma unroll
            for (int m = 0; m < 4; ++m) { const int row = row0 + ai * HALF + m * 16; const float rs = rsv[ai][m];
#pragma unroll
                for (int bj = 0; bj < 2; ++bj) { const f32x4 v0 = acc[ai][bj][m][0] * rs, v1 = acc[ai][bj][m][1] * rs;
                    u32x4 w; w.x = pkbf(v0[0], v0[1]); w.y = pkbf(v0[2], v0[3]); w.z = pkbf(v1[0], v1[1]); w.w = pkbf(v1[2], v1[3]);
                    bf16_t* dst = O + (size_t)row * ldc + col0 + bj * HALF;
                    if (vs != nullptr) { const int ct = 2 * u.pn + bj;
                        if (ct == 7 || ct == 8) { bf16_t* base = ct == 7 ? (wc < 2 ? vs : vw) : cv + (size_t)(wc >> 1) * 512 * 4096;
                            dst = base + (size_t)(row >> 6) * 4096 + (((wc & 1) * 4 + ((row & 63) >> 4)) * 512 + (row & 15) * 32 + 8 * fq); } }
                    *(u32x4*)dst = w; } }
    }
};
struct EpiRes {
    static constexpr bool PERM = false, AFTER_DRAIN = false, ROW_RSTD = false;
    bf16_t* xb; float* ssq; int mode; unsigned char* x8p; float* outp; int w8, fin;
    __device__ __forceinline__ void operator()(const f32x4 (&acc)[2][2][4][2], const Unit& u, int wr, int wc, int fr_, int fq_) const {
        int tl_ = threadIdx.x; asm volatile("" : "+v"(tl_)); const int fr = tl_ & 15, fq = (tl_ >> 4) & 3; (void)fr_; (void)fq_;
        const int row0 = u.pm * BM + wr * 64 + fr, col0 = u.pn * BM + wc * 32 + 4 * fq;
        int md_ = __builtin_amdgcn_readfirstlane(mode), w8_ = __builtin_amdgcn_readfirstlane(w8), fin_ = __builtin_amdgcn_readfirstlane(fin); asm volatile("" : "+s"(md_), "+s"(w8_), "+s"(fin_));
        const float alpha = md_ == 0 ? 0.5f : (md_ == 1 ? 0.5f / 256.0f : 1.0f);
        float* const outf = fin_ ? outp : nullptr; unsigned char* const x8 = w8_ ? x8p : nullptr;
#pragma unroll
        for (int ai = 0; ai < 2; ++ai) { u32x2 old[4][2][2];
#pragma unroll
            for (int m = 0; m < 4; ++m)
#pragma unroll
                for (int bj = 0; bj < 2; ++bj)
#pragma unroll
                    for (int n = 0; n < 2; ++n) old[m][bj][n] = *(const u32x2*)(xb + (size_t)(row0 + ai * HALF + m * 16) * 1024 + col0 + bj * HALF + n * 16);
            float ssv[4];
#pragma unroll
            for (int m = 0; m < 4; ++m) { const int row = row0 + ai * HALF + m * 16; const size_t off = (size_t)row * 1024 + col0; float ss = 0.f;
#pragma unroll
                for (int bj = 0; bj < 2; ++bj)
#pragma unroll
                    for (int n = 0; n < 2; ++n) { const u32x2 ow = old[m][bj][n]; const f32x4 xo = (f32x4){bf_lo(ow.x), bf_hi(ow.x), bf_lo(ow.y), bf_hi(ow.y)}; const f32x4 xn = xo + acc[ai][bj][m][n] * alpha;
                        if (outf) *(f32x4*)(outf + off + bj * HALF + n * 16) = xn;
                        else { ss += (xn[0] * xn[0] + xn[1] * xn[1]) + (xn[2] * xn[2] + xn[3] * xn[3]);
                            u32x2 w; w.x = pkbf(xn[0], xn[1]); w.y = pkbf(xn[2], xn[3]); *(u32x2*)(xb + off + bj * HALF + n * 16) = w;
                            if (x8) *(unsigned*)(x8 + off + bj * HALF + n * 16) = pk4_fp8(xn[0], xn[1], xn[2], xn[3]); } }
                ssv[m] = ss; }
            if (!outf) { float tv[4];
#pragma unroll
                for (int m = 0; m < 4; ++m) ssv[m] = swap32_add(ssv[m]);
#pragma unroll
                for (int m = 0; m < 4; ++m) tv[m] = __shfl_xor(ssv[m], 16);
#pragma unroll
                for (int m = 0; m < 4; ++m) if (fq == 0) ssq[(size_t)(row0 + ai * HALF + m * 16) * 16 + u.pn * 4 + wc] = ssv[m] + tv[m]; }
            asm volatile("" ::: "memory"); }
    }
};

struct EpiNull {
    static constexpr bool PERM = true, AFTER_DRAIN = false, ROW_RSTD = false;
    float* sink;
    __device__ __forceinline__ void operator()(const f32x4 (&acc)[2][2][4][2], const Unit& u, int wr, int wc, int fr, int fq) const {
        float s = 0.f;
#pragma unroll
        for (int ai = 0; ai < 2; ++ai)
#pragma unroll
            for (int bj = 0; bj < 2; ++bj)
#pragma unroll
                for (int m = 0; m < 4; ++m)
#pragma unroll
                    for (int n = 0; n < 2; ++n) s += acc[ai][bj][m][n][0];
        if (s == 12345.678f) sink[0] = s;
    }
};
template <int PIN> struct FixedOrder : StaticOrder {
    __device__ bool next(int i, Unit& u) const { const bool ok = StaticOrder::next(i, u); if (PIN & 1) u.pn = 0; if (PIN & 2) u.pm = (int)(blockIdx.x & 7); return ok; }
};
template <class Epi, class Sched, bool ALIGN_EPI = false, bool SP2 = false, bool FP8 = false, int GID = 0>
__device__ __forceinline__ void gemm_phase(PG8_LAS unsigned char* lds, const Gemm g, const Sched& S, const Epi& E) {
    int tid = threadIdx.x; asm volatile("" : "+v"(tid));
    const int wid = __builtin_amdgcn_readfirstlane(tid >> 6), lane = tid & 63, wr = wid >> 2, wc = wid & 3, fr = lane & 15, fq = lane >> 4;
    const int K = g.K, nt = K / BK;
    unsigned voffA[2], voffB[2];
#pragma unroll
    for (int i = 0; i < 2; ++i) { int R, C; stage_rc(tid * 16 + i * 8192, R, C); const int Rb = Epi::PERM ? ((R & ~31) + perm32(R & 31)) : R;
        voffA[i] = (unsigned)(R * K + C) * 2u; voffB[i] = (unsigned)(Rb * K + C) * 2u; }
    const size_t kstep = (size_t)(BK * 2);
    const size_t hstep = (size_t)HALF * K * 2;
    const size_t tstep = 2 * hstep;
    const unsigned ldsw = (unsigned)wid * 1024u;
    const int aoff = lds_byte(wr * 64 + fr, fq * 8), boff = lds_byte(wc * 32 + fr, fq * 8);
#define PG8_SA(b, h) (((b) * 2 + (h)) * HTB)
#define PG8_SB(b, h) ((4 + (b) * 2 + (h)) * HTB)
#define PG8_STAGE(bufoff, gbase, voff) do { _Pragma("unroll") for (int _i = 0; _i < 2; ++_i) \
        __builtin_amdgcn_global_load_lds((const unsigned*)((const char*)(gbase) + (voff)[_i]), (PG8_LAS unsigned*)(lds + (bufoff) + ldsw + _i * 8192), 16, 0, 0); } while (0)
#define PG8_LDA(dst, b, h) do { if constexpr (FP8) { _Pragma("unroll") for (int m = 0; m < 4; ++m) dst##8[m] = cat8(*(const PG8_LAS bf16x8*)(lds + PG8_SA(b, h) + aoff + m * 2048), *(const PG8_LAS bf16x8*)(lds + PG8_SA(b, h) + aoff + m * 2048 + 1024)); } \
        else { _Pragma("unroll") for (int m = 0; m < 4; ++m) _Pragma("unroll") for (int k = 0; k < 2; ++k) dst[m][k] = *(const PG8_LAS bf16x8*)(lds + PG8_SA(b, h) + aoff + m * 2048 + k * 1024); } } while (0)
#define PG8_LDB(dst, b, h) do { if constexpr (FP8) { _Pragma("unroll") for (int n = 0; n < 2; ++n) dst##8[n] = cat8(*(const PG8_LAS bf16x8*)(lds + PG8_SB(b, h) + boff + n * 2048), *(const PG8_LAS bf16x8*)(lds + PG8_SB(b, h) + boff + n * 2048 + 1024)); } \
        else { _Pragma("unroll") for (int n = 0; n < 2; ++n) _Pragma("unroll") for (int k = 0; k < 2; ++k) dst[n][k] = *(const PG8_LAS bf16x8*)(lds + PG8_SB(b, h) + boff + n * 2048 + k * 1024); } } while (0)
#define PG8_MMA(ai, bj, At, Bt) do { __builtin_amdgcn_s_setprio(1); \
        if constexpr (FP8) { _Pragma("unroll") for (int m = 0; m < 4; ++m) _Pragma("unroll") for (int n = 0; n < 2; ++n) \
            mfma8(acc[ai][bj][m][n], Bt##8[n], At##8[m], sc8); } \
        else { _Pragma("unroll") for (int m = 0; m < 4; ++m) _Pragma("unroll") for (int n = 0; n < 2; ++n) _Pragma("unroll") for (int k = 0; k < 2; ++k) \
            acc[ai][bj][m][n] = __builtin_amdgcn_mfma_f32_16x16x32_bf16(Bt[n][k], At[m][k], acc[ai][bj][m][n], 0, 0, 0); } \
        __builtin_amdgcn_s_setprio(0); } while (0)
#define PG8_WAIT_V(n) asm volatile("s_waitcnt vmcnt(" #n ")" ::: "memory")
#define PG8_WAIT_L(n) asm volatile("s_waitcnt lgkmcnt(" #n ")" ::: "memory")
#define PG8_BAR __builtin_amdgcn_s_barrier()
#define PG8_SCHED __builtin_amdgcn_sched_barrier(0)
    Unit cur, nxt; int ui = 0;
    if (!S.next(0, cur)) return;
    if constexpr (Epi::ROW_RSTD) {
        int p0 = cur.pm, p1 = -1, p2 = -1, p3 = -1; { Unit t_; for (int n_ = 1; S.next(n_, t_); ++n_) { const int p = t_.pm; if (p != p0 && p != p1 && p != p2 && p != p3) { if (p1 < 0) p1 = p; else if (p2 < 0) p2 = p; else p3 = p; } } }
        E.fill_rstd(lds + STAGE_BYTES, p0, wid, lane); if (p1 >= 0) E.fill_rstd(lds + STAGE_BYTES + 1024, p1, wid, lane); if (p2 >= 0) E.fill_rstd(lds + STAGE_BYTES + 2048, p2, wid, lane); if (p3 >= 0) E.fill_rstd(lds + STAGE_BYTES + 3072, p3, wid, lane);
        E.set_panels(p0, p1, p2);
        PG8_WAIT_L(0); PG8_BAR; asm volatile("" ::: "memory"); }
    f32x4 acc[2][2][4][2];
#pragma unroll
    for (int a = 0; a < 2; ++a)
#pragma unroll
        for (int b = 0; b < 2; ++b)
#pragma unroll
            for (int m = 0; m < 4; ++m)
#pragma unroll
                for (int n = 0; n < 2; ++n) acc[a][b][m][n] = (f32x4){0.f, 0.f, 0.f, 0.f};
    bf16x8 At[4][2], B0[2][2], B1[2][2]; i32x8 At8[4], B08[2], B18[2]; int sc8 = 0x7F7F7F7F; asm volatile("" : "+v"(sc8));
    const size_t astep = tstep + (size_t)g.apad;
    const char* cA = (const char*)g.A + (size_t)cur.pm * astep; const char* cB = (const char*)g.Bt + (size_t)cur.pn * tstep;
    S.a_ready(cur);
    if constexpr (SP2) {
        PG8_STAGE(PG8_SB(0, 0), cB, voffB); PG8_STAGE(PG8_SB(0, 1), cB + hstep, voffB); PG8_STAGE(PG8_SA(0, 0), cA, voffA); PG8_STAGE(PG8_SA(0, 1), cA + hstep, voffA);
        if (wr == 1) PG8_BAR;
        PG8_WAIT_V(2); PG8_BAR;
        PG8_STAGE(PG8_SB(1, 0), cB + kstep, voffB); PG8_STAGE(PG8_SA(1, 0), cA + kstep, voffA); PG8_STAGE(PG8_SB(1, 1), cB + hstep + kstep, voffB);
        PG8_WAIT_V(6); PG8_BAR;
    } else {
        PG8_STAGE(PG8_SB(0, 0), cB, voffB); PG8_STAGE(PG8_SA(0, 0), cA, voffA); PG8_STAGE(PG8_SB(0, 1), cB + hstep, voffB); PG8_STAGE(PG8_SA(0, 1), cA + hstep, voffA);
        if (wr == 1) PG8_BAR;
        PG8_WAIT_V(4); PG8_BAR;
        PG8_STAGE(PG8_SB(1, 0), cB + kstep, voffB); PG8_STAGE(PG8_SA(1, 0), cA + kstep, voffA); PG8_STAGE(PG8_SB(1, 1), cB + hstep + kstep, voffB);
        PG8_WAIT_V(6); PG8_BAR;
    }
    for (;;) {
        const bool has_next = S.next(ui + 1, nxt);
        const char* nA = has_next ? (const char*)g.A + (size_t)nxt.pm * astep : cA; const char* nB = has_next ? (const char*)g.Bt + (size_t)nxt.pn * tstep : cB;
#pragma nounroll
        for (int t = 0; t < nt; t += 2) {
            const bool last = (t == nt - 2);
            const char* a1 = cA + (size_t)(t + 1) * kstep;
            const char* a2 = last ? nA : cA + (size_t)(t + 2) * kstep; const char* b2 = last ? nB : cB + (size_t)(t + 2) * kstep;
            const char* a3 = a2 + kstep; const char* b3 = b2 + kstep;
            if (last && has_next) S.a_ready(nxt);
            if constexpr (SP2) {
            PG8_LDB(B0, 0, 0); PG8_LDB(B1, 0, 1); PG8_SCHED; PG8_LDA(At, 0, 0); PG8_STAGE(PG8_SA(1, 1), a1 + hstep, voffA);
            PG8_WAIT_V(8); PG8_WAIT_L(0); PG8_BAR; PG8_MMA(0, 0, At, B0); PG8_MMA(0, 1, At, B1); PG8_BAR; PG8_SCHED;
            PG8_LDA(At, 0, 1); PG8_STAGE(PG8_SB(0, 0), b2, voffB); PG8_STAGE(PG8_SB(0, 1), b2 + hstep, voffB); PG8_STAGE(PG8_SA(0, 0), a2, voffA);
            PG8_WAIT_V(8); PG8_WAIT_L(0); PG8_BAR; PG8_MMA(1, 0, At, B0); PG8_MMA(1, 1, At, B1); PG8_BAR; PG8_SCHED;
            PG8_LDB(B0, 1, 0); PG8_LDB(B1, 1, 1); PG8_SCHED; PG8_LDA(At, 1, 0); PG8_STAGE(PG8_SA(0, 1), a2 + hstep, voffA);
            PG8_WAIT_V(8); PG8_WAIT_L(0); PG8_BAR; PG8_MMA(0, 0, At, B0); PG8_MMA(0, 1, At, B1); PG8_BAR; PG8_SCHED;
            PG8_LDA(At, 1, 1); PG8_STAGE(PG8_SB(1, 0), b3, voffB); PG8_STAGE(PG8_SB(1, 1), b3 + hstep, voffB); PG8_STAGE(PG8_SA(1, 0), a3, voffA);
            PG8_WAIT_V(8); PG8_WAIT_L(0); PG8_BAR; PG8_MMA(1, 0, At, B0); PG8_MMA(1, 1, At, B1); PG8_BAR; PG8_SCHED;
            } else {
            PG8_LDB(B0, 0, 0); PG8_SCHED; PG8_LDA(At, 0, 0); PG8_STAGE(PG8_SA(1, 1), a1 + hstep, voffA);
            PG8_WAIT_L(8); PG8_BAR; PG8_WAIT_L(0); PG8_MMA(0, 0, At, B0); PG8_BAR; PG8_SCHED;
            PG8_LDB(B1, 0, 1); PG8_STAGE(PG8_SB(0, 0), b2, voffB);
            PG8_BAR; PG8_WAIT_L(0); PG8_MMA(0, 1, At, B1); PG8_BAR;
            PG8_LDA(At, 0, 1); PG8_STAGE(PG8_SA(0, 0), a2, voffA);
            PG8_BAR; PG8_WAIT_L(0); PG8_MMA(1, 0, At, B0); PG8_BAR; PG8_SCHED;
            PG8_STAGE(PG8_SB(0, 1), b2 + hstep, voffB);
            PG8_WAIT_V(6); PG8_BAR; PG8_MMA(1, 1, At, B1); PG8_BAR;
            PG8_LDB(B0, 1, 0); PG8_SCHED; PG8_LDA(At, 1, 0); PG8_STAGE(PG8_SA(0, 1), a2 + hstep, voffA);
            PG8_WAIT_L(8); PG8_BAR; PG8_WAIT_L(0); PG8_MMA(0, 0, At, B0); PG8_BAR; PG8_SCHED;
            PG8_LDB(B1, 1, 1); PG8_STAGE(PG8_SB(1, 0), b3, voffB);
            PG8_BAR; PG8_WAIT_L(0); PG8_MMA(0, 1, At, B1); PG8_BAR;
            PG8_LDA(At, 1, 1); PG8_STAGE(PG8_SA(1, 0), a3, voffA);
            PG8_BAR; PG8_WAIT_L(0); PG8_MMA(1, 0, At, B0); PG8_BAR; PG8_SCHED;
            PG8_STAGE(PG8_SB(1, 1), b3 + hstep, voffB);
            PG8_WAIT_V(6); PG8_BAR; PG8_MMA(1, 1, At, B1); PG8_BAR;
            }
        }
        if constexpr (ALIGN_EPI) { if (wr == 0) PG8_BAR; }
        TS(lds, 40 + 2 * GID);
        if constexpr (FP8) asm volatile("s_nop 15\n\ts_nop 15" ::: "memory");
        if constexpr (!Epi::AFTER_DRAIN) { E(acc, cur, wr, wc, fr, fq); S.done(cur); }
        TS(lds, 41 + 2 * GID);
        if (!has_next) break;
#pragma unroll
        for (int a = 0; a < 2; ++a)
#pragma unroll
            for (int b = 0; b < 2; ++b)
#pragma unroll
                for (int m = 0; m < 4; ++m)
#pragma unroll
                    for (int n = 0; n < 2; ++n) acc[a][b][m][n] = (f32x4){0.f, 0.f, 0.f, 0.f};
        cur = nxt; cA = nA; cB = nB; ++ui;
        if constexpr (ALIGN_EPI) { if (wr == 1) PG8_BAR; }
    }
    PG8_WAIT_V(0);
    if constexpr (!ALIGN_EPI) { if (wr == 0) PG8_BAR; }
    PG8_BAR;
    if constexpr (Epi::AFTER_DRAIN) { E.fused(acc, cur, wr, wc, fr, fq, lds, wid, lane); S.done(cur); }
#undef PG8_SA
#undef PG8_SB
#undef PG8_STAGE
#undef PG8_LDA
#undef PG8_LDB
#undef PG8_MMA
#undef PG8_WAIT_V
#undef PG8_WAIT_L
#undef PG8_BAR
#undef PG8_SCHED
}
}

constexpr int NWAVES = 8;
constexpr int BATCH = 16, T = 2048, D = 1024, M = BATCH * T, DFF = 2816, NF1 = 2 * DFF, NU = 2304, DEPTH = 2, NCP = 128;
constexpr float EPS = 1e-6f, LOG2E = 1.4426950408889634f, C2 = 0.125f * LOG2E;
constexpr int UQ = 0, UKS = 256, UKW = 320, UCK = 384, UCQ = 512, UKC = 768, UVC = 832, UVS = 896, UVW = 960, UCV = 1024, UG = 1152, UBB = 1280, UBC = 1536, UBX = 1792, UDV = 2048;
constexpr size_t MiB = 1u << 20;
constexpr size_t WS_CTL = 0, CTL_ZERO_BYTES = 1 * MiB;
constexpr size_t WS_W13 = 1 * MiB, WS_W2 = 45 * MiB, WS_WIN = 67 * MiB, WS_WOUT = 76 * MiB, WS_C1 = 80 * MiB;
constexpr size_t WS_SSQ = 82 * MiB, WS_GATES = 84 * MiB, WS_KC = 86 * MiB, WS_VC = 86 * MiB + 512 * 1024;
constexpr size_t WS_XB = 88 * MiB, WS_QKN = 152 * MiB, WS_YN = 200 * MiB, WS_ACT = 264 * MiB, WS_U = WS_ACT, WS_X8 = 440 * MiB, WS_IMG = 472 * MiB, WS_END = 504 * MiB;
#ifndef UP8_MASK_V
#define UP8_MASK_V 0xE
#endif
#ifndef DN8_MASK_V
#define DN8_MASK_V 0xF
#endif
constexpr unsigned UP8_MASK = UP8_MASK_V, DN8_MASK = DN8_MASK_V;
constexpr float W8_SCALE = 64.0f, ACT8_SCALE = 4.0f; static_assert(W8_SCALE * ACT8_SCALE == 256.0f, "EpiRes mode 1");
constexpr int CW_BAR = 4096;
constexpr int LDS_BYTES = 163840, MISC_OFF = LDS_BYTES - 256;

#define GAS __attribute__((address_space(1)))
#define LAS __attribute__((address_space(3)))
typedef unsigned short bf16;
typedef unsigned v4u __attribute__((ext_vector_type(4)));
typedef unsigned u32x2 __attribute__((ext_vector_type(2)));
typedef float f32x4 __attribute__((ext_vector_type(4)));
typedef float f32x2_t __attribute__((ext_vector_type(2)));
typedef __bf16 bf16x2_t __attribute__((ext_vector_type(2)));
typedef short bf16x8 __attribute__((ext_vector_type(8)));
typedef float f32x16 __attribute__((ext_vector_type(16)));
typedef short v4i16_t __attribute__((ext_vector_type(4)));
#define LDS_WAIT() asm volatile("s_waitcnt lgkmcnt(0)" ::: "memory")
__device__ __forceinline__ unsigned pk2(float lo, float hi) { f32x2_t v = {lo, hi}; bf16x2_t b = __builtin_convertvector(v, bf16x2_t); return __builtin_bit_cast(unsigned, b); }
__device__ __forceinline__ float bflo(unsigned u) { return __builtin_bit_cast(float, u << 16); }
__device__ __forceinline__ float bfhi(unsigned u) { return __builtin_bit_cast(float, u & 0xffff0000u); }
__device__ __forceinline__ f32x4 ld4bf(const bf16* p) { const u32x2 w = *(const u32x2*)p; return (f32x4){bflo(w.x), bfhi(w.x), bflo(w.y), bfhi(w.y)}; }
__device__ __forceinline__ void st4bf(bf16* p, f32x4 v) { u32x2 w; w.x = pk2(v[0], v[1]); w.y = pk2(v[2], v[3]); *(u32x2*)p = w; }
template <int CTRL> __device__ __forceinline__ float dpp_add(float v) { return v + __builtin_bit_cast(float, __builtin_amdgcn_update_dpp(0, __builtin_bit_cast(int, v), CTRL, 0xf, 0xf, true)); }
__device__ __forceinline__ float row16_sum(float v) { v = dpp_add<0xB1>(v); v = dpp_add<0x4E>(v); v = dpp_add<0x141>(v); v = dpp_add<0x140>(v); return v; }
__device__ __forceinline__ float wave_sum(float v) {
    v = row16_sum(v); v += __shfl_xor(v, 16);
    auto rr = __builtin_amdgcn_permlane32_swap(__float_as_uint(v), __float_as_uint(v), false, false); return __uint_as_float(rr[0]) + __uint_as_float(rr[1]);
}
__device__ __forceinline__ f32x4 up4(u32x2 w) { return (f32x4){bflo(w.x), bfhi(w.x), bflo(w.y), bfhi(w.y)}; }
__device__ __forceinline__ float sq4(f32x4 v) { return (v[0] * v[0] + v[1] * v[1]) + (v[2] * v[2] + v[3] * v[3]); }

__device__ __forceinline__ int kimg_off(int r, int d) { return (d >> 3) * 512 + r * 8 + (d & 7); }
__device__ __forceinline__ int vimg_off(int r, int d) { return ((d >> 5) * 4 + (r >> 4)) * 512 + (r & 15) * 32 + (d & 31); }
#define XB_TMO      128
#define XB_XCNT(j)  (256  + 64 * (j))
#define XB_XSUB(j)  (1280 + 64 * (j))
#define XB_XGEN(j)  (2304 + 64 * (j))
#define XB_TOP      3328
#define XB_TOPGEN   3392
#define XCD_BAR_WORDS 3456
#define XB_SPIN_CAP (1u << 18)

__device__ __forceinline__ unsigned xb_ld(unsigned* p)              { return __hip_atomic_load(p, __ATOMIC_RELAXED, __HIP_MEMORY_SCOPE_AGENT); }
__device__ __forceinline__ unsigned xb_add(unsigned* p, unsigned v) { return __hip_atomic_fetch_add(p, v, __ATOMIC_RELAXED, __HIP_MEMORY_SCOPE_AGENT); }
__device__ __forceinline__ unsigned xb_xcc_id() { return (unsigned)__builtin_amdgcn_s_getreg((3 << 11) | 20) & 0xFu; }
#define XB_SPIN(cond, bar) do { unsigned _sp = 0; while (cond) { __builtin_amdgcn_s_sleep(1); \
    if ((++_sp & 255u) == 0u) { if (xb_ld(&(bar)[XB_TMO])) break; if (_sp > XB_SPIN_CAP) { atomicAdd(&(bar)[XB_TMO], 1u); break; } } } } while (0)

struct XcdBarrier {
    unsigned* bar; unsigned x;
    volatile LAS unsigned* st;
};

__device__ __forceinline__ XcdBarrier xcd_barrier_post(unsigned* bar, volatile LAS unsigned* st) {
    XcdBarrier b; b.bar = bar; b.x = xb_xcc_id(); b.st = st;
    if (threadIdx.x == 0) (void)xb_add(&bar[XB_XCNT(b.x)], 1u);
    return b;
}
__device__ __forceinline__ void xcd_barrier_complete(unsigned* bar, unsigned x, unsigned& nloc, unsigned& nx) {
    const unsigned G = gridDim.x * gridDim.y * gridDim.z;
    unsigned sum, cnt, mine, sp = 0u;
    for (;;) {
        sum = 0u; cnt = 0u; mine = 0u;
#pragma unroll
        for (unsigned j = 0; j < 16; ++j) { const unsigned c = xb_ld(&bar[XB_XCNT(j)]); sum += c; cnt += (c > 0u) ? 1u : 0u; mine = (j == x) ? c : mine; }
        if (sum == G) break;
        __builtin_amdgcn_s_sleep(1);
        if ((++sp & 255u) == 0u) { if (xb_ld(&bar[XB_TMO])) break; if (sp > XB_SPIN_CAP) { atomicAdd(&bar[XB_TMO], 1u); break; } }
    }
    nloc = mine > 0u ? mine : 1u; nx = cnt > 0u ? cnt : 1u;
}

__device__ __forceinline__ void xcd_barrier(const XcdBarrier& b) {
    asm volatile("s_waitcnt vmcnt(0)" ::: "memory");
    __syncthreads();
    if (threadIdx.x == 0) {
        unsigned* bar = b.bar;
        __builtin_amdgcn_s_waitcnt(0);
        unsigned nloc = b.st[0], nx = b.st[1];
        if (nloc == 0u) { xcd_barrier_complete(bar, b.x, nloc, nx); b.st[0] = nloc; b.st[1] = nx; }
        const unsigned old = xb_add(&bar[XB_XSUB(b.x)], 1u);
        const unsigned gen = old / nloc;
        if (old + 1u == (gen + 1u) * nloc) {
            __builtin_amdgcn_fence(__ATOMIC_RELEASE, "agent");
            asm volatile("s_waitcnt vmcnt(0)" ::: "memory");
            const unsigned og = xb_add(&bar[XB_TOP], 1u);
            const unsigned tg = og / nx;
            if (og + 1u == (tg + 1u) * nx) xb_add(&bar[XB_TOPGEN], 1u);
            else XB_SPIN(xb_ld(&bar[XB_TOPGEN]) == tg, bar);
            __builtin_amdgcn_fence(__ATOMIC_ACQUIRE, "agent");
            xb_add(&bar[XB_XGEN(b.x)], 1u);
            asm volatile("s_waitcnt vmcnt(0)" ::: "memory");
        } else {
            XB_SPIN(xb_ld(&bar[XB_XGEN(b.x)]) == gen, bar);
            __builtin_amdgcn_fence(__ATOMIC_ACQUIRE, "agent");
            asm volatile("s_waitcnt vmcnt(0)" ::: "memory");
        }
    }
    __syncthreads();
}

#define XL_SUB(j)  (3520 + 64 * (j))
#define XL_GEN(j)  (4608 + 64 * (j))
#define XL_RANK(j) (5696 + 64 * (j))
#define XL_CMP(j)  (6784 + 128 * (j))
__device__ __forceinline__ void xcc_local_barrier(unsigned* bar, unsigned x) {
    asm volatile("s_waitcnt vmcnt(0)" ::: "memory");
    __syncthreads();
    if (threadIdx.x == 0) {
        __builtin_amdgcn_s_waitcnt(0);
        asm volatile("buffer_inv sc1" ::: "memory");
        const unsigned old = xb_add(&bar[XL_SUB(x)], 1u), gen = old / 32u;
        if (old + 1u == (gen + 1u) * 32u) xb_add(&bar[XL_GEN(x)], 1u);
        else XB_SPIN(xb_ld(&bar[XL_GEN(x)]) == gen, bar);
        asm volatile("s_waitcnt vmcnt(0)" ::: "memory");
    }
    __syncthreads();
}


typedef KArgs Args;
struct Frame {
    LAS unsigned char* lds;
    int tid, lane, wave, vcu, G, cid;
    const Args* a;
};
#define FIN(i) (F.a->in[i])
#define FOUT (F.a->out)
#define FWS(off, type) ((type*)(F.a->ws + (off)))
#define F_W13T FWS(WS_W13, bf16)
#define F_W2T FWS(WS_W2, bf16)
#define F_WINT FWS(WS_WIN, bf16)
#define F_WOUTT FWS(WS_WOUT, bf16)
#define F_C1T FWS(WS_C1, bf16)
#define F_XB FWS(WS_XB, bf16)
#define F_QA FWS(WS_QKN, bf16)
#define F_QC FWS(WS_QKN + 16 * MiB, bf16)
#define F_KSI FWS(WS_IMG, bf16)
#define F_KWI FWS(WS_IMG + 4 * MiB, bf16)
#define F_CKI FWS(WS_IMG + 8 * MiB, bf16)
#define F_VSI FWS(WS_IMG + 16 * MiB, bf16)
#define F_VWI FWS(WS_IMG + 20 * MiB, bf16)
#define F_CVI FWS(WS_IMG + 24 * MiB, bf16)
#define F_YN FWS(WS_YN, bf16)
#define F_ACT FWS(WS_ACT, bf16)
#define F_U FWS(WS_U, bf16)
#define F_KC FWS(WS_KC, bf16)
#define F_VC FWS(WS_VC, bf16)
#define F_SSQ FWS(WS_SSQ, float)
#define F_GATES FWS(WS_GATES, float)
#define F_X8 FWS(WS_X8, unsigned char)
enum { I_X = 0, I_F1N, I_F1W1, I_F1W3, I_F1W2, I_MIXN, I_WIN, I_NQN, I_NKCN, I_NKSN, I_NKWN, I_POSK, I_C1K, I_C2K, I_POSV, I_C1V, I_C2V, I_CONVW, I_SQN, I_SKN, I_SINK, I_POOLW, I_POOLS, I_GN, I_WOUT,
       I_F2N, I_F2W1, I_F2W3, I_F2W2 };

__device__ __forceinline__ int win_src_col(int dr) {
    if (dr < 256) return dr;
    if (dr < 320) return 384 + (dr - 256);
    if (dr < 384) return 512 + (dr - 320);
    if (dr < 512) return 1676 + (dr - 384);
    if (dr < 768) return 1420 + (dr - 512);
    if (dr < 832) return 256 + (dr - 768);
    if (dr < 896) return 320 + (dr - 832);
    if (dr < 960) return 448 + (dr - 896);
    if (dr < 1024) return 576 + (dr - 960);
    if (dr < 1152) return 1804 + (dr - 1024);
    if (dr < 1164) return 640 + (dr - 1152);
    if (dr < 1280) return -1;
    if (dr < 1536) return 652 + (dr - 1280);
    if (dr < 1792) return 908 + (dr - 1536);
    if (dr < 2048) return 1164 + (dr - 1792);
    return 1932 + (dr - 2048);
}
struct TrItem { const float* src; const float* gain; void* dst; int N, K, k0, n0, srcmode, dstmode, w, ncols; bool f8; };
__device__ __forceinline__ void tr_decode(Frame& F, int it, TrItem& t) {
    constexpr int PER_LAYER = 6 * 176 + 144 + 64 + 64;
    const int L = it / PER_LAYER; int r = it % PER_LAYER;
    t.gain = nullptr; t.f8 = false; t.srcmode = 0; t.dstmode = 0; t.w = 0; t.ncols = 256;
    if (r < 6 * 176) { const int mat = r / 176, rr = r % 176, ffn = mat / 3, w = mat % 3;
        if (w < 2) { t.k0 = 64 * (rr / 11); t.n0 = 256 * (rr % 11); t.N = DFF; t.K = D; t.dstmode = 1; t.w = w;
            t.src = FIN(ffn ? (w ? I_F2W3 : I_F2W1) : (w ? I_F1W3 : I_F1W1)) + (size_t)L * D * DFF; t.gain = FIN(ffn ? I_F2N : I_F1N) + L * D;
            t.dst = (unsigned char*)F_W13T + (size_t)(L * 2 + ffn) * NF1 * D * 2; t.f8 = (UP8_MASK >> (L * 2 + ffn)) & 1u; }
        else { t.k0 = 64 * (rr / 4); t.n0 = 256 * (rr % 4); t.N = D; t.K = DFF;
            t.src = FIN(ffn ? I_F2W2 : I_F1W2) + (size_t)L * DFF * D; t.dst = (unsigned char*)F_W2T + (size_t)(L * 2 + ffn) * D * DFF * 2; t.f8 = (DN8_MASK >> (L * 2 + ffn)) & 1u; } }
    else { r -= 6 * 176;
        if (r < 144) { t.k0 = 64 * (r / 9); t.n0 = 256 * (r % 9); t.N = 2188; t.K = D; t.srcmode = 1;
            t.src = FIN(I_WIN) + (size_t)L * D * 2188; t.gain = FIN(I_MIXN) + L * D; t.dst = F_WINT + (size_t)L * NU * D; }
        else if (r < 144 + 64) { r -= 144; t.k0 = 64 * (r / 4); t.n0 = 256 * (r % 4); t.N = D; t.K = D;
            t.src = FIN(I_WOUT) + (size_t)L * D * D; t.gain = FIN(I_GN) + L * D; t.dst = F_WOUTT + (size_t)L * D * D; }
        else { r -= 144 + 64; const int kv = r / 32; t.k0 = 64 * (r % 32); t.n0 = 0; t.N = 128; t.K = 2048; t.ncols = 128;
            t.src = FIN(kv ? I_C1V : I_C1K) + (size_t)L * 2048 * 128; t.dst = F_C1T + (size_t)(L * 2 + kv) * 128 * 2048; } }
}
__device__ __forceinline__ void tr_load(const TrItem& t, f32x4 (&v)[8], int wave, int lane) {
    const int c = 4 * lane; const int sc = t.srcmode ? win_src_col(t.n0 + c) : (c < t.ncols ? t.n0 + c : -1);
#pragma unroll
    for (int i = 0; i < 8; ++i) { v[i] = (f32x4){0.f, 0.f, 0.f, 0.f}; if (sc >= 0) v[i] = *(const f32x4*)(t.src + (size_t)(t.k0 + 8 * wave + i) * t.N + sc); }
}
__device__ __forceinline__ void tr_to_lds(const TrItem& t, const f32x4 (&v)[8], LAS float* T, int wave, int lane) {
#pragma unroll
    for (int i = 0; i < 8; ++i) { const int k = 8 * wave + i; const float g = t.gain ? t.gain[t.k0 + k] : 1.0f; LAS float* p = T + k * 257 + 4 * lane;
        p[0] = v[i][0] * g; p[1] = v[i][1] * g; p[2] = v[i][2] * g; p[3] = v[i][3] * g; }
}
__device__ __forceinline__ void tr_out(const TrItem& t, const LAS float* T, int wave, int lane) {
    if (t.f8) { const int c = lane & 3;
#pragma unroll
        for (int j = 0; j < 2; ++j) { const int row = 32 * wave + 16 * j + (lane >> 2); if (row < t.ncols) { const int n = t.n0 + row; const int dr = t.dstmode ? ((n >> 7) * 256 + t.w * 128 + (n & 127)) : n;
            const LAS float* q = T + (16 * c) * 257 + row; v4u o;
            o.x = pg8::pk4_fp8(q[0 * 257] * W8_SCALE, q[1 * 257] * W8_SCALE, q[2 * 257] * W8_SCALE, q[3 * 257] * W8_SCALE); o.y = pg8::pk4_fp8(q[4 * 257] * W8_SCALE, q[5 * 257] * W8_SCALE, q[6 * 257] * W8_SCALE, q[7 * 257] * W8_SCALE);
            o.z = pg8::pk4_fp8(q[8 * 257] * W8_SCALE, q[9 * 257] * W8_SCALE, q[10 * 257] * W8_SCALE, q[11 * 257] * W8_SCALE); o.w = pg8::pk4_fp8(q[12 * 257] * W8_SCALE, q[13 * 257] * W8_SCALE, q[14 * 257] * W8_SCALE, q[15 * 257] * W8_SCALE);
            *(v4u*)((unsigned char*)t.dst + (size_t)dr * t.K + t.k0 + 16 * c) = o; } } }
    else { const int c = lane & 7;
#pragma unroll
        for (int j = 0; j < 4; ++j) { const int row = 32 * wave + 8 * j + (lane >> 3); if (row < t.ncols) { const int n = t.n0 + row; const int dr = t.dstmode ? ((n >> 7) * 256 + t.w * 128 + (n & 127)) : n;
            const LAS float* q = T + (8 * c) * 257 + row;
            v4u o; o.x = pk2(q[0 * 257], q[1 * 257]); o.y = pk2(q[2 * 257], q[3 * 257]); o.z = pk2(q[4 * 257], q[5 * 257]); o.w = pk2(q[6 * 257], q[7 * 257]);
            *(v4u*)((bf16*)t.dst + (size_t)dr * t.K + t.k0 + 8 * c) = o; } } }
}
__device__ __forceinline__ void prologue(Frame& F) {
    int lane = F.lane; asm volatile("" : "+v"(lane));
    LAS float* TT = (LAS float*)F.lds;
    const int wave = F.wave, gw = F.vcu * NWAVES + F.wave, NGW = F.G * NWAVES;
    constexpr int NITEMS = DEPTH * (6 * 176 + 144 + 64 + 64);
    { TrItem ta, tb; f32x4 va[8];
      int it = F.vcu; bool have = it < NITEMS;
      if (have) { tr_decode(F, it, ta); tr_load(ta, va, wave, lane); }
      while (have) {
          tr_to_lds(ta, va, TT, wave, lane);
          __syncthreads();
          const int nx = it + F.G; const bool hn = nx < NITEMS; tb = ta;
          if (hn) { tr_decode(F, nx, ta); tr_load(ta, va, wave, lane); }
          tr_out(tb, TT, wave, lane);
          __syncthreads();
          it = nx; have = hn;
      } }
    const float* x = FIN(I_X);
    for (int m4 = gw * 4; m4 < M; m4 += NGW * 4) {
        f32x4 v[4][4];
#pragma unroll
        for (int r = 0; r < 4; ++r)
#pragma unroll
            for (int j = 0; j < 4; ++j) v[r][j] = *((const f32x4*)(x + (size_t)(m4 + r) * D) + lane + 64 * j);
#pragma unroll
        for (int r = 0; r < 4; ++r) { float sr = 0.f;
#pragma unroll
            for (int j = 0; j < 4; ++j) { sr += sq4(v[r][j]); st4bf(F_XB + (size_t)(m4 + r) * D + 256 * j + 4 * lane, v[r][j]);
                if (UP8_MASK & 1u) *(unsigned*)(F_X8 + (size_t)(m4 + r) * D + 256 * j + 4 * lane) = pg8::pk4_fp8(v[r][j][0], v[r][j][1], v[r][j][2], v[r][j][3]); }
            sr = wave_sum(sr);
            if (lane < 16) F_SSQ[(size_t)(m4 + r) * 16 + lane] = lane == 0 ? sr : 0.f; }
    }
}

#ifndef PROBE_PREP
#define PROBE_PREP 0
#endif
__device__ __forceinline__ void prep_phase(Frame& F, int L, unsigned* cmpc  ) {
    int tid = F.tid; asm volatile("" : "+v"(tid));
    const int lane = tid & 63, ch = 4 * lane;
    LAS bf16* PWt = (LAS bf16*)F.lds;
    LAS bf16* DTb = (LAS bf16*)(F.lds + 65536) + F.wave * (16 * 264);
    LAS float* PART = (LAS float*)F.lds;
    LAS float* H = (LAS float*)(F.lds + 65536);
    LAS float* O2 = (LAS float*)(F.lds + 65536 + 16384);
    const int fr = lane & 15, fq = lane >> 4, wave = F.wave;
    for (int rep8 = 0; rep8 < ((PROBE_PREP & 8) ? 2 : 1); ++rep8)
    for (int uid = F.vcu; uid < 256; uid += F.G) {
        const int b = uid >> 4, kv = (uid >> 3) & 1, n0 = 16 * (uid & 7);
        const bf16* W1t = F_C1T + (size_t)(L * 2 + kv) * 128 * 2048;
        const float* pos = FIN(kv ? I_POSV : I_POSK) + (size_t)L * 2048;
        const float* W2 = FIN(kv ? I_C2V : I_C2K) + (size_t)L * 128 * 64;
        const int nrow = (n0 + fr) < 126 ? (n0 + fr) : 126;
        const bf16* arow = F_U + (size_t)(b * T + 16 * nrow) * NU + UKC + 64 * kv;
        const bf16* brow = W1t + (size_t)fr * 2048;
        f32x4 acc[8];
#pragma unroll
        for (int ct = 0; ct < 8; ++ct) acc[ct] = (f32x4){0.f, 0.f, 0.f, 0.f};
        v4u car[3]; f32x4 cp0[3], cp1[3]; bf16x8 cb[3][8];
#define CMP_LOAD(bi, ks) do { const int kk_ = 8 * wave + (ks), l_ = kk_ >> 1, c_ = 32 * (kk_ & 1) + 8 * fq; \
            car[bi] = *(const v4u*)(arow + (size_t)l_ * NU + c_); cp0[bi] = *(const f32x4*)(pos + l_ * 64 + c_); cp1[bi] = *(const f32x4*)(pos + l_ * 64 + c_ + 4); \
            _Pragma("unroll") for (int ct = 0; ct < 8; ++ct) cb[bi][ct] = *(const bf16x8*)(brow + (size_t)(16 * ct) * 2048 + 32 * kk_ + 8 * fq); } while (0)
#define CMP_MMA(bi) do { const v4u ar = car[bi]; const f32x4 p0 = cp0[bi], p1 = cp1[bi]; v4u aw; \
            aw.x = pk2(bflo(ar.x) + p0[0], bfhi(ar.x) + p0[1]); aw.y = pk2(bflo(ar.y) + p0[2], bfhi(ar.y) + p0[3]); aw.z = pk2(bflo(ar.z) + p1[0], bfhi(ar.z) + p1[1]); aw.w = pk2(bflo(ar.w) + p1[2], bfhi(ar.w) + p1[3]); \
            _Pragma("unroll") for (int ct = 0; ct < 8; ++ct) acc[ct] = __builtin_amdgcn_mfma_f32_16x16x32_bf16(__builtin_bit_cast(bf16x8, aw), cb[bi][ct], acc[ct], 0, 0, 0); } while (0)
        CMP_LOAD(0, 0); CMP_LOAD(1, 1); CMP_LOAD(2, 2);
        CMP_MMA(0); CMP_LOAD(0, 3); CMP_MMA(1); CMP_LOAD(1, 4); CMP_MMA(2); CMP_LOAD(2, 5);
        CMP_MMA(0); CMP_LOAD(0, 6); CMP_MMA(1); CMP_LOAD(1, 7); CMP_MMA(2); CMP_MMA(0); CMP_MMA(1);
#undef CMP_LOAD
#undef CMP_MMA
        TS(F.lds, 36);
#pragma unroll
        for (int ct = 0; ct < 8; ++ct)
#pragma unroll
            for (int i = 0; i < 4; ++i) PART[(wave * 16 + 4 * fq + i) * 128 + 16 * ct + fr] = acc[ct][i];
        __syncthreads();
        TS(F.lds, 37);
        { const int e0 = 4 * tid; f32x4 sum = *(const LAS f32x4*)(PART + e0);
#pragma unroll
          for (int w = 1; w < 8; ++w) sum += *(const LAS f32x4*)(PART + w * 2048 + e0);
          const int hr = e0 >> 7, hc = e0 & 127;
#pragma unroll
          for (int i = 0; i < 4; ++i) { const float xh = sum[i]; const float y2 = 2.0f * 0.7978845608028654f * (xh + 0.044715f * xh * xh * xh); H[hr * 132 + hc + i] = xh * __builtin_amdgcn_rcpf(1.0f + __builtin_amdgcn_exp2f(y2 * -LOG2E)); } }
        __syncthreads();
        if (wave < 4) { f32x4 a2 = {0.f, 0.f, 0.f, 0.f};
#pragma unroll
            for (int s = 0; s < 4; ++s) { const LAS float* hp = H + fr * 132 + 32 * s + 8 * fq; const float* wp = W2 + (size_t)(32 * s + 8 * fq) * 64 + 16 * wave + fr;
                v4u aw; aw.x = pk2(hp[0], hp[1]); aw.y = pk2(hp[2], hp[3]); aw.z = pk2(hp[4], hp[5]); aw.w = pk2(hp[6], hp[7]);
                v4u bw; bw.x = pk2(wp[0], wp[64]); bw.y = pk2(wp[128], wp[192]); bw.z = pk2(wp[256], wp[320]); bw.w = pk2(wp[384], wp[448]);
                a2 = __builtin_amdgcn_mfma_f32_16x16x32_bf16(__builtin_bit_cast(bf16x8, aw), __builtin_bit_cast(bf16x8, bw), a2, 0, 0, 0); }
#pragma unroll
            for (int i = 0; i < 4; ++i) O2[(4 * fq + i) * 68 + 16 * wave + fr] = a2[i]; }
        __syncthreads();
        if (wave == 0) { const int row = lane >> 2, c0 = (lane & 3) * 16; float v[16]; float ss = 0.f;
#pragma unroll
            for (int e = 0; e < 16; ++e) { v[e] = O2[row * 68 + c0 + e]; ss += v[e] * v[e]; }
            ss += __shfl_xor(ss, 1); ss += __shfl_xor(ss, 2);
            const float rs = __builtin_amdgcn_rsqf(ss * (1.f / 64.f) + EPS); const float* gn = FIN(I_NKCN) + L * 64 + c0;
            const int n = n0 + row; const bool dead = n >= 127;
            v4u w0, w1; float o[16];
#pragma unroll
            for (int e = 0; e < 16; ++e) { o[e] = kv ? v[e] : v[e] * rs * gn[e]; if (dead) o[e] = 0.f; }
            w0.x = pk2(o[0], o[1]); w0.y = pk2(o[2], o[3]); w0.z = pk2(o[4], o[5]); w0.w = pk2(o[6], o[7]); w1.x = pk2(o[8], o[9]); w1.y = pk2(o[10], o[11]); w1.z = pk2(o[12], o[13]); w1.w = pk2(o[14], o[15]);
            const int tl = n >> 6, rr = n & 63;
            if (kv) { bf16* dstp = F_VC + (size_t)(b * 2 + tl) * 4096 + vimg_off(rr, c0); *(v4u*)dstp = w0; *(v4u*)(dstp + 8) = w1; }
            else { bf16* dstp = F_KC + (size_t)(b * 2 + tl) * 4096; *(v4u*)(dstp + kimg_off(rr, c0)) = w0; *(v4u*)(dstp + kimg_off(rr, c0 + 8)) = w1; } }
        __syncthreads();
    }
    if (cmpc != nullptr) { asm volatile("s_waitcnt vmcnt(0)" ::: "memory"); __syncthreads(); if (F.tid == 0) (void)xb_add(cmpc + 64 * ((F.vcu >> 4) & 1), 1u); }
    __syncthreads();
    { const float* pw = FIN(I_POOLW) + (size_t)L * 16384;
      for (int i = tid; i < 16384; i += NWAVES * 64) { const int g = i >> 12, c = (i >> 6) & 63, e = i & 63; PWt[(g * 64 + e) * 72 + c] = (bf16)(pk2(pw[i], 0.f) & 0xffffu); } }
    __syncthreads();
    f32x4 g0, g1, g2, cw0, cw1, cw2;
    { const float* nq = FIN(I_NQN) + L * 64; const float* nks = FIN(I_NKSN) + L * 64; const float* nkw = FIN(I_NKWN) + L * 64; const float* sk = FIN(I_SKN) + L * 64; const float* sq = FIN(I_SQN) + L * 64;
      g0 = (f32x4){0.f, 0.f, 0.f, 0.f}; (void)nq;
      g1 = (f32x4){0.f, 0.f, 0.f, 0.f}; (void)nks; (void)nkw; (void)sk;
      g2 = (f32x4){0.f, 0.f, 0.f, 0.f}; (void)sq;
      const float* cw = FIN(I_CONVW) + L * 768; cw0 = *(const f32x4*)(cw + ch); cw1 = *(const f32x4*)(cw + 256 + ch); cw2 = *(const f32x4*)(cw + 512 + ch);
      }
    const int grp = lane >> 4, win = 2 << grp;
    const int gw = F.vcu * NWAVES + F.wave, NGW = F.G * NWAVES;
    TS(F.lds, 30);
    for (int blk = gw; blk < M / 16; blk += NGW) {
        const int m0 = blk * 16, t0 = m0 & (T - 1);
        const bf16* u0 = F_U + (size_t)m0 * NU;
        TS(F.lds, 31);
        TS(F.lds, 32);
        { f32x4 zm1 = {0.f, 0.f, 0.f, 0.f}, zm2 = {0.f, 0.f, 0.f, 0.f};
          if (t0 > 0) { zm1 = ld4bf(u0 - NU + UBC + ch) * ld4bf(u0 - NU + UBX + ch); zm2 = ld4bf(u0 - 2 * NU + UBC + ch) * ld4bf(u0 - 2 * NU + UBX + ch); }
#pragma nounroll
          for (int i8 = 0; i8 < 16; i8 += 8) { u32x2 raw[8][3]; f32x4 ob[8]; float ss[8];
#pragma unroll
              for (int i = 0; i < 8; ++i)
#pragma unroll
                  for (int k = 0; k < 3; ++k) raw[i][k] = *(const u32x2*)(u0 + (size_t)(i8 + i) * NU + UBB + 256 * k + ch);
#pragma unroll
              for (int i = 0; i < 8; ++i) { const f32x4 z0 = up4(raw[i][1]) * up4(raw[i][2]);
                  ob[i] = up4(raw[i][0]) * (cw2 * z0 + cw1 * zm1 + cw0 * zm2); zm2 = zm1; zm1 = z0; ss[i] = sq4(ob[i]); }
#pragma unroll
              for (int i = 0; i < 8; ++i) ss[i] = wave_sum(ss[i]);
#pragma unroll
              for (int i = 0; i < 8; ++i) st4bf(F_YN + (size_t)(m0 + i8 + i) * D + 256 + ch, ob[i] * (__builtin_amdgcn_rsqf(ss[i] * (1.f / 256.f) + EPS))); } }
        TS(F.lds, 33);
        { u32x2 raw[32];
#pragma unroll
          for (int i = 0; i < 16; ++i) { raw[i] = (u32x2){0u, 0u}; if (t0 > 0) raw[i] = *(const u32x2*)(u0 - (size_t)(16 - i) * NU + UDV + ch); }
#pragma unroll
          for (int i = 0; i < 16; ++i) raw[16 + i] = *(const u32x2*)(u0 + (size_t)i * NU + UDV + ch);
          f32x4 S2 = up4(raw[15]) + up4(raw[14]), S4 = S2 + up4(raw[13]) + up4(raw[12]), S8 = S4, S16;
#pragma unroll
          for (int i = 8; i < 12; ++i) S8 += up4(raw[i]);
          S16 = S8;
#pragma unroll
          for (int i = 0; i < 8; ++i) S16 += up4(raw[i]);
#pragma unroll
          for (int ti = 0; ti < 16; ++ti) { const f32x4 v = up4(raw[16 + ti]);
              S2 += v - up4(raw[16 + ti - 2]); S4 += v - up4(raw[16 + ti - 4]); S8 += v - up4(raw[16 + ti - 8]); S16 += v - up4(raw[ti]);
              const f32x4 Sw = grp == 0 ? S2 : (grp == 1 ? S4 : (grp == 2 ? S8 : S16));
              const int cn = (t0 + ti + 1) < win ? (t0 + ti + 1) : win;
              const f32x4 dd = Sw * __builtin_amdgcn_rcpf((float)cn) - v;
              u32x2 w; w.x = pk2(dd[0], dd[1]); w.y = pk2(dd[2], dd[3]); *(LAS u32x2*)(DTb + ti * 264 + ch) = w; }
          const int fr = lane & 15, fq = lane >> 4;
          const float* psp = FIN(I_POOLS) + L * 256 + fr;
          f32x4 acc[4][4];
#pragma unroll
          for (int g = 0; g < 4; ++g) { const bf16x8 a0 = *(const LAS bf16x8*)(DTb + fr * 264 + g * 64 + 8 * fq), a1 = *(const LAS bf16x8*)(DTb + fr * 264 + g * 64 + 32 + 8 * fq);
#pragma unroll
              for (int cb = 0; cb < 4; ++cb) { const LAS bf16* bp = PWt + (g * 64 + 16 * cb + fr) * 72 + 8 * fq;
                  f32x4 c = {0.f, 0.f, 0.f, 0.f};
                  c = __builtin_amdgcn_mfma_f32_16x16x32_bf16(a0, *(const LAS bf16x8*)bp, c, 0, 0, 0);
                  c = __builtin_amdgcn_mfma_f32_16x16x32_bf16(a1, *(const LAS bf16x8*)(bp + 32), c, 0, 0, 0);
                  acc[g][cb] = c * psp[g * 64 + 16 * cb]; } }
          float ss[4];
#pragma unroll
          for (int i = 0; i < 4; ++i) { float q = 0.f;
#pragma unroll
              for (int g = 0; g < 4; ++g)
#pragma unroll
                  for (int cb = 0; cb < 4; ++cb) q += acc[g][cb][i] * acc[g][cb][i];
              ss[i] = __builtin_amdgcn_rsqf(row16_sum(q) * (1.f / 256.f) + EPS); }
          asm volatile("s_waitcnt lgkmcnt(0)" ::: "memory");
#pragma unroll
          for (int g = 0; g < 4; ++g)
#pragma unroll
              for (int cb = 0; cb < 4; ++cb)
#pragma unroll
                  for (int i = 0; i < 4; ++i) DTb[(4 * fq + i) * 264 + g * 64 + 16 * cb + fr] = (bf16)(pk2(acc[g][cb][i] * ss[i], 0.f) & 0xffffu);
#pragma unroll
          for (int ti = 0; ti < 16; ++ti) *(u32x2*)(F_YN + (size_t)(m0 + ti) * D + 768 + ch) = *(const LAS u32x2*)(DTb + ti * 264 + ch); }
        TS(F.lds, 34);
    }
    __syncthreads();
    TS(F.lds, 35);

}

#ifndef PROBE_ATT
#define PROBE_ATT 0
#endif
#define TSA(l_, k_) do { if (PROBE_TS >= 20 && PROBE_TS < 80 && !(PROBE_TS >= 30 && PROBE_TS < 60)) TS(l_, k_); } while (0)
namespace att {
constexpr int STG = 32768;
constexpr int L_STG = 0, L_IA = 65536, IAB = 4 * 64 * 33 * 4, L_IB = L_IA + IAB, L_SC = L_IB + IAB, L_SEL = L_SC + 64 * 36 * 4, L_UNI = L_SEL + 256, L_WSF = L_UNI + 256, L_FAC = L_WSF + NWAVES * 256, L_END = L_FAC + 4 * 64 * 2 * 4;
static_assert(L_END <= MISC_OFF, "attention LDS map");
constexpr int OSTP = 264;
#define ATT_BAR() asm volatile("s_waitcnt vmcnt(0) lgkmcnt(0)\n\ts_barrier" ::: "memory")
#define ATT_LBAR() asm volatile("s_waitcnt lgkmcnt(0)\n\ts_barrier" ::: "memory")
__device__ __forceinline__ int crow(int r, int hi) { return (r & 3) + 8 * (r >> 2) + 4 * hi; }
__device__ __forceinline__ float pair_max(float v) { auto rr = __builtin_amdgcn_permlane32_swap(__float_as_uint(v), __float_as_uint(v), false, false); return fmaxf(__uint_as_float(rr[0]), __uint_as_float(rr[1])); }
__device__ __forceinline__ float pair_sum(float v) { auto rr = __builtin_amdgcn_permlane32_swap(__float_as_uint(v), __float_as_uint(v), false, false); return __uint_as_float(rr[0]) + __uint_as_float(rr[1]); }
__device__ __forceinline__ void dma_tile(const bf16* tile, LAS unsigned char* slot, int wave, int lane) {
    __builtin_amdgcn_global_load_lds((const unsigned*)(tile + wave * 512 + lane * 8), (LAS unsigned*)(slot + wave * 1024), 16, 0, 0); }
__device__ __forceinline__ void qk_tile(f32x16& p0, f32x16& p1, const LAS unsigned char* kslot, const bf16x8 (&qr)[4], const f32x16& cin, int r32, int hi) {
    const LAS unsigned char* kp = kslot + hi * 1024 + r32 * 16;
#pragma unroll
    for (int d0 = 0; d0 < 4; ++d0) { const bf16x8 b0 = *(const LAS bf16x8*)(kp + d0 * 2048), b1 = *(const LAS bf16x8*)(kp + d0 * 2048 + 512);
        if (d0 == 0) { p0 = __builtin_amdgcn_mfma_f32_32x32x16_bf16(b0, qr[0], cin, 0, 0, 0); p1 = __builtin_amdgcn_mfma_f32_32x32x16_bf16(b1, qr[0], cin, 0, 0, 0); }
        else { p0 = __builtin_amdgcn_mfma_f32_32x32x16_bf16(b0, qr[d0], p0, 0, 0, 0); p1 = __builtin_amdgcn_mfma_f32_32x32x16_bf16(b1, qr[d0], p1, 0, 0, 0); } }
}
__device__ __forceinline__ v4i16_t vtr(const LAS unsigned char* p) { return __builtin_amdgcn_ds_read_tr16_b64_v4i16((LAS v4i16_t*)p); }
__device__ __forceinline__ void pv_tile(f32x16& o0, f32x16& o1, const LAS unsigned char* vslot, const v4u (&pw)[4], int lane, int hi) {
    const unsigned vb = (unsigned)(uintptr_t)(vslot + ((lane >> 4) & 1) * 32 + (lane & 3) * 8 + (4 * hi + ((lane & 15) >> 2)) * 64);
#define PV_HALF(o_, OFF) do { v4i16_t a0[4], a1[4]; \
        _Pragma("unroll") for (int s_ = 0; s_ < 4; ++s_) { \
            asm volatile("ds_read_b64_tr_b16 %0, %1 offset:%c2" : "=&v"(a0[s_]) : "v"(vb), "i"((OFF) + s_ * 1024) : "memory"); \
            asm volatile("ds_read_b64_tr_b16 %0, %1 offset:%c2" : "=&v"(a1[s_]) : "v"(vb), "i"((OFF) + s_ * 1024 + 512) : "memory"); } \
        PV_STEP(o_, 0, 6); PV_STEP(o_, 1, 4); PV_STEP(o_, 2, 2); PV_STEP(o_, 3, 0); } while (0)
#define PV_STEP(o_, s_, N) do { asm volatile("s_waitcnt lgkmcnt(" #N ")" : "+v"(a0[s_]), "+v"(a1[s_]) :: "memory"); \
        const bf16x8 v0 = (bf16x8){a0[s_][0], a0[s_][1], a0[s_][2], a0[s_][3], a1[s_][0], a1[s_][1], a1[s_][2], a1[s_][3]}; \
        o_ = __builtin_amdgcn_mfma_f32_32x32x16_bf16(__builtin_bit_cast(bf16x8, pw[s_]), v0, o_, 0, 0, 0); } while (0)
    PV_HALF(o0, 0); PV_HALF(o1, 4096);
#undef PV_STEP
#undef PV_HALF
}
__device__ __forceinline__ void pack_p(v4u (&pw)[4], const f32x16& p0, const f32x16& p1) {
    pw[0] = (v4u){pk2(p0[0], p0[1]), pk2(p0[2], p0[3]), pk2(p0[4], p0[5]), pk2(p0[6], p0[7])};
    pw[1] = (v4u){pk2(p0[8], p0[9]), pk2(p0[10], p0[11]), pk2(p0[12], p0[13]), pk2(p0[14], p0[15])};
    pw[2] = (v4u){pk2(p1[0], p1[1]), pk2(p1[2], p1[3]), pk2(p1[4], p1[5]), pk2(p1[6], p1[7])};
    pw[3] = (v4u){pk2(p1[8], p1[9]), pk2(p1[10], p1[11]), pk2(p1[12], p1[13]), pk2(p1[14], p1[15])};
}
#define MX3(a, b, c) __builtin_fmaxf(__builtin_fmaxf((a), (b)), (c))
__device__ __forceinline__ void softmax_step(float& m, f32x16& negm, float& l, f32x16& o0, f32x16& o1, f32x16& p0, f32x16& p1, v4u (&pw)[4], LAS float* wsf, int r32, int hi) {
    float xa = MX3(p0[0], p0[1], p1[0]), xb = MX3(p0[2], p0[3], p1[1]); xa = MX3(xa, p1[2], p1[3]);
#pragma unroll
    for (int r = 4; r < 16; r += 4) { xa = MX3(xa, p0[r], p0[r + 1]); xb = MX3(xb, p0[r + 2], p0[r + 3]); xa = MX3(xa, p1[r], p1[r + 1]); xb = MX3(xb, p1[r + 2], p1[r + 3]); }
    const float mt = pair_max(__builtin_fmaxf(xa, xb));
    if (__any(mt > 8.0f)) {
        const float dl = __builtin_fmaxf(mt, 0.f), al = __builtin_amdgcn_exp2f(-dl); l *= al; m += dl;
        if (hi == 0) wsf[r32] = al;
        f32x4 a[4];
#pragma unroll
        for (int g = 0; g < 4; ++g) a[g] = *(const LAS f32x4*)(wsf + 8 * g + 4 * hi);
#pragma unroll
        for (int r = 0; r < 16; ++r) { o0[r] *= a[r >> 2][r & 3]; o1[r] *= a[r >> 2][r & 3]; p0[r] -= dl; p1[r] -= dl; negm[r] = -m; }
    }
    float rs0 = 0.f, rs1 = 0.f;
#pragma unroll
    for (int r = 0; r < 16; ++r) { p0[r] = __builtin_amdgcn_exp2f(p0[r]); p1[r] = __builtin_amdgcn_exp2f(p1[r]); rs0 += p0[r]; rs1 += p1[r]; }
    l += rs0 + rs1;
    pack_p(pw, p0, p1);
}
__device__ __forceinline__ void scale_rows(f32x16& a0, f32x16& a1, const f32x16& o0, const f32x16& o1, float fac, LAS float* wsf, int r32, int hi) {
    if (hi == 0) wsf[32 + r32] = fac;
    f32x4 f[4];
#pragma unroll
    for (int g = 0; g < 4; ++g) f[g] = *(const LAS f32x4*)(wsf + 32 + 8 * g + 4 * hi);
#pragma unroll
    for (int r = 0; r < 16; ++r) { a0[r] += o0[r] * f[r >> 2][r & 3]; a1[r] += o1[r] * f[r >> 2][r & 3]; }
}
__device__ __forceinline__ void load_q_normed(bf16x8 (&qr)[4], const bf16* up, const float* gn, int hi) {
    v4u raw[4];
#pragma unroll
    for (int d0 = 0; d0 < 4; ++d0) raw[d0] = *(const v4u*)(up + d0 * 16 + hi * 8);
    float ss = 0.f;
#pragma unroll
    for (int d0 = 0; d0 < 4; ++d0) { const unsigned w_[4] = {raw[d0].x, raw[d0].y, raw[d0].z, raw[d0].w};
#pragma unroll
        for (int e = 0; e < 4; ++e) { const float a = bflo(w_[e]), c = bfhi(w_[e]); ss += a * a + c * c; } }
    ss = pair_sum(ss);
    const float r = __builtin_amdgcn_rsqf(ss * (1.f / 64.f) + EPS);
#pragma unroll
    for (int d0 = 0; d0 < 4; ++d0) { const f32x4 ga = *(const f32x4*)(gn + d0 * 16 + hi * 8) * C2, gb = *(const f32x4*)(gn + d0 * 16 + hi * 8 + 4) * C2;
        const unsigned w_[4] = {raw[d0].x, raw[d0].y, raw[d0].z, raw[d0].w}; v4u o;
        o.x = pk2(bflo(w_[0]) * r * ga[0], bfhi(w_[0]) * r * ga[1]); o.y = pk2(bflo(w_[1]) * r * ga[2], bfhi(w_[1]) * r * ga[3]);
        o.z = pk2(bflo(w_[2]) * r * gb[0], bfhi(w_[2]) * r * gb[1]); o.w = pk2(bflo(w_[3]) * r * gb[2], bfhi(w_[3]) * r * gb[3]);
        qr[d0] = __builtin_bit_cast(bf16x8, o); }
}
constexpr int L_OTS = 65536;
__device__ __forceinline__ void ots_put(const f32x16& a0, const f32x16& a1, LAS unsigned char* lds, int wave, int lane) {
    LAS float* S = (LAS float*)(lds + L_OTS) + wave * 2048 + lane;
#pragma unroll
    for (int r = 0; r < 16; ++r) { S[r * 64] = a0[r]; S[(16 + r) * 64] = a1[r]; }
}
__device__ __forceinline__ void ots_get(f32x16& a0, f32x16& a1, const LAS unsigned char* lds, int wave, int lane) {
    const LAS float* S = (const LAS float*)(lds + L_OTS) + wave * 2048 + lane;
#pragma unroll
    for (int r = 0; r < 16; ++r) { a0[r] = S[r * 64]; a1[r] = S[(16 + r) * 64]; }
}
struct CmpOut { LAS float* ia; LAS float* ib; float m0, m1; };
template <int MODE>
__device__ __forceinline__ void run_branch(CmpOut& co, unsigned tiles, const bf16* Kg  , const bf16* Vg, int kvsel, unsigned selm, int tq, const bf16x8 (&qr)[4],
                                           float& m, float& l, f32x16& o0, f32x16& o1, LAS unsigned char* lds, LAS float* wsf, int wave, int lane) {
    constexpr int NKV = MODE == 2 ? 2 : 1, SLOT = 16384 * NKV, NS = 4;
    const int r32 = lane & 31, hi = lane >> 5;
    m = 0.f; l = 0.f; o0 = (f32x16){}; o1 = (f32x16){}; f32x16 negm = (f32x16){};
    unsigned remc = (unsigned)__builtin_amdgcn_readfirstlane((int)tiles), remi = remc;
    int nleft = __builtin_popcount(remc), slot_i = 0, slot_c = 0;
    ATT_LBAR();
#define ATT_ISSUE() do { const int ji = __builtin_ctz(remi); remi &= remi - 1; LAS unsigned char* st_ = lds + L_STG + slot_i * SLOT; slot_i = (slot_i + 1) & (NS - 1); \
        _Pragma("unroll") for (int g = 0; g < NKV; ++g) { dma_tile(Kg + (size_t)(g * 512 + ji) * 4096, st_ + g * 8192, wave, lane); dma_tile(Vg + (size_t)(g * 512 + ji) * 4096, st_ + NKV * 8192 + g * 8192, wave, lane); } } while (0)
#define ATT_WB(n) asm volatile("s_waitcnt vmcnt(" #n ") lgkmcnt(0)\n\ts_barrier" ::: "memory")
#pragma nounroll
    for (int k = 0; k < NS - 2; ++k) if (remi) ATT_ISSUE();
    TSA(lds, 70 + MODE);
    const bool lead = true; v4u pw[4] = {}; const LAS unsigned char* stp = lds + L_STG;
    bool havep = false;
    constexpr int W = MODE == 1 ? 512 : 128;
    const int curt = __builtin_amdgcn_readfirstlane(tq) >> 6;
#define ATT_QS(j_, st_) do { const int kb = 64 * (j_) + 4 * hi; const bool sel = MODE != 0 || ((selm >> (j_)) & 1u); \
        const bool edge = MODE == 3 || (j_) == curt || (MODE != 0 && (j_) + W / 64 == curt);     \
        f32x16 p0, p1; \
        if (MODE == 0) { f32x16 cin;     \
            _Pragma("unroll") for (int r = 0; r < 16; ++r) cin[r] = sel ? negm[r] : -INFINITY; \
            qk_tile(p0, p1, (st_) + kvsel * 8192, qr, cin, r32, hi); } \
        else qk_tile(p0, p1, (st_) + kvsel * 8192, qr, negm, r32, hi); \
        if (edge) { _Pragma("unroll") for (int r = 0; r < 16; ++r) { const int kp = kb + (r & 3) + 8 * (r >> 2); bool v0, v1; \
                if (MODE == 0) { v0 = kp <= tq; v1 = kp + 32 <= tq; } \
                else if (MODE == 3) { v0 = 16 * kp + 31 <= tq; v1 = 16 * (kp + 32) + 31 <= tq; } \
                else { v0 = kp <= tq && kp + W > tq; v1 = kp + 32 <= tq && kp + 32 + W > tq; } \
                p0[r] = v0 ? p0[r] : -INFINITY; p1[r] = v1 ? p1[r] : -INFINITY; } } \
        softmax_step(m, negm, l, o0, o1, p0, p1, pw, wsf, r32, hi); \
        if (MODE == 3) { _Pragma("unroll") for (int G = 0; G < 4; ++G) { \
                co.ia[hi + 2 * (G + 8 * (j_))] = (p0[4 * G] + p0[4 * G + 1]) + (p0[4 * G + 2] + p0[4 * G + 3]); co.ib[hi + 2 * (G + 8 * (j_))] = p0[4 * G + 3]; \
                co.ia[hi + 2 * (G + 4 + 8 * (j_))] = (p1[4 * G] + p1[4 * G + 1]) + (p1[4 * G + 2] + p1[4 * G + 3]); co.ib[hi + 2 * (G + 4 + 8 * (j_))] = p1[4 * G + 3]; } \
            if ((j_) == 0) co.m0 = m; else co.m1 = m; } } while (0)
    for (;;) {
        const int pend = (nleft - 1 < NS - 3 ? nleft - 1 : NS - 3) * NKV;
        switch (pend) { case 0: ATT_WB(0); break; case 1: ATT_WB(2); break; case 2: ATT_WB(4); break; case 3: ATT_WB(6); break; case 4: ATT_WB(8); break; default: ATT_WB(10); break; }
        if (remi) ATT_ISSUE();
        const int j = __builtin_ctz(remc); remc &= remc - 1; --nleft;
        const LAS unsigned char* st = lds + L_STG + slot_c * SLOT; slot_c = (slot_c + 1) & (NS - 1);
        if (lead) { ATT_QS(j, st); pv_tile(o0, o1, st + NKV * 8192 + kvsel * 8192, pw, lane, hi); }
        else { if (havep) pv_tile(o0, o1, stp + NKV * 8192 + kvsel * 8192, pw, lane, hi); ATT_QS(j, st); }
        stp = st; havep = true;
        TSA(lds, 60 + MODE);
        if (nleft == 0) break;
    }
    if (!lead) pv_tile(o0, o1, stp + NKV * 8192 + kvsel * 8192, pw, lane, hi);
#undef ATT_QS
#undef ATT_ISSUE
#undef ATT_WB
}
__device__ __forceinline__ void stage_norm_store(const f32x16& o0, const f32x16& o1, bf16* ynb  , LAS unsigned char* lds, int wave, int lane) {
    const int r32 = lane & 31, hi = lane >> 5, h = wave & 3, th = wave >> 2;
    LAS bf16* OST = (LAS bf16*)(lds + L_STG);
    ATT_LBAR();
#pragma unroll
    for (int r = 0; r < 16; ++r) { LAS bf16* p = OST + (32 * th + crow(r, hi)) * OSTP + h * 64 + r32;
        p[0] = (bf16)(pk2(o0[r], 0.f) & 0xffffu); p[32] = (bf16)(pk2(o1[r], 0.f) & 0xffffu); }
    ATT_LBAR();
    f32x4 vv[8]; float ssn[8];
#pragma unroll
    for (int i = 0; i < 8; ++i) { const u32x2 w = *(const LAS u32x2*)(OST + (8 * wave + i) * OSTP + 4 * lane); vv[i] = (f32x4){bflo(w.x), bfhi(w.x), bflo(w.y), bfhi(w.y)}; ssn[i] = sq4(vv[i]); }
#pragma unroll
    for (int i = 0; i < 8; ++i) ssn[i] = wave_sum(ssn[i]);
#pragma unroll
    for (int i = 0; i < 8; ++i) st4bf(ynb + (size_t)(8 * wave + i) * D + 4 * lane, vv[i] * __builtin_amdgcn_rsqf(ssn[i] * (1.f / 256.f) + EPS));
}
__device__ __forceinline__ void attn_unit(Frame& F, int L, int b, int qt) {
    LAS unsigned char* lds = F.lds;
    int tid = F.tid; asm volatile("" : "+v"(tid));
    const int wave = F.wave, lane = tid & 63, r32 = lane & 31, hi = lane >> 5, h = wave & 3, th = wave >> 2;
    const int t0 = qt * 64, cur = qt, qrow = 32 * th + r32, tq = t0 + qrow;
    const size_t mrow = (size_t)b * T + tq;
    LAS float* wsf = (LAS float*)(lds + L_WSF) + wave * 64;
    LAS float* IA = (LAS float*)(lds + L_IA); LAS float* IB = (LAS float*)(lds + L_IB); LAS float* SC = (LAS float*)(lds + L_SC);
    LAS unsigned* SEL = (LAS unsigned*)(lds + L_SEL); LAS unsigned* UNI = (LAS unsigned*)(lds + L_UNI);
    const size_t tb = (size_t)b * 32 * 4096;
    bf16x8 qr[4];
#pragma unroll
    for (int d0 = 0; d0 < 1; ++d0) load_q_normed(qr, F_U + mrow * NU + UQ + h * 64, FIN(I_NQN) + L * 64, hi);
    const bf16* gp = F_U + mrow * NU + UG + h * 3;
    const float g0 = __builtin_amdgcn_rcpf(1.0f + __builtin_amdgcn_exp2f(bflo((unsigned)gp[0]) * -LOG2E)), g1 = __builtin_amdgcn_rcpf(1.0f + __builtin_amdgcn_exp2f(bflo((unsigned)gp[1]) * -LOG2E)), g2 = __builtin_amdgcn_rcpf(1.0f + __builtin_amdgcn_exp2f(bflo((unsigned)gp[2]) * -LOG2E));
    float mb, lb; f32x16 ob0, ob1; CmpOut cod{nullptr, nullptr, 0.f, 0.f};
    for (int rep = 0; rep < ((PROBE_ATT & 4) ? 2 : 1); ++rep) {
        if (rep) { ATT_LBAR(); }
        if (tid == 0) UNI[0] = 0u;
        LAS float* ia = IA + (h * 64 + qrow) * 33; LAS float* ib = IB + (h * 64 + qrow) * 33;
        CmpOut co{ia, ib, 0.f, 0.f};
        run_branch<3>(co, 3u, F_KC + (size_t)b * 2 * 4096, F_VC + (size_t)b * 2 * 4096, 0, 0u, tq, qr, mb, lb, ob0, ob1, lds, wsf, wave, lane);
        TSA(lds, 20);
        const float lt = pair_sum(lb); const float inv = lt > 0.f ? 1.0f / lt : 0.f;
        f32x16 oc0 = (f32x16){}, oc1 = (f32x16){}; scale_rows(oc0, oc1, ob0, ob1, g0 * inv, wsf, r32, hi);
        if (hi == 0) { LAS float* fc = (LAS float*)(lds + L_FAC) + (h * 64 + qrow) * 2; fc[0] = __builtin_amdgcn_exp2f(co.m0 - mb) * inv; fc[1] = __builtin_amdgcn_exp2f(co.m1 - mb) * inv; }
        TSA(lds, 27);
        ATT_LBAR();
        const int q = tid >> 3, jg = tid & 7, tqq = t0 + q;
#pragma unroll
        for (int i = 0; i < 4; ++i) { const int j = 4 * jg + i; float imp = 0.f;
#pragma unroll
            for (int hh = 0; hh < 4; ++hh) { const LAS float* fc = (const LAS float*)(lds + L_FAC) + (hh * 64 + q) * 2; imp += IA[(hh * 64 + q) * 33 + j] * fc[j >> 4]; if (j > 0) imp += IB[(hh * 64 + q) * 33 + j - 1] * fc[(j - 1) >> 4]; }
            const bool forced = j == 0 || j == cur || j == cur - 1, future = j * 64 > tqq;
            SC[q * 36 + j] = forced ? 1e4f : (future ? -1.0f : imp); }
        ATT_LBAR();
        TSA(lds, 28);
        unsigned bits = 0u;
        { f32x4 sc4[8];
#pragma unroll
          for (int g = 0; g < 8; ++g) sc4[g] = *(const LAS f32x4*)(SC + q * 36 + 4 * g);
          const f32x4 mine = *(const LAS f32x4*)(SC + q * 36 + 4 * jg);
#pragma unroll
          for (int i = 0; i < 4; ++i) { const int j = 4 * jg + i; const float sj = mine[i]; int rank = 0;
#pragma unroll
              for (int k = 0; k < 32; ++k) { const float sk = sc4[k >> 2][k & 3]; rank += (sk > sj || (sk == sj && k < j)) ? 1 : 0; }
              if (rank < 8) bits |= 1u << j; } }
        TSA(lds, 29);
        bits |= __shfl_xor(bits, 1); bits |= __shfl_xor(bits, 2); bits |= __shfl_xor(bits, 4);
        if (jg == 0) { SEL[q] = bits; atomicOr((unsigned*)UNI, bits); }
        ATT_LBAR();
        ots_put(oc0, oc1, lds, wave, lane);
    }
    TSA(lds, 21);
    { const unsigned selm = SEL[qrow]; const unsigned uni = UNI[0] & ((2u << cur) - 1u);
      if (PROBE_ATT & 1) run_branch<0>(cod, uni, F_KSI + tb, F_VSI + tb, 0, selm, tq, qr, mb, lb, ob0, ob1, lds, wsf, wave, lane);
      run_branch<0>(cod, uni, F_KSI + tb, F_VSI + tb, 0, selm, tq, qr, mb, lb, ob0, ob1, lds, wsf, wave, lane);
      const float lt = pair_sum(lb); f32x16 ot0, ot1; ots_get(ot0, ot1, lds, wave, lane); scale_rows(ot0, ot1, ob0, ob1, g1 / lt, wsf, r32, hi); ots_put(ot0, ot1, lds, wave, lane); }
    TSA(lds, 22);
    { const int lo = cur >= 8 ? cur - 8 : 0; const unsigned tiles = ((2u << cur) - 1u) & ~((1u << lo) - 1u);
      if (PROBE_ATT & 2) run_branch<1>(cod, tiles, F_KWI + tb, F_VWI + tb, 0, 0u, tq, qr, mb, lb, ob0, ob1, lds, wsf, wave, lane);
      run_branch<1>(cod, tiles, F_KWI + tb, F_VWI + tb, 0, 0u, tq, qr, mb, lb, ob0, ob1, lds, wsf, wave, lane);
      const float lt = pair_sum(lb); f32x16 ot0, ot1; ots_get(ot0, ot1, lds, wave, lane); scale_rows(ot0, ot1, ob0, ob1, g2 / lt, wsf, r32, hi);
      stage_norm_store(ot0, ot1, F_YN + ((size_t)b * T + t0) * D + 0, lds, wave, lane); }
    for (int rep = 0; rep < ((PROBE_ATT & 16) ? 2 : 1); ++rep) {
#pragma unroll
        for (int d0 = 0; d0 < 1; ++d0) load_q_normed(qr, F_U + mrow * NU + UCQ + h * 64, FIN(I_SQN) + L * 64, hi);
        const int lo = cur >= 2 ? cur - 2 : 0; const unsigned tiles = ((2u << cur) - 1u) & ~((1u << lo) - 1u);
        run_branch<2>(cod, tiles, F_CKI + tb, F_CVI + tb, h >> 1, 0u, tq, qr, mb, lb, ob0, ob1, lds, wsf, wave, lane);
        TSA(lds, 25);
        const float sink2 = FIN(I_SINK)[L * 4 + h] * LOG2E;
        const float mf = fmaxf(mb, sink2), sc = __builtin_amdgcn_exp2f(mb - mf);
        const float lt = pair_sum(lb) * sc + __builtin_amdgcn_exp2f(sink2 - mf);
        f32x16 ot0 = (f32x16){}, ot1 = (f32x16){};
        scale_rows(ot0, ot1, ob0, ob1, sc / lt, wsf, r32, hi);
        stage_norm_store(ot0, ot1, F_YN + ((size_t)b * T + t0) * D + 512, lds, wave, lane);
        TSA(lds, 26);
    }
}
__device__ __forceinline__ void attn_phase(Frame& F, int L) {
    for (int w = F.vcu; w < 256; w += F.G) { const int b = w >> 4, i = w & 15;
#pragma nounroll
        for (int u2 = 0; u2 < 2; ++u2) attn_unit(F, L, b, u2 ? 31 - i : i); }
    ATT_LBAR();
}
}

__global__ void __launch_bounds__(NWAVES * 64, 2) fwd(Args args) {
    extern __shared__ __attribute__((aligned(16))) unsigned char lds[];
    Frame F;
    F.lds = (LAS unsigned char*)lds;
    F.tid = threadIdx.x; F.lane = F.tid & 63; F.wave = __builtin_amdgcn_readfirstlane(F.tid >> 6);
    F.G = gridDim.x; { const int bx = blockIdx.x; F.vcu = (F.G % 8 == 0) ? (bx % 8) * (F.G / 8) + bx / 8 : bx; }
    F.a = &args;
    unsigned char* ws = args.ws;
    volatile LAS unsigned* MISC = (volatile LAS unsigned*)(F.lds + MISC_OFF);
    if (F.tid < 64) MISC[F.tid] = 0u;
    __syncthreads();
#define GRID_BAR() do { if (fastp) { xcc_local_barrier(bar.bar, bar.x); __builtin_amdgcn_s_waitcnt(0); break; } XcdBarrier b2_ = bar; { unsigned xx_ = b2_.x; asm volatile("" : "+s"(xx_)); b2_.x = xx_; }     \
        xcd_barrier(b2_); if (PROBE_DUP & 1024) xcd_barrier(b2_); __builtin_amdgcn_s_waitcnt(0); } while (0)
    XcdBarrier bar = xcd_barrier_post((unsigned*)(ws + WS_CTL) + CW_BAR, MISC + 8);
#ifndef CMP_FLAG
#define CMP_FLAG 1
#endif
#ifndef PN_ROT
#define PN_ROT 1
#endif
    bool fastp = false; int xidx = 0;
    if (F.tid == 0) MISC[12] = xb_add(&bar.bar[XL_RANK(bar.x)], 1u);
    __syncthreads();
    const unsigned myrank = MISC[12];
    F.cid = (int)blockIdx.x;

#ifndef PH_MASK
#define PH_MASK 127
#endif
#ifndef PROBE_DUP
#define PROBE_DUP 0
#endif
    TS(F.lds, 0);
    if (PH_MASK & 1) prologue(F);
    TS(F.lds, 1);
    if (PROBE_DUP & 1) prologue(F);
    GRID_BAR(); TS(F.lds, 14);
#ifndef XCC_PARTITION
#define XCC_PARTITION 1
#endif
    if (XCC_PARTITION) {
        if (F.tid == 0) { unsigned cnt = 0u, ok = 1u, xi = 0u;
            for (unsigned j = 0; j < 16; ++j) { const unsigned c = xb_ld(&bar.bar[XB_XCNT(j)]); if (c) { if (c != 32u) ok = 0u; if (j < bar.x) ++xi; ++cnt; } }
            if (cnt != 8u || F.G != 256 || myrank >= 32u) ok = 0u;
            MISC[13] = ok; MISC[14] = xi; }
        __syncthreads();
        fastp = MISC[13] != 0u;
        if (fastp) { xidx = (int)MISC[14]; F.cid = (int)myrank * 8 + xidx; F.vcu = xidx * 32 + (int)myrank; }
#ifndef XCC_SKEW_US
#define XCC_SKEW_US 0
#endif
        if (XCC_SKEW_US > 0 && fastp && (int)MISC[14] >= 4) {
            const unsigned long long t0_ = __builtin_amdgcn_s_memrealtime(); while (__builtin_amdgcn_s_memrealtime() - t0_ < (unsigned long long)XCC_SKEW_US * 100ull) __builtin_amdgcn_s_sleep(8); }
    }
    static_assert((DN8_MASK & 0xFu) == 0xFu, "the act / u overlay assumes every FFN's act is e4m3 (a bf16 act panel does not fit a u panel)");
    constexpr long ACT_PPAD = 256L * (NU * 2 - DFF);
    for (int s = 0; s < 2 * DEPTH; ++s) {
        const int L = s >> 1, which = s & 1;
        const bool up8 = (UP8_MASK >> s) & 1u, dn8 = (DN8_MASK >> s) & 1u;
        if (PH_MASK & 2) {
            const bf16* wt = (const bf16*)((unsigned char*)F_W13T + (size_t)s * NF1 * D * 2); pg8::StaticOrder S; S.init(M, NF1, F.G, F.cid); if (PN_ROT && fastp) S.rot = (xidx * 3) % (NF1 / 256);
            if (up8) { pg8::Gemm g{(const bf16*)F_X8, wt, M, NF1, D / 2};
                if (PROBE_DUP & 128) { pg8::EpiNull EN{F_GATES}; pg8::gemm_phase<pg8::EpiNull, pg8::StaticOrder, true, true, true>(F.lds, g, S, EN); }
                if (PROBE_DUP & 256) { pg8::EpiNull EN{F_GATES}; pg8::FixedOrder<1> S2; S2.init(M, NF1, F.G, F.cid); pg8::gemm_phase<pg8::EpiNull, pg8::FixedOrder<1>, true, true, true>(F.lds, g, S2, EN); }
                if (PROBE_DUP & 512) { pg8::EpiNull EN{F_GATES}; pg8::FixedOrder<3> S2; S2.init(M, NF1, F.G, F.cid); pg8::gemm_phase<pg8::EpiNull, pg8::FixedOrder<3>, true, true, true>(F.lds, g, S2, EN); }
                if (dn8) { pg8::EpiSwiglu<true> E{(void*)F_ACT, DFF, F_SSQ, 1.0f / W8_SCALE, ACT8_SCALE, F.lds + pg8::STAGE_BYTES, 0, 0, 0, ACT_PPAD}; for (int rep = 0; rep < ((PROBE_DUP & 2) ? 2 : 1); ++rep) pg8::gemm_phase<pg8::EpiSwiglu<true>, pg8::StaticOrder, true, true, true, 1>(F.lds, g, S, E); }
                else if (((UP8_MASK & ~DN8_MASK) & 0xFu) != 0u) { pg8::EpiSwiglu<false> E{(void*)F_ACT, DFF, F_SSQ, 1.0f / W8_SCALE, 1.0f, F.lds + pg8::STAGE_BYTES, 0, 0, 0}; for (int rep = 0; rep < ((PROBE_DUP & 2) ? 2 : 1); ++rep) pg8::gemm_phase<pg8::EpiSwiglu<false>, pg8::StaticOrder, true, true, true>(F.lds, g, S, E); } }
            else { pg8::Gemm g{F_XB, wt, M, NF1, D};
                if (dn8) { if (((~UP8_MASK & DN8_MASK) & 0xFu) != 0u) { pg8::EpiSwiglu<true> E{(void*)F_ACT, DFF, F_SSQ, 1.0f, ACT8_SCALE, F.lds + pg8::STAGE_BYTES, 0, 0, 0, ACT_PPAD}; for (int rep = 0; rep < ((PROBE_DUP & 2) ? 2 : 1); ++rep) pg8::gemm_phase<pg8::EpiSwiglu<true>, pg8::StaticOrder, true, true, false, 2>(F.lds, g, S, E); } }
                else if (((~UP8_MASK & ~DN8_MASK) & 0xFu) != 0u) { pg8::EpiSwiglu<false> E{(void*)F_ACT, DFF, F_SSQ, 1.0f, 1.0f, F.lds + pg8::STAGE_BYTES, 0, 0, 0}; for (int rep = 0; rep < ((PROBE_DUP & 2) ? 2 : 1); ++rep) pg8::gemm_phase<pg8::EpiSwiglu<false>, pg8::StaticOrder, true, true, false>(F.lds, g, S, E); } }
        }
        TS(F.lds, 2); GRID_BAR(); TS(F.lds, 3);
        if (PH_MASK & 4) {
            const bf16* wt = (const bf16*)((unsigned char*)F_W2T + (size_t)s * D * DFF * 2); pg8::StaticOrder S; S.init(M, D, F.G, F.cid); if (PN_ROT && fastp) S.rot = xidx & 3;
            const int last = (s + 1 == 2 * DEPTH) ? 1 : 0, w8 = ((s & 1) && !last && ((UP8_MASK >> (s + 1)) & 1u)) ? 1 : 0;
            if (dn8) { if (DN8_MASK & 0xFu) { pg8::Gemm g{F_ACT, wt, M, D, DFF / 2, ACT_PPAD}; pg8::EpiRes E{F_XB, F_SSQ, 1, F_X8, FOUT, w8, last}; pg8::gemm_phase<pg8::EpiRes, pg8::StaticOrder, true, true, true, 3>(F.lds, g, S, E); } }
            else if ((~DN8_MASK) & 0xFu) { pg8::Gemm g{F_ACT, wt, M, D, DFF}; pg8::EpiRes E{F_XB, F_SSQ, 0, F_X8, FOUT, w8, last}; pg8::gemm_phase<pg8::EpiRes, pg8::StaticOrder, true, true, false, 4>(F.lds, g, S, E); }
        }
        TS(F.lds, 4); if (s + 1 < 2 * DEPTH) GRID_BAR(); TS(F.lds, 5);
        if (which == 0) {
            if (PH_MASK & 8) {
                pg8::Gemm g{F_XB, F_WINT + (size_t)L * NU * D, M, NU, D}; pg8::StaticOrder S; S.init(M, NU, F.G, F.cid); if (PN_ROT && fastp) S.rot = xidx;
                pg8::EpiScaleBf16 E{F_U, NU, F_SSQ, F.lds + pg8::STAGE_BYTES, 0, 0, 0, F_KSI, F_KWI, F_CKI, FIN(I_NKSN) + L * 64, FIN(I_NKWN) + L * 64, FIN(I_SKN) + L * 64, (LAS float*)(F.lds + pg8::STAGE_BYTES + 8192), F_VSI, F_VWI, F_CVI};
                for (int rep = 0; rep < ((PROBE_DUP & 8) ? 2 : 1); ++rep) pg8::gemm_phase<pg8::EpiScaleBf16, pg8::StaticOrder, true, true, false, 5>(F.lds, g, S, E);
            }
            TS(F.lds, 6); GRID_BAR(); TS(F.lds, 7);
            if (PH_MASK & 16) prep_phase(F, L, (CMP_FLAG && fastp) ? &bar.bar[XL_CMP(bar.x)] : (unsigned*)nullptr);
            TS(F.lds, 8);
            if (CMP_FLAG && fastp) {
                if (F.tid == 0) XB_SPIN(xb_ld(&bar.bar[XL_CMP(bar.x)] + 64 * ((F.vcu >> 4) & 1)) < 16u * (unsigned)(L + 1), bar.bar);
                __syncthreads(); __builtin_amdgcn_s_waitcnt(0); }
            else GRID_BAR();
            TS(F.lds, 9);
            if (PH_MASK & 32) att::attn_phase(F, L);
            if (PROBE_DUP & 32) att::attn_phase(F, L);
            TS(F.lds, 10); GRID_BAR(); TS(F.lds, 11);
            if (PH_MASK & 64) {
                pg8::Gemm g{F_YN, F_WOUTT + (size_t)L * D * D, M, D, D}; pg8::StaticOrder S; S.init(M, D, F.G, F.cid); if (PN_ROT && fastp) S.rot = xidx & 3;
                pg8::EpiRes E{F_XB, F_SSQ, 2, F_X8, FOUT, (int)((UP8_MASK >> (2 * L + 1)) & 1u), 0};
                pg8::gemm_phase<pg8::EpiRes, pg8::StaticOrder, true, true, false, 6>(F.lds, g, S, E);
            }
            TS(F.lds, 12); GRID_BAR(); TS(F.lds, 13);
        }
    }
    if (PROBE_TS && blockIdx.x == 0 && threadIdx.x == 0) {
        volatile LAS unsigned* m_ = (volatile LAS unsigned*)(F.lds + 163648); const unsigned long long t0_ = __builtin_amdgcn_s_memrealtime(), d_ = (unsigned long long)m_[1] * TS_AMP;
        while (__builtin_amdgcn_s_memrealtime() - t0_ < d_) __builtin_amdgcn_s_sleep(8); }
}

extern "C" void kernel_launch(void* const* d_in, const int* in_sizes, int n_in, void* d_out, int out_size, void* d_ws, size_t ws_size, hipStream_t stream) {
    static int grid = 0;
    if (grid == 0) {
        if (n_in != 29 || in_sizes[0] != M * D || out_size != M * D || ws_size < WS_END) { fprintf(stderr, "kernel_launch: unexpected shapes (n_in %d, in0 %d, out %d, ws %zu); nothing launched\n", n_in, n_in > 0 ? in_sizes[0] : -1, out_size, ws_size); grid = -1; return; }
        int dev = 0, cus = 0, per_cu = 0;
        if (hipGetDevice(&dev) != hipSuccess || hipDeviceGetAttribute(&cus, hipDeviceAttributeMultiprocessorCount, dev) != hipSuccess) { grid = -1; return; }
        if (hipFuncSetAttribute((const void*)fwd, hipFuncAttributeMaxDynamicSharedMemorySize, LDS_BYTES) != hipSuccess) { fprintf(stderr, "kernel_launch: hipFuncSetAttribute failed\n"); grid = -1; return; }
        if (hipOccupancyMaxActiveBlocksPerMultiprocessor(&per_cu, (const void*)fwd, NWAVES * 64, LDS_BYTES) != hipSuccess || per_cu < 1) fprintf(stderr, "kernel_launch: occupancy query says %d\n", per_cu);
        (void)hipGetLastError();
        grid = cus;
    }
    if (grid < 0) return;
    if (hipMemsetAsync((char*)d_ws + WS_CTL, 0, CTL_ZERO_BYTES, stream) != hipSuccess) return;
    Args a{};
    for (int i = 0; i < 29; ++i) a.in[i] = (const float*)d_in[i];
    a.out = (float*)d_out; a.ws = (unsigned char*)d_ws;
    hipLaunchKernelGGL(fwd, dim3(grid), dim3(NWAVES * 64), LDS_BYTES, stream, a);
}
```
